# Optimizing an MI355X kernel written in HIP

```python
import jax, jax.numpy as jnp
from jax import lax
import numpy as np

D_MODEL = 1024
BATCH = 2
SEQ = 8192
DEPTH = 2

N_A_LAYERS = DEPTH // 2
N_B_LAYERS = DEPTH - N_A_LAYERS
D_FF = 2816
RMS_EPS = 1e-6
S5_GROUP = 16
S5_GROUPS = D_MODEL // S5_GROUP
S5_STATE = 64
S5_DT_MIN = 1e-3
S5_DT_MAX = 1e-1
N_HEADS = 8
HEAD_DIM = D_MODEL // N_HEADS
N_KV_HEADS = 2
KV_GROUP = N_HEADS // N_KV_HEADS
ROPE_DIM = HEAD_DIM // 4
ROPE_THETA = 500000.0
MOBA_BLOCK = 256
MOBA_TOPK = 3
Q_BLOCK = 64
NEG_INF = -1e30

kernel_name = "yoco_s5_moba_macaron"


def rmsnorm(x, g):
    xf = x.astype(jnp.float32)
    y = xf * lax.rsqrt(jnp.mean(xf * xf, axis=-1, keepdims=True) + RMS_EPS)
    return (y * g.astype(jnp.float32)).astype(x.dtype)


def swiglu_ffn(h, w_in, w_out):
    gate, up = jnp.split(h @ w_in, 2, axis=-1)
    return (jax.nn.silu(gate) * up) @ w_out


def partial_rope(x):
    s = x.shape[1]
    pos = jnp.arange(s, dtype=jnp.float32)
    inv_freq = ROPE_THETA ** (-jnp.arange(0, ROPE_DIM, 2, dtype=jnp.float32) / ROPE_DIM)
    ang = pos[:, None] * inv_freq[None, :]
    cos = jnp.cos(ang)[None, :, None, :]
    sin = jnp.sin(ang)[None, :, None, :]
    xr = x[..., :ROPE_DIM].astype(jnp.float32)
    x1, x2 = xr[..., :ROPE_DIM // 2], xr[..., ROPE_DIM // 2:]
    rot = jnp.concatenate([x1 * cos - x2 * sin, x2 * cos + x1 * sin], axis=-1).astype(x.dtype)
    return jnp.concatenate([rot, x[..., ROPE_DIM:]], axis=-1)


def s5_mixer(u, a_re, a_im, log_step, b_re, b_im, c_re, c_im, d_skip, w_glu):
    f32 = jnp.float32
    bsz, s, _ = u.shape
    uf = u.astype(f32).reshape(bsz, s, S5_GROUPS, S5_GROUP)
    dt = jnp.exp(log_step.astype(f32))[:, None]
    lr, li = a_re.astype(f32), a_im.astype(f32)
    mag = jnp.exp(lr * dt)
    abar_re = mag * jnp.cos(li * dt)
    abar_im = mag * jnp.sin(li * dt)
    nr, ni = abar_re - 1.0, abar_im
    den = lr * lr + li * li
    coef_re = (nr * lr + ni * li) / den
    coef_im = (ni * lr - nr * li) / den
    bu_re = jnp.einsum('bsgc,gpc->bsgp', uf, b_re.astype(f32))
    bu_im = jnp.einsum('bsgc,gpc->bsgp', uf, b_im.astype(f32))
    x_re = coef_re * bu_re - coef_im * bu_im
    x_im = coef_re * bu_im + coef_im * bu_re
    a_re_t = jnp.broadcast_to(abar_re, (1, s) + abar_re.shape)
    a_im_t = jnp.broadcast_to(abar_im, (1, s) + abar_im.shape)

    def combine(left, right):
        ar1, ai1, br1, bi1 = left
        ar2, ai2, br2, bi2 = right
        return (ar2 * ar1 - ai2 * ai1,
                ar2 * ai1 + ai2 * ar1,
                ar2 * br1 - ai2 * bi1 + br2,
                ar2 * bi1 + ai2 * br1 + bi2)

    _, _, h_re, h_im = lax.associative_scan(combine, (a_re_t, a_im_t, x_re, x_im), axis=1)
    y = (jnp.einsum('bsgp,gcp->bsgc', h_re, c_re.astype(f32))
         - jnp.einsum('bsgp,gcp->bsgc', h_im, c_im.astype(f32)))
    y = y.reshape(bsz, s, D_MODEL) + d_skip.astype(f32) * u.astype(f32)
    y = jax.nn.gelu(y).astype(u.dtype)
    val, gate = jnp.split(y @ w_glu, 2, axis=-1)
    return val * jax.nn.sigmoid(gate)


def shared_kv(x, g, w_k, w_v):
    h = rmsnorm(x, g)
    bsz, s, _ = x.shape
    k = partial_rope((h @ w_k).reshape(bsz, s, N_KV_HEADS, HEAD_DIM))
    v = (h @ w_v).reshape(bsz, s, N_KV_HEADS, HEAD_DIM)
    n_blk = -(-s // MOBA_BLOCK)
    pad = n_blk * MOBA_BLOCK - s
    k = jnp.pad(k, ((0, 0), (0, pad), (0, 0), (0, 0)))
    v = jnp.pad(v, ((0, 0), (0, pad), (0, 0), (0, 0)))
    k_blocks = k.reshape(bsz, n_blk, MOBA_BLOCK, N_KV_HEADS, HEAD_DIM).transpose(0, 3, 1, 2, 4)
    v_blocks = v.reshape(bsz, n_blk, MOBA_BLOCK, N_KV_HEADS, HEAD_DIM).transpose(0, 3, 1, 2, 4)
    k_mean = jnp.mean(k_blocks.astype(jnp.float32), axis=3).astype(k.dtype)
    return k_blocks, v_blocks, k_mean


def moba_mixer(h, w_q, w_o, k_blocks, v_blocks, k_mean):
    bsz, s, _ = h.shape
    n_blk = k_blocks.shape[2]
    top_k = min(MOBA_TOPK, n_blk)
    n_qblk = s // Q_BLOCK
    q = partial_rope((h @ w_q).reshape(bsz, s, N_HEADS, HEAD_DIM)) * (HEAD_DIM ** -0.5)
    q = q.reshape(bsz, n_qblk, Q_BLOCK, N_KV_HEADS, KV_GROUP, HEAD_DIM).transpose(1, 0, 3, 4, 2, 5)
    b_idx = jnp.arange(bsz)[:, None, None, None, None]
    h_idx = jnp.arange(N_KV_HEADS)[None, :, None, None, None]
    key_off = jnp.arange(MOBA_BLOCK)
    blk_ids = jnp.arange(n_blk)
    sel_slot = jnp.arange(top_k)

    def attend_block(args):
        qb, i = args
        q_pos = i * Q_BLOCK + jnp.arange(Q_BLOCK)
        own = (i * Q_BLOCK) // MOBA_BLOCK
        k_own = lax.dynamic_index_in_dim(k_blocks, own, axis=2, keepdims=False)
        v_own = lax.dynamic_index_in_dim(v_blocks, own, axis=2, keepdims=False)
        s_own = jnp.einsum('bhgqd,bhkd->bhgqk', qb, k_own).astype(jnp.float32)
        causal = (own * MOBA_BLOCK + key_off)[None, :] <= q_pos[:, None]
        s_own = jnp.where(causal, s_own, NEG_INF)
        gate = jnp.einsum('bhgqd,bhnd->bhgqn', qb, k_mean).astype(jnp.float32)
        gate = jnp.where(blk_ids < own, gate, NEG_INF)
        _, idx = lax.top_k(gate, top_k)
        k_sel = k_blocks[b_idx, h_idx, idx]
        v_sel = v_blocks[b_idx, h_idx, idx]
        s_sel = jnp.einsum('bhgqd,bhgqjkd->bhgqjk', qb, k_sel).astype(jnp.float32)
        s_sel = jnp.where((sel_slot < own)[:, None], s_sel, NEG_INF)
        scores = jnp.concatenate(
            [s_own, s_sel.reshape(s_sel.shape[:4] + (top_k * MOBA_BLOCK,))], axis=-1)
        p = jax.nn.softmax(scores, axis=-1).astype(v_blocks.dtype)
        p_own = p[..., :MOBA_BLOCK]
        p_sel = p[..., MOBA_BLOCK:].reshape(s_sel.shape)
        return (jnp.einsum('bhgqk,bhkd->bhgqd', p_own, v_own)
                + jnp.einsum('bhgqjk,bhgqjkd->bhgqd', p_sel, v_sel))

    out = lax.map(attend_block, (q, jnp.arange(n_qblk)))
    out = out.transpose(1, 0, 4, 2, 3, 5).reshape(bsz, s, N_HEADS * HEAD_DIM)
    return out @ w_o


def setup_inputs(seed: int = 0) -> dict:
    key = jax.random.key(seed)
    ks = jax.random.split(key, 24)
    f32 = jnp.float32

    def nrm(k, shape, scale):
        return jax.random.normal(k, shape, f32) * scale

    x = jax.random.normal(ks[0], (BATCH, SEQ, D_MODEL), f32)
    norm_g = 1.0 + nrm(ks[1], (DEPTH, 3, D_MODEL), 0.02)
    ffn_w_in = nrm(ks[2], (DEPTH, 2, D_MODEL, 2 * D_FF), D_MODEL ** -0.5)
    ffn_w_out = nrm(ks[3], (DEPTH, 2, D_FF, D_MODEL), D_FF ** -0.5)
    n_idx = jnp.arange(S5_STATE, dtype=f32)
    s5_a_re = -0.5 + nrm(ks[4], (N_A_LAYERS, S5_GROUPS, S5_STATE), 0.01)
    s5_a_im = jnp.pi * n_idx + nrm(ks[5], (N_A_LAYERS, S5_GROUPS, S5_STATE), 0.01)
    s5_log_step = jax.random.uniform(ks[6], (N_A_LAYERS, S5_GROUPS), f32,
                                     float(np.log(S5_DT_MIN)), float(np.log(S5_DT_MAX)))
    b_scale = (2.0 * S5_GROUP) ** -0.5
    s5_b_re = nrm(ks[7], (N_A_LAYERS, S5_GROUPS, S5_STATE, S5_GROUP), b_scale)
    s5_b_im = nrm(ks[8], (N_A_LAYERS, S5_GROUPS, S5_STATE, S5_GROUP), b_scale)
    c_scale = S5_STATE ** -0.5
    s5_c_re = nrm(ks[9], (N_A_LAYERS, S5_GROUPS, S5_GROUP, S5_STATE), c_scale)
    s5_c_im = nrm(ks[10], (N_A_LAYERS, S5_GROUPS, S5_GROUP, S5_STATE), c_scale)
    s5_d = nrm(ks[11], (N_A_LAYERS, D_MODEL), 1.0)
    s5_w_glu = nrm(ks[12], (N_A_LAYERS, D_MODEL, 2 * D_MODEL), D_MODEL ** -0.5)
    kv_norm_g = 1.0 + nrm(ks[13], (D_MODEL,), 0.02)
    w_k = nrm(ks[14], (D_MODEL, N_KV_HEADS * HEAD_DIM), D_MODEL ** -0.5)
    w_v = nrm(ks[15], (D_MODEL, N_KV_HEADS * HEAD_DIM), D_MODEL ** -0.5)
    w_q = nrm(ks[16], (N_B_LAYERS, D_MODEL, N_HEADS * HEAD_DIM), D_MODEL ** -0.5)
    w_o = nrm(ks[17], (N_B_LAYERS, N_HEADS * HEAD_DIM, D_MODEL), (N_HEADS * HEAD_DIM) ** -0.5)
    final_g = 1.0 + nrm(ks[18], (D_MODEL,), 0.02)
    return {"x": x, "norm_g": norm_g, "ffn_w_in": ffn_w_in, "ffn_w_out": ffn_w_out,
            "s5_a_re": s5_a_re, "s5_a_im": s5_a_im, "s5_log_step": s5_log_step,
            "s5_b_re": s5_b_re, "s5_b_im": s5_b_im, "s5_c_re": s5_c_re, "s5_c_im": s5_c_im,
            "s5_d": s5_d, "s5_w_glu": s5_w_glu, "kv_norm_g": kv_norm_g, "w_k": w_k, "w_v": w_v,
            "w_q": w_q, "w_o": w_o, "final_g": final_g}


def reference(x, norm_g, ffn_w_in, ffn_w_out, s5_a_re, s5_a_im, s5_log_step,
              s5_b_re, s5_b_im, s5_c_re, s5_c_im, s5_d, s5_w_glu, kv_norm_g, w_k, w_v,
              w_q, w_o, final_g):
    kv = None
    for layer in range(DEPTH):
        if layer == N_A_LAYERS:
            kv = shared_kv(x, kv_norm_g, w_k, w_v)
        x = x + 0.5 * swiglu_ffn(rmsnorm(x, norm_g[layer, 0]), ffn_w_in[layer, 0], ffn_w_out[layer, 0])
        h = rmsnorm(x, norm_g[layer, 1])
        if layer < N_A_LAYERS:
            j = layer
            x = x + s5_mixer(h, s5_a_re[j], s5_a_im[j], s5_log_step[j], s5_b_re[j], s5_b_im[j],
                             s5_c_re[j], s5_c_im[j], s5_d[j], s5_w_glu[j])
        else:
            j = layer - N_A_LAYERS
            x = x + moba_mixer(h, w_q[j], w_o[j], kv[0], kv[1], kv[2])
        x = x + 0.5 * swiglu_ffn(rmsnorm(x, norm_g[layer, 2]), ffn_w_in[layer, 1], ffn_w_out[layer, 1])
    return rmsnorm(x, final_g)
```

```cpp
#include <hip/hip_runtime.h>
#include <hip/hip_cooperative_groups.h>
#include <cstdio>
namespace cg = cooperative_groups;

#define LAS __attribute__((address_space(3)))
#define DI __device__ __forceinline__
typedef unsigned short bf16_t;
typedef short bf16x8 __attribute__((ext_vector_type(8)));
typedef float f32x4 __attribute__((ext_vector_type(4)));
typedef float f32x2 __attribute__((ext_vector_type(2)));
typedef unsigned u32x4 __attribute__((ext_vector_type(4)));
typedef unsigned u32x2 __attribute__((ext_vector_type(2)));

constexpr int T_TOK = 16384, DM = 1024, FF = 2816, SEQ = 8192;
constexpr float RMS_EPS = 1e-6f;
constexpr int LDS_BYTES = 139296;
constexpr int NJOBS = 13;

struct WJob { const float* W; const float* g; bf16_t* dst; int K; int Nsrc; int ndst; int mode; int item0; int pad; };

struct Params {
    const float *x, *norm_g, *ffn_w_in, *ffn_w_out, *a_re, *a_im, *log_step, *b_re, *b_im, *c_re, *c_im, *s5_d, *w_glu, *kv_norm_g, *w_k, *w_v, *w_q, *w_o, *final_g;
    float* out;
    float* xres; bf16_t* xb; bf16_t* act; bf16_t* yb; bf16_t* qbuf; bf16_t* attn; bf16_t* kbuf; bf16_t* vbuf;
    float* kmean; float* rowss; float* E; float* rope;
    bf16_t* vT; bf16_t* part[4]; float* part_ml; int* lists; int* gcount; unsigned* bar; float* s5tab; int* pcnt;
    bf16_t* wt_up[4]; bf16_t* wt_dn[4]; bf16_t* wt_glu; bf16_t* wt_q; bf16_t* wt_o;
    WJob jobs[NJOBS];
    int nitems; int ph_lo; int ph_hi; int pad; int it1; int it2;
};

DI unsigned cvt_pk_bf16(float lo, float hi) { unsigned r; asm volatile("v_cvt_pk_bf16_f32 %0, %1, %2" : "=v"(r) : "v"(lo), "v"(hi)); return r; }
DI float bf_lo(unsigned w) { return __uint_as_float(w << 16); }
DI float bf_hi(unsigned w) { return __uint_as_float(w & 0xffff0000u); }
DI float wave_sum(float v) {
#pragma unroll
    for (int o = 1; o < 64; o <<= 1) v += __shfl_xor(v, o);
    return v;
}
DI float wave_max(float v) {
#pragma unroll
    for (int o = 1; o < 64; o <<= 1) v = fmaxf(v, __shfl_xor(v, o));
    return v;
}

namespace pg8 {
constexpr int BM = 256, BK = 64, HALF = 128, HTB = HALF * BK * 2, NXCD = 8, WGM = 8;
DI int lds_byte(int r, int c) { const int st = (r >> 4) * 2 + (c >> 5), rr = r & 15, cc = c & 31, ob = rr * 64 + cc * 2; return st * 1024 + (ob ^ (((ob >> 9) & 1) << 5)); }
DI void stage_rc(int b, int& R, int& C) { const int st = b / 1024, sb = b % 1024, swz = sb ^ (((sb >> 9) & 1) << 5); R = (st >> 1) * 16 + swz / 64; C = (st & 1) * 32 + (swz % 64) / 2; }
struct Unit { int pm, pn; };
struct Gemm { const bf16_t* A; const bf16_t* Bt; int M, N, K; };
struct StaticOrder {
    int nM, nN, nwg, G, c;
    DI void init(int M, int N, int G_, int c_) { nM = M / BM; nN = N / BM; nwg = nM * nN; G = G_; c = c_; }
    DI bool next(int i, Unit& u) const {
        const long L = (long)i * G + c; if (L >= nwg) return false;
        int wgid = (int)L; { const int q = nwg / NXCD, r = nwg % NXCD, xcd = wgid % NXCD, off = wgid / NXCD; wgid = (xcd < r ? xcd * (q + 1) : r * (q + 1) + (xcd - r) * q) + off; }
        const int nig = WGM * nN, gid = wgid / nig, fm = gid * WGM, gsz = (nM - fm) < WGM ? (nM - fm) : WGM;
        u.pm = fm + ((wgid % nig) % gsz); u.pn = (wgid % nig) / gsz; return true;
    }
};

template <class Epi>
DI void gemm_phase(LAS unsigned char* lds, const Gemm g, const StaticOrder& S, const Epi& E) {
    int tid_ = threadIdx.x; asm volatile("" : "+v"(tid_));
    const int tid = tid_, wid = __builtin_amdgcn_readfirstlane(tid >> 6), lane = tid & 63, wr = wid >> 2, wc = wid & 3, fr = lane & 15, fq = lane >> 4;
    const int K = g.K, nt = K / BK;
    unsigned voffA[2], voffB[2];
#pragma unroll
    for (int i = 0; i < 2; ++i) { int R, C; stage_rc(tid * 16 + i * 8192, R, C); voffA[i] = (unsigned)(R * K + C) * 2u; voffB[i] = voffA[i]; }
    const size_t kstep = (size_t)(BK * 2);
    const size_t hstep = (size_t)HALF * K * 2;
    const size_t tstep = 2 * hstep;
    const unsigned ldsw = (unsigned)wid * 1024u;
    const int aoff = lds_byte(wr * 64 + fr, fq * 8), boff = lds_byte(wc * 32 + fr, fq * 8);
#define PG8_SA(b, h) (((b) * 2 + (h)) * HTB)
#define PG8_SB(b, h) ((4 + (b) * 2 + (h)) * HTB)
#define PG8_STAGE(bufoff, gbase, voff) do { _Pragma("unroll") for (int _i = 0; _i < 2; ++_i) \
        __builtin_amdgcn_global_load_lds((const unsigned*)((const char*)(gbase) + (voff)[_i]), (LAS unsigned*)(lds + (bufoff) + ldsw + _i * 8192), 16, 0, 0); } while (0)
#define PG8_LDA(dst, b, h) do { _Pragma("unroll") for (int m = 0; m < 4; ++m) _Pragma("unroll") for (int k = 0; k < 2; ++k) dst[m][k] = *(const LAS bf16x8*)(lds + PG8_SA(b, h) + aoff + m * 2048 + k * 1024); } while (0)
#define PG8_LDB(dst, b, h) do { _Pragma("unroll") for (int n = 0; n < 2; ++n) _Pragma("unroll") for (int k = 0; k < 2; ++k) dst[n][k] = *(const LAS bf16x8*)(lds + PG8_SB(b, h) + boff + n * 2048 + k * 1024); } while (0)
#define PG8_MMA(ai, bj, At, Bt) do { __builtin_amdgcn_s_setprio(1); _Pragma("unroll") for (int m = 0; m < 4; ++m) _Pragma("unroll") for (int n = 0; n < 2; ++n) _Pragma("unroll") for (int k = 0; k < 2; ++k) \
        acc[ai][bj][m][n] = __builtin_amdgcn_mfma_f32_16x16x32_bf16(Bt[n][k], At[m][k], acc[ai][bj][m][n], 0, 0, 0); __builtin_amdgcn_s_setprio(0); } while (0)
#define PG8_WAIT_V(n) asm volatile("s_waitcnt vmcnt(" #n ")" ::: "memory")
#define PG8_WAIT_L(n) asm volatile("s_waitcnt lgkmcnt(" #n ")" ::: "memory")
#define PG8_BAR __builtin_amdgcn_s_barrier()
#define PG8_SCHED __builtin_amdgcn_sched_barrier(0)
    Unit cur, nxt; int ui = 0;
    if (!S.next(0, cur)) return;
    f32x4 acc[2][2][4][2];
#pragma unroll
    for (int a = 0; a < 2; ++a)
#pragma unroll
        for (int b = 0; b < 2; ++b)
#pragma unroll
            for (int m = 0; m < 4; ++m)
#pragma unroll
                for (int n = 0; n < 2; ++n) acc[a][b][m][n] = (f32x4){0.f, 0.f, 0.f, 0.f};
    bf16x8 At[4][2], B0[2][2], B1[2][2];
    const char* cA = (const char*)g.A + (size_t)cur.pm * tstep; const char* cB = (const char*)g.Bt + (size_t)cur.pn * tstep;
    PG8_STAGE(PG8_SB(0, 0), cB, voffB); PG8_STAGE(PG8_SA(0, 0), cA, voffA); PG8_STAGE(PG8_SB(0, 1), cB + hstep, voffB); PG8_STAGE(PG8_SA(0, 1), cA + hstep, voffA);
    if (wr == 1) PG8_BAR;
    PG8_WAIT_V(4); PG8_BAR;
    PG8_STAGE(PG8_SB(1, 0), cB + kstep, voffB); PG8_STAGE(PG8_SA(1, 0), cA + kstep, voffA); PG8_STAGE(PG8_SB(1, 1), cB + hstep + kstep, voffB);
    PG8_WAIT_V(6); PG8_BAR;
    for (;;) {
        const bool has_next = S.next(ui + 1, nxt);
        const char* nA = has_next ? (const char*)g.A + (size_t)nxt.pm * tstep : cA; const char* nB = has_next ? (const char*)g.Bt + (size_t)nxt.pn * tstep : cB;
        for (int t = 0; t < nt; t += 2) {
            const bool last = (t == nt - 2);
            const char* a1 = cA + (size_t)(t + 1) * kstep;
            const char* a2 = last ? nA : cA + (size_t)(t + 2) * kstep; const char* b2 = last ? nB : cB + (size_t)(t + 2) * kstep;
            const char* a3 = a2 + kstep; const char* b3 = b2 + kstep;
            PG8_LDB(B0, 0, 0); PG8_SCHED; PG8_LDA(At, 0, 0); PG8_STAGE(PG8_SA(1, 1), a1 + hstep, voffA);
            PG8_WAIT_L(8); PG8_BAR; PG8_WAIT_L(0); PG8_MMA(0, 0, At, B0); PG8_BAR; PG8_SCHED;
            PG8_LDB(B1, 0, 1); PG8_STAGE(PG8_SB(0, 0), b2, voffB);
            PG8_BAR; PG8_WAIT_L(0); PG8_MMA(0, 1, At, B1); PG8_BAR;
            PG8_LDA(At, 0, 1); PG8_STAGE(PG8_SA(0, 0), a2, voffA);
            PG8_BAR; PG8_WAIT_L(0); PG8_MMA(1, 0, At, B0); PG8_BAR; PG8_SCHED;
            PG8_STAGE(PG8_SB(0, 1), b2 + hstep, voffB);
            PG8_WAIT_V(6); PG8_BAR; PG8_MMA(1, 1, At, B1); PG8_BAR;
            PG8_LDB(B0, 1, 0); PG8_SCHED; PG8_LDA(At, 1, 0); PG8_STAGE(PG8_SA(0, 1), a2 + hstep, voffA);
            PG8_WAIT_L(8); PG8_BAR; PG8_WAIT_L(0); PG8_MMA(0, 0, At, B0); PG8_BAR; PG8_SCHED;
            PG8_LDB(B1, 1, 1); PG8_STAGE(PG8_SB(1, 0), b3, voffB);
            PG8_BAR; PG8_WAIT_L(0); PG8_MMA(0, 1, At, B1); PG8_BAR;
            PG8_LDA(At, 1, 1); PG8_STAGE(PG8_SA(1, 0), a3, voffA);
            PG8_BAR; PG8_WAIT_L(0); PG8_MMA(1, 0, At, B0); PG8_BAR; PG8_SCHED;
            PG8_STAGE(PG8_SB(1, 1), b3 + hstep, voffB);
            PG8_WAIT_V(6); PG8_BAR; PG8_MMA(1, 1, At, B1); PG8_BAR;
        }
        E(acc, cur, wr, wc, fr, fq, ui);
        if (!has_next) break;
#pragma unroll
        for (int a = 0; a < 2; ++a)
#pragma unroll
            for (int b = 0; b < 2; ++b)
#pragma unroll
                for (int m = 0; m < 4; ++m)
#pragma unroll
                    for (int n = 0; n < 2; ++n) acc[a][b][m][n] = (f32x4){0.f, 0.f, 0.f, 0.f};
        cur = nxt; cA = nA; cB = nB; ++ui;
    }
    PG8_WAIT_V(0);
    if (wr == 0) PG8_BAR;
    PG8_BAR;
#undef PG8_SA
#undef PG8_SB
#undef PG8_STAGE
#undef PG8_LDA
#undef PG8_LDB
#undef PG8_MMA
#undef PG8_WAIT_V
#undef PG8_WAIT_L
#undef PG8_BAR
#undef PG8_SCHED
}
}
using pg8::Unit;
typedef f32x4 AccT[2][2][4][2];

DI void store_bf4(bf16_t* p, f32x4 v) { u32x2 o; o.x = cvt_pk_bf16(v.x, v.y); o.y = cvt_pk_bf16(v.z, v.w); *(u32x2*)p = o; }
DI float sigmoidf_(float x) { return __builtin_amdgcn_rcpf(1.f + __builtin_amdgcn_exp2f(-1.4426950408889634f * x)); }

struct EpiAct {
    bf16_t* act; const float* rowss; bf16_t* kbuf; bf16_t* vbuf; const float* rope; const LAS float* rsl;
    DI void operator()(const AccT& acc, const Unit& u, int wr, int wc, int fr, int fq, int ui) const {
        const int row0 = u.pm * 256 + wr * 64 + fr;
        if (u.pn < 22) {
#pragma unroll
            for (int ai = 0; ai < 2; ++ai)
#pragma unroll
                for (int m = 0; m < 4; ++m) {
                    const int row = row0 + ai * 128 + m * 16;
                    const float rs = rsl[ui * 256 + wr * 64 + fr + ai * 128 + m * 16];
#pragma unroll
                    for (int bj = 0; bj < 2; ++bj) {
                        const f32x4 gt = acc[ai][bj][m][0] * rs, up = acc[ai][bj][m][1] * rs;
                        f32x4 a;
#pragma unroll
                        for (int j = 0; j < 4; ++j) a[j] = gt[j] * sigmoidf_(gt[j]) * up[j];
                        const int col = 16 * (8 * u.pn + 4 * bj + wc) + 4 * fq;
                        store_bf4(act + (size_t)row * FF + col, a);
                    }
                }
        } else if (u.pn == 22) {
            const bool do_rope = (wc == 0);
#pragma unroll
            for (int ai = 0; ai < 2; ++ai)
#pragma unroll
                for (int m = 0; m < 4; ++m) {
                    const int row = row0 + ai * 128 + m * 16;
                    const float rs = rsqrtf(rowss[row] * (1.f / DM) + RMS_EPS);
                    const int b = row >> 13, pos = row & (SEQ - 1);
#pragma unroll
                    for (int bj = 0; bj < 2; ++bj) {
                        f32x4 v0 = acc[ai][bj][m][0] * rs, v1 = acc[ai][bj][m][1] * rs;
                        if (do_rope) {
                            const f32x4* rp = (const f32x4*)(rope + ((size_t)pos * 16 + 4 * fq) * 2);
                            const f32x4 cs0 = rp[0], cs1 = rp[1];
                            const float c[4] = {cs0.x, cs0.z, cs1.x, cs1.z}, s[4] = {cs0.y, cs0.w, cs1.y, cs1.w};
#pragma unroll
                            for (int j = 0; j < 4; ++j) { const float x1 = v0[j], x2 = v1[j]; v0[j] = x1 * c[j] - x2 * s[j]; v1[j] = x2 * c[j] + x1 * s[j]; }
                        }
                        bf16_t* d = kbuf + ((size_t)(b * 2 + bj) * SEQ + pos) * 128 + 32 * wc + 4 * fq;
                        store_bf4(d, v0); store_bf4(d + 16, v1);
                    }
                }
        } else {
            const int lane = fr + 16 * fq, qi = lane & 3;
#pragma unroll
            for (int ai = 0; ai < 2; ++ai)
#pragma unroll
                for (int m = 0; m < 4; ++m) {
                    const int row = row0 + ai * 128 + m * 16;
                    const float rs = rsqrtf(rowss[row] * (1.f / DM) + RMS_EPS);
                    const int b = row >> 13, posq = (row & (SEQ - 1)) & ~3;
#pragma unroll
                    for (int bj = 0; bj < 2; ++bj)
#pragma unroll
                        for (int n = 0; n < 2; ++n) {
                            const f32x4 v = acc[ai][bj][m][n] * rs;
                            f32x4 w;
#pragma unroll
                            for (int k = 0; k < 4; ++k) {
                                const int src = (lane & ~3) | k;
                                const float t0 = __shfl(v[0], src), t1 = __shfl(v[1], src), t2 = __shfl(v[2], src), t3 = __shfl(v[3], src);
                                w[k] = qi == 0 ? t0 : (qi == 1 ? t1 : (qi == 2 ? t2 : t3));
                            }
                            const int d = 32 * wc + 16 * n + 4 * fq + qi;
                            store_bf4(vbuf + ((size_t)((b * 2 + bj) * 128 + d)) * SEQ + posq, w);
                        }
                }
        }
    }
};

struct EpiRes {
    const float* xin; float* xout; bf16_t* xb; float* rowss_out; float alpha;
    DI void operator()(const AccT& acc, const Unit& u, int wr, int wc, int fr, int fq, int ui) const {
        const int row0 = u.pm * 256 + wr * 64 + fr;
#pragma unroll
        for (int ai = 0; ai < 2; ++ai)
#pragma unroll
            for (int m = 0; m < 4; ++m) {
                const int row = row0 + ai * 128 + m * 16;
                float ss = 0.f;
#pragma unroll
                for (int bj = 0; bj < 2; ++bj)
#pragma unroll
                    for (int n = 0; n < 2; ++n) {
                        const size_t off = (size_t)row * DM + u.pn * 256 + bj * 128 + wc * 32 + n * 16 + 4 * fq;
                        const f32x4 xo = *(const f32x4*)(xin + off);
                        const f32x4 v = xo + alpha * acc[ai][bj][m][n];
                        *(f32x4*)(xout + off) = v;
                        store_bf4(xb + off, v);
                        ss += v.x * v.x + v.y * v.y + v.z * v.z + v.w * v.w;
                    }
                ss += __shfl_xor(ss, 16); ss += __shfl_xor(ss, 32);
                if (fq == 0) atomicAdd(rowss_out + row, ss);
            }
    }
};

struct EpiGlu {
    float* xres; bf16_t* xb; float* rowss_out;
    DI void operator()(const AccT& acc, const Unit& u, int wr, int wc, int fr, int fq, int ui) const {
        const int row0 = u.pm * 256 + wr * 64 + fr;
#pragma unroll
        for (int ai = 0; ai < 2; ++ai)
#pragma unroll
            for (int m = 0; m < 4; ++m) {
                const int row = row0 + ai * 128 + m * 16;
                float ss = 0.f;
#pragma unroll
                for (int bj = 0; bj < 2; ++bj) {
                    const size_t off = (size_t)row * DM + 16 * (8 * u.pn + 4 * bj + wc) + 4 * fq;
                    const f32x4 val = acc[ai][bj][m][0], gt = acc[ai][bj][m][1];
                    f32x4 v = *(const f32x4*)(xres + off);
#pragma unroll
                    for (int j = 0; j < 4; ++j) v[j] += val[j] * sigmoidf_(gt[j]);
                    *(f32x4*)(xres + off) = v;
                    store_bf4(xb + off, v);
                    ss += v.x * v.x + v.y * v.y + v.z * v.z + v.w * v.w;
                }
                ss += __shfl_xor(ss, 16); ss += __shfl_xor(ss, 32);
                if (fq == 0) atomicAdd(rowss_out + row, ss);
            }
    }
};

struct EpiQ {
    bf16_t* qbuf; const float* rowss; const float* rope;
    DI void operator()(const AccT& acc, const Unit& u, int wr, int wc, int fr, int fq, int ui) const {
        const int row0 = u.pm * 256 + wr * 64 + fr;
#pragma unroll
        for (int ai = 0; ai < 2; ++ai)
#pragma unroll
            for (int m = 0; m < 4; ++m) {
                const int row = row0 + ai * 128 + m * 16;
                const float rs = rsqrtf(rowss[row] * (1.f / DM) + RMS_EPS) * 0.08838834764831845f;
                const int pos = row & (SEQ - 1);
#pragma unroll
                for (int bj = 0; bj < 2; ++bj) {
                    f32x4 v0 = acc[ai][bj][m][0] * rs, v1 = acc[ai][bj][m][1] * rs;
                    if (wc == 0) {
                        const f32x4* rp = (const f32x4*)(rope + ((size_t)pos * 16 + 4 * fq) * 2);
                        const f32x4 cs0 = rp[0], cs1 = rp[1];
                        const float c[4] = {cs0.x, cs0.z, cs1.x, cs1.z}, s[4] = {cs0.y, cs0.w, cs1.y, cs1.w};
#pragma unroll
                        for (int j = 0; j < 4; ++j) { const float x1 = v0[j], x2 = v1[j]; v0[j] = x1 * c[j] - x2 * s[j]; v1[j] = x2 * c[j] + x1 * s[j]; }
                    }
                    bf16_t* d = qbuf + (size_t)row * DM + u.pn * 256 + bj * 128 + 32 * wc + 4 * fq;
                    store_bf4(d, v0); store_bf4(d + 16, v1);
                }
            }
    }
};

DI void preload_rs(LAS unsigned char* lds, int vbid, const float* rowss, int N) {
    pg8::StaticOrder S; S.init(T_TOK, N, gridDim.x, vbid);
    LAS float* rsl = (LAS float*)(lds + 131072);
    pg8::Unit u;
    for (int i = 0; i < 8 && S.next(i, u); ++i)
        if (threadIdx.x < 256) rsl[i * 256 + threadIdx.x] = rsqrtf(rowss[u.pm * 256 + threadIdx.x] * (1.f / DM) + RMS_EPS);
    __syncthreads();
}
template <class Epi>
DI void run_gemm_v(LAS unsigned char* lds, int vbid, const bf16_t* A, const bf16_t* Bt, int N, int K, const Epi& E) {
    pg8::Gemm g{A, Bt, T_TOK, N, K};
    pg8::StaticOrder S; S.init(T_TOK, N, gridDim.x, vbid);
    pg8::gemm_phase<Epi>(lds, g, S, E);
}

struct S5Coef { float ar, ai, cr, ci; };
DI S5Coef s5_coefs_compute(const Params& P, int g, int p) {
    const float dt = expf(P.log_step[g]); const float lr = P.a_re[g * 64 + p], li = P.a_im[g * 64 + p];
    const float mag = expf(lr * dt); S5Coef c; c.ar = mag * cosf(li * dt); c.ai = mag * sinf(li * dt);
    const float nr = c.ar - 1.f, ni = c.ai, den = lr * lr + li * li;
    c.cr = (nr * lr + ni * li) / den; c.ci = (ni * lr - nr * li) / den; return c;
}
DI S5Coef s5_coefs(const Params& P, int g, int p) { const f32x4 v = *(const f32x4*)(P.s5tab + (size_t)(g * 64 + p) * 4); S5Coef c; c.ar = v.x; c.ai = v.y; c.cr = v.z; c.ci = v.w; return c; }

DI void p0_transpose_item(const WJob& J, LAS float* scr, int item, int lane) {
    const int nblk = J.ndst / 32, kb = item / nblk, nb = item % nblk, k0 = 64 * kb, r0 = 32 * nb;
    const int i = lane & 31;
    int scol;
    if (J.mode == 0) scol = r0 + i;
    else { const int G = r0 >> 5; scol = (i < 16) ? (16 * G + i) : ((J.Nsrc >> 1) + 16 * G + (i - 16)); }
    float wv[32];
    const float* wp = J.W + (size_t)(k0 + (lane >> 5)) * J.Nsrc + scol;
#pragma unroll
    for (int it = 0; it < 32; ++it) wv[it] = wp[(size_t)(2 * it) * J.Nsrc];
    if (J.g) {
        const float* gp = J.g + k0 + (lane >> 5);
#pragma unroll
        for (int it = 0; it < 32; ++it) wv[it] *= gp[2 * it];
    }
#pragma unroll
    for (int it = 0; it < 32; ++it) scr[(2 * it + (lane >> 5)) * 33 + i] = wv[it];
    __builtin_amdgcn_fence(__ATOMIC_RELEASE, "wavefront"); __builtin_amdgcn_wave_barrier(); __builtin_amdgcn_fence(__ATOMIC_ACQUIRE, "wavefront");
    const int c = lane & 7;
#pragma unroll
    for (int j = 0; j < 4; ++j) {
        const int n = (lane >> 3) + 8 * j; const LAS float* s = scr + (8 * c) * 33 + n;
        u32x4 o; o.x = cvt_pk_bf16(s[0 * 33], s[1 * 33]); o.y = cvt_pk_bf16(s[2 * 33], s[3 * 33]); o.z = cvt_pk_bf16(s[4 * 33], s[5 * 33]); o.w = cvt_pk_bf16(s[6 * 33], s[7 * 33]);
        *(u32x4*)(J.dst + (size_t)(r0 + n) * J.K + k0 + 8 * c) = o;
    }
    __builtin_amdgcn_fence(__ATOMIC_RELEASE, "wavefront"); __builtin_amdgcn_wave_barrier(); __builtin_amdgcn_fence(__ATOMIC_ACQUIRE, "wavefront");
}

DI void convert_items(const Params& P, LAS unsigned char* lds, int lo, int hi, int gw, int NGW) {
    const int wave = threadIdx.x >> 6, lane = threadIdx.x & 63;
    LAS float* scr = (LAS float*)(lds + wave * 16384);
    for (int it = lo + gw; it < hi; it += NGW) {
        int j = 0;
#pragma unroll 1
        for (int q = 1; q < NJOBS; ++q) if (it >= P.jobs[q].item0) j = q;
        p0_transpose_item(P.jobs[j], scr, it - P.jobs[j].item0, lane);
    }
}
DI void convert_by_light_blocks(const Params& P, LAS unsigned char* lds, int vbid, int units, int lo, int hi) {
    asm volatile("" : "+s"(vbid), "+s"(lo), "+s"(hi));
    const int G = gridDim.x, extra = units % G, first = extra, nlight = G - extra;
    if (vbid >= first) convert_items(P, lds, lo, hi, (vbid - first) * 8 + (threadIdx.x >> 6), nlight * 8);
}

DI void phase_prep(const Params& P, LAS unsigned char* lds) {
    const int tid = threadIdx.x, wave = tid >> 6, lane = tid & 63;
    const int gw = blockIdx.x * 8 + wave, NGW = gridDim.x * 8;
    LAS float* scr = (LAS float*)(lds + wave * 16384);
    convert_items(P, lds, 0, P.it1, gw, NGW);
    for (int row = gw; row < T_TOK; row += NGW) {
        const f32x4* xr = (const f32x4*)(P.x + (size_t)row * DM) + lane;
        f32x4 v[4]; float s = 0.f;
#pragma unroll
        for (int j = 0; j < 4; ++j) { v[j] = xr[64 * j]; s += v[j].x * v[j].x + v[j].y * v[j].y + v[j].z * v[j].z + v[j].w * v[j].w; }
        s = wave_sum(s);
        if (lane == 0) P.rowss[row] = s;
        bf16_t* o = P.xb + (size_t)row * DM + 4 * lane;
#pragma unroll
        for (int j = 0; j < 4; ++j) store_bf4(o + 256 * j, v[j]);
    }
    const int gt = blockIdx.x * 512 + tid, NGT = gridDim.x * 512;
    for (int i = gt; i < 6 * T_TOK; i += NGT) P.rowss[T_TOK + i] = 0.f;
    if (gt < 128) P.gcount[gt] = 0;
    if (gt < 64) P.pcnt[gt] = 0;
    for (int i = gt; i < 4096; i += NGT) { const S5Coef c = s5_coefs_compute(P, i >> 6, i & 63); *(f32x4*)(P.s5tab + (size_t)i * 4) = (f32x4){c.ar, c.ai, c.cr, c.ci}; }
    for (int i = gt; i < SEQ * 16; i += NGT) {
        const int pos = i >> 4, d = i & 15;
        const float inv = exp2f(-(float)d * (18.931568569324174f / 16.f));
        const float ang = (float)pos * inv;
        P.rope[2 * i] = cosf(ang); P.rope[2 * i + 1] = sinf(ang);
    }
}

DI float gelu_tanh(float x) { const float u = 0.7978845608028654f * (x + 0.044715f * x * x * x); return x * __builtin_amdgcn_rcpf(1.f + __builtin_amdgcn_exp2f(-2.f * 1.4426950408889634f * u)); }

typedef float f32x16 __attribute__((ext_vector_type(16)));
typedef __bf16 bf2_t __attribute__((ext_vector_type(2)));
DI unsigned pk_bf16(float lo, float hi) { const f32x2 v = {lo, hi}; return __builtin_bit_cast(unsigned, __builtin_convertvector(v, bf2_t)); }
#define WAVE_LDS_SYNC() asm volatile("s_waitcnt lgkmcnt(0)" ::: "memory")

DI void s5_bfrags(const Params& P, int g, int lane, bf16x8 (&bf)[4]) {
    const int q = lane & 31, h = lane >> 5;
#pragma unroll
    for (int pj = 0; pj < 2; ++pj) {
        const int p = q + 32 * pj;
        const S5Coef c = s5_coefs(P, g, p);
        const f32x4* br = (const f32x4*)(P.b_re + ((size_t)g * 64 + p) * 16 + 8 * h);
        const f32x4* bi = (const f32x4*)(P.b_im + ((size_t)g * 64 + p) * 16 + 8 * h);
        const f32x4 r0 = br[0], r1 = br[1], i0 = bi[0], i1 = bi[1];
        float re[8], im[8];
#pragma unroll
        for (int j = 0; j < 4; ++j) {
            re[j] = c.cr * r0[j] - c.ci * i0[j]; im[j] = c.cr * i0[j] + c.ci * r0[j];
            re[4 + j] = c.cr * r1[j] - c.ci * i1[j]; im[4 + j] = c.cr * i1[j] + c.ci * r1[j];
        }
        const u32x4 wr = {pk_bf16(re[0], re[1]), pk_bf16(re[2], re[3]), pk_bf16(re[4], re[5]), pk_bf16(re[6], re[7])};
        const u32x4 wi = {pk_bf16(im[0], im[1]), pk_bf16(im[2], im[3]), pk_bf16(im[4], im[5]), pk_bf16(im[6], im[7])};
        bf[2 * pj] = __builtin_bit_cast(bf16x8, wr); bf[2 * pj + 1] = __builtin_bit_cast(bf16x8, wi);
    }
}
DI bf16x8 s5_ufrag(const Params& P, int rowbase, int g, int lane, const f32x4& ga, const f32x4& gb) {
    const int t = lane & 31, h = lane >> 5, row = rowbase + t;
    const float rs = rsqrtf(P.rowss[T_TOK + row] * (1.f / DM) + RMS_EPS);
    const f32x4* xp = (const f32x4*)(P.xres + (size_t)row * DM + 16 * g + 8 * h);
    const f32x4 a = xp[0] * rs * ga, b = xp[1] * rs * gb;
    const u32x4 w = {pk_bf16(a.x, a.y), pk_bf16(a.z, a.w), pk_bf16(b.x, b.y), pk_bf16(b.z, b.w)};
    return __builtin_bit_cast(bf16x8, w);
}
template <bool WRITE>
DI void s5_scan32(const f32x16 (&X)[4], int h, int p, float ar, float ai, float& hr, float& hi, LAS unsigned char* hs) {
    float lo_re[16], lo_im[16], hi_re[16], hi_im[16];
#pragma unroll
    for (int r = 0; r < 16; ++r) {
        const float sre = h ? X[0][r] : X[2][r], sim = h ? X[1][r] : X[3][r];
        const float rre = __shfl_xor(sre, 32), rim = __shfl_xor(sim, 32);
        const float ore = h ? X[2][r] : X[0][r], oim = h ? X[3][r] : X[1][r];
        lo_re[r] = h ? rre : ore; lo_im[r] = h ? rim : oim;
        hi_re[r] = h ? ore : rre; hi_im[r] = h ? oim : rim;
    }
#pragma unroll
    for (int i = 0; i < 4; ++i)
#pragma unroll
        for (int half = 0; half < 2; ++half)
#pragma unroll
            for (int j = 0; j < 4; ++j) {
                const int r = 4 * i + j, token = 8 * i + 4 * half + j;
                const float xr = half ? hi_re[r] : lo_re[r], xi = half ? hi_im[r] : lo_im[r];
                const float nhr = ar * hr - ai * hi + xr, nhi = ar * hi + ai * hr + xi; hr = nhr; hi = nhi;
                if (WRITE) {
                    const unsigned whi = pk_bf16(hr, hi);
                    *(LAS unsigned*)(hs + token * 272 + 4 * p) = whi;
                    *(LAS unsigned*)(hs + 69632 + token * 272 + 4 * p) = pk_bf16(hr - bf_lo(whi), hi - bf_hi(whi));
                }
            }
}

struct S5In { f32x4 x0, x1; float ss; };
DI S5In s5_in_load(const Params& P, int rowbase, int g, int lane) {
    const int row = rowbase + (lane & 31);
    const f32x4* xp = (const f32x4*)(P.xres + (size_t)row * DM + 16 * g + 8 * (lane >> 5));
    S5In r; r.x0 = xp[0]; r.x1 = xp[1]; r.ss = P.rowss[T_TOK + row]; return r;
}
DI bf16x8 s5_in_frag(const S5In& in, const f32x4& ga, const f32x4& gb) {
    const float rs = rsqrtf(in.ss * (1.f / DM) + RMS_EPS);
    const f32x4 a = in.x0 * rs * ga, b = in.x1 * rs * gb;
    const u32x4 w = {pk_bf16(a.x, a.y), pk_bf16(a.z, a.w), pk_bf16(b.x, b.y), pk_bf16(b.z, b.w)};
    return __builtin_bit_cast(bf16x8, w);
}
DI int s5_row0(int L, int wave) { const int bc = L & 31; return (bc >> 4) * SEQ + ((bc & 15) * 8 + wave) * 64; }

DI void phase_s5a(const Params& P, LAS unsigned char* lds) {
    const int tid = threadIdx.x, wave = tid >> 6, lane = tid & 63, h = lane >> 5;
    for (int base = blockIdx.x * 8; base < 2048; base += gridDim.x * 8) {
        const int g = base >> 5;
        const S5Coef cf = s5_coefs(P, g, lane);
        bf16x8 bf[4]; s5_bfrags(P, g, lane, bf);
        const f32x4 ga = *(const f32x4*)(P.norm_g + DM + 16 * g + 8 * h), gb = *(const f32x4*)(P.norm_g + DM + 16 * g + 8 * h + 4);
        float hr = 0.f, hi = 0.f;
        S5In pre = s5_in_load(P, s5_row0(base, wave), g, lane);
#pragma unroll 1
        for (int step = 0; step < 16; ++step) {
            const int L = base + (step >> 1), sub = step & 1;
            const S5In cur = pre;
            if (step < 15) pre = s5_in_load(P, s5_row0(base + ((step + 1) >> 1), wave) + 32 * ((step + 1) & 1), g, lane);
            const bf16x8 a = s5_in_frag(cur, ga, gb);
            f32x16 X[4];
#pragma unroll
            for (int j = 0; j < 4; ++j) {
#pragma unroll
                for (int r = 0; r < 16; ++r) X[j][r] = 0.f;
                X[j] = __builtin_amdgcn_mfma_f32_32x32x16_bf16(a, bf[j], X[j], 0, 0, 0);
            }
            if (sub == 0) { hr = 0.f; hi = 0.f; }
            s5_scan32<false>(X, h, lane, cf.ar, cf.ai, hr, hi, lds);
            if (sub == 1) { const int bc = L & 31, ch = (bc & 15) * 8 + wave; *(f32x2*)(P.E + ((size_t)(((bc >> 4) * 128 + ch) * 64 + g) * 64 + lane) * 2) = (f32x2){hr, hi}; }
        }
    }
}

DI void phase_s5carry(const Params& P) {
    if (blockIdx.x < 128 && threadIdx.x < 64) {
        const int idx = blockIdx.x * 64 + threadIdx.x, b = idx >> 12, g = (idx >> 6) & 63, p = idx & 63;
        const S5Coef cf = s5_coefs(P, g, p);
        float alr = cf.ar, ali = cf.ai;
#pragma unroll
        for (int q = 0; q < 6; ++q) { const float r = alr * alr - ali * ali, i2 = 2.f * alr * ali; alr = r; ali = i2; }
        f32x2* Ep = (f32x2*)P.E + (size_t)(b * 128) * 4096 + g * 64 + p;
        float hr = 0.f, hi = 0.f;
#pragma unroll 1
        for (int j0 = 0; j0 < 128; j0 += 32) {
            f32x2 e[32];
#pragma unroll
            for (int u = 0; u < 32; ++u) e[u] = Ep[(size_t)(j0 + u) * 4096];
#pragma unroll
            for (int u = 0; u < 32; ++u) {
                Ep[(size_t)(j0 + u) * 4096] = (f32x2){hr, hi};
                const float nr = alr * hr - ali * hi + e[u].x, ni = alr * hi + ali * hr + e[u].y; hr = nr; hi = ni;
            }
        }
    }
}

DI void phase_s5b(const Params& P, LAS unsigned char* lds) {
    const int tid = threadIdx.x, wave = tid >> 6, lane = tid & 63, h = lane >> 5, c16 = lane & 15, kq = lane >> 4;
    LAS unsigned char* hs = lds + wave * 8704;
    for (int base = blockIdx.x * 8; base < 2048; base += gridDim.x * 8) {
        const int g = base >> 5;
        const S5Coef cf = s5_coefs(P, g, lane);
        bf16x8 bf[4]; s5_bfrags(P, g, lane, bf);
        const f32x4 ga = *(const f32x4*)(P.norm_g + DM + 16 * g + 8 * h), gb = *(const f32x4*)(P.norm_g + DM + 16 * g + 8 * h + 4);
        bf16x8 cmf[4], cml[4];
#pragma unroll
        for (int ks = 0; ks < 4; ++ks) {
            const int p0 = ks * 16 + kq * 4;
            const f32x4 cr = *(const f32x4*)(P.c_re + ((size_t)g * 16 + c16) * 64 + p0), ci = *(const f32x4*)(P.c_im + ((size_t)g * 16 + c16) * 64 + p0);
            const float v[8] = {cr.x, -ci.x, cr.y, -ci.y, cr.z, -ci.z, cr.w, -ci.w};
            u32x4 wh, wl;
#pragma unroll
            for (int e = 0; e < 4; ++e) { wh[e] = pk_bf16(v[2 * e], v[2 * e + 1]); wl[e] = pk_bf16(v[2 * e] - bf_lo(wh[e]), v[2 * e + 1] - bf_hi(wh[e])); }
            cmf[ks] = __builtin_bit_cast(bf16x8, wh); cml[ks] = __builtin_bit_cast(bf16x8, wl);
        }
        const f32x4 d4 = *(const f32x4*)(P.s5_d + 16 * g + 4 * kq), ge = *(const f32x4*)(P.norm_g + DM + 16 * g + 4 * kq);
        float hr = 0.f, hi = 0.f;
        S5In pre = s5_in_load(P, s5_row0(base, wave), g, lane);
        f32x2 cpre; { const int bc = base & 31, ch = (bc & 15) * 8 + wave; cpre = *((const f32x2*)P.E + ((size_t)((bc >> 4) * 128 + ch) * 64 + g) * 64 + lane); }
#pragma unroll 1
        for (int step = 0; step < 16; ++step) {
            const int L = base + (step >> 1), sub = step & 1, rowb = s5_row0(L, wave) + 32 * sub;
            const S5In cur = pre;
            if (sub == 0) { hr = cpre.x; hi = cpre.y; }
            if (step < 15) pre = s5_in_load(P, s5_row0(base + ((step + 1) >> 1), wave) + 32 * ((step + 1) & 1), g, lane);
            if (sub == 1 && step < 15) { const int bc = (L + 1) & 31, ch = (bc & 15) * 8 + wave; cpre = *((const f32x2*)P.E + ((size_t)((bc >> 4) * 128 + ch) * 64 + g) * 64 + lane); }
            const bf16x8 a = s5_in_frag(cur, ga, gb);
            f32x16 X[4];
#pragma unroll
            for (int j = 0; j < 4; ++j) {
#pragma unroll
                for (int r = 0; r < 16; ++r) X[j][r] = 0.f;
                X[j] = __builtin_amdgcn_mfma_f32_32x32x16_bf16(a, bf[j], X[j], 0, 0, 0);
            }
            s5_scan32<true>(X, h, lane, cf.ar, cf.ai, hr, hi, hs);
            WAVE_LDS_SYNC();
#pragma unroll
            for (int tt = 0; tt < 2; ++tt) {
                f32x4 acc = {0.f, 0.f, 0.f, 0.f};
#pragma unroll
                for (int ks = 0; ks < 4; ++ks) {
                    const LAS unsigned char* ha = hs + (tt * 16 + c16) * 272 + ks * 64 + kq * 16;
                    const bf16x8 hbh = *(const LAS bf16x8*)ha, hbl = *(const LAS bf16x8*)(ha + 69632);
                    acc = __builtin_amdgcn_mfma_f32_16x16x32_bf16(cml[ks], hbh, acc, 0, 0, 0);
                    acc = __builtin_amdgcn_mfma_f32_16x16x32_bf16(cmf[ks], hbl, acc, 0, 0, 0);
                    acc = __builtin_amdgcn_mfma_f32_16x16x32_bf16(cmf[ks], hbh, acc, 0, 0, 0);
                }
                const int row = rowb + 16 * tt + c16;
                const float rs = rsqrtf(P.rowss[T_TOK + row] * (1.f / DM) + RMS_EPS);
                const f32x4 u4 = *(const f32x4*)(P.xres + (size_t)row * DM + 16 * g + 4 * kq) * rs * ge;
                f32x4 y;
#pragma unroll
                for (int j = 0; j < 4; ++j) y[j] = gelu_tanh(acc[j] + d4[j] * u4[j]);
                store_bf4(P.yb + (size_t)row * DM + 16 * g + 4 * kq, y);
            }
            WAVE_LDS_SYNC();
        }
    }
}

DI void phase_kmean(const Params& P, LAS unsigned char* lds) {
    if (blockIdx.x < 128) {
        const int j = blockIdx.x, d = threadIdx.x & 127, part = threadIdx.x >> 7;
        const bf16_t* kb = P.kbuf + ((size_t)(j >> 5) * SEQ + (j & 31) * 256 + part * 64) * 128 + d;
        float s = 0.f;
#pragma unroll 1
        for (int k0 = 0; k0 < 64; k0 += 16) {
            unsigned short v[16];
#pragma unroll
            for (int u = 0; u < 16; ++u) v[u] = kb[(size_t)(k0 + u) * 128];
#pragma unroll
            for (int u = 0; u < 16; ++u) s += __uint_as_float(((unsigned)v[u]) << 16);
        }
        LAS float* red = (LAS float*)lds;
        red[threadIdx.x] = s;
        __syncthreads();
        if (threadIdx.x < 128) P.kmean[j * 128 + d] = (red[d] + red[128 + d] + red[256 + d] + red[384 + d]) * (1.f / 256.f);
    }
}

DI int list_off(int c, int n) { return c * (496 * 1024) + 1024 * (31 * n - (n * (n - 1)) / 2); }

DI void phase_gate(const Params& P, LAS unsigned char* lds) {
    const int tid = threadIdx.x, wave = tid >> 6, lane = tid & 63;
    LAS float* km = (LAS float*)lds;
    LAS int* cnt = (LAS int*)(lds + 32768);
    LAS int* base = cnt + 64;
    for (int qb = blockIdx.x; qb < 256; qb += gridDim.x) {
        const int b = qb >> 7, i = qb & 127, own = i >> 2;
        for (int e = tid; e < 2048; e += 512) ((LAS f32x4*)km)[e] = ((const f32x4*)(P.kmean + b * 8192))[e];
        if (tid < 64) cnt[tid] = 0;
        __syncthreads();
        const int hq = wave, hk = hq >> 2, t = b * SEQ + i * 64 + lane;
        float g[32];
#pragma unroll
        for (int n = 0; n < 32; ++n) g[n] = 0.f;
        const u32x4* qr = (const u32x4*)(P.qbuf + (size_t)t * DM + hq * 128);
#pragma unroll
        for (int nc = 0; nc < 4; ++nc) {
            u32x4 wa = qr[0], wb = qr[1];
#pragma unroll 1
            for (int c = 0; c < 16; ++c) {
                const u32x4 w = wa; wa = wb; wb = qr[(c + 2) & 15];
                const float q0 = bf_lo(w.x), q1 = bf_hi(w.x), q2 = bf_lo(w.y), q3 = bf_hi(w.y), q4 = bf_lo(w.z), q5 = bf_hi(w.z), q6 = bf_lo(w.w), q7 = bf_hi(w.w);
#pragma unroll
                for (int n8 = 0; n8 < 8; ++n8) {
                    const int n = nc * 8 + n8;
                    const LAS f32x4* kp = (const LAS f32x4*)(km + (hk * 32 + n) * 128 + 8 * c);
                    const f32x4 ka = kp[0], kb = kp[1];
                    g[n] += q0 * ka.x + q1 * ka.y + q2 * ka.z + q3 * ka.w + q4 * kb.x + q5 * kb.y + q6 * kb.z + q7 * kb.w;
                }
            }
        }
        const int nsel = own < 3 ? own : 3;
        int s0 = -1, s1 = -1, s2 = -1;
        { float best = -3e38f;
#pragma unroll
          for (int n = 0; n < 32; ++n) if (n < own && g[n] > best) { best = g[n]; s0 = n; } }
        { float best = -3e38f;
#pragma unroll
          for (int n = 0; n < 32; ++n) if (n < own && n != s0 && g[n] > best) { best = g[n]; s1 = n; } }
        { float best = -3e38f;
#pragma unroll
          for (int n = 0; n < 32; ++n) if (n < own && n != s0 && n != s1 && g[n] > best) { best = g[n]; s2 = n; } }
        int l0 = 0, l1 = 0, l2 = 0;
        if (nsel > 0) l0 = atomicAdd((int*)&cnt[hk * 32 + s0], 1);
        if (nsel > 1) l1 = atomicAdd((int*)&cnt[hk * 32 + s1], 1);
        if (nsel > 2) l2 = atomicAdd((int*)&cnt[hk * 32 + s2], 1);
        __syncthreads();
        if (tid < 64) { const int c = cnt[tid]; base[tid] = c > 0 ? atomicAdd(P.gcount + b * 64 + tid, c) : 0; }
        __syncthreads();
        const int row = t * 8 + hq, c2 = b * 2 + hk;
        if (nsel > 0) P.lists[list_off(c2, s0) + base[hk * 32 + s0] + l0] = row * 4 + 1;
        if (nsel > 1) P.lists[list_off(c2, s1) + base[hk * 32 + s1] + l1] = row * 4 + 2;
        if (nsel > 2) P.lists[list_off(c2, s2) + base[hk * 32 + s2] + l2] = row * 4 + 3;
        __syncthreads();
    }
}

template <bool OWN>
DI void phase_attn(const Params& P, LAS unsigned char* lds) {
    const int tid = threadIdx.x, wave = __builtin_amdgcn_readfirstlane(tid >> 6), lane = tid & 63, h = lane >> 5, l32 = lane & 31;
    LAS unsigned char* Ks = lds;
    LAS unsigned char* Vs = lds + 69632;
    LAS int* pref = (LAS int*)(lds + 136192);
    if constexpr (!OWN) {
        LAS int* cntl = pref + 132;
        if (tid < 128) cntl[tid] = (P.gcount[tid] + 255) >> 8;
        __syncthreads();
        if (tid <= 128) { int a = 0; for (int i = 0; i < 128; ++i) a += (i < tid) ? cntl[i] : 0; pref[tid] = a; }
        __syncthreads();
    }
    const int total = OWN ? 512 : pref[128];
    constexpr float LOG2E = 1.4426950408889634f;
    int rnd = 0;
    for (int idx = blockIdx.x; idx < total; idx += gridDim.x, ++rnd) {
        const int item = (OWN && (rnd & 1)) ? (idx ^ 3) : idx;
        int c, n, i_q = 0, nrows = 256; const int* lst = P.lists; constexpr bool is_own = OWN;
        if (is_own) { c = item >> 7; i_q = item & 127; n = i_q >> 2; }
        else {
            const int s = item; int lo = 0, hi = 128;
            while (hi - lo > 1) { const int mid = (lo + hi) >> 1; if (pref[mid] <= s) lo = mid; else hi = mid; }
            c = lo >> 5; n = lo & 31; const int grp = s - pref[lo]; lst = P.lists + list_off(c, n) + grp * 256; nrows = P.gcount[lo] - grp * 256; if (nrows > 256) nrows = 256;
        }
        const int b = c >> 1, hk = c & 1;
        {
            const bf16_t* kg = P.kbuf + ((size_t)c * SEQ + n * 256) * 128;
            const bf16_t* vg = P.vT + (size_t)c * 128 * SEQ + n * 256;
            const bf16_t* kgl = kg + (size_t)(tid >> 4) * 128 + (tid & 15) * 8;
            LAS unsigned char* kl = Ks + (tid >> 4) * 272 + (tid & 15) * 16;
#pragma unroll
            for (int q = 0; q < 8; ++q) { const u32x4 w = *(const u32x4*)(kgl + q * 4096); *(LAS u32x4*)(kl + q * 8704) = w; }
            const bf16_t* vgl = vg + (size_t)(tid >> 5) * SEQ + (tid & 31) * 8;
            LAS unsigned char* vl = Vs + (tid >> 5) * 520 + (tid & 31) * 16;
#pragma unroll
            for (int q = 0; q < 8; ++q) { const u32x4 w = *(const u32x4*)(vgl + (size_t)q * 16 * SEQ); LAS u32x2* dst = (LAS u32x2*)(vl + q * 8320); dst[0] = (u32x2){w.x, w.y}; dst[1] = (u32x2){w.z, w.w}; }
        }
        int ent; bool valid = true; const int rho = wave * 32 + l32;
        if (is_own) { const int hq = hk * 4 + (rho >> 6), t = b * SEQ + i_q * 64 + (rho & 63); ent = (t * 8 + hq) * 4; }
        else { valid = rho < nrows; ent = lst[valid ? rho : 0]; }
        bf16x8 qf[8];
        { const int row = ent >> 2, t = row >> 3, hq = row & 7; const bf16_t* qp = P.qbuf + (size_t)t * DM + hq * 128 + 8 * h;
#pragma unroll
          for (int ks = 0; ks < 8; ++ks) qf[ks] = *(const bf16x8*)(qp + ks * 16); }
        __syncthreads();
        if (wave < 4) __builtin_amdgcn_s_setprio(2);
        if (wave * 32 < nrows) {
            const int nkt = is_own ? (2 * (i_q & 3) + (wave & 1) + 1) : 8;
            const int posb = is_own ? (64 * (i_q & 3) + (rho & 63)) : 100000;
            float m_run = -1e30f, l_run = 0.f;
            f32x16 o[4];
#pragma unroll
            for (int db = 0; db < 4; ++db)
#pragma unroll
                for (int r = 0; r < 16; ++r) o[db][r] = 0.f;
#pragma unroll 1
            for (int hf = 0; hf < 2; ++hf) {
                if (4 * hf >= nkt) break;
                f32x16 s[4];
#pragma unroll
                for (int kq = 0; kq < 4; ++kq) {
                    const int kt = 4 * hf + kq;
                    if (kt < nkt) {
#pragma unroll
                        for (int r = 0; r < 16; ++r) s[kq][r] = 0.f;
#pragma unroll
                        for (int ks = 0; ks < 8; ++ks) {
                            const bf16x8 a = *(const LAS bf16x8*)(Ks + (kt * 32 + l32) * 272 + ks * 32 + 16 * h);
                            s[kq] = __builtin_amdgcn_mfma_f32_32x32x16_bf16(a, qf[ks], s[kq], 0, 0, 0);
                            asm volatile("" :: "v"(a));
                        }
                        if (is_own) {
#pragma unroll
                            for (int r = 0; r < 16; ++r) { const int key = kt * 32 + (r & 3) + 8 * (r >> 2) + 4 * h; if (key > posb) s[kq][r] = -1e30f; }
                        }
                    } else {
#pragma unroll
                        for (int r = 0; r < 16; ++r) s[kq][r] = -1e30f;
                    }
                    __builtin_amdgcn_sched_barrier(0);
                }
                float mx = -1e30f;
#pragma unroll
                for (int kq = 0; kq < 4; ++kq)
#pragma unroll
                    for (int r = 0; r < 16; ++r) mx = fmaxf(mx, s[kq][r]);
                mx = fmaxf(mx, __shfl_xor(mx, 32));
                const float m_new = fmaxf(m_run, mx), mL = m_new * LOG2E;
                const float alpha = __builtin_amdgcn_exp2f((m_run - m_new) * LOG2E);
                float lsum = 0.f;
#pragma unroll
                for (int kq = 0; kq < 4; ++kq)
#pragma unroll
                    for (int r = 0; r < 16; ++r) { const float p = __builtin_amdgcn_exp2f(s[kq][r] * LOG2E - mL); s[kq][r] = p; lsum += p; }
                lsum += __shfl_xor(lsum, 32);
                l_run = l_run * alpha + lsum; m_run = m_new;
                if (hf == 1) {
#pragma unroll
                    for (int db = 0; db < 4; ++db)
#pragma unroll
                        for (int r = 0; r < 16; ++r) o[db][r] *= alpha;
                }
#pragma unroll
                for (int kq = 0; kq < 4; ++kq) {
                    const int kt = 4 * hf + kq;
                    if (kt < nkt) {
#pragma unroll
                        for (int st = 0; st < 2; ++st) {
                            u32x4 pw;
                            pw.x = pk_bf16(s[kq][8 * st + 0], s[kq][8 * st + 1]); pw.y = pk_bf16(s[kq][8 * st + 2], s[kq][8 * st + 3]);
                            pw.z = pk_bf16(s[kq][8 * st + 4], s[kq][8 * st + 5]); pw.w = pk_bf16(s[kq][8 * st + 6], s[kq][8 * st + 7]);
                            const bf16x8 pf = __builtin_bit_cast(bf16x8, pw);
#pragma unroll
                            for (int db = 0; db < 4; ++db) {
                                const LAS unsigned char* va = Vs + (32 * db + l32) * 520 + (kt * 32 + 16 * st + 4 * h) * 2;
                                const u32x2 vlo = *(const LAS u32x2*)va, vhi = *(const LAS u32x2*)(va + 16);
                                const u32x4 vw = {vlo.x, vlo.y, vhi.x, vhi.y};
                                o[db] = __builtin_amdgcn_mfma_f32_32x32x16_bf16(__builtin_bit_cast(bf16x8, vw), pf, o[db], 0, 0, 0);
                            }
                            __builtin_amdgcn_sched_barrier(0);
                        }
                    }
                }
            }
            asm volatile("" : "+v"(ent));
            if constexpr (!OWN) {
                if (valid) {
                    const float inv = 1.f / l_run;
                    const int slot = ent & 3; const int row = ent >> 2;
                    if (h == 0) *(f32x2*)(P.part_ml + (size_t)ent * 2) = (f32x2){m_run, l_run};
                    int h2 = h; asm volatile("" : "+v"(h2));
                    bf16_t* pb = P.part[1];
                    if (slot == 2) pb = P.part[2]; else if (slot == 3) pb = P.part[3];
                    bf16_t* po = pb + ((size_t)row * 128 + 4 * h2);
#pragma unroll
                    for (int db = 0; db < 4; ++db)
#pragma unroll
                        for (int rq = 0; rq < 4; ++rq) {
                            u32x2 w; w.x = pk_bf16(o[db][4 * rq] * inv, o[db][4 * rq + 1] * inv); w.y = pk_bf16(o[db][4 * rq + 2] * inv, o[db][4 * rq + 3] * inv);
                            *(u32x2*)(po + 32 * db + 8 * rq) = w;
                        }
                }
            } else {
                const int row = ent >> 2, nsel = n < 3 ? n : 3;
                int h2 = h; asm volatile("" : "+v"(h2));
                float M = m_run; f32x2 ml[3];
#pragma unroll
                for (int s2 = 0; s2 < 3; ++s2) { ml[s2] = (f32x2){-1e30f, 0.f}; if (s2 < nsel) { ml[s2] = *(const f32x2*)(P.part_ml + ((size_t)row * 4 + s2 + 1) * 2); M = fmaxf(M, ml[s2].x); } }
                const float w0 = __builtin_amdgcn_exp2f((m_run - M) * LOG2E);
                float ws[3], L = l_run * w0;
#pragma unroll
                for (int s2 = 0; s2 < 3; ++s2) { ws[s2] = ml[s2].y * __builtin_amdgcn_exp2f((ml[s2].x - M) * LOG2E); L += ws[s2]; }
                const float inv = 1.f / L, w0i = w0 * inv;
                const size_t poff = (size_t)row * 128 + 4 * h2;
                bf16_t* ao = P.attn + (size_t)(row >> 3) * DM + (row & 7) * 128 + 4 * h2;
#pragma unroll
                for (int db = 0; db < 4; ++db) {
                    u32x2 pv[3][4];
#pragma unroll
                    for (int s2 = 0; s2 < 3; ++s2)
#pragma unroll
                        for (int rq = 0; rq < 4; ++rq) { pv[s2][rq] = (u32x2){0u, 0u}; if (s2 < nsel) pv[s2][rq] = *(const u32x2*)(P.part[s2 + 1] + poff + 32 * db + 8 * rq); }
#pragma unroll
                    for (int rq = 0; rq < 4; ++rq) {
                        float a0 = o[db][4 * rq] * w0i, a1 = o[db][4 * rq + 1] * w0i, a2 = o[db][4 * rq + 2] * w0i, a3 = o[db][4 * rq + 3] * w0i;
#pragma unroll
                        for (int s2 = 0; s2 < 3; ++s2) { const float wv = ws[s2] * inv; a0 += wv * bf_lo(pv[s2][rq].x); a1 += wv * bf_hi(pv[s2][rq].x); a2 += wv * bf_lo(pv[s2][rq].y); a3 += wv * bf_hi(pv[s2][rq].y); }
                        u32x2 w; w.x = pk_bf16(a0, a1); w.y = pk_bf16(a2, a3);
                        *(u32x2*)(ao + 32 * db + 8 * rq) = w;
                    }
                }
            }
        }
        __builtin_amdgcn_s_setprio(0);
        __syncthreads();
    }
}

DI void phase_combine(const Params& P) {
    const int tid = threadIdx.x, wave = tid >> 6, lane = tid & 63;
    const int gw = blockIdx.x * 8 + wave, NGW = gridDim.x * 8;
    for (int row = gw; row < T_TOK * 8; row += NGW) {
        const int t = row >> 3, hq = row & 7, own = (t & (SEQ - 1)) >> 8, nsel = own < 3 ? own : 3;
        float m[4], l[4];
#pragma unroll
        for (int s = 0; s < 4; ++s) { if (s <= nsel) { const f32x2 ml = *(const f32x2*)(P.part_ml + ((size_t)row * 4 + s) * 2); m[s] = ml.x; l[s] = ml.y; } else { m[s] = -1e30f; l[s] = 0.f; } }
        const float M = fmaxf(fmaxf(m[0], m[1]), fmaxf(m[2], m[3]));
        float o0 = 0.f, o1 = 0.f, L = 0.f;
#pragma unroll
        for (int s = 0; s < 4; ++s) {
            if (s <= nsel) {
                const float w = l[s] * __expf(m[s] - M); L += w;
                const unsigned v = *(const unsigned*)(P.part[s] + (size_t)row * 128 + 2 * lane);
                o0 += w * bf_lo(v); o1 += w * bf_hi(v);
            }
        }
        const float inv = 1.f / L;
        *(unsigned*)(P.attn + (size_t)t * DM + hq * 128 + 2 * lane) = cvt_pk_bf16(o0 * inv, o1 * inv);
    }
}

DI void phase_final(const Params& P) {
    const int tid = threadIdx.x, wave = tid >> 6, lane = tid & 63;
    const int gw = blockIdx.x * 8 + wave, NGW = gridDim.x * 8;
    for (int row = gw; row < T_TOK; row += NGW) {
        const float rs = rsqrtf(P.rowss[6 * T_TOK + row] * (1.f / DM) + RMS_EPS);
        const f32x4* xr = (const f32x4*)(P.xres + (size_t)row * DM) + lane;
        const f32x4* gr = (const f32x4*)P.final_g + lane;
        f32x4* o = (f32x4*)(P.out + (size_t)row * DM) + lane;
#pragma unroll
        for (int j = 0; j < 4; ++j) o[64 * j] = xr[64 * j] * rs * gr[64 * j];
    }
}

DI void phase_final_fused(const Params& P, LAS unsigned char* lds, int vbid) {
    pg8::StaticOrder S; S.init(T_TOK, DM, gridDim.x, vbid);
    pg8::Unit u;
    if (!S.next(0, u)) return;
    const int tid = threadIdx.x, wave = tid >> 6, lane = tid & 63;
    asm volatile("s_waitcnt vmcnt(0)" ::: "memory");
    __syncthreads();
    LAS int* flag = (LAS int*)lds;
    if (tid == 0) flag[0] = atomicAdd(P.pcnt + u.pm, 1);
    __syncthreads();
    if (flag[0] != 3) return;
    __builtin_amdgcn_fence(__ATOMIC_ACQUIRE, "agent");
    asm volatile("s_waitcnt vmcnt(0)" ::: "memory");
    const f32x4* gr = (const f32x4*)P.final_g + lane;
    const f32x4 g0 = gr[0], g1 = gr[64], g2 = gr[128], g3 = gr[192];
#pragma unroll 1
    for (int r0 = wave * 32; r0 < wave * 32 + 32; r0 += 4) {
        f32x4 v[4][4]; float ss[4];
#pragma unroll
        for (int i = 0; i < 4; ++i) {
            const int row = u.pm * 256 + r0 + i;
            const f32x4* xr = (const f32x4*)(P.xres + (size_t)row * DM) + lane;
            ss[i] = P.rowss[6 * T_TOK + row];
            v[i][0] = xr[0]; v[i][1] = xr[64]; v[i][2] = xr[128]; v[i][3] = xr[192];
        }
#pragma unroll
        for (int i = 0; i < 4; ++i) {
            const int row = u.pm * 256 + r0 + i;
            const float rs = rsqrtf(ss[i] * (1.f / DM) + RMS_EPS);
            f32x4* o = (f32x4*)(P.out + (size_t)row * DM) + lane;
            o[0] = v[i][0] * rs * g0; o[64] = v[i][1] * rs * g1; o[128] = v[i][2] * rs * g2; o[192] = v[i][3] * rs * g3;
        }
    }
}

#define XB_TMO      128
#define XB_XCNT(j)  (256  + 64 * (j))
#define XB_XSUB(j)  (1280 + 64 * (j))
#define XB_XGEN(j)  (2304 + 64 * (j))
#define XB_TOP      3328
#define XB_TOPGEN   3392
#define XCD_BAR_WORDS 3456
#define XB_SPIN_CAP (1u << 18)
DI unsigned xb_ld(unsigned* p)              { return __hip_atomic_load(p, __ATOMIC_RELAXED, __HIP_MEMORY_SCOPE_AGENT); }
DI unsigned xb_add(unsigned* p, unsigned v) { return __hip_atomic_fetch_add(p, v, __ATOMIC_RELAXED, __HIP_MEMORY_SCOPE_AGENT); }
DI unsigned xb_xcc_id() { return (unsigned)__builtin_amdgcn_s_getreg((3 << 11) | 20) & 0xFu; }
#define XB_SPIN(cond, bar) do { unsigned _sp = 0; while (cond) { __builtin_amdgcn_s_sleep(1); \
    if ((++_sp & 255u) == 0u) { if (xb_ld(&(bar)[XB_TMO])) break; if (_sp > XB_SPIN_CAP) { atomicAdd(&(bar)[XB_TMO], 1u); break; } } } } while (0)
struct XcdBarrier { unsigned* bar; unsigned x; volatile LAS unsigned* st; };
DI XcdBarrier xcd_barrier_post(unsigned* bar, volatile LAS unsigned* st) {
    XcdBarrier b; b.bar = bar; b.x = xb_xcc_id(); b.st = st;
    if (threadIdx.x == 0) (void)xb_add(&bar[XB_XCNT(b.x)], 1u);
    return b;
}
DI void xcd_barrier_complete(unsigned* bar, unsigned x, unsigned& nloc, unsigned& nx) {
    const unsigned G = gridDim.x * gridDim.y * gridDim.z;
    unsigned sum, cnt, mine, sp = 0u;
    for (;;) {
        sum = 0u; cnt = 0u; mine = 0u;
#pragma unroll
        for (unsigned j = 0; j < 16; ++j) { const unsigned c = xb_ld(&bar[XB_XCNT(j)]); sum += c; cnt += (c > 0u) ? 1u : 0u; mine = (j == x) ? c : mine; }
        if (sum == G) break;
        __builtin_amdgcn_s_sleep(1);
        if ((++sp & 255u) == 0u) { if (xb_ld(&bar[XB_TMO])) break; if (sp > XB_SPIN_CAP) { atomicAdd(&bar[XB_TMO], 1u); break; } }
    }
    nloc = mine > 0u ? mine : 1u; nx = cnt > 0u ? cnt : 1u;
}
DI void xcd_barrier(const XcdBarrier& b) {
    asm volatile("s_waitcnt vmcnt(0)" ::: "memory");
    __syncthreads();
    if (threadIdx.x == 0) {
        unsigned* bar = b.bar;
        __builtin_amdgcn_s_waitcnt(0);
        unsigned nloc = b.st[0], nx = b.st[1];
        if (nloc == 0u) { xcd_barrier_complete(bar, b.x, nloc, nx); b.st[0] = nloc; b.st[1] = nx; }
        const unsigned old = xb_add(&bar[XB_XSUB(b.x)], 1u);
        const unsigned gen = old / nloc;
        if (old + 1u == (gen + 1u) * nloc) {
            __builtin_amdgcn_fence(__ATOMIC_RELEASE, "agent");
            asm volatile("s_waitcnt vmcnt(0)" ::: "memory");
            const unsigned og = xb_add(&bar[XB_TOP], 1u);
            const unsigned tg = og / nx;
            if (og + 1u == (tg + 1u) * nx) xb_add(&bar[XB_TOPGEN], 1u);
            else XB_SPIN(xb_ld(&bar[XB_TOPGEN]) == tg, bar);
            __builtin_amdgcn_fence(__ATOMIC_ACQUIRE, "agent");
            xb_add(&bar[XB_XGEN(b.x)], 1u);
            asm volatile("s_waitcnt vmcnt(0)" ::: "memory");
        } else {
            XB_SPIN(xb_ld(&bar[XB_XGEN(b.x)]) == gen, bar);
            __builtin_amdgcn_fence(__ATOMIC_ACQUIRE, "agent");
            asm volatile("s_waitcnt vmcnt(0)" ::: "memory");
        }
    }
    __syncthreads();
}

constexpr int NPHASES = 18;
#ifndef PHMASK
#define PHMASK 0xFFFFF
#endif
#define PHON(n) if constexpr (((PHMASK) >> (n)) & 1)
#ifndef DUPSEL
#define DUPSEL 0
#endif
__global__ void __launch_bounds__(512, 2) mega_fwd(const Params P) {
    extern __shared__ __attribute__((aligned(16))) unsigned char smem[];
    LAS unsigned char* lds = (LAS unsigned char*)smem;
    cg::grid_group grid = cg::this_grid();
    if (P.ph_hi < 0) grid.sync();
    volatile LAS unsigned* xst = (volatile LAS unsigned*)(lds + 139264);
    if (threadIdx.x == 0) { xst[0] = 0u; xst[1] = 0u; xst[2] = 0u; xst[3] = 0u; xst[4] = 0u; }
    __syncthreads();
    XcdBarrier xb; xb.bar = P.bar; xb.x = xb_xcc_id(); xb.st = xst;
    if (threadIdx.x == 0) xst[2] = xb_add(&P.bar[XB_XCNT(xb.x)], 1u);
    PHON(0) if (P.ph_lo <= 0 && 0 < P.ph_hi) { phase_prep(P, lds); }
    if constexpr (DUPSEL == 4) { xcd_barrier(xb); phase_prep(P, lds); }
    if (P.ph_lo < 1 && 1 < P.ph_hi) xcd_barrier(xb);
    if (threadIdx.x == 0) {
        bool ok = (gridDim.x % 8u) == 0u;
        for (unsigned j = 0; j < 16; ++j) { const unsigned c = xb_ld(&P.bar[XB_XCNT(j)]); ok = ok && (c == (j < 8 ? gridDim.x / 8u : 0u)); }
        xst[3] = ok ? (xb.x + 8u * xst[2]) : blockIdx.x; xst[4] = ok ? 1u : 0u;
    }
    __syncthreads();
    const int vbid = (int)xst[3];
    const bool vb_ok = xst[4] != 0u;
    preload_rs(lds, vbid, P.rowss + 0 * T_TOK, 5632); run_gemm_v(lds, vbid, P.xb, P.wt_up[0], 5632, DM, EpiAct{P.act, P.rowss + 0 * T_TOK, P.kbuf, P.vT, P.rope, (const LAS float*)(lds + 131072)});
    convert_by_light_blocks(P, lds, vbid, 64 * 22, P.it1, P.it2);
    if constexpr (DUPSEL == 2) { xcd_barrier(xb); preload_rs(lds, vbid, P.rowss + 0 * T_TOK, 5632); run_gemm_v(lds, vbid, P.xb, P.wt_up[0], 5632, DM, EpiAct{P.act, P.rowss + 0 * T_TOK, P.kbuf, P.vT, P.rope, (const LAS float*)(lds + 131072)}); }
    if (P.ph_lo < 2 && 2 < P.ph_hi) xcd_barrier(xb);
    PHON(2) if (P.ph_lo <= 2 && 2 < P.ph_hi) { run_gemm_v(lds, vbid, P.act, P.wt_dn[0], DM, FF, EpiRes{P.x, P.xres, P.xb, P.rowss + 1 * T_TOK, 0.5f}); }
    if (P.ph_lo < 3 && 3 < P.ph_hi) xcd_barrier(xb);
    PHON(3) if (P.ph_lo <= 3 && 3 < P.ph_hi) { phase_s5a(P, lds); }
    xcd_barrier(xb);
    phase_s5carry(P);
    if (P.ph_lo < 4 && 4 < P.ph_hi) xcd_barrier(xb);
    PHON(4) if (P.ph_lo <= 4 && 4 < P.ph_hi) { phase_s5b(P, lds); }
    if constexpr (DUPSEL == 3) { xcd_barrier(xb); phase_s5a(P, lds); xcd_barrier(xb); phase_s5carry(P); xcd_barrier(xb); phase_s5b(P, lds); }

    if (P.ph_lo < 5 && 5 < P.ph_hi) xcd_barrier(xb);
    PHON(5) if (P.ph_lo <= 5 && 5 < P.ph_hi) { run_gemm_v(lds, vbid, P.yb, P.wt_glu, 2048, DM, EpiGlu{P.xres, P.xb, P.rowss + 2 * T_TOK}); }
    if (P.ph_lo < 6 && 6 < P.ph_hi) xcd_barrier(xb);
    PHON(6) if (P.ph_lo <= 6 && 6 < P.ph_hi) { preload_rs(lds, vbid, P.rowss + 2 * T_TOK, 5632); run_gemm_v(lds, vbid, P.xb, P.wt_up[1], 5632, DM, EpiAct{P.act, P.rowss + 2 * T_TOK, P.kbuf, P.vT, P.rope, (const LAS float*)(lds + 131072)}); convert_by_light_blocks(P, lds, vbid, 64 * 22, P.it2, P.nitems); }
    if (P.ph_lo < 7 && 7 < P.ph_hi) xcd_barrier(xb);
    PHON(7) if (P.ph_lo <= 7 && 7 < P.ph_hi) { run_gemm_v(lds, vbid, P.act, P.wt_dn[1], DM, FF, EpiRes{P.xres, P.xres, P.xb, P.rowss + 3 * T_TOK, 0.5f}); }
    if (P.ph_lo < 8 && 8 < P.ph_hi) xcd_barrier(xb);
    PHON(8) if (P.ph_lo <= 8 && 8 < P.ph_hi) { preload_rs(lds, vbid, P.rowss + 3 * T_TOK, 6144); run_gemm_v(lds, vbid, P.xb, P.wt_up[2], 6144, DM, EpiAct{P.act, P.rowss + 3 * T_TOK, P.kbuf, P.vT, P.rope, (const LAS float*)(lds + 131072)}); }
    if (P.ph_lo < 9 && 9 < P.ph_hi) xcd_barrier(xb);
    PHON(9) if (P.ph_lo <= 9 && 9 < P.ph_hi) { run_gemm_v(lds, vbid, P.act, P.wt_dn[2], DM, FF, EpiRes{P.xres, P.xres, P.xb, P.rowss + 4 * T_TOK, 0.5f}); phase_kmean(P, lds); }
    if (P.ph_lo < 10 && 10 < P.ph_hi) xcd_barrier(xb);
    PHON(10) if (P.ph_lo <= 10 && 10 < P.ph_hi) { run_gemm_v(lds, vbid, P.xb, P.wt_q, DM, DM, EpiQ{P.qbuf, P.rowss + 4 * T_TOK, P.rope}); }
    if (P.ph_lo < 11 && 11 < P.ph_hi) xcd_barrier(xb);
    PHON(11) if (P.ph_lo <= 11 && 11 < P.ph_hi) { phase_gate(P, lds); }
    if (P.ph_lo < 12 && 12 < P.ph_hi) xcd_barrier(xb);
    PHON(12) if (P.ph_lo <= 12 && 12 < P.ph_hi) { phase_attn<false>(P, lds); }
    if constexpr (DUPSEL == 6) { xcd_barrier(xb); phase_attn<false>(P, lds); }
    if (P.ph_lo < 13 && 13 < P.ph_hi) xcd_barrier(xb);
    PHON(13) if (P.ph_lo <= 13 && 13 < P.ph_hi) { phase_attn<true>(P, lds); }
    if constexpr (DUPSEL == 1) { for (int i = 0; i < 8; ++i) xcd_barrier(xb); }
    if (P.ph_lo < 14 && 14 < P.ph_hi) xcd_barrier(xb);
    PHON(14) if (P.ph_lo <= 14 && 14 < P.ph_hi) { run_gemm_v(lds, vbid, P.attn, P.wt_o, DM, DM, EpiRes{P.xres, P.xres, P.xb, P.rowss + 5 * T_TOK, 1.0f}); }
    if (P.ph_lo < 15 && 15 < P.ph_hi) xcd_barrier(xb);
    PHON(15) if (P.ph_lo <= 15 && 15 < P.ph_hi) { preload_rs(lds, vbid, P.rowss + 5 * T_TOK, 5632); run_gemm_v(lds, vbid, P.xb, P.wt_up[3], 5632, DM, EpiAct{P.act, P.rowss + 5 * T_TOK, P.kbuf, P.vT, P.rope, (const LAS float*)(lds + 131072)}); }
    if (P.ph_lo < 16 && 16 < P.ph_hi) xcd_barrier(xb);
    PHON(16) if (P.ph_lo <= 16 && 16 < P.ph_hi) { run_gemm_v(lds, vbid, P.act, P.wt_dn[3], DM, FF, EpiRes{P.xres, P.xres, P.xb, P.rowss + 6 * T_TOK, 0.5f}); }
    if (vb_ok && gridDim.x == 256u) { phase_final_fused(P, lds, vbid); }
    else { xcd_barrier(xb); phase_final(P); }
}

extern "C" void kernel_launch(void* const* d_in, const int* in_sizes, int n_in, void* d_out, int out_size, void* d_ws, size_t ws_size, hipStream_t stream) {
    static int grid_blocks = 0;
    if (!grid_blocks) {
        int dev = 0, cus = 0, per_cu = 0;
        hipGetDevice(&dev);
        hipDeviceGetAttribute(&cus, hipDeviceAttributeMultiprocessorCount, dev);
        hipFuncSetAttribute((const void*)mega_fwd, hipFuncAttributeMaxDynamicSharedMemorySize, LDS_BYTES);
        hipOccupancyMaxActiveBlocksPerMultiprocessor(&per_cu, (const void*)mega_fwd, 512, LDS_BYTES);
        if (per_cu < 1) per_cu = 1;
        if (per_cu > 1) per_cu = 1;
        grid_blocks = cus * per_cu;
    }
    Params p{};
    const float** in = (const float**)&p.x;
    for (int i = 0; i < 19; ++i) in[i] = (const float*)d_in[i];
    p.out = (float*)d_out;
    unsigned char* ws = (unsigned char*)d_ws; size_t off = 0;
    auto take = [&](size_t bytes) { unsigned char* r = ws + off; off += (bytes + 255) & ~(size_t)255; return r; };
    p.xres = (float*)take((size_t)T_TOK * DM * 4);
    p.xb = (bf16_t*)take((size_t)T_TOK * DM * 2);
    p.act = (bf16_t*)take((size_t)T_TOK * FF * 2);
    p.qbuf = p.act;
    p.attn = p.act + (size_t)T_TOK * DM;
    p.part_ml = (float*)(p.act + (size_t)2 * T_TOK * DM);
    p.kbuf = (bf16_t*)take((size_t)T_TOK * 256 * 2);
    p.vT = (bf16_t*)take((size_t)T_TOK * 256 * 2);
    p.kmean = (float*)take(128 * 128 * 4);
    p.rowss = (float*)take((size_t)7 * T_TOK * 4 + 1024);
    p.gcount = (int*)(p.rowss + 7 * T_TOK);
    p.E = (float*)take((size_t)2 * 128 * 64 * 64 * 2 * 4);
    p.lists = (int*)p.E;
    p.rope = (float*)take((size_t)SEQ * 16 * 2 * 4);
    p.bar = (unsigned*)take((size_t)XCD_BAR_WORDS * 4);
    p.s5tab = (float*)take(4096 * 4 * 4);
    p.pcnt = (int*)take(256);
    p.wt_up[0] = (bf16_t*)take((size_t)6144 * DM * 2); p.wt_up[1] = (bf16_t*)take((size_t)6144 * DM * 2);
    p.wt_dn[0] = (bf16_t*)take((size_t)DM * FF * 2); p.wt_dn[1] = (bf16_t*)take((size_t)DM * FF * 2);
    p.wt_glu = (bf16_t*)take((size_t)2048 * DM * 2);
    p.wt_up[2] = (bf16_t*)take((size_t)6144 * DM * 2); p.wt_up[3] = (bf16_t*)take((size_t)6144 * DM * 2);
    p.wt_dn[2] = (bf16_t*)take((size_t)DM * FF * 2); p.wt_dn[3] = (bf16_t*)take((size_t)DM * FF * 2);
    p.wt_q = (bf16_t*)take((size_t)DM * DM * 2);
    p.wt_o = (bf16_t*)take((size_t)DM * DM * 2);
    p.part[0] = p.xb;
    p.part[1] = (bf16_t*)take((size_t)T_TOK * DM * 2);
    p.part[2] = (bf16_t*)take((size_t)T_TOK * DM * 2);
    p.part[3] = p.wt_up[0];
    p.yb = p.part[1];
    int nj = 0, items = 0;
    auto job = [&](const float* W, const float* g, bf16_t* dst, int K, int Nsrc, int ndst, int mode) {
        WJob& J = p.jobs[nj++]; J.W = W; J.g = g; J.dst = dst; J.K = K; J.Nsrc = Nsrc; J.ndst = ndst; J.mode = mode; J.item0 = items; J.pad = 0;
        items += (K / 64) * (ndst / 32);
    };
    auto job_up = [&](int l, int f) { job(p.ffn_w_in + (size_t)(l * 2 + f) * DM * 2 * FF, p.norm_g + (size_t)(l * 3 + (f ? 2 : 0)) * DM, p.wt_up[l * 2 + f], DM, 2 * FF, 2 * FF, 1); };
    auto job_dn = [&](int l, int f) { job(p.ffn_w_out + (size_t)(l * 2 + f) * FF * DM, nullptr, p.wt_dn[l * 2 + f], FF, DM, DM, 0); };
    job_up(0, 0);
    p.it1 = items;
    job_dn(0, 0); job(p.w_glu, nullptr, p.wt_glu, DM, 2048, 2048, 1); job_up(0, 1); job_dn(0, 1);
    p.it2 = items;
    job_up(1, 0);
    job(p.w_k, p.kv_norm_g, p.wt_up[2] + (size_t)5632 * DM, DM, 256, 256, 0);
    job(p.w_v, p.kv_norm_g, p.wt_up[2] + (size_t)5888 * DM, DM, 256, 256, 0);
    job_dn(1, 0); job_up(1, 1); job_dn(1, 1);
    job(p.w_q, p.norm_g + (size_t)4 * DM, p.wt_q, DM, DM, DM, 0);
    job(p.w_o, nullptr, p.wt_o, DM, DM, DM, 0);
    p.nitems = items; p.ph_lo = 0; p.ph_hi = NPHASES; p.pad = 0;
    if (off > ws_size) { fprintf(stderr, "workspace too small: need %zu have %zu\n", off, ws_size); return; }
    (void)hipMemsetAsync(p.bar, 0, (size_t)XCD_BAR_WORDS * 4, stream);
    void* args[] = {&p};
    hipError_t e = hipLaunchCooperativeKernel((const void*)mega_fwd, dim3(grid_blocks), dim3(512), args, LDS_BYTES, stream);
    if (e != hipSuccess) fprintf(stderr, "cooperative launch failed: %s (grid %d)\n", hipGetErrorString(e), grid_blocks);
}
```

```cpp
#include <hip/hip_runtime.h>
#include <hip/hip_cooperative_groups.h>
#include <cstdio>
namespace cg = cooperative_groups;

#define LAS __attribute__((address_space(3)))
#define DI __device__ __forceinline__
typedef unsigned short bf16_t;
typedef short bf16x8 __attribute__((ext_vector_type(8)));
typedef float f32x4 __attribute__((ext_vector_type(4)));
typedef float f32x2 __attribute__((ext_vector_type(2)));
typedef unsigned u32x4 __attribute__((ext_vector_type(4)));
typedef unsigned u32x2 __attribute__((ext_vector_type(2)));

constexpr int T_TOK = 16384, DM = 1024, FF = 2816, SEQ = 8192;
constexpr float RMS_EPS = 1e-6f;
constexpr int LDS_BYTES = 139296;
constexpr int NJOBS = 13;

struct WJob { const float* W; const float* g; bf16_t* dst; int K; int Nsrc; int ndst; int mode; int item0; int pad; };

struct Params {
    const float *x, *norm_g, *ffn_w_in, *ffn_w_out, *a_re, *a_im, *log_step, *b_re, *b_im, *c_re, *c_im, *s5_d, *w_glu, *kv_norm_g, *w_k, *w_v, *w_q, *w_o, *final_g;
    float* out;
    float* xres; bf16_t* xb; bf16_t* act; bf16_t* yb; bf16_t* qbuf; bf16_t* attn; bf16_t* kbuf; bf16_t* vbuf;
    float* kmean; float* rowss; float* E; float* rope;
    bf16_t* vT; bf16_t* part[4]; float* part_ml; int* lists; int* gcount; unsigned* bar; float* s5tab; int* pcnt;
    bf16_t* wt_up[4]; bf16_t* wt_dn[4]; bf16_t* wt_glu; bf16_t* wt_q; bf16_t* wt_o;
    WJob jobs[NJOBS];
    int nitems; int ph_lo; int ph_hi; int pad; int it1; int it2;
};

DI unsigned cvt_pk_bf16(float lo, float hi) { unsigned r; asm volatile("v_cvt_pk_bf16_f32 %0, %1, %2" : "=v"(r) : "v"(lo), "v"(hi)); return r; }
DI float bf_lo(unsigned w) { return __uint_as_float(w << 16); }
DI float bf_hi(unsigned w) { return __uint_as_float(w & 0xffff0000u); }
DI float wave_sum(float v) {
#pragma unroll
    for (int o = 1; o < 64; o <<= 1) v += __shfl_xor(v, o);
    return v;
}
DI float wave_max(float v) {
#pragma unroll
    for (int o = 1; o < 64; o <<= 1) v = fmaxf(v, __shfl_xor(v, o));
    return v;
}

namespace pg8 {
constexpr int BM = 256, BK = 64, HALF = 128, HTB = HALF * BK * 2, NXCD = 8, WGM = 8;
DI int lds_byte(int r, int c) { const int st = (r >> 4) * 2 + (c >> 5), rr = r & 15, cc = c & 31, ob = rr * 64 + cc * 2; return st * 1024 + (ob ^ (((ob >> 9) & 1) << 5)); }
DI void stage_rc(int b, int& R, int& C) { const int st = b / 1024, sb = b % 1024, swz = sb ^ (((sb >> 9) & 1) << 5); R = (st >> 1) * 16 + swz / 64; C = (st & 1) * 32 + (swz % 64) / 2; }
struct Unit { int pm, pn; };
struct Gemm { const bf16_t* A; const bf16_t* Bt; int M, N, K; };
struct StaticOrder {
    int nM, nN, nwg, G, c;
    DI void init(int M, int N, int G_, int c_) { nM = M / BM; nN = N / BM; nwg = nM * nN; G = G_; c = c_; }
    DI bool next(int i, Unit& u) const {
        const long L = (long)i * G + c; if (L >= nwg) return false;
        int wgid = (int)L; { const int q = nwg / NXCD, r = nwg % NXCD, xcd = wgid % NXCD, off = wgid / NXCD; wgid = (xcd < r ? xcd * (q + 1) : r * (q + 1) + (xcd - r) * q) + off; }
        const int nig = WGM * nN, gid = wgid / nig, fm = gid * WGM, gsz = (nM - fm) < WGM ? (nM - fm) : WGM;
        u.pm = fm + ((wgid % nig) % gsz); u.pn = (wgid % nig) / gsz; return true;
    }
};

template <class Epi>
DI void gemm_phase(LAS unsigned char* lds, const Gemm g, const StaticOrder& S, const Epi& E) {
    int tid_ = threadIdx.x; asm volatile("" : "+v"(tid_));
    const int tid = tid_, wid = __builtin_amdgcn_readfirstlane(tid >> 6), lane = tid & 63, wr = wid >> 2, wc = wid & 3, fr = lane & 15, fq = lane >> 4;
    const int K = g.K, nt = K / BK;
    unsigned voffA[2], voffB[2];
#pragma unroll
    for (int i = 0; i < 2; ++i) { int R, C; stage_rc(tid * 16 + i * 8192, R, C); voffA[i] = (unsigned)(R * K + C) * 2u; voffB[i] = voffA[i]; }
    const size_t kstep = (size_t)(BK * 2);
    const size_t hstep = (size_t)HALF * K * 2;
    const size_t tstep = 2 * hstep;
    const unsigned ldsw = (unsigned)wid * 1024u;
    const int aoff = lds_byte(wr * 64 + fr, fq * 8), boff = lds_byte(wc * 32 + fr, fq * 8);
#define PG8_SA(b, h) (((b) * 2 + (h)) * HTB)
#define PG8_SB(b, h) ((4 + (b) * 2 + (h)) * HTB)
#define PG8_STAGE(bufoff, gbase, voff) do { _Pragma("unroll") for (int _i = 0; _i < 2; ++_i) \
        __builtin_amdgcn_global_load_lds((const unsigned*)((const char*)(gbase) + (voff)[_i]), (LAS unsigned*)(lds + (bufoff) + ldsw + _i * 8192), 16, 0, 0); } while (0)
#define PG8_LDA(dst, b, h) do { _Pragma("unroll") for (int m = 0; m < 4; ++m) _Pragma("unroll") for (int k = 0; k < 2; ++k) dst[m][k] = *(const LAS bf16x8*)(lds + PG8_SA(b, h) + aoff + m * 2048 + k * 1024); } while (0)
#define PG8_LDB(dst, b, h) do { _Pragma("unroll") for (int n = 0; n < 2; ++n) _Pragma("unroll") for (int k = 0; k < 2; ++k) dst[n][k] = *(const LAS bf16x8*)(lds + PG8_SB(b, h) + boff + n * 2048 + k * 1024); } while (0)
#define PG8_MMA(ai, bj, At, Bt) do { __builtin_amdgcn_s_setprio(1); _Pragma("unroll") for (int m = 0; m < 4; ++m) _Pragma("unroll") for (int n = 0; n < 2; ++n) _Pragma("unroll") for (int k = 0; k < 2; ++k) \
        acc[ai][bj][m][n] = __builtin_amdgcn_mfma_f32_16x16x32_bf16(Bt[n][k], At[m][k], acc[ai][bj][m][n], 0, 0, 0); __builtin_amdgcn_s_setprio(0); } while (0)
#define PG8_WAIT_V(n) asm volatile("s_waitcnt vmcnt(" #n ")" ::: "memory")
#define PG8_WAIT_L(n) asm volatile("s_waitcnt lgkmcnt(" #n ")" ::: "memory")
#define PG8_BAR __builtin_amdgcn_s_barrier()
#define PG8_SCHED __builtin_amdgcn_sched_barrier(0)
    Unit cur, nxt; int ui = 0;
    if (!S.next(0, cur)) return;
    f32x4 acc[2][2][4][2];
#pragma unroll
    for (int a = 0; a < 2; ++a)
#pragma unroll
        for (int b = 0; b < 2; ++b)
#pragma unroll
            for (int m = 0; m < 4; ++m)
#pragma unroll
                for (int n = 0; n < 2; ++n) acc[a][b][m][n] = (f32x4){0.f, 0.f, 0.f, 0.f};
    bf16x8 At[4][2], B0[2][2], B1[2][2];
    const char* cA = (const char*)g.A + (size_t)cur.pm * tstep; const char* cB = (const char*)g.Bt + (size_t)cur.pn * tstep;
    PG8_STAGE(PG8_SB(0, 0), cB, voffB); PG8_STAGE(PG8_SA(0, 0), cA, voffA); PG8_STAGE(PG8_SB(0, 1), cB + hstep, voffB); PG8_STAGE(PG8_SA(0, 1), cA + hstep, voffA);
    if (wr == 1) PG8_BAR;
    PG8_WAIT_V(4); PG8_BAR;
    PG8_STAGE(PG8_SB(1, 0), cB + kstep, voffB); PG8_STAGE(PG8_SA(1, 0), cA + kstep, voffA); PG8_STAGE(PG8_SB(1, 1), cB + hstep + kstep, voffB);
    PG8_WAIT_V(6); PG8_BAR;
    for (;;) {
        const bool has_next = S.next(ui + 1, nxt);
        const char* nA = has_next ? (const char*)g.A + (size_t)nxt.pm * tstep : cA; const char* nB = has_next ? (const char*)g.Bt + (size_t)nxt.pn * tstep : cB;
        for (int t = 0; t < nt; t += 2) {
            const bool last = (t == nt - 2);
            const char* a1 = cA + (size_t)(t + 1) * kstep;
            const char* a2 = last ? nA : cA + (size_t)(t + 2) * kstep; const char* b2 = last ? nB : cB + (size_t)(t + 2) * kstep;
            const char* a3 = a2 + kstep; const char* b3 = b2 + kstep;
            PG8_LDB(B0, 0, 0); PG8_SCHED; PG8_LDA(At, 0, 0); PG8_STAGE(PG8_SA(1, 1), a1 + hstep, voffA);
            PG8_WAIT_L(8); PG8_BAR; PG8_WAIT_L(0); PG8_MMA(0, 0, At, B0); PG8_BAR; PG8_SCHED;
            PG8_LDB(B1, 0, 1); PG8_STAGE(PG8_SB(0, 0), b2, voffB);
            PG8_BAR; PG8_WAIT_L(0); PG8_MMA(0, 1, At, B1); PG8_BAR;
            PG8_LDA(At, 0, 1); PG8_STAGE(PG8_SA(0, 0), a2, voffA);
            PG8_BAR; PG8_WAIT_L(0); PG8_MMA(1, 0, At, B0); PG8_BAR; PG8_SCHED;
            PG8_STAGE(PG8_SB(0, 1), b2 + hstep, voffB);
            PG8_WAIT_V(6); PG8_BAR; PG8_MMA(1, 1, At, B1); PG8_BAR;
            PG8_LDB(B0, 1, 0); PG8_SCHED; PG8_LDA(At, 1, 0); PG8_STAGE(PG8_SA(0, 1), a2 + hstep, voffA);
            PG8_WAIT_L(8); PG8_BAR; PG8_WAIT_L(0); PG8_MMA(0, 0, At, B0); PG8_BAR; PG8_SCHED;
            PG8_LDB(B1, 1, 1); PG8_STAGE(PG8_SB(1, 0), b3, voffB);
            PG8_BAR; PG8_WAIT_L(0); PG8_MMA(0, 1, At, B1); PG8_BAR;
            PG8_LDA(At, 1, 1); PG8_STAGE(PG8_SA(1, 0), a3, voffA);
            PG8_BAR; PG8_WAIT_L(0); PG8_MMA(1, 0, At, B0); PG8_BAR; PG8_SCHED;
            PG8_STAGE(PG8_SB(1, 1), b3 + hstep, voffB);
            PG8_WAIT_V(6); PG8_BAR; PG8_MMA(1, 1, At, B1); PG8_BAR;
        }
        E(acc, cur, wr, wc, fr, fq, ui);
        if (!has_next) break;
#pragma unroll
        for (int a = 0; a < 2; ++a)
#pragma unroll
            for (int b = 0; b < 2; ++b)
#pragma unroll
                for (int m = 0; m < 4; ++m)
#pragma unroll
                    for (int n = 0; n < 2; ++n) acc[a][b][m][n] = (f32x4){0.f, 0.f, 0.f, 0.f};
        cur = nxt; cA = nA; cB = nB; ++ui;
    }
    PG8_WAIT_V(0);
    if (wr == 0) PG8_BAR;
    PG8_BAR;
#undef PG8_SA
#undef PG8_SB
#undef PG8_STAGE
#undef PG8_LDA
#undef PG8_LDB
#undef PG8_MMA
#undef PG8_WAIT_V
#undef PG8_WAIT_L
#undef PG8_BAR
#undef PG8_SCHED
}
}
using pg8::Unit;
typedef f32x4 AccT[2][2][4][2];

DI void store_bf4(bf16_t* p, f32x4 v) { u32x2 o; o.x = cvt_pk_bf16(v.x, v.y); o.y = cvt_pk_bf16(v.z, v.w); *(u32x2*)p = o; }
DI float sigmoidf_(float x) { return __builtin_amdgcn_rcpf(1.f + __builtin_amdgcn_exp2f(-1.4426950408889634f * x)); }

struct EpiAct {
    bf16_t* act; const float* rowss; bf16_t* kbuf; bf16_t* vbuf; const float* rope; const LAS float* rsl;
    DI void operator()(const AccT& acc, const Unit& u, int wr, int wc, int fr, int fq, int ui) const {
        const int row0 = u.pm * 256 + wr * 64 + fr;
        if (u.pn < 22) {
#pragma unroll
            for (int ai = 0; ai < 2; ++ai)
#pragma unroll
                for (int m = 0; m < 4; ++m) {
                    const int row = row0 + ai * 128 + m * 16;
                    const float rs = rsl[ui * 256 + wr * 64 + fr + ai * 128 + m * 16];
#pragma unroll
                    for (int bj = 0; bj < 2; ++bj) {
                        const f32x4 gt = acc[ai][bj][m][0] * rs, up = acc[ai][bj][m][1] * rs;
                        f32x4 a;
#pragma unroll
                        for (int j = 0; j < 4; ++j) a[j] = gt[j] * sigmoidf_(gt[j]) * up[j];
                        const int col = 16 * (8 * u.pn + 4 * bj + wc) + 4 * fq;
                        store_bf4(act + (size_t)row * FF + col, a);
                    }
                }
        } else if (u.pn == 22) {
            const bool do_rope = (wc == 0);
#pragma unroll
            for (int ai = 0; ai < 2; ++ai)
#pragma unroll
                for (int m = 0; m < 4; ++m) {
                    const int row = row0 + ai * 128 + m * 16;
                    const float rs = rsqrtf(rowss[row] * (1.f / DM) + RMS_EPS);
                    const int b = row >> 13, pos = row & (SEQ - 1);
#pragma unroll
                    for (int bj = 0; bj < 2; ++bj) {
                        f32x4 v0 = acc[ai][bj][m][0] * rs, v1 = acc[ai][bj][m][1] * rs;
                        if (do_rope) {
                            const f32x4* rp = (const f32x4*)(rope + ((size_t)pos * 16 + 4 * fq) * 2);
                            const f32x4 cs0 = rp[0], cs1 = rp[1];
                            const float c[4] = {cs0.x, cs0.z, cs1.x, cs1.z}, s[4] = {cs0.y, cs0.w, cs1.y, cs1.w};
#pragma unroll
                            for (int j = 0; j < 4; ++j) { const float x1 = v0[j], x2 = v1[j]; v0[j] = x1 * c[j] - x2 * s[j]; v1[j] = x2 * c[j] + x1 * s[j]; }
                        }
                        bf16_t* d = kbuf + ((size_t)(b * 2 + bj) * SEQ + pos) * 128 + 32 * wc + 4 * fq;
                        store_bf4(d, v0); store_bf4(d + 16, v1);
                    }
                }
        } else {
            const int lane = fr + 16 * fq, qi = lane & 3;
#pragma unroll
            for (int ai = 0; ai < 2; ++ai)
#pragma unroll
                for (int m = 0; m < 4; ++m) {
                    const int row = row0 + ai * 128 + m * 16;
                    const float rs = rsqrtf(rowss[row] * (1.f / DM) + RMS_EPS);
                    const int b = row >> 13, posq = (row & (SEQ - 1)) & ~3;
#pragma unroll
                    for (int bj = 0; bj < 2; ++bj)
#pragma unroll
                        for (int n = 0; n < 2; ++n) {
                            const f32x4 v = acc[ai][bj][m][n] * rs;
                            f32x4 w;
#pragma unroll
                            for (int k = 0; k < 4; ++k) {
                                const int src = (lane & ~3) | k;
                                const float t0 = __shfl(v[0], src), t1 = __shfl(v[1], src), t2 = __shfl(v[2], src), t3 = __shfl(v[3], src);
                                w[k] = qi == 0 ? t0 : (qi == 1 ? t1 : (qi == 2 ? t2 : t3));
                            }
                            const int d = 32 * wc + 16 * n + 4 * fq + qi;
                            store_bf4(vbuf + ((size_t)((b * 2 + bj) * 128 + d)) * SEQ + posq, w);
                        }
                }
        }
    }
};

struct EpiRes {
    const float* xin; float* xout; bf16_t* xb; float* rowss_out; float alpha;
    DI void operator()(const AccT& acc, const Unit& u, int wr, int wc, int fr, int fq, int ui) const {
        const int row0 = u.pm * 256 + wr * 64 + fr;
#pragma unroll
        for (int ai = 0; ai < 2; ++ai)
#pragma unroll
            for (int m = 0; m < 4; ++m) {
                const int row = row0 + ai * 128 + m * 16;
                float ss = 0.f;
#pragma unroll
                for (int bj = 0; bj < 2; ++bj)
#pragma unroll
                    for (int n = 0; n < 2; ++n) {
                        const size_t off = (size_t)row * DM + u.pn * 256 + bj * 128 + wc * 32 + n * 16 + 4 * fq;
                        const f32x4 xo = *(const f32x4*)(xin + off);
                        const f32x4 v = xo + alpha * acc[ai][bj][m][n];
                        *(f32x4*)(xout + off) = v;
                        store_bf4(xb + off, v);
                        ss += v.x * v.x + v.y * v.y + v.z * v.z + v.w * v.w;
                    }
                ss += __shfl_xor(ss, 16); ss += __shfl_xor(ss, 32);
                if (fq == 0) atomicAdd(rowss_out + row, ss);
            }
    }
};

struct EpiGlu {
    float* xres; bf16_t* xb; float* rowss_out;
    DI void operator()(const AccT& acc, const Unit& u, int wr, int wc, int fr, int fq, int ui) const {
        const int row0 = u.pm * 256 + wr * 64 + fr;
#pragma unroll
        for (int ai = 0; ai < 2; ++ai)
#pragma unroll
            for (int m = 0; m < 4; ++m) {
                const int row = row0 + ai * 128 + m * 16;
                float ss = 0.f;
#pragma unroll
                for (int bj = 0; bj < 2; ++bj) {
                    const size_t off = (size_t)row * DM + 16 * (8 * u.pn + 4 * bj + wc) + 4 * fq;
                    const f32x4 val = acc[ai][bj][m][0], gt = acc[ai][bj][m][1];
                    f32x4 v = *(const f32x4*)(xres + off);
#pragma unroll
                    for (int j = 0; j < 4; ++j) v[j] += val[j] * sigmoidf_(gt[j]);
                    *(f32x4*)(xres + off) = v;
                    store_bf4(xb + off, v);
                    ss += v.x * v.x + v.y * v.y + v.z * v.z + v.w * v.w;
                }
                ss += __shfl_xor(ss, 16); ss += __shfl_xor(ss, 32);
                if (fq == 0) atomicAdd(rowss_out + row, ss);
            }
    }
};

struct EpiQ {
    bf16_t* qbuf; const float* rowss; const float* rope;
    DI void operator()(const AccT& acc, const Unit& u, int wr, int wc, int fr, int fq, int ui) const {
        const int row0 = u.pm * 256 + wr * 64 + fr;
#pragma unroll
        for (int ai = 0; ai < 2; ++ai)
#pragma unroll
            for (int m = 0; m < 4; ++m) {
                const int row = row0 + ai * 128 + m * 16;
                const float rs = rsqrtf(rowss[row] * (1.f / DM) + RMS_EPS) * 0.08838834764831845f;
                const int pos = row & (SEQ - 1);
#pragma unroll
                for (int bj = 0; bj < 2; ++bj) {
                    f32x4 v0 = acc[ai][bj][m][0] * rs, v1 = acc[ai][bj][m][1] * rs;
                    if (wc == 0) {
                        const f32x4* rp = (const f32x4*)(rope + ((size_t)pos * 16 + 4 * fq) * 2);
                        const f32x4 cs0 = rp[0], cs1 = rp[1];
                        const float c[4] = {cs0.x, cs0.z, cs1.x, cs1.z}, s[4] = {cs0.y, cs0.w, cs1.y, cs1.w};
#pragma unroll
                        for (int j = 0; j < 4; ++j) { const float x1 = v0[j], x2 = v1[j]; v0[j] = x1 * c[j] - x2 * s[j]; v1[j] = x2 * c[j] + x1 * s[j]; }
                    }
                    bf16_t* d = qbuf + (size_t)row * DM + u.pn * 256 + bj * 128 + 32 * wc + 4 * fq;
                    store_bf4(d, v0); store_bf4(d + 16, v1);
                }
            }
    }
};

DI void preload_rs(LAS unsigned char* lds, int vbid, const float* rowss, int N) {
    pg8::StaticOrder S; S.init(T_TOK, N, gridDim.x, vbid);
    LAS float* rsl = (LAS float*)(lds + 131072);
    pg8::Unit u;
    for (int i = 0; i < 8 && S.next(i, u); ++i)
        if (threadIdx.x < 256) rsl[i * 256 + threadIdx.x] = rsqrtf(rowss[u.pm * 256 + threadIdx.x] * (1.f / DM) + RMS_EPS);
    __syncthreads();
}
template <class Epi>
DI void run_gemm_v(LAS unsigned char* lds, int vbid, const bf16_t* A, const bf16_t* Bt, int N, int K, const Epi& E) {
    pg8::Gemm g{A, Bt, T_TOK, N, K};
    pg8::StaticOrder S; S.init(T_TOK, N, gridDim.x, vbid);
    pg8::gemm_phase<Epi>(lds, g, S, E);
}

struct S5Coef { float ar, ai, cr, ci; };
DI S5Coef s5_coefs_compute(const Params& P, int g, int p) {
    const float dt = expf(P.log_step[g]); const float lr = P.a_re[g * 64 + p], li = P.a_im[g * 64 + p];
    const float mag = expf(lr * dt); S5Coef c; c.ar = mag * cosf(li * dt); c.ai = mag * sinf(li * dt);
    const float nr = c.ar - 1.f, ni = c.ai, den = lr * lr + li * li;
    c.cr = (nr * lr + ni * li) / den; c.ci = (ni * lr - nr * li) / den; return c;
}
DI S5Coef s5_coefs(const Params& P, int g, int p) { const f32x4 v = *(const f32x4*)(P.s5tab + (size_t)(g * 64 + p) * 4); S5Coef c; c.ar = v.x; c.ai = v.y; c.cr = v.z; c.ci = v.w; return c; }

DI void p0_transpose_item(const WJob& J, LAS float* scr, int item, int lane) {
    const int nblk = J.ndst / 32, kb = item / nblk, nb = item % nblk, k0 = 64 * kb, r0 = 32 * nb;
    const int i = lane & 31;
    int scol;
    if (J.mode == 0) scol = r0 + i;
    else { const int G = r0 >> 5; scol = (i < 16) ? (16 * G + i) : ((J.Nsrc >> 1) + 16 * G + (i - 16)); }
    float wv[32];
    const float* wp = J.W + (size_t)(k0 + (lane >> 5)) * J.Nsrc + scol;
#pragma unroll
    for (int it = 0; it < 32; ++it) wv[it] = wp[(size_t)(2 * it) * J.Nsrc];
    if (J.g) {
        const float* gp = J.g + k0 + (lane >> 5);
#pragma unroll
        for (int it = 0; it < 32; ++it) wv[it] *= gp[2 * it];
    }
#pragma unroll
    for (int it = 0; it < 32; ++it) scr[(2 * it + (lane >> 5)) * 33 + i] = wv[it];
    __builtin_amdgcn_fence(__ATOMIC_RELEASE, "wavefront"); __builtin_amdgcn_wave_barrier(); __builtin_amdgcn_fence(__ATOMIC_ACQUIRE, "wavefront");
    const int c = lane & 7;
#pragma unroll
    for (int j = 0; j < 4; ++j) {
        const int n = (lane >> 3) + 8 * j; const LAS float* s = scr + (8 * c) * 33 + n;
        u32x4 o; o.x = cvt_pk_bf16(s[0 * 33], s[1 * 33]); o.y = cvt_pk_bf16(s[2 * 33], s[3 * 33]); o.z = cvt_pk_bf16(s[4 * 33], s[5 * 33]); o.w = cvt_pk_bf16(s[6 * 33], s[7 * 33]);
        *(u32x4*)(J.dst + (size_t)(r0 + n) * J.K + k0 + 8 * c) = o;
    }
    __builtin_amdgcn_fence(__ATOMIC_RELEASE, "wavefront"); __builtin_amdgcn_wave_barrier(); __builtin_amdgcn_fence(__ATOMIC_ACQUIRE, "wavefront");
}

DI void convert_items(const Params& P, LAS unsigned char* lds, int lo, int hi, int gw, int NGW) {
    const int wave = threadIdx.x >> 6, lane = threadIdx.x & 63;
    LAS float* scr = (LAS float*)(lds + wave * 16384);
    for (int it = lo + gw; it < hi; it += NGW) {
        int j = 0;
#pragma unroll 1
        for (int q = 1; q < NJOBS; ++q) if (it >= P.jobs[q].item0) j = q;
        p0_transpose_item(P.jobs[j], scr, it - P.jobs[j].item0, lane);
    }
}
DI void convert_by_light_blocks(const Params& P, LAS unsigned char* lds, int vbid, int units, int lo, int hi) {
    asm volatile("" : "+s"(vbid), "+s"(lo), "+s"(hi));
    const int G = gridDim.x, extra = units % G, first = extra, nlight = G - extra;
    if (vbid >= first) convert_items(P, lds, lo, hi, (vbid - first) * 8 + (threadIdx.x >> 6), nlight * 8);
}

DI void phase_prep(const Params& P, LAS unsigned char* lds) {
    const int tid = threadIdx.x, wave = tid >> 6, lane = tid & 63;
    const int gw = blockIdx.x * 8 + wave, NGW = gridDim.x * 8;
    LAS float* scr = (LAS float*)(lds + wave * 16384);
    convert_items(P, lds, 0, P.it1, gw, NGW);
    for (int row = gw; row < T_TOK; row += NGW) {
        const f32x4* xr = (const f32x4*)(P.x + (size_t)row * DM) + lane;
        f32x4 v[4]; float s = 0.f;
#pragma unroll
        for (int j = 0; j < 4; ++j) { v[j] = xr[64 * j]; s += v[j].x * v[j].x + v[j].y * v[j].y + v[j].z * v[j].z + v[j].w * v[j].w; }
        s = wave_sum(s);
        if (lane == 0) P.rowss[row] = s;
        bf16_t* o = P.xb + (size_t)row * DM + 4 * lane;
#pragma unroll
        for (int j = 0; j < 4; ++j) store_bf4(o + 256 * j, v[j]);
    }
    const int gt = blockIdx.x * 512 + tid, NGT = gridDim.x * 512;
    for (int i = gt; i < 6 * T_TOK; i += NGT) P.rowss[T_TOK + i] = 0.f;
    if (gt < 128) P.gcount[gt] = 0;
    if (gt < 64) P.pcnt[gt] = 0;
    for (int i = gt; i < 4096; i += NGT) { const S5Coef c = s5_coefs_compute(P, i >> 6, i & 63); *(f32x4*)(P.s5tab + (size_t)i * 4) = (f32x4){c.ar, c.ai, c.cr, c.ci}; }
    for (int i = gt; i < SEQ * 16; i += NGT) {
        const int pos = i >> 4, d = i & 15;
        const float inv = exp2f(-(float)d * (18.931568569324174f / 16.f));
        const float ang = (float)pos * inv;
        P.rope[2 * i] = cosf(ang); P.rope[2 * i + 1] = sinf(ang);
    }
}

DI float gelu_tanh(float x) { const float u = 0.7978845608028654f * (x + 0.044715f * x * x * x); return x * __builtin_amdgcn_rcpf(1.f + __builtin_amdgcn_exp2f(-2.f * 1.4426950408889634f * u)); }

typedef float f32x16 __attribute__((ext_vector_type(16)));
typedef __bf16 bf2_t __attribute__((ext_vector_type(2)));
DI unsigned pk_bf16(float lo, float hi) { const f32x2 v = {lo, hi}; return __builtin_bit_cast(unsigned, __builtin_convertvector(v, bf2_t)); }
#define WAVE_LDS_SYNC() asm volatile("s_waitcnt lgkmcnt(0)" ::: "memory")

DI void s5_bfrags(const Params& P, int g, int lane, bf16x8 (&bf)[4]) {
    const int q = lane & 31, h = lane >> 5;
#pragma unroll
    for (int pj = 0; pj < 2; ++pj) {
        const int p = q + 32 * pj;
        const S5Coef c = s5_coefs(P, g, p);
        const f32x4* br = (const f32x4*)(P.b_re + ((size_t)g * 64 + p) * 16 + 8 * h);
        const f32x4* bi = (const f32x4*)(P.b_im + ((size_t)g * 64 + p) * 16 + 8 * h);
        const f32x4 r0 = br[0], r1 = br[1], i0 = bi[0], i1 = bi[1];
        float re[8], im[8];
#pragma unroll
        for (int j = 0; j < 4; ++j) {
            re[j] = c.cr * r0[j] - c.ci * i0[j]; im[j] = c.cr * i0[j] + c.ci * r0[j];
            re[4 + j] = c.cr * r1[j] - c.ci * i1[j]; im[4 + j] = c.cr * i1[j] + c.ci * r1[j];
        }
        const u32x4 wr = {pk_bf16(re[0], re[1]), pk_bf16(re[2], re[3]), pk_bf16(re[4], re[5]), pk_bf16(re[6], re[7])};
        const u32x4 wi = {pk_bf16(im[0], im[1]), pk_bf16(im[2], im[3]), pk_bf16(im[4], im[5]), pk_bf16(im[6], im[7])};
        bf[2 * pj] = __builtin_bit_cast(bf16x8, wr); bf[2 * pj + 1] = __builtin_bit_cast(bf16x8, wi);
    }
}
DI bf16x8 s5_ufrag(const Params& P, int rowbase, int g, int lane, const f32x4& ga, const f32x4& gb) {
    const int t = lane & 31, h = lane >> 5, row = rowbase + t;
    const float rs = rsqrtf(P.rowss[T_TOK + row] * (1.f / DM) + RMS_EPS);
    const f32x4* xp = (const f32x4*)(P.xres + (size_t)row * DM + 16 * g + 8 * h);
    const f32x4 a = xp[0] * rs * ga, b = xp[1] * rs * gb;
    const u32x4 w = {pk_bf16(a.x, a.y), pk_bf16(a.z, a.w), pk_bf16(b.x, b.y), pk_bf16(b.z, b.w)};
    return __builtin_bit_cast(bf16x8, w);
}
template <bool WRITE>
DI void s5_scan32(const f32x16 (&X)[4], int h, int p, float ar, float ai, float& hr, float& hi, LAS unsigned char* hs) {
    float lo_re[16], lo_im[16], hi_re[16], hi_im[16];
#pragma unroll
    for (int r = 0; r < 16; ++r) {
        const auto sr = __builtin_amdgcn_permlane32_swap(__float_as_uint(X[0][r]), __float_as_uint(X[2][r]), false, false);
        const auto si = __builtin_amdgcn_permlane32_swap(__float_as_uint(X[1][r]), __float_as_uint(X[3][r]), false, false);
        lo_re[r] = __uint_as_float(sr[0]); hi_re[r] = __uint_as_float(sr[1]);
        lo_im[r] = __uint_as_float(si[0]); hi_im[r] = __uint_as_float(si[1]);
    }
#pragma unroll
    for (int i = 0; i < 4; ++i)
#pragma unroll
        for (int half = 0; half < 2; ++half)
#pragma unroll
            for (int j = 0; j < 4; ++j) {
                const int r = 4 * i + j, token = 8 * i + 4 * half + j;
                const float xr = half ? hi_re[r] : lo_re[r], xi = half ? hi_im[r] : lo_im[r];
                const float nhr = ar * hr - ai * hi + xr, nhi = ar * hi + ai * hr + xi; hr = nhr; hi = nhi;
                if (WRITE) {
                    const unsigned whi = pk_bf16(hr, hi);
                    *(LAS unsigned*)(hs + token * 272 + 4 * p) = whi;
                    *(LAS unsigned*)(hs + 69632 + token * 272 + 4 * p) = pk_bf16(hr - bf_lo(whi), hi - bf_hi(whi));
                }
            }
}

struct S5In { f32x4 x0, x1; float ss; };
DI S5In s5_in_load(const Params& P, int rowbase, int g, int lane) {
    const int row = rowbase + (lane & 31);
    const f32x4* xp = (const f32x4*)(P.xres + (size_t)row * DM + 16 * g + 8 * (lane >> 5));
    S5In r; r.x0 = xp[0]; r.x1 = xp[1]; r.ss = P.rowss[T_TOK + row]; return r;
}
DI bf16x8 s5_in_frag(const S5In& in, const f32x4& ga, const f32x4& gb) {
    const float rs = rsqrtf(in.ss * (1.f / DM) + RMS_EPS);
    const f32x4 a = in.x0 * rs * ga, b = in.x1 * rs * gb;
    const u32x4 w = {pk_bf16(a.x, a.y), pk_bf16(a.z, a.w), pk_bf16(b.x, b.y), pk_bf16(b.z, b.w)};
    return __builtin_bit_cast(bf16x8, w);
}
DI int s5_row0(int L, int wave) { const int bc = L & 31; return (bc >> 4) * SEQ + ((bc & 15) * 8 + wave) * 64; }

DI void phase_s5a(const Params& P, LAS unsigned char* lds) {
    const int tid = threadIdx.x, wave = tid >> 6, lane = tid & 63, h = lane >> 5;
    for (int base = blockIdx.x * 8; base < 2048; base += gridDim.x * 8) {
        const int g = base >> 5;
        const S5Coef cf = s5_coefs(P, g, lane);
        bf16x8 bf[4]; s5_bfrags(P, g, lane, bf);
        const f32x4 ga = *(const f32x4*)(P.norm_g + DM + 16 * g + 8 * h), gb = *(const f32x4*)(P.norm_g + DM + 16 * g + 8 * h + 4);
        float hr = 0.f, hi = 0.f;
        S5In pre = s5_in_load(P, s5_row0(base, wave), g, lane);
#pragma unroll 1
        for (int step = 0; step < 16; ++step) {
            const int L = base + (step >> 1), sub = step & 1;
            const S5In cur = pre;
            if (step < 15) pre = s5_in_load(P, s5_row0(base + ((step + 1) >> 1), wave) + 32 * ((step + 1) & 1), g, lane);
            const bf16x8 a = s5_in_frag(cur, ga, gb);
            f32x16 X[4];
#pragma unroll
            for (int j = 0; j < 4; ++j) {
#pragma unroll
                for (int r = 0; r < 16; ++r) X[j][r] = 0.f;
                X[j] = __builtin_amdgcn_mfma_f32_32x32x16_bf16(a, bf[j], X[j], 0, 0, 0);
            }
            if (sub == 0) { hr = 0.f; hi = 0.f; }
            s5_scan32<false>(X, h, lane, cf.ar, cf.ai, hr, hi, lds);
            if (sub == 1) { const int bc = L & 31, ch = (bc & 15) * 8 + wave; *(f32x2*)(P.E + ((size_t)(((bc >> 4) * 128 + ch) * 64 + g) * 64 + lane) * 2) = (f32x2){hr, hi}; }
        }
    }
}

DI void phase_s5carry(const Params& P) {
    if (blockIdx.x < 128 && threadIdx.x < 64) {
        const int idx = blockIdx.x * 64 + threadIdx.x, b = idx >> 12, g = (idx >> 6) & 63, p = idx & 63;
        const S5Coef cf = s5_coefs(P, g, p);
        float alr = cf.ar, ali = cf.ai;
#pragma unroll
        for (int q = 0; q < 6; ++q) { const float r = alr * alr - ali * ali, i2 = 2.f * alr * ali; alr = r; ali = i2; }
        f32x2* Ep = (f32x2*)P.E + (size_t)(b * 128) * 4096 + g * 64 + p;
        float hr = 0.f, hi = 0.f;
#pragma unroll 1
        for (int j0 = 0; j0 < 128; j0 += 32) {
            f32x2 e[32];
#pragma unroll
            for (int u = 0; u < 32; ++u) e[u] = Ep[(size_t)(j0 + u) * 4096];
#pragma unroll
            for (int u = 0; u < 32; ++u) {
                Ep[(size_t)(j0 + u) * 4096] = (f32x2){hr, hi};
                const float nr = alr * hr - ali * hi + e[u].x, ni = alr * hi + ali * hr + e[u].y; hr = nr; hi = ni;
            }
        }
    }
}

DI void phase_s5b(const Params& P, LAS unsigned char* lds) {
    const int tid = threadIdx.x, wave = tid >> 6, lane = tid & 63, h = lane >> 5, c16 = lane & 15, kq = lane >> 4;
    LAS unsigned char* hs = lds + wave * 8704;
    for (int base = blockIdx.x * 8; base < 2048; base += gridDim.x * 8) {
        const int g = base >> 5;
        const S5Coef cf = s5_coefs(P, g, lane);
        bf16x8 bf[4]; s5_bfrags(P, g, lane, bf);
        const f32x4 ga = *(const f32x4*)(P.norm_g + DM + 16 * g + 8 * h), gb = *(const f32x4*)(P.norm_g + DM + 16 * g + 8 * h + 4);
        bf16x8 cmf[4], cml[4];
#pragma unroll
        for (int ks = 0; ks < 4; ++ks) {
            const int p0 = ks * 16 + kq * 4;
            const f32x4 cr = *(const f32x4*)(P.c_re + ((size_t)g * 16 + c16) * 64 + p0), ci = *(const f32x4*)(P.c_im + ((size_t)g * 16 + c16) * 64 + p0);
            const float v[8] = {cr.x, -ci.x, cr.y, -ci.y, cr.z, -ci.z, cr.w, -ci.w};
            u32x4 wh, wl;
#pragma unroll
            for (int e = 0; e < 4; ++e) { wh[e] = pk_bf16(v[2 * e], v[2 * e + 1]); wl[e] = pk_bf16(v[2 * e] - bf_lo(wh[e]), v[2 * e + 1] - bf_hi(wh[e])); }
            cmf[ks] = __builtin_bit_cast(bf16x8, wh); cml[ks] = __builtin_bit_cast(bf16x8, wl);
        }
        const f32x4 d4 = *(const f32x4*)(P.s5_d + 16 * g + 4 * kq), ge = *(const f32x4*)(P.norm_g + DM + 16 * g + 4 * kq);
        float hr = 0.f, hi = 0.f;
        S5In pre = s5_in_load(P, s5_row0(base, wave), g, lane);
        f32x2 cpre; { const int bc = base & 31, ch = (bc & 15) * 8 + wave; cpre = *((const f32x2*)P.E + ((size_t)((bc >> 4) * 128 + ch) * 64 + g) * 64 + lane); }
#pragma unroll 1
        for (int step = 0; step < 16; ++step) {
            const int L = base + (step >> 1), sub = step & 1, rowb = s5_row0(L, wave) + 32 * sub;
            const S5In cur = pre;
            if (sub == 0) { hr = cpre.x; hi = cpre.y; }
            if (step < 15) pre = s5_in_load(P, s5_row0(base + ((step + 1) >> 1), wave) + 32 * ((step + 1) & 1), g, lane);
            if (sub == 1 && step < 15) { const int bc = (L + 1) & 31, ch = (bc & 15) * 8 + wave; cpre = *((const f32x2*)P.E + ((size_t)((bc >> 4) * 128 + ch) * 64 + g) * 64 + lane); }
            const bf16x8 a = s5_in_frag(cur, ga, gb);
            f32x16 X[4];
#pragma unroll
            for (int j = 0; j < 4; ++j) {
#pragma unroll
                for (int r = 0; r < 16; ++r) X[j][r] = 0.f;
                X[j] = __builtin_amdgcn_mfma_f32_32x32x16_bf16(a, bf[j], X[j], 0, 0, 0);
            }
            s5_scan32<true>(X, h, lane, cf.ar, cf.ai, hr, hi, hs);
            WAVE_LDS_SYNC();
#pragma unroll
            for (int tt = 0; tt < 2; ++tt) {
                f32x4 acc = {0.f, 0.f, 0.f, 0.f};
#pragma unroll
                for (int ks = 0; ks < 4; ++ks) {
                    const LAS unsigned char* ha = hs + (tt * 16 + c16) * 272 + ks * 64 + kq * 16;
                    const bf16x8 hbh = *(const LAS bf16x8*)ha, hbl = *(const LAS bf16x8*)(ha + 69632);
                    acc = __builtin_amdgcn_mfma_f32_16x16x32_bf16(cml[ks], hbh, acc, 0, 0, 0);
                    acc = __builtin_amdgcn_mfma_f32_16x16x32_bf16(cmf[ks], hbl, acc, 0, 0, 0);
                    acc = __builtin_amdgcn_mfma_f32_16x16x32_bf16(cmf[ks], hbh, acc, 0, 0, 0);
                }
                const int row = rowb + 16 * tt + c16;
                const float rs = rsqrtf(P.rowss[T_TOK + row] * (1.f / DM) + RMS_EPS);
                const f32x4 u4 = *(const f32x4*)(P.xres + (size_t)row * DM + 16 * g + 4 * kq) * rs * ge;
                f32x4 y;
#pragma unroll
                for (int j = 0; j < 4; ++j) y[j] = gelu_tanh(acc[j] + d4[j] * u4[j]);
                store_bf4(P.yb + (size_t)row * DM + 16 * g + 4 * kq, y);
            }
            WAVE_LDS_SYNC();
        }
    }
}

DI void phase_kmean(const Params& P, LAS unsigned char* lds) {
    if (blockIdx.x < 128) {
        const int j = blockIdx.x, d = threadIdx.x & 127, part = threadIdx.x >> 7;
        const bf16_t* kb = P.kbuf + ((size_t)(j >> 5) * SEQ + (j & 31) * 256 + part * 64) * 128 + d;
        float s = 0.f;
#pragma unroll 1
        for (int k0 = 0; k0 < 64; k0 += 16) {
            unsigned short v[16];
#pragma unroll
            for (int u = 0; u < 16; ++u) v[u] = kb[(size_t)(k0 + u) * 128];
#pragma unroll
            for (int u = 0; u < 16; ++u) s += __uint_as_float(((unsigned)v[u]) << 16);
        }
        LAS float* red = (LAS float*)lds;
        red[threadIdx.x] = s;
        __syncthreads();
        if (threadIdx.x < 128) P.kmean[j * 128 + d] = (red[d] + red[128 + d] + red[256 + d] + red[384 + d]) * (1.f / 256.f);
    }
}

DI int list_off(int c, int n) { return c * (496 * 1024) + 1024 * (31 * n - (n * (n - 1)) / 2); }

DI void phase_gate(const Params& P, LAS unsigned char* lds) {
    const int tid = threadIdx.x, wave = tid >> 6, lane = tid & 63;
    LAS float* km = (LAS float*)lds;
    LAS int* cnt = (LAS int*)(lds + 32768);
    LAS int* base = cnt + 64;
    for (int qb = blockIdx.x; qb < 256; qb += gridDim.x) {
        const int b = qb >> 7, i = qb & 127, own = i >> 2;
        for (int e = tid; e < 2048; e += 512) ((LAS f32x4*)km)[e] = ((const f32x4*)(P.kmean + b * 8192))[e];
        if (tid < 64) cnt[tid] = 0;
        __syncthreads();
        const int hq = wave, hk = hq >> 2, t = b * SEQ + i * 64 + lane;
        float g[32];
#pragma unroll
        for (int n = 0; n < 32; ++n) g[n] = 0.f;
        const u32x4* qr = (const u32x4*)(P.qbuf + (size_t)t * DM + hq * 128);
#pragma unroll
        for (int nc = 0; nc < 4; ++nc) {
            u32x4 wa = qr[0], wb = qr[1];
#pragma unroll 1
            for (int c = 0; c < 16; ++c) {
                const u32x4 w = wa; wa = wb; wb = qr[(c + 2) & 15];
                const float q0 = bf_lo(w.x), q1 = bf_hi(w.x), q2 = bf_lo(w.y), q3 = bf_hi(w.y), q4 = bf_lo(w.z), q5 = bf_hi(w.z), q6 = bf_lo(w.w), q7 = bf_hi(w.w);
#pragma unroll
                for (int n8 = 0; n8 < 8; ++n8) {
                    const int n = nc * 8 + n8;
                    const LAS f32x4* kp = (const LAS f32x4*)(km + (hk * 32 + n) * 128 + 8 * c);
                    const f32x4 ka = kp[0], kb = kp[1];
                    g[n] += q0 * ka.x + q1 * ka.y + q2 * ka.z + q3 * ka.w + q4 * kb.x + q5 * kb.y + q6 * kb.z + q7 * kb.w;
                }
            }
        }
        const int nsel = own < 3 ? own : 3;
        int s0 = -1, s1 = -1, s2 = -1;
        { float best = -3e38f;
#pragma unroll
          for (int n = 0; n < 32; ++n) if (n < own && g[n] > best) { best = g[n]; s0 = n; } }
        { float best = -3e38f;
#pragma unroll
          for (int n = 0; n < 32; ++n) if (n < own && n != s0 && g[n] > best) { best = g[n]; s1 = n; } }
        { float best = -3e38f;
#pragma unroll
          for (int n = 0; n < 32; ++n) if (n < own && n != s0 && n != s1 && g[n] > best) { best = g[n]; s2 = n; } }
        int l0 = 0, l1 = 0, l2 = 0;
        if (nsel > 0) l0 = atomicAdd((int*)&cnt[hk * 32 + s0], 1);
        if (nsel > 1) l1 = atomicAdd((int*)&cnt[hk * 32 + s1], 1);
        if (nsel > 2) l2 = atomicAdd((int*)&cnt[hk * 32 + s2], 1);
        __syncthreads();
        if (tid < 64) { const int c = cnt[tid]; base[tid] = c > 0 ? atomicAdd(P.gcount + b * 64 + tid, c) : 0; }
        __syncthreads();
        const int row = t * 8 + hq, c2 = b * 2 + hk;
        if (nsel > 0) P.lists[list_off(c2, s0) + base[hk * 32 + s0] + l0] = row * 4 + 1;
        if (nsel > 1) P.lists[list_off(c2, s1) + base[hk * 32 + s1] + l1] = row * 4 + 2;
        if (nsel > 2) P.lists[list_off(c2, s2) + base[hk * 32 + s2] + l2] = row * 4 + 3;
        __syncthreads();
    }
}

template <bool OWN>
DI void phase_attn(const Params& P, LAS unsigned char* lds) {
    const int tid = threadIdx.x, wave = __builtin_amdgcn_readfirstlane(tid >> 6), lane = tid & 63, h = lane >> 5, l32 = lane & 31;
    LAS unsigned char* Ks = lds;
    LAS unsigned char* Vs = lds + 69632;
    LAS int* pref = (LAS int*)(lds + 136192);
    if constexpr (!OWN) {
        LAS int* cntl = pref + 132;
        if (tid < 128) cntl[tid] = (P.gcount[tid] + 255) >> 8;
        __syncthreads();
        if (tid <= 128) { int a = 0; for (int i = 0; i < 128; ++i) a += (i < tid) ? cntl[i] : 0; pref[tid] = a; }
        __syncthreads();
    }
    const int total = OWN ? 512 : pref[128];
    constexpr float LOG2E = 1.4426950408889634f;
    int rnd = 0;
    for (int idx = blockIdx.x; idx < total; idx += gridDim.x, ++rnd) {
        const int item = (OWN && (rnd & 1)) ? (idx ^ 3) : idx;
        int c, n, i_q = 0, nrows = 256; const int* lst = P.lists; constexpr bool is_own = OWN;
        if (is_own) { c = item >> 7; i_q = item & 127; n = i_q >> 2; }
        else {
            const int s = item; int lo = 0, hi = 128;
            while (hi - lo > 1) { const int mid = (lo + hi) >> 1; if (pref[mid] <= s) lo = mid; else hi = mid; }
            c = lo >> 5; n = lo & 31; const int grp = s - pref[lo]; lst = P.lists + list_off(c, n) + grp * 256; nrows = P.gcount[lo] - grp * 256; if (nrows > 256) nrows = 256;
        }
        const int b = c >> 1, hk = c & 1;
        {
            const bf16_t* kg = P.kbuf + ((size_t)c * SEQ + n * 256) * 128;
            const bf16_t* vg = P.vT + (size_t)c * 128 * SEQ + n * 256;
            const bf16_t* kgl = kg + (size_t)(tid >> 4) * 128 + (tid & 15) * 8;
            LAS unsigned char* kl = Ks + (tid >> 4) * 272 + (tid & 15) * 16;
#pragma unroll
            for (int q = 0; q < 8; ++q) { const u32x4 w = *(const u32x4*)(kgl + q * 4096); *(LAS u32x4*)(kl + q * 8704) = w; }
            const bf16_t* vgl = vg + (size_t)(tid >> 5) * SEQ + (tid & 31) * 8;
            LAS unsigned char* vl = Vs + (tid >> 5) * 520 + (tid & 31) * 16;
#pragma unroll
            for (int q = 0; q < 8; ++q) { const u32x4 w = *(const u32x4*)(vgl + (size_t)q * 16 * SEQ); LAS u32x2* dst = (LAS u32x2*)(vl + q * 8320); dst[0] = (u32x2){w.x, w.y}; dst[1] = (u32x2){w.z, w.w}; }
        }
        int ent; bool valid = true; const int rho = wave * 32 + l32;
        if (is_own) { const int hq = hk * 4 + (rho >> 6), t = b * SEQ + i_q * 64 + (rho & 63); ent = (t * 8 + hq) * 4; }
        else { valid = rho < nrows; ent = lst[valid ? rho : 0]; }
        bf16x8 qf[8];
        { const int row = ent >> 2, t = row >> 3, hq = row & 7; const bf16_t* qp = P.qbuf + (size_t)t * DM + hq * 128 + 8 * h;
#pragma unroll
          for (int ks = 0; ks < 8; ++ks) qf[ks] = *(const bf16x8*)(qp + ks * 16); }
        __syncthreads();
        if (wave < 4) __builtin_amdgcn_s_setprio(2);
        if (wave * 32 < nrows) {
            const int nkt = is_own ? (2 * (i_q & 3) + (wave & 1) + 1) : 8;
            const int posb = is_own ? (64 * (i_q & 3) + (rho & 63)) : 100000;
            float m_run = -1e30f, l_run = 0.f;
            f32x16 o[4];
#pragma unroll
            for (int db = 0; db < 4; ++db)
#pragma unroll
                for (int r = 0; r < 16; ++r) o[db][r] = 0.f;
#pragma unroll 1
            for (int hf = 0; hf < 2; ++hf) {
                if (4 * hf >= nkt) break;
                f32x16 s[4];
#pragma unroll
                for (int kq = 0; kq < 4; ++kq) {
                    const int kt = 4 * hf + kq;
                    if (kt < nkt) {
#pragma unroll
                        for (int r = 0; r < 16; ++r) s[kq][r] = 0.f;
#pragma unroll
                        for (int ks = 0; ks < 8; ++ks) {
                            const bf16x8 a = *(const LAS bf16x8*)(Ks + (kt * 32 + l32) * 272 + ks * 32 + 16 * h);
                            s[kq] = __builtin_amdgcn_mfma_f32_32x32x16_bf16(a, qf[ks], s[kq], 0, 0, 0);
                            asm volatile("" :: "v"(a));
                        }
                        if (is_own) {
#pragma unroll
                            for (int r = 0; r < 16; ++r) { const int key = kt * 32 + (r & 3) + 8 * (r >> 2) + 4 * h; if (key > posb) s[kq][r] = -1e30f; }
                        }
                    } else {
#pragma unroll
                        for (int r = 0; r < 16; ++r) s[kq][r] = -1e30f;
                    }
                    __builtin_amdgcn_sched_barrier(0);
                }
                float mx = -1e30f;
#pragma unroll
                for (int kq = 0; kq < 4; ++kq)
#pragma unroll
                    for (int r = 0; r < 16; ++r) mx = fmaxf(mx, s[kq][r]);
                mx = fmaxf(mx, __shfl_xor(mx, 32));
                const float m_new = fmaxf(m_run, mx), mL = m_new * LOG2E;
                const float alpha = __builtin_amdgcn_exp2f((m_run - m_new) * LOG2E);
                float lsum = 0.f;
#pragma unroll
                for (int kq = 0; kq < 4; ++kq)
#pragma unroll
                    for (int r = 0; r < 16; ++r) { const float p = __builtin_amdgcn_exp2f(s[kq][r] * LOG2E - mL); s[kq][r] = p; lsum += p; }
                lsum += __shfl_xor(lsum, 32);
                l_run = l_run * alpha + lsum; m_run = m_new;
                if (hf == 1) {
#pragma unroll
                    for (int db = 0; db < 4; ++db)
#pragma unroll
                        for (int r = 0; r < 16; ++r) o[db][r] *= alpha;
                }
#pragma unroll
                for (int kq = 0; kq < 4; ++kq) {
                    const int kt = 4 * hf + kq;
                    if (kt < nkt) {
#pragma unroll
                        for (int st = 0; st < 2; ++st) {
                            u32x4 pw;
                            pw.x = pk_bf16(s[kq][8 * st + 0], s[kq][8 * st + 1]); pw.y = pk_bf16(s[kq][8 * st + 2], s[kq][8 * st + 3]);
                            pw.z = pk_bf16(s[kq][8 * st + 4], s[kq][8 * st + 5]); pw.w = pk_bf16(s[kq][8 * st + 6], s[kq][8 * st + 7]);
                            const bf16x8 pf = __builtin_bit_cast(bf16x8, pw);
#pragma unroll
                            for (int db = 0; db < 4; ++db) {
                                const LAS unsigned char* va = Vs + (32 * db + l32) * 520 + (kt * 32 + 16 * st + 4 * h) * 2;
                                const u32x2 vlo = *(const LAS u32x2*)va, vhi = *(const LAS u32x2*)(va + 16);
                                const u32x4 vw = {vlo.x, vlo.y, vhi.x, vhi.y};
                                o[db] = __builtin_amdgcn_mfma_f32_32x32x16_bf16(__builtin_bit_cast(bf16x8, vw), pf, o[db], 0, 0, 0);
                            }
                            __builtin_amdgcn_sched_barrier(0);
                        }
                    }
                }
            }
            asm volatile("" : "+v"(ent));
            if constexpr (!OWN) {
                if (valid) {
                    const float inv = 1.f / l_run;
                    const int slot = ent & 3; const int row = ent >> 2;
                    if (h == 0) *(f32x2*)(P.part_ml + (size_t)ent * 2) = (f32x2){m_run, l_run};
                    int h2 = h; asm volatile("" : "+v"(h2));
                    bf16_t* pb = P.part[1];
                    if (slot == 2) pb = P.part[2]; else if (slot == 3) pb = P.part[3];
                    bf16_t* po = pb + ((size_t)row * 128 + 4 * h2);
#pragma unroll
                    for (int db = 0; db < 4; ++db)
#pragma unroll
                        for (int rq = 0; rq < 4; ++rq) {
                            u32x2 w; w.x = pk_bf16(o[db][4 * rq] * inv, o[db][4 * rq + 1] * inv); w.y = pk_bf16(o[db][4 * rq + 2] * inv, o[db][4 * rq + 3] * inv);
                            *(u32x2*)(po + 32 * db + 8 * rq) = w;
                        }
                }
            } else {
                const int row = ent >> 2, nsel = n < 3 ? n : 3;
                int h2 = h; asm volatile("" : "+v"(h2));
                float M = m_run; f32x2 ml[3];
#pragma unroll
                for (int s2 = 0; s2 < 3; ++s2) { ml[s2] = (f32x2){-1e30f, 0.f}; if (s2 < nsel) { ml[s2] = *(const f32x2*)(P.part_ml + ((size_t)row * 4 + s2 + 1) * 2); M = fmaxf(M, ml[s2].x); } }
                const float w0 = __builtin_amdgcn_exp2f((m_run - M) * LOG2E);
                float ws[3], L = l_run * w0;
#pragma unroll
                for (int s2 = 0; s2 < 3; ++s2) { ws[s2] = ml[s2].y * __builtin_amdgcn_exp2f((ml[s2].x - M) * LOG2E); L += ws[s2]; }
                const float inv = 1.f / L, w0i = w0 * inv;
                const size_t poff = (size_t)row * 128 + 4 * h2;
                bf16_t* ao = P.attn + (size_t)(row >> 3) * DM + (row & 7) * 128 + 4 * h2;
#pragma unroll
                for (int db = 0; db < 4; ++db) {
                    u32x2 pv[3][4];
#pragma unroll
                    for (int s2 = 0; s2 < 3; ++s2)
#pragma unroll
                        for (int rq = 0; rq < 4; ++rq) { pv[s2][rq] = (u32x2){0u, 0u}; if (s2 < nsel) pv[s2][rq] = *(const u32x2*)(P.part[s2 + 1] + poff + 32 * db + 8 * rq); }
#pragma unroll
                    for (int rq = 0; rq < 4; ++rq) {
                        float a0 = o[db][4 * rq] * w0i, a1 = o[db][4 * rq + 1] * w0i, a2 = o[db][4 * rq + 2] * w0i, a3 = o[db][4 * rq + 3] * w0i;
#pragma unroll
                        for (int s2 = 0; s2 < 3; ++s2) { const float wv = ws[s2] * inv; a0 += wv * bf_lo(pv[s2][rq].x); a1 += wv * bf_hi(pv[s2][rq].x); a2 += wv * bf_lo(pv[s2][rq].y); a3 += wv * bf_hi(pv[s2][rq].y); }
                        u32x2 w; w.x = pk_bf16(a0, a1); w.y = pk_bf16(a2, a3);
                        *(u32x2*)(ao + 32 * db + 8 * rq) = w;
                    }
                }
            }
        }
        __builtin_amdgcn_s_setprio(0);
        __syncthreads();
    }
}

DI void phase_combine(const Params& P) {
    const int tid = threadIdx.x, wave = tid >> 6, lane = tid & 63;
    const int gw = blockIdx.x * 8 + wave, NGW = gridDim.x * 8;
    for (int row = gw; row < T_TOK * 8; row += NGW) {
        const int t = row >> 3, hq = row & 7, own = (t & (SEQ - 1)) >> 8, nsel = own < 3 ? own : 3;
        float m[4], l[4];
#pragma unroll
        for (int s = 0; s < 4; ++s) { if (s <= nsel) { const f32x2 ml = *(const f32x2*)(P.part_ml + ((size_t)row * 4 + s) * 2); m[s] = ml.x; l[s] = ml.y; } else { m[s] = -1e30f; l[s] = 0.f; } }
        const float M = fmaxf(fmaxf(m[0], m[1]), fmaxf(m[2], m[3]));
        float o0 = 0.f, o1 = 0.f, L = 0.f;
#pragma unroll
        for (int s = 0; s < 4; ++s) {
            if (s <= nsel) {
                const float w = l[s] * __expf(m[s] - M); L += w;
                const unsigned v = *(const unsigned*)(P.part[s] + (size_t)row * 128 + 2 * lane);
                o0 += w * bf_lo(v); o1 += w * bf_hi(v);
            }
        }
        const float inv = 1.f / L;
        *(unsigned*)(P.attn + (size_t)t * DM + hq * 128 + 2 * lane) = cvt_pk_bf16(o0 * inv, o1 * inv);
    }
}

DI void phase_final(const Params& P) {
    const int tid = threadIdx.x, wave = tid >> 6, lane = tid & 63;
    const int gw = blockIdx.x * 8 + wave, NGW = gridDim.x * 8;
    for (int row = gw; row < T_TOK; row += NGW) {
        const float rs = rsqrtf(P.rowss[6 * T_TOK + row] * (1.f / DM) + RMS_EPS);
        const f32x4* xr = (const f32x4*)(P.xres + (size_t)row * DM) + lane;
        const f32x4* gr = (const f32x4*)P.final_g + lane;
        f32x4* o = (f32x4*)(P.out + (size_t)row * DM) + lane;
#pragma unroll
        for (int j = 0; j < 4; ++j) o[64 * j] = xr[64 * j] * rs * gr[64 * j];
    }
}

DI void phase_final_fused(const Params& P, LAS unsigned char* lds, int vbid) {
    pg8::StaticOrder S; S.init(T_TOK, DM, gridDim.x, vbid);
    pg8::Unit u;
    if (!S.next(0, u)) return;
    const int tid = threadIdx.x, wave = tid >> 6, lane = tid & 63;
    asm volatile("s_waitcnt vmcnt(0)" ::: "memory");
    __syncthreads();
    LAS int* flag = (LAS int*)lds;
    if (tid == 0) flag[0] = atomicAdd(P.pcnt + u.pm, 1);
    __syncthreads();
    if (flag[0] != 3) return;
    __builtin_amdgcn_fence(__ATOMIC_ACQUIRE, "agent");
    asm volatile("s_waitcnt vmcnt(0)" ::: "memory");
    const f32x4* gr = (const f32x4*)P.final_g + lane;
    const f32x4 g0 = gr[0], g1 = gr[64], g2 = gr[128], g3 = gr[192];
#pragma unroll 1
    for (int r0 = wave * 32; r0 < wave * 32 + 32; r0 += 4) {
        f32x4 v[4][4]; float ss[4];
#pragma unroll
        for (int i = 0; i < 4; ++i) {
            const int row = u.pm * 256 + r0 + i;
            const f32x4* xr = (const f32x4*)(P.xres + (size_t)row * DM) + lane;
            ss[i] = P.rowss[6 * T_TOK + row];
            v[i][0] = xr[0]; v[i][1] = xr[64]; v[i][2] = xr[128]; v[i][3] = xr[192];
        }
#pragma unroll
        for (int i = 0; i < 4; ++i) {
            const int row = u.pm * 256 + r0 + i;
            const float rs = rsqrtf(ss[i] * (1.f / DM) + RMS_EPS);
            f32x4* o = (f32x4*)(P.out + (size_t)row * DM) + lane;
            o[0] = v[i][0] * rs * g0; o[64] = v[i][1] * rs * g1; o[128] = v[i][2] * rs * g2; o[192] = v[i][3] * rs * g3;
        }
    }
}

#define XB_TMO      128
#define XB_XCNT(j)  (256  + 64 * (j))
#define XB_XSUB(j)  (1280 + 64 * (j))
#define XB_XGEN(j)  (2304 + 64 * (j))
#define XB_TOP      3328
#define XB_TOPGEN   3392
#define XCD_BAR_WORDS 3456
#define XB_SPIN_CAP (1u << 18)
DI unsigned xb_ld(unsigned* p)              { return __hip_atomic_load(p, __ATOMIC_RELAXED, __HIP_MEMORY_SCOPE_AGENT); }
DI unsigned xb_add(unsigned* p, unsigned v) { return __hip_atomic_fetch_add(p, v, __ATOMIC_RELAXED, __HIP_MEMORY_SCOPE_AGENT); }
DI unsigned xb_xcc_id() { return (unsigned)__builtin_amdgcn_s_getreg((3 << 11) | 20) & 0xFu; }
#define XB_SPIN(cond, bar) do { unsigned _sp = 0; while (cond) { __builtin_amdgcn_s_sleep(1); \
    if ((++_sp & 255u) == 0u) { if (xb_ld(&(bar)[XB_TMO])) break; if (_sp > XB_SPIN_CAP) { atomicAdd(&(bar)[XB_TMO], 1u); break; } } } } while (0)
struct XcdBarrier { unsigned* bar; unsigned x; volatile LAS unsigned* st; };
DI XcdBarrier xcd_barrier_post(unsigned* bar, volatile LAS unsigned* st) {
    XcdBarrier b; b.bar = bar; b.x = xb_xcc_id(); b.st = st;
    if (threadIdx.x == 0) (void)xb_add(&bar[XB_XCNT(b.x)], 1u);
    return b;
}
DI void xcd_barrier_complete(unsigned* bar, unsigned x, unsigned& nloc, unsigned& nx) {
    const unsigned G = gridDim.x * gridDim.y * gridDim.z;
    unsigned sum, cnt, mine, sp = 0u;
    for (;;) {
        sum = 0u; cnt = 0u; mine = 0u;
#pragma unroll
        for (unsigned j = 0; j < 16; ++j) { const unsigned c = xb_ld(&bar[XB_XCNT(j)]); sum += c; cnt += (c > 0u) ? 1u : 0u; mine = (j == x) ? c : mine; }
        if (sum == G) break;
        __builtin_amdgcn_s_sleep(1);
        if ((++sp & 255u) == 0u) { if (xb_ld(&bar[XB_TMO])) break; if (sp > XB_SPIN_CAP) { atomicAdd(&bar[XB_TMO], 1u); break; } }
    }
    nloc = mine > 0u ? mine : 1u; nx = cnt > 0u ? cnt : 1u;
}
DI void xcd_barrier(const XcdBarrier& b) {
    asm volatile("s_waitcnt vmcnt(0)" ::: "memory");
    __syncthreads();
    if (threadIdx.x == 0) {
        unsigned* bar = b.bar;
        __builtin_amdgcn_s_waitcnt(0);
        unsigned nloc = b.st[0], nx = b.st[1];
        if (nloc == 0u) { xcd_barrier_complete(bar, b.x, nloc, nx); b.st[0] = nloc; b.st[1] = nx; }
        const unsigned old = xb_add(&bar[XB_XSUB(b.x)], 1u);
        const unsigned gen = old / nloc;
        if (old + 1u == (gen + 1u) * nloc) {
            __builtin_amdgcn_fence(__ATOMIC_RELEASE, "agent");
            asm volatile("s_waitcnt vmcnt(0)" ::: "memory");
            const unsigned og = xb_add(&bar[XB_TOP], 1u);
            const unsigned tg = og / nx;
            if (og + 1u == (tg + 1u) * nx) xb_add(&bar[XB_TOPGEN], 1u);
            else XB_SPIN(xb_ld(&bar[XB_TOPGEN]) == tg, bar);
            __builtin_amdgcn_fence(__ATOMIC_ACQUIRE, "agent");
            xb_add(&bar[XB_XGEN(b.x)], 1u);
            asm volatile("s_waitcnt vmcnt(0)" ::: "memory");
        } else {
            XB_SPIN(xb_ld(&bar[XB_XGEN(b.x)]) == gen, bar);
            __builtin_amdgcn_fence(__ATOMIC_ACQUIRE, "agent");
            asm volatile("s_waitcnt vmcnt(0)" ::: "memory");
        }
    }
    __syncthreads();
}

constexpr int NPHASES = 18;
#ifndef PHMASK
#define PHMASK 0xFFFFF
#endif
#define PHON(n) if constexpr (((PHMASK) >> (n)) & 1)
#ifndef DUPSEL
#define DUPSEL 0
#endif
__global__ void __launch_bounds__(512, 2) mega_fwd(const Params P) {
    extern __shared__ __attribute__((aligned(16))) unsigned char smem[];
    LAS unsigned char* lds = (LAS unsigned char*)smem;
    cg::grid_group grid = cg::this_grid();
    if (P.ph_hi < 0) grid.sync();
    volatile LAS unsigned* xst = (volatile LAS unsigned*)(lds + 139264);
    if (threadIdx.x == 0) { xst[0] = 0u; xst[1] = 0u; xst[2] = 0u; xst[3] = 0u; xst[4] = 0u; }
    __syncthreads();
    XcdBarrier xb; xb.bar = P.bar; xb.x = xb_xcc_id(); xb.st = xst;
    if (threadIdx.x == 0) xst[2] = xb_add(&P.bar[XB_XCNT(xb.x)], 1u);
    PHON(0) if (P.ph_lo <= 0 && 0 < P.ph_hi) { phase_prep(P, lds); }
    if constexpr (DUPSEL == 4) { xcd_barrier(xb); phase_prep(P, lds); }
    if (P.ph_lo < 1 && 1 < P.ph_hi) xcd_barrier(xb);
    if (threadIdx.x == 0) {
        bool ok = (gridDim.x % 8u) == 0u;
        for (unsigned j = 0; j < 16; ++j) { const unsigned c = xb_ld(&P.bar[XB_XCNT(j)]); ok = ok && (c == (j < 8 ? gridDim.x / 8u : 0u)); }
        xst[3] = ok ? (xb.x + 8u * xst[2]) : blockIdx.x; xst[4] = ok ? 1u : 0u;
    }
    __syncthreads();
    const int vbid = (int)xst[3];
    const bool vb_ok = xst[4] != 0u;
    preload_rs(lds, vbid, P.rowss + 0 * T_TOK, 5632); run_gemm_v(lds, vbid, P.xb, P.wt_up[0], 5632, DM, EpiAct{P.act, P.rowss + 0 * T_TOK, P.kbuf, P.vT, P.rope, (const LAS float*)(lds + 131072)});
    convert_by_light_blocks(P, lds, vbid, 64 * 22, P.it1, P.it2);
    if constexpr (DUPSEL == 2) { xcd_barrier(xb); preload_rs(lds, vbid, P.rowss + 0 * T_TOK, 5632); run_gemm_v(lds, vbid, P.xb, P.wt_up[0], 5632, DM, EpiAct{P.act, P.rowss + 0 * T_TOK, P.kbuf, P.vT, P.rope, (const LAS float*)(lds + 131072)}); }
    if (P.ph_lo < 2 && 2 < P.ph_hi) xcd_barrier(xb);
    PHON(2) if (P.ph_lo <= 2 && 2 < P.ph_hi) { run_gemm_v(lds, vbid, P.act, P.wt_dn[0], DM, FF, EpiRes{P.x, P.xres, P.xb, P.rowss + 1 * T_TOK, 0.5f}); }
    if (P.ph_lo < 3 && 3 < P.ph_hi) xcd_barrier(xb);
    PHON(3) if (P.ph_lo <= 3 && 3 < P.ph_hi) { phase_s5a(P, lds); }
    xcd_barrier(xb);
    phase_s5carry(P);
    if (P.ph_lo < 4 && 4 < P.ph_hi) xcd_barrier(xb);
    PHON(4) if (P.ph_lo <= 4 && 4 < P.ph_hi) { phase_s5b(P, lds); }
    if constexpr (DUPSEL == 3) { xcd_barrier(xb); phase_s5a(P, lds); xcd_barrier(xb); phase_s5carry(P); xcd_barrier(xb); phase_s5b(P, lds); }

    if (P.ph_lo < 5 && 5 < P.ph_hi) xcd_barrier(xb);
    PHON(5) if (P.ph_lo <= 5 && 5 < P.ph_hi) { run_gemm_v(lds, vbid, P.yb, P.wt_glu, 2048, DM, EpiGlu{P.xres, P.xb, P.rowss + 2 * T_TOK}); }
    if (P.ph_lo < 6 && 6 < P.ph_hi) xcd_barrier(xb);
    PHON(6) if (P.ph_lo <= 6 && 6 < P.ph_hi) { preload_rs(lds, vbid, P.rowss + 2 * T_TOK, 5632); run_gemm_v(lds, vbid, P.xb, P.wt_up[1], 5632, DM, EpiAct{P.act, P.rowss + 2 * T_TOK, P.kbuf, P.vT, P.rope, (const LAS float*)(lds + 131072)}); convert_by_light_blocks(P, lds, vbid, 64 * 22, P.it2, P.nitems); }
    if (P.ph_lo < 7 && 7 < P.ph_hi) xcd_barrier(xb);
    PHON(7) if (P.ph_lo <= 7 && 7 < P.ph_hi) { run_gemm_v(lds, vbid, P.act, P.wt_dn[1], DM, FF, EpiRes{P.xres, P.xres, P.xb, P.rowss + 3 * T_TOK, 0.5f}); }
    if (P.ph_lo < 8 && 8 < P.ph_hi) xcd_barrier(xb);
    PHON(8) if (P.ph_lo <= 8 && 8 < P.ph_hi) { preload_rs(lds, vbid, P.rowss + 3 * T_TOK, 6144); run_gemm_v(lds, vbid, P.xb, P.wt_up[2], 6144, DM, EpiAct{P.act, P.rowss + 3 * T_TOK, P.kbuf, P.vT, P.rope, (const LAS float*)(lds + 131072)}); }
    if (P.ph_lo < 9 && 9 < P.ph_hi) xcd_barrier(xb);
    PHON(9) if (P.ph_lo <= 9 && 9 < P.ph_hi) { run_gemm_v(lds, vbid, P.act, P.wt_dn[2], DM, FF, EpiRes{P.xres, P.xres, P.xb, P.rowss + 4 * T_TOK, 0.5f}); phase_kmean(P, lds); }
    if (P.ph_lo < 10 && 10 < P.ph_hi) xcd_barrier(xb);
    PHON(10) if (P.ph_lo <= 10 && 10 < P.ph_hi) { run_gemm_v(lds, vbid, P.xb, P.wt_q, DM, DM, EpiQ{P.qbuf, P.rowss + 4 * T_TOK, P.rope}); }
    if (P.ph_lo < 11 && 11 < P.ph_hi) xcd_barrier(xb);
    PHON(11) if (P.ph_lo <= 11 && 11 < P.ph_hi) { phase_gate(P, lds); }
    if (P.ph_lo < 12 && 12 < P.ph_hi) xcd_barrier(xb);
    PHON(12) if (P.ph_lo <= 12 && 12 < P.ph_hi) { phase_attn<false>(P, lds); }
    if constexpr (DUPSEL == 6) { xcd_barrier(xb); phase_attn<false>(P, lds); }
    if (P.ph_lo < 13 && 13 < P.ph_hi) xcd_barrier(xb);
    PHON(13) if (P.ph_lo <= 13 && 13 < P.ph_hi) { phase_attn<true>(P, lds); }
    if constexpr (DUPSEL == 1) { for (int i = 0; i < 8; ++i) xcd_barrier(xb); }
    if (P.ph_lo < 14 && 14 < P.ph_hi) xcd_barrier(xb);
    PHON(14) if (P.ph_lo <= 14 && 14 < P.ph_hi) { run_gemm_v(lds, vbid, P.attn, P.wt_o, DM, DM, EpiRes{P.xres, P.xres, P.xb, P.rowss + 5 * T_TOK, 1.0f}); }
    if (P.ph_lo < 15 && 15 < P.ph_hi) xcd_barrier(xb);
    PHON(15) if (P.ph_lo <= 15 && 15 < P.ph_hi) { preload_rs(lds, vbid, P.rowss + 5 * T_TOK, 5632); run_gemm_v(lds, vbid, P.xb, P.wt_up[3], 5632, DM, EpiAct{P.act, P.rowss + 5 * T_TOK, P.kbuf, P.vT, P.rope, (const LAS float*)(lds + 131072)}); }
    if (P.ph_lo < 16 && 16 < P.ph_hi) xcd_barrier(xb);
    PHON(16) if (P.ph_lo <= 16 && 16 < P.ph_hi) { run_gemm_v(lds, vbid, P.act, P.wt_dn[3], DM, FF, EpiRes{P.xres, P.xres, P.xb, P.rowss + 6 * T_TOK, 0.5f}); }
    if (vb_ok && gridDim.x == 256u) { phase_final_fused(P, lds, vbid); }
    else { xcd_barrier(xb); phase_final(P); }
}

extern "C" void kernel_launch(void* const* d_in, const int* in_sizes, int n_in, void* d_out, int out_size, void* d_ws, size_t ws_size, hipStream_t stream) {
    static int grid_blocks = 0;
    if (!grid_blocks) {
        int dev = 0, cus = 0, per_cu = 0;
        hipGetDevice(&dev);
        hipDeviceGetAttribute(&cus, hipDeviceAttributeMultiprocessorCount, dev);
        hipFuncSetAttribute((const void*)mega_fwd, hipFuncAttributeMaxDynamicSharedMemorySize, LDS_BYTES);
        hipOccupancyMaxActiveBlocksPerMultiprocessor(&per_cu, (const void*)mega_fwd, 512, LDS_BYTES);
        if (per_cu < 1) per_cu = 1;
        if (per_cu > 1) per_cu = 1;
        grid_blocks = cus * per_cu;
    }
    Params p{};
    const float** in = (const float**)&p.x;
    for (int i = 0; i < 19; ++i) in[i] = (const float*)d_in[i];
    p.out = (float*)d_out;
    unsigned char* ws = (unsigned char*)d_ws; size_t off = 0;
    auto take = [&](size_t bytes) { unsigned char* r = ws + off; off += (bytes + 255) & ~(size_t)255; return r; };
    p.xres = (float*)take((size_t)T_TOK * DM * 4);
    p.xb = (bf16_t*)take((size_t)T_TOK * DM * 2);
    p.act = (bf16_t*)take((size_t)T_TOK * FF * 2);
    p.qbuf = p.act;
    p.attn = p.act + (size_t)T_TOK * DM;
    p.part_ml = (float*)(p.act + (size_t)2 * T_TOK * DM);
    p.kbuf = (bf16_t*)take((size_t)T_TOK * 256 * 2);
    p.vT = (bf16_t*)take((size_t)T_TOK * 256 * 2);
    p.kmean = (float*)take(128 * 128 * 4);
    p.rowss = (float*)take((size_t)7 * T_TOK * 4 + 1024);
    p.gcount = (int*)(p.rowss + 7 * T_TOK);
    p.E = (float*)take((size_t)2 * 128 * 64 * 64 * 2 * 4);
    p.lists = (int*)p.E;
    p.rope = (float*)take((size_t)SEQ * 16 * 2 * 4);
    p.bar = (unsigned*)take((size_t)XCD_BAR_WORDS * 4);
    p.s5tab = (float*)take(4096 * 4 * 4);
    p.pcnt = (int*)take(256);
    p.wt_up[0] = (bf16_t*)take((size_t)6144 * DM * 2); p.wt_up[1] = (bf16_t*)take((size_t)6144 * DM * 2);
    p.wt_dn[0] = (bf16_t*)take((size_t)DM * FF * 2); p.wt_dn[1] = (bf16_t*)take((size_t)DM * FF * 2);
    p.wt_glu = (bf16_t*)take((size_t)2048 * DM * 2);
    p.wt_up[2] = (bf16_t*)take((size_t)6144 * DM * 2); p.wt_up[3] = (bf16_t*)take((size_t)6144 * DM * 2);
    p.wt_dn[2] = (bf16_t*)take((size_t)DM * FF * 2); p.wt_dn[3] = (bf16_t*)take((size_t)DM * FF * 2);
    p.wt_q = (bf16_t*)take((size_t)DM * DM * 2);
    p.wt_o = (bf16_t*)take((size_t)DM * DM * 2);
    p.part[0] = p.xb;
    p.part[1] = (bf16_t*)take((size_t)T_TOK * DM * 2);
    p.part[2] = (bf16_t*)take((size_t)T_TOK * DM * 2);
    p.part[3] = p.wt_up[0];
    p.yb = p.part[1];
    int nj = 0, items = 0;
    auto job = [&](const float* W, const float* g, bf16_t* dst, int K, int Nsrc, int ndst, int mode) {
        WJob& J = p.jobs[nj++]; J.W = W; J.g = g; J.dst = dst; J.K = K; J.Nsrc = Nsrc; J.ndst = ndst; J.mode = mode; J.item0 = items; J.pad = 0;
        items += (K / 64) * (ndst / 32);
    };
    auto job_up = [&](int l, int f) { job(p.ffn_w_in + (size_t)(l * 2 + f) * DM * 2 * FF, p.norm_g + (size_t)(l * 3 + (f ? 2 : 0)) * DM, p.wt_up[l * 2 + f], DM, 2 * FF, 2 * FF, 1); };
    auto job_dn = [&](int l, int f) { job(p.ffn_w_out + (size_t)(l * 2 + f) * FF * DM, nullptr, p.wt_dn[l * 2 + f], FF, DM, DM, 0); };
    job_up(0, 0);
    p.it1 = items;
    job_dn(0, 0); job(p.w_glu, nullptr, p.wt_glu, DM, 2048, 2048, 1); job_up(0, 1); job_dn(0, 1);
    p.it2 = items;
    job_up(1, 0);
    job(p.w_k, p.kv_norm_g, p.wt_up[2] + (size_t)5632 * DM, DM, 256, 256, 0);
    job(p.w_v, p.kv_norm_g, p.wt_up[2] + (size_t)5888 * DM, DM, 256, 256, 0);
    job_dn(1, 0); job_up(1, 1); job_dn(1, 1);
    job(p.w_q, p.norm_g + (size_t)4 * DM, p.wt_q, DM, DM, DM, 0);
    job(p.w_o, nullptr, p.wt_o, DM, DM, DM, 0);
    p.nitems = items; p.ph_lo = 0; p.ph_hi = NPHASES; p.pad = 0;
    if (off > ws_size) { fprintf(stderr, "workspace too small: need %zu have %zu\n", off, ws_size); return; }
    (void)hipMemsetAsync(p.bar, 0, (size_t)XCD_BAR_WORDS * 4, stream);
    void* args[] = {&p};
    hipError_t e = hipLaunchCooperativeKernel((const void*)mega_fwd, dim3(grid_blocks), dim3(512), args, LDS_BYTES, stream);
    if (e != hipSuccess) fprintf(stderr, "cooperative launch failed: %s (grid %d)\n", hipGetErrorString(e), grid_blocks);
}
```

```cpp
#include <hip/hip_runtime.h>
#include <hip/hip_cooperative_groups.h>
#include <cstdio>
namespace cg = cooperative_groups;

#define LAS __attribute__((address_space(3)))
#define DI __device__ __forceinline__
typedef unsigned short bf16_t;
typedef short bf16x8 __attribute__((ext_vector_type(8)));
typedef float f32x4 __attribute__((ext_vector_type(4)));
typedef float f32x2 __attribute__((ext_vector_type(2)));
typedef unsigned u32x4 __attribute__((ext_vector_type(4)));
typedef unsigned u32x2 __attribute__((ext_vector_type(2)));

constexpr int T_TOK = 16384, DM = 1024, FF = 2816, SEQ = 8192;
constexpr float RMS_EPS = 1e-6f;
constexpr int LDS_BYTES = 139296;
constexpr int NJOBS = 13;

struct WJob { const float* W; const float* g; bf16_t* dst; int K; int Nsrc; int ndst; int mode; int item0; int pad; };

struct Params {
    const float *x, *norm_g, *ffn_w_in, *ffn_w_out, *a_re, *a_im, *log_step, *b_re, *b_im, *c_re, *c_im, *s5_d, *w_glu, *kv_norm_g, *w_k, *w_v, *w_q, *w_o, *final_g;
    float* out;
    float* xres; bf16_t* xb; bf16_t* act; bf16_t* yb; bf16_t* qbuf; bf16_t* attn; bf16_t* kbuf; bf16_t* vbuf;
    float* kmean; float* rowss; float* E; float* rope;
    bf16_t* vT; bf16_t* part[4]; float* part_ml; int* lists; int* gcount; unsigned* bar; float* s5tab; int* pcnt;
    bf16_t* wt_up[4]; bf16_t* wt_dn[4]; bf16_t* wt_glu; bf16_t* wt_q; bf16_t* wt_o;
    WJob jobs[NJOBS];
    int nitems; int ph_lo; int ph_hi; int pad; int it1; int it2;
};

DI unsigned cvt_pk_bf16(float lo, float hi) { unsigned r; asm volatile("v_cvt_pk_bf16_f32 %0, %1, %2" : "=v"(r) : "v"(lo), "v"(hi)); return r; }
DI float bf_lo(unsigned w) { return __uint_as_float(w << 16); }
DI float bf_hi(unsigned w) { return __uint_as_float(w & 0xffff0000u); }
DI float wave_sum(float v) {
#pragma unroll
    for (int o = 1; o < 64; o <<= 1) v += __shfl_xor(v, o);
    return v;
}
DI float wave_max(float v) {
#pragma unroll
    for (int o = 1; o < 64; o <<= 1) v = fmaxf(v, __shfl_xor(v, o));
    return v;
}

namespace pg8 {
constexpr int BM = 256, BK = 64, HALF = 128, HTB = HALF * BK * 2, NXCD = 8, WGM = 8;
DI int lds_byte(int r, int c) { const int st = (r >> 4) * 2 + (c >> 5), rr = r & 15, cc = c & 31, ob = rr * 64 + cc * 2; return st * 1024 + (ob ^ (((ob >> 9) & 1) << 5)); }
DI void stage_rc(int b, int& R, int& C) { const int st = b / 1024, sb = b % 1024, swz = sb ^ (((sb >> 9) & 1) << 5); R = (st >> 1) * 16 + swz / 64; C = (st & 1) * 32 + (swz % 64) / 2; }
struct Unit { int pm, pn; };
struct Gemm { const bf16_t* A; const bf16_t* Bt; int M, N, K; };
struct StaticOrder {
    int nM, nN, nwg, G, c;
    DI void init(int M, int N, int G_, int c_) { nM = M / BM; nN = N / BM; nwg = nM * nN; G = G_; c = c_; }
    DI bool next(int i, Unit& u) const {
        const long L = (long)i * G + c; if (L >= nwg) return false;
        int wgid = (int)L; { const int q = nwg / NXCD, r = nwg % NXCD, xcd = wgid % NXCD, off = wgid / NXCD; wgid = (xcd < r ? xcd * (q + 1) : r * (q + 1) + (xcd - r) * q) + off; }
        const int nig = WGM * nN, gid = wgid / nig, fm = gid * WGM, gsz = (nM - fm) < WGM ? (nM - fm) : WGM;
        u.pm = fm + ((wgid % nig) % gsz); u.pn = (wgid % nig) / gsz; return true;
    }
};

template <class Epi>
DI void gemm_phase(LAS unsigned char* lds, const Gemm g, const StaticOrder& S, const Epi& E) {
    int tid_ = threadIdx.x; asm volatile("" : "+v"(tid_));
    const int tid = tid_, wid = __builtin_amdgcn_readfirstlane(tid >> 6), lane = tid & 63, wr = wid >> 2, wc = wid & 3, fr = lane & 15, fq = lane >> 4;
    const int K = g.K, nt = K / BK;
    unsigned voffA[2], voffB[2];
#pragma unroll
    for (int i = 0; i < 2; ++i) { int R, C; stage_rc(tid * 16 + i * 8192, R, C); voffA[i] = (unsigned)(R * K + C) * 2u; voffB[i] = voffA[i]; }
    const size_t kstep = (size_t)(BK * 2);
    const size_t hstep = (size_t)HALF * K * 2;
    const size_t tstep = 2 * hstep;
    const unsigned ldsw = (unsigned)wid * 1024u;
    const int aoff = lds_byte(wr * 64 + fr, fq * 8), boff = lds_byte(wc * 32 + fr, fq * 8);
#define PG8_SA(b, h) (((b) * 2 + (h)) * HTB)
#define PG8_SB(b, h) ((4 + (b) * 2 + (h)) * HTB)
#define PG8_STAGE(bufoff, gbase, voff) do { _Pragma("unroll") for (int _i = 0; _i < 2; ++_i) \
        __builtin_amdgcn_global_load_lds((const unsigned*)((const char*)(gbase) + (voff)[_i]), (LAS unsigned*)(lds + (bufoff) + ldsw + _i * 8192), 16, 0, 0); } while (0)
#define PG8_LDA(dst, b, h) do { _Pragma("unroll") for (int m = 0; m < 4; ++m) _Pragma("unroll") for (int k = 0; k < 2; ++k) dst[m][k] = *(const LAS bf16x8*)(lds + PG8_SA(b, h) + aoff + m * 2048 + k * 1024); } while (0)
#define PG8_LDB(dst, b, h) do { _Pragma("unroll") for (int n = 0; n < 2; ++n) _Pragma("unroll") for (int k = 0; k < 2; ++k) dst[n][k] = *(const LAS bf16x8*)(lds + PG8_SB(b, h) + boff + n * 2048 + k * 1024); } while (0)
#define PG8_MMA(ai, bj, At, Bt) do { __builtin_amdgcn_s_setprio(1); _Pragma("unroll") for (int m = 0; m < 4; ++m) _Pragma("unroll") for (int n = 0; n < 2; ++n) _Pragma("unroll") for (int k = 0; k < 2; ++k) \
        acc[ai][bj][m][n] = __builtin_amdgcn_mfma_f32_16x16x32_bf16(Bt[n][k], At[m][k], acc[ai][bj][m][n], 0, 0, 0); __builtin_amdgcn_s_setprio(0); } while (0)
#define PG8_WAIT_V(n) asm volatile("s_waitcnt vmcnt(" #n ")" ::: "memory")
#define PG8_WAIT_L(n) asm volatile("s_waitcnt lgkmcnt(" #n ")" ::: "memory")
#define PG8_BAR __builtin_amdgcn_s_barrier()
#define PG8_SCHED __builtin_amdgcn_sched_barrier(0)
    Unit cur, nxt; int ui = 0;
    if (!S.next(0, cur)) return;
    f32x4 acc[2][2][4][2];
#pragma unroll
    for (int a = 0; a < 2; ++a)
#pragma unroll
        for (int b = 0; b < 2; ++b)
#pragma unroll
            for (int m = 0; m < 4; ++m)
#pragma unroll
                for (int n = 0; n < 2; ++n) acc[a][b][m][n] = (f32x4){0.f, 0.f, 0.f, 0.f};
    bf16x8 At[4][2], B0[2][2], B1[2][2];
    const char* cA = (const char*)g.A + (size_t)cur.pm * tstep; const char* cB = (const char*)g.Bt + (size_t)cur.pn * tstep;
    PG8_STAGE(PG8_SB(0, 0), cB, voffB); PG8_STAGE(PG8_SA(0, 0), cA, voffA); PG8_STAGE(PG8_SB(0, 1), cB + hstep, voffB); PG8_STAGE(PG8_SA(0, 1), cA + hstep, voffA);
    if (wr == 1) PG8_BAR;
    PG8_WAIT_V(4); PG8_BAR;
    PG8_STAGE(PG8_SB(1, 0), cB + kstep, voffB); PG8_STAGE(PG8_SA(1, 0), cA + kstep, voffA); PG8_STAGE(PG8_SB(1, 1), cB + hstep + kstep, voffB);
    PG8_WAIT_V(6); PG8_BAR;
    for (;;) {
        const bool has_next = S.next(ui + 1, nxt);
        const char* nA = has_next ? (const char*)g.A + (size_t)nxt.pm * tstep : cA; const char* nB = has_next ? (const char*)g.Bt + (size_t)nxt.pn * tstep : cB;
        for (int t = 0; t < nt; t += 2) {
            const bool last = (t == nt - 2);
            const char* a1 = cA + (size_t)(t + 1) * kstep;
            const char* a2 = last ? nA : cA + (size_t)(t + 2) * kstep; const char* b2 = last ? nB : cB + (size_t)(t + 2) * kstep;
            const char* a3 = a2 + kstep; const char* b3 = b2 + kstep;
            PG8_LDB(B0, 0, 0); PG8_SCHED; PG8_LDA(At, 0, 0); PG8_STAGE(PG8_SA(1, 1), a1 + hstep, voffA);
            PG8_WAIT_L(8); PG8_BAR; PG8_WAIT_L(0); PG8_MMA(0, 0, At, B0); PG8_BAR; PG8_SCHED;
            PG8_LDB(B1, 0, 1); PG8_STAGE(PG8_SB(0, 0), b2, voffB);
            PG8_BAR; PG8_WAIT_L(0); PG8_MMA(0, 1, At, B1); PG8_BAR;
            PG8_LDA(At, 0, 1); PG8_STAGE(PG8_SA(0, 0), a2, voffA);
            PG8_BAR; PG8_WAIT_L(0); PG8_MMA(1, 0, At, B0); PG8_BAR; PG8_SCHED;
            PG8_STAGE(PG8_SB(0, 1), b2 + hstep, voffB);
            PG8_WAIT_V(6); PG8_BAR; PG8_MMA(1, 1, At, B1); PG8_BAR;
            PG8_LDB(B0, 1, 0); PG8_SCHED; PG8_LDA(At, 1, 0); PG8_STAGE(PG8_SA(0, 1), a2 + hstep, voffA);
            PG8_WAIT_L(8); PG8_BAR; PG8_WAIT_L(0); PG8_MMA(0, 0, At, B0); PG8_BAR; PG8_SCHED;
            PG8_LDB(B1, 1, 1); PG8_STAGE(PG8_SB(1, 0), b3, voffB);
            PG8_BAR; PG8_WAIT_L(0); PG8_MMA(0, 1, At, B1); PG8_BAR;
            PG8_LDA(At, 1, 1); PG8_STAGE(PG8_SA(1, 0), a3, voffA);
            PG8_BAR; PG8_WAIT_L(0); PG8_MMA(1, 0, At, B0); PG8_BAR; PG8_SCHED;
            PG8_STAGE(PG8_SB(1, 1), b3 + hstep, voffB);
            PG8_WAIT_V(6); PG8_BAR; PG8_MMA(1, 1, At, B1); PG8_BAR;
        }
        E(acc, cur, wr, wc, fr, fq, ui);
        if (!has_next) break;
#pragma unroll
        for (int a = 0; a < 2; ++a)
#pragma unroll
            for (int b = 0; b < 2; ++b)
#pragma unroll
                for (int m = 0; m < 4; ++m)
#pragma unroll
                    for (int n = 0; n < 2; ++n) acc[a][b][m][n] = (f32x4){0.f, 0.f, 0.f, 0.f};
        cur = nxt; cA = nA; cB = nB; ++ui;
    }
    PG8_WAIT_V(0);
    if (wr == 0) PG8_BAR;
    PG8_BAR;
#undef PG8_SA
#undef PG8_SB
#undef PG8_STAGE
#undef PG8_LDA
#undef PG8_LDB
#undef PG8_MMA
#undef PG8_WAIT_V
#undef PG8_WAIT_L
#undef PG8_BAR
#undef PG8_SCHED
}
}
using pg8::Unit;
typedef f32x4 AccT[2][2][4][2];

DI void store_bf4(bf16_t* p, f32x4 v) { u32x2 o; o.x = cvt_pk_bf16(v.x, v.y); o.y = cvt_pk_bf16(v.z, v.w); *(u32x2*)p = o; }
DI float sigmoidf_(float x) { return __builtin_amdgcn_rcpf(1.f + __builtin_amdgcn_exp2f(-1.4426950408889634f * x)); }

struct EpiAct {
    bf16_t* act; const float* rowss; bf16_t* kbuf; bf16_t* vbuf; const float* rope; const LAS float* rsl;
    DI void operator()(const AccT& acc, const Unit& u, int wr, int wc, int fr, int fq, int ui) const {
        const int row0 = u.pm * 256 + wr * 64 + fr;
        if (u.pn < 22) {
#pragma unroll
            for (int ai = 0; ai < 2; ++ai)
#pragma unroll
                for (int m = 0; m < 4; ++m) {
                    const int row = row0 + ai * 128 + m * 16;
                    const float rs = rsl[ui * 256 + wr * 64 + fr + ai * 128 + m * 16];
#pragma unroll
                    for (int bj = 0; bj < 2; ++bj) {
                        const f32x4 gt = acc[ai][bj][m][0] * rs, up = acc[ai][bj][m][1] * rs;
                        f32x4 a;
#pragma unroll
                        for (int j = 0; j < 4; ++j) a[j] = gt[j] * sigmoidf_(gt[j]) * up[j];
                        const int col = 16 * (8 * u.pn + 4 * bj + wc) + 4 * fq;
                        store_bf4(act + (size_t)row * FF + col, a);
                    }
                }
        } else if (u.pn == 22) {
            const bool do_rope = (wc == 0);
#pragma unroll
            for (int ai = 0; ai < 2; ++ai)
#pragma unroll
                for (int m = 0; m < 4; ++m) {
                    const int row = row0 + ai * 128 + m * 16;
                    const float rs = rsqrtf(rowss[row] * (1.f / DM) + RMS_EPS);
                    const int b = row >> 13, pos = row & (SEQ - 1);
#pragma unroll
                    for (int bj = 0; bj < 2; ++bj) {
                        f32x4 v0 = acc[ai][bj][m][0] * rs, v1 = acc[ai][bj][m][1] * rs;
                        if (do_rope) {
                            const f32x4* rp = (const f32x4*)(rope + ((size_t)pos * 16 + 4 * fq) * 2);
                            const f32x4 cs0 = rp[0], cs1 = rp[1];
                            const float c[4] = {cs0.x, cs0.z, cs1.x, cs1.z}, s[4] = {cs0.y, cs0.w, cs1.y, cs1.w};
#pragma unroll
                            for (int j = 0; j < 4; ++j) { const float x1 = v0[j], x2 = v1[j]; v0[j] = x1 * c[j] - x2 * s[j]; v1[j] = x2 * c[j] + x1 * s[j]; }
                        }
                        bf16_t* d = kbuf + ((size_t)(b * 2 + bj) * SEQ + pos) * 128 + 32 * wc + 4 * fq;
                        store_bf4(d, v0); store_bf4(d + 16, v1);
                    }
                }
        } else {
            const int lane = fr + 16 * fq, qi = lane & 3;
#pragma unroll
            for (int ai = 0; ai < 2; ++ai)
#pragma unroll
                for (int m = 0; m < 4; ++m) {
                    const int row = row0 + ai * 128 + m * 16;
                    const float rs = rsqrtf(rowss[row] * (1.f / DM) + RMS_EPS);
                    const int b = row >> 13, posq = (row & (SEQ - 1)) & ~3;
#pragma unroll
                    for (int bj = 0; bj < 2; ++bj)
#pragma unroll
                        for (int n = 0; n < 2; ++n) {
                            const f32x4 v = acc[ai][bj][m][n] * rs;
                            f32x4 w;
#pragma unroll
                            for (int k = 0; k < 4; ++k) {
                                const int src = (lane & ~3) | k;
                                const float t0 = __shfl(v[0], src), t1 = __shfl(v[1], src), t2 = __shfl(v[2], src), t3 = __shfl(v[3], src);
                                w[k] = qi == 0 ? t0 : (qi == 1 ? t1 : (qi == 2 ? t2 : t3));
                            }
                            const int d = 32 * wc + 16 * n + 4 * fq + qi;
                            store_bf4(vbuf + ((size_t)((b * 2 + bj) * 128 + d)) * SEQ + posq, w);
                        }
                }
        }
    }
};

struct EpiRes {
    const float* xin; float* xout; bf16_t* xb; float* rowss_out; float alpha;
    DI void operator()(const AccT& acc, const Unit& u, int wr, int wc, int fr, int fq, int ui) const {
        const int row0 = u.pm * 256 + wr * 64 + fr;
#pragma unroll
        for (int ai = 0; ai < 2; ++ai)
#pragma unroll
            for (int m = 0; m < 4; ++m) {
                const int row = row0 + ai * 128 + m * 16;
                float ss = 0.f;
#pragma unroll
                for (int bj = 0; bj < 2; ++bj)
#pragma unroll
                    for (int n = 0; n < 2; ++n) {
                        const size_t off = (size_t)row * DM + u.pn * 256 + bj * 128 + wc * 32 + n * 16 + 4 * fq;
                        const f32x4 xo = *(const f32x4*)(xin + off);
                        const f32x4 v = xo + alpha * acc[ai][bj][m][n];
                        *(f32x4*)(xout + off) = v;
                        store_bf4(xb + off, v);
                        ss += v.x * v.x + v.y * v.y + v.z * v.z + v.w * v.w;
                    }
                ss += __shfl_xor(ss, 16); ss += __shfl_xor(ss, 32);
                if (fq == 0) atomicAdd(rowss_out + row, ss);
            }
    }
};

struct EpiGlu {
    float* xres; bf16_t* xb; float* rowss_out;
    DI void operator()(const AccT& acc, const Unit& u, int wr, int wc, int fr, int fq, int ui) const {
        const int row0 = u.pm * 256 + wr * 64 + fr;
#pragma unroll
        for (int ai = 0; ai < 2; ++ai)
#pragma unroll
            for (int m = 0; m < 4; ++m) {
                const int row = row0 + ai * 128 + m * 16;
                float ss = 0.f;
#pragma unroll
                for (int bj = 0; bj < 2; ++bj) {
                    const size_t off = (size_t)row * DM + 16 * (8 * u.pn + 4 * bj + wc) + 4 * fq;
                    const f32x4 val = acc[ai][bj][m][0], gt = acc[ai][bj][m][1];
                    f32x4 v = *(const f32x4*)(xres + off);
#pragma unroll
                    for (int j = 0; j < 4; ++j) v[j] += val[j] * sigmoidf_(gt[j]);
                    *(f32x4*)(xres + off) = v;
                    store_bf4(xb + off, v);
                    ss += v.x * v.x + v.y * v.y + v.z * v.z + v.w * v.w;
                }
                ss += __shfl_xor(ss, 16); ss += __shfl_xor(ss, 32);
                if (fq == 0) atomicAdd(rowss_out + row, ss);
            }
    }
};

struct EpiQ {
    bf16_t* qbuf; const float* rowss; const float* rope;
    DI void operator()(const AccT& acc, const Unit& u, int wr, int wc, int fr, int fq, int ui) const {
        const int row0 = u.pm * 256 + wr * 64 + fr;
#pragma unroll
        for (int ai = 0; ai < 2; ++ai)
#pragma unroll
            for (int m = 0; m < 4; ++m) {
                const int row = row0 + ai * 128 + m * 16;
                const float rs = rsqrtf(rowss[row] * (1.f / DM) + RMS_EPS) * 0.08838834764831845f;
                const int pos = row & (SEQ - 1);
#pragma unroll
                for (int bj = 0; bj < 2; ++bj) {
                    f32x4 v0 = acc[ai][bj][m][0] * rs, v1 = acc[ai][bj][m][1] * rs;
                    if (wc == 0) {
                        const f32x4* rp = (const f32x4*)(rope + ((size_t)pos * 16 + 4 * fq) * 2);
                        const f32x4 cs0 = rp[0], cs1 = rp[1];
                        const float c[4] = {cs0.x, cs0.z, cs1.x, cs1.z}, s[4] = {cs0.y, cs0.w, cs1.y, cs1.w};
#pragma unroll
                        for (int j = 0; j < 4; ++j) { const float x1 = v0[j], x2 = v1[j]; v0[j] = x1 * c[j] - x2 * s[j]; v1[j] = x2 * c[j] + x1 * s[j]; }
                    }
                    bf16_t* d = qbuf + (size_t)row * DM + u.pn * 256 + bj * 128 + 32 * wc + 4 * fq;
                    store_bf4(d, v0); store_bf4(d + 16, v1);
                }
            }
    }
};

DI void preload_rs(LAS unsigned char* lds, int vbid, const float* rowss, int N) {
    pg8::StaticOrder S; S.init(T_TOK, N, gridDim.x, vbid);
    LAS float* rsl = (LAS float*)(lds + 131072);
    pg8::Unit u;
    for (int i = 0; i < 8 && S.next(i, u); ++i)
        if (threadIdx.x < 256) rsl[i * 256 + threadIdx.x] = rsqrtf(rowss[u.pm * 256 + threadIdx.x] * (1.f / DM) + RMS_EPS);
    __syncthreads();
}
template <class Epi>
DI void run_gemm_v(LAS unsigned char* lds, int vbid, const bf16_t* A, const bf16_t* Bt, int N, int K, const Epi& E) {
    pg8::Gemm g{A, Bt, T_TOK, N, K};
    pg8::StaticOrder S; S.init(T_TOK, N, gridDim.x, vbid);
    pg8::gemm_phase<Epi>(lds, g, S, E);
}

struct S5Coef { float ar, ai, cr, ci; };
DI S5Coef s5_coefs_compute(const Params& P, int g, int p) {
    const float dt = expf(P.log_step[g]); const float lr = P.a_re[g * 64 + p], li = P.a_im[g * 64 + p];
    const float mag = expf(lr * dt); S5Coef c; c.ar = mag * cosf(li * dt); c.ai = mag * sinf(li * dt);
    const float nr = c.ar - 1.f, ni = c.ai, den = lr * lr + li * li;
    c.cr = (nr * lr + ni * li) / den; c.ci = (ni * lr - nr * li) / den; return c;
}
DI S5Coef s5_coefs(const Params& P, int g, int p) { const f32x4 v = *(const f32x4*)(P.s5tab + (size_t)(g * 64 + p) * 4); S5Coef c; c.ar = v.x; c.ai = v.y; c.cr = v.z; c.ci = v.w; return c; }

DI void p0_transpose_item(const WJob& J, LAS float* scr, int item, int lane) {
    const int nblk = J.ndst / 32, kb = item / nblk, nb = item % nblk, k0 = 64 * kb, r0 = 32 * nb;
    const int i = lane & 31;
    int scol;
    if (J.mode == 0) scol = r0 + i;
    else { const int G = r0 >> 5; scol = (i < 16) ? (16 * G + i) : ((J.Nsrc >> 1) + 16 * G + (i - 16)); }
    float wv[32];
    const float* wp = J.W + (size_t)(k0 + (lane >> 5)) * J.Nsrc + scol;
#pragma unroll
    for (int it = 0; it < 32; ++it) wv[it] = wp[(size_t)(2 * it) * J.Nsrc];
    if (J.g) {
        const float* gp = J.g + k0 + (lane >> 5);
#pragma unroll
        for (int it = 0; it < 32; ++it) wv[it] *= gp[2 * it];
    }
#pragma unroll
    for (int it = 0; it < 32; ++it) scr[(2 * it + (lane >> 5)) * 33 + i] = wv[it];
    __builtin_amdgcn_fence(__ATOMIC_RELEASE, "wavefront"); __builtin_amdgcn_wave_barrier(); __builtin_amdgcn_fence(__ATOMIC_ACQUIRE, "wavefront");
    const int c = lane & 7;
#pragma unroll
    for (int j = 0; j < 4; ++j) {
        const int n = (lane >> 3) + 8 * j; const LAS float* s = scr + (8 * c) * 33 + n;
        u32x4 o; o.x = cvt_pk_bf16(s[0 * 33], s[1 * 33]); o.y = cvt_pk_bf16(s[2 * 33], s[3 * 33]); o.z = cvt_pk_bf16(s[4 * 33], s[5 * 33]); o.w = cvt_pk_bf16(s[6 * 33], s[7 * 33]);
        *(u32x4*)(J.dst + (size_t)(r0 + n) * J.K + k0 + 8 * c) = o;
    }
    __builtin_amdgcn_fence(__ATOMIC_RELEASE, "wavefront"); __builtin_amdgcn_wave_barrier(); __builtin_amdgcn_fence(__ATOMIC_ACQUIRE, "wavefront");
}

DI void convert_items(const Params& P, LAS unsigned char* lds, int lo, int hi, int gw, int NGW) {
    const int wave = threadIdx.x >> 6, lane = threadIdx.x & 63;
    LAS float* scr = (LAS float*)(lds + wave * 16384);
    for (int it = lo + gw; it < hi; it += NGW) {
        int j = 0;
#pragma unroll 1
        for (int q = 1; q < NJOBS; ++q) if (it >= P.jobs[q].item0) j = q;
        p0_transpose_item(P.jobs[j], scr, it - P.jobs[j].item0, lane);
    }
}
DI void convert_by_light_blocks(const Params& P, LAS unsigned char* lds, int vbid, int units, int lo, int hi) {
    asm volatile("" : "+s"(vbid), "+s"(lo), "+s"(hi));
    const int G = gridDim.x, extra = units % G, first = extra, nlight = G - extra;
    if (vbid >= first) convert_items(P, lds, lo, hi, (vbid - first) * 8 + (threadIdx.x >> 6), nlight * 8);
}

DI void phase_prep(const Params& P, LAS unsigned char* lds) {
    const int tid = threadIdx.x, wave = tid >> 6, lane = tid & 63;
    const int gw = blockIdx.x * 8 + wave, NGW = gridDim.x * 8;
    LAS float* scr = (LAS float*)(lds + wave * 16384);
    convert_items(P, lds, 0, P.it1, gw, NGW);
    for (int row = gw; row < T_TOK; row += NGW) {
        const f32x4* xr = (const f32x4*)(P.x + (size_t)row * DM) + lane;
        f32x4 v[4]; float s = 0.f;
#pragma unroll
        for (int j = 0; j < 4; ++j) { v[j] = xr[64 * j]; s += v[j].x * v[j].x + v[j].y * v[j].y + v[j].z * v[j].z + v[j].w * v[j].w; }
        s = wave_sum(s);
        if (lane == 0) P.rowss[row] = s;
        bf16_t* o = P.xb + (size_t)row * DM + 4 * lane;
#pragma unroll
        for (int j = 0; j < 4; ++j) store_bf4(o + 256 * j, v[j]);
    }
    const int gt = blockIdx.x * 512 + tid, NGT = gridDim.x * 512;
    for (int i = gt; i < 6 * T_TOK; i += NGT) P.rowss[T_TOK + i] = 0.f;
    if (gt < 128) P.gcount[gt] = 0;
    if (gt < 64) P.pcnt[gt] = 0;
    for (int i = gt; i < 4096; i += NGT) { const S5Coef c = s5_coefs_compute(P, i >> 6, i & 63); *(f32x4*)(P.s5tab + (size_t)i * 4) = (f32x4){c.ar, c.ai, c.cr, c.ci}; }
    for (int i = gt; i < SEQ * 16; i += NGT) {
        const int pos = i >> 4, d = i & 15;
        const float inv = exp2f(-(float)d * (18.931568569324174f / 16.f));
        const float ang = (float)pos * inv;
        P.rope[2 * i] = cosf(ang); P.rope[2 * i + 1] = sinf(ang);
    }
}

DI float gelu_tanh(float x) { const float u = 0.7978845608028654f * (x + 0.044715f * x * x * x); return x * __builtin_amdgcn_rcpf(1.f + __builtin_amdgcn_exp2f(-2.f * 1.4426950408889634f * u)); }

typedef float f32x16 __attribute__((ext_vector_type(16)));
typedef __bf16 bf2_t __attribute__((ext_vector_type(2)));
DI unsigned pk_bf16(float lo, float hi) { const f32x2 v = {lo, hi}; return __builtin_bit_cast(unsigned, __builtin_convertvector(v, bf2_t)); }
#define WAVE_LDS_SYNC() asm volatile("s_waitcnt lgkmcnt(0)" ::: "memory")

DI void s5_bfrags(const Params& P, int g, int lane, bf16x8 (&bf)[4]) {
    const int q = lane & 31, h = lane >> 5;
#pragma unroll
    for (int pj = 0; pj < 2; ++pj) {
        const int p = q + 32 * pj;
        const S5Coef c = s5_coefs(P, g, p);
        const f32x4* br = (const f32x4*)(P.b_re + ((size_t)g * 64 + p) * 16 + 8 * h);
        const f32x4* bi = (const f32x4*)(P.b_im + ((size_t)g * 64 + p) * 16 + 8 * h);
        const f32x4 r0 = br[0], r1 = br[1], i0 = bi[0], i1 = bi[1];
        float re[8], im[8];
#pragma unroll
        for (int j = 0; j < 4; ++j) {
            re[j] = c.cr * r0[j] - c.ci * i0[j]; im[j] = c.cr * i0[j] + c.ci * r0[j];
            re[4 + j] = c.cr * r1[j] - c.ci * i1[j]; im[4 + j] = c.cr * i1[j] + c.ci * r1[j];
        }
        const u32x4 wr = {pk_bf16(re[0], re[1]), pk_bf16(re[2], re[3]), pk_bf16(re[4], re[5]), pk_bf16(re[6], re[7])};
        const u32x4 wi = {pk_bf16(im[0], im[1]), pk_bf16(im[2], im[3]), pk_bf16(im[4], im[5]), pk_bf16(im[6], im[7])};
        bf[2 * pj] = __builtin_bit_cast(bf16x8, wr); bf[2 * pj + 1] = __builtin_bit_cast(bf16x8, wi);
    }
}
DI bf16x8 s5_ufrag(const Params& P, int rowbase, int g, int lane, const f32x4& ga, const f32x4& gb) {
    const int t = lane & 31, h = lane >> 5, row = rowbase + t;
    const float rs = rsqrtf(P.rowss[T_TOK + row] * (1.f / DM) + RMS_EPS);
    const f32x4* xp = (const f32x4*)(P.xres + (size_t)row * DM + 16 * g + 8 * h);
    const f32x4 a = xp[0] * rs * ga, b = xp[1] * rs * gb;
    const u32x4 w = {pk_bf16(a.x, a.y), pk_bf16(a.z, a.w), pk_bf16(b.x, b.y), pk_bf16(b.z, b.w)};
    return __builtin_bit_cast(bf16x8, w);
}
template <bool WRITE>
DI void s5_scan32(const f32x16 (&X)[4], int h, int p, float ar, float ai, float& hr, float& hi, LAS unsigned char* hs) {
    float lo_re[16], lo_im[16], hi_re[16], hi_im[16];
#pragma unroll
    for (int r = 0; r < 16; ++r) {
        const auto sr = __builtin_amdgcn_permlane32_swap(__float_as_uint(X[0][r]), __float_as_uint(X[2][r]), false, false);
        const auto si = __builtin_amdgcn_permlane32_swap(__float_as_uint(X[1][r]), __float_as_uint(X[3][r]), false, false);
        lo_re[r] = __uint_as_float(sr[0]); hi_re[r] = __uint_as_float(sr[1]);
        lo_im[r] = __uint_as_float(si[0]); hi_im[r] = __uint_as_float(si[1]);
    }
#pragma unroll
    for (int i = 0; i < 4; ++i)
#pragma unroll
        for (int half = 0; half < 2; ++half)
#pragma unroll
            for (int j = 0; j < 4; ++j) {
                const int r = 4 * i + j, token = 8 * i + 4 * half + j;
                const float xr = half ? hi_re[r] : lo_re[r], xi = half ? hi_im[r] : lo_im[r];
                const float nhr = ar * hr - ai * hi + xr, nhi = ar * hi + ai * hr + xi; hr = nhr; hi = nhi;
                if (WRITE) {
                    const unsigned whi = pk_bf16(hr, hi);
                    *(LAS unsigned*)(hs + token * 272 + 4 * p) = whi;
                    *(LAS unsigned*)(hs + 69632 + token * 272 + 4 * p) = pk_bf16(hr - bf_lo(whi), hi - bf_hi(whi));
                }
            }
}

struct S5In { f32x4 x0, x1; float ss; };
DI S5In s5_in_load(const Params& P, int rowbase, int g, int lane) {
    const int row = rowbase + (lane & 31);
    const f32x4* xp = (const f32x4*)(P.xres + (size_t)row * DM + 16 * g + 8 * (lane >> 5));
    S5In r; r.x0 = xp[0]; r.x1 = xp[1]; r.ss = P.rowss[T_TOK + row]; return r;
}
DI bf16x8 s5_in_frag(const S5In& in, const f32x4& ga, const f32x4& gb) {
    const float rs = rsqrtf(in.ss * (1.f / DM) + RMS_EPS);
    const f32x4 a = in.x0 * rs * ga, b = in.x1 * rs * gb;
    const u32x4 w = {pk_bf16(a.x, a.y), pk_bf16(a.z, a.w), pk_bf16(b.x, b.y), pk_bf16(b.z, b.w)};
    return __builtin_bit_cast(bf16x8, w);
}
DI int s5_row0(int L, int wave) { const int bc = L & 31; return (bc >> 4) * SEQ + ((bc & 15) * 8 + wave) * 64; }

DI void phase_s5a(const Params& P, LAS unsigned char* lds) {
    const int tid = threadIdx.x, wave = tid >> 6, lane = tid & 63, h = lane >> 5;
    for (int base = blockIdx.x * 8; base < 2048; base += gridDim.x * 8) {
        const int g = base >> 5;
        const S5Coef cf = s5_coefs(P, g, lane);
        bf16x8 bf[4]; s5_bfrags(P, g, lane, bf);
        const f32x4 ga = *(const f32x4*)(P.norm_g + DM + 16 * g + 8 * h), gb = *(const f32x4*)(P.norm_g + DM + 16 * g + 8 * h + 4);
        float hr = 0.f, hi = 0.f;
        S5In pre = s5_in_load(P, s5_row0(base, wave), g, lane);
#pragma unroll 1
        for (int step = 0; step < 16; ++step) {
            const int L = base + (step >> 1), sub = step & 1;
            const S5In cur = pre;
            if (step < 15) pre = s5_in_load(P, s5_row0(base + ((step + 1) >> 1), wave) + 32 * ((step + 1) & 1), g, lane);
            const bf16x8 a = s5_in_frag(cur, ga, gb);
            f32x16 X[4];
#pragma unroll
            for (int j = 0; j < 4; ++j) {
#pragma unroll
                for (int r = 0; r < 16; ++r) X[j][r] = 0.f;
                X[j] = __builtin_amdgcn_mfma_f32_32x32x16_bf16(a, bf[j], X[j], 0, 0, 0);
            }
            if (sub == 0) { hr = 0.f; hi = 0.f; }
            s5_scan32<false>(X, h, lane, cf.ar, cf.ai, hr, hi, lds);
            if (sub == 1) { const int bc = L & 31, ch = (bc & 15) * 8 + wave; *(f32x2*)(P.E + ((size_t)(((bc >> 4) * 128 + ch) * 64 + g) * 64 + lane) * 2) = (f32x2){hr, hi}; }
        }
    }
}

DI void phase_s5carry(const Params& P) {
    if (blockIdx.x < 128 && threadIdx.x < 64) {
        const int idx = blockIdx.x * 64 + threadIdx.x, b = idx >> 12, g = (idx >> 6) & 63, p = idx & 63;
        const S5Coef cf = s5_coefs(P, g, p);
        float alr = cf.ar, ali = cf.ai;
#pragma unroll
        for (int q = 0; q < 6; ++q) { const float r = alr * alr - ali * ali, i2 = 2.f * alr * ali; alr = r; ali = i2; }
        f32x2* Ep = (f32x2*)P.E + (size_t)(b * 128) * 4096 + g * 64 + p;
        float hr = 0.f, hi = 0.f;
#pragma unroll 1
        for (int j0 = 0; j0 < 128; j0 += 32) {
            f32x2 e[32];
#pragma unroll
            for (int u = 0; u < 32; ++u) e[u] = Ep[(size_t)(j0 + u) * 4096];
#pragma unroll
            for (int u = 0; u < 32; ++u) {
                Ep[(size_t)(j0 + u) * 4096] = (f32x2){hr, hi};
                const float nr = alr * hr - ali * hi + e[u].x, ni = alr * hi + ali * hr + e[u].y; hr = nr; hi = ni;
            }
        }
    }
}

DI void phase_s5b(const Params& P, LAS unsigned char* lds) {
    const int tid = threadIdx.x, wave = tid >> 6, lane = tid & 63, h = lane >> 5, c16 = lane & 15, kq = lane >> 4;
    LAS unsigned char* hs = lds + wave * 8704;
    for (int base = blockIdx.x * 8; base < 2048; base += gridDim.x * 8) {
        const int g = base >> 5;
        const S5Coef cf = s5_coefs(P, g, lane);
        bf16x8 bf[4]; s5_bfrags(P, g, lane, bf);
        const f32x4 ga = *(const f32x4*)(P.norm_g + DM + 16 * g + 8 * h), gb = *(const f32x4*)(P.norm_g + DM + 16 * g + 8 * h + 4);
        bf16x8 cmf[4], cml[4];
#pragma unroll
        for (int ks = 0; ks < 4; ++ks) {
            const int p0 = ks * 16 + kq * 4;
            const f32x4 cr = *(const f32x4*)(P.c_re + ((size_t)g * 16 + c16) * 64 + p0), ci = *(const f32x4*)(P.c_im + ((size_t)g * 16 + c16) * 64 + p0);
            const float v[8] = {cr.x, -ci.x, cr.y, -ci.y, cr.z, -ci.z, cr.w, -ci.w};
            u32x4 wh, wl;
#pragma unroll
            for (int e = 0; e < 4; ++e) { wh[e] = pk_bf16(v[2 * e], v[2 * e + 1]); wl[e] = pk_bf16(v[2 * e] - bf_lo(wh[e]), v[2 * e + 1] - bf_hi(wh[e])); }
            cmf[ks] = __builtin_bit_cast(bf16x8, wh); cml[ks] = __builtin_bit_cast(bf16x8, wl);
        }
        const f32x4 d4 = *(const f32x4*)(P.s5_d + 16 * g + 4 * kq), ge = *(const f32x4*)(P.norm_g + DM + 16 * g + 4 * kq);
        float hr = 0.f, hi = 0.f;
        S5In pre = s5_in_load(P, s5_row0(base, wave), g, lane);
        f32x2 cpre; { const int bc = base & 31, ch = (bc & 15) * 8 + wave; cpre = *((const f32x2*)P.E + ((size_t)((bc >> 4) * 128 + ch) * 64 + g) * 64 + lane); }
#pragma unroll 1
        for (int step = 0; step < 16; ++step) {
            const int L = base + (step >> 1), sub = step & 1, rowb = s5_row0(L, wave) + 32 * sub;
            const S5In cur = pre;
            if (sub == 0) { hr = cpre.x; hi = cpre.y; }
            if (step < 15) pre = s5_in_load(P, s5_row0(base + ((step + 1) >> 1), wave) + 32 * ((step + 1) & 1), g, lane);
            if (sub == 1 && step < 15) { const int bc = (L + 1) & 31, ch = (bc & 15) * 8 + wave; cpre = *((const f32x2*)P.E + ((size_t)((bc >> 4) * 128 + ch) * 64 + g) * 64 + lane); }
            const bf16x8 a = s5_in_frag(cur, ga, gb);
            f32x16 X[4];
#pragma unroll
            for (int j = 0; j < 4; ++j) {
#pragma unroll
                for (int r = 0; r < 16; ++r) X[j][r] = 0.f;
                X[j] = __builtin_amdgcn_mfma_f32_32x32x16_bf16(a, bf[j], X[j], 0, 0, 0);
            }
            s5_scan32<true>(X, h, lane, cf.ar, cf.ai, hr, hi, hs);
            WAVE_LDS_SYNC();
#pragma unroll
            for (int tt = 0; tt < 2; ++tt) {
                f32x4 acc = {0.f, 0.f, 0.f, 0.f};
#pragma unroll
                for (int ks = 0; ks < 4; ++ks) {
                    const LAS unsigned char* ha = hs + (tt * 16 + c16) * 272 + ks * 64 + kq * 16;
                    const bf16x8 hbh = *(const LAS bf16x8*)ha, hbl = *(const LAS bf16x8*)(ha + 69632);
                    acc = __builtin_amdgcn_mfma_f32_16x16x32_bf16(cml[ks], hbh, acc, 0, 0, 0);
                    acc = __builtin_amdgcn_mfma_f32_16x16x32_bf16(cmf[ks], hbl, acc, 0, 0, 0);
                    acc = __builtin_amdgcn_mfma_f32_16x16x32_bf16(cmf[ks], hbh, acc, 0, 0, 0);
                }
                const int row = rowb + 16 * tt + c16;
                const float rs = rsqrtf(P.rowss[T_TOK + row] * (1.f / DM) + RMS_EPS);
                const f32x4 u4 = *(const f32x4*)(P.xres + (size_t)row * DM + 16 * g + 4 * kq) * rs * ge;
                f32x4 y;
#pragma unroll
                for (int j = 0; j < 4; ++j) y[j] = gelu_tanh(acc[j] + d4[j] * u4[j]);
                store_bf4(P.yb + (size_t)row * DM + 16 * g + 4 * kq, y);
            }
            WAVE_LDS_SYNC();
        }
    }
}

DI void phase_kmean(const Params& P, LAS unsigned char* lds) {
    if (blockIdx.x < 128) {
        const int j = blockIdx.x, d = threadIdx.x & 127, part = threadIdx.x >> 7;
        const bf16_t* kb = P.kbuf + ((size_t)(j >> 5) * SEQ + (j & 31) * 256 + part * 64) * 128 + d;
        float s = 0.f;
#pragma unroll 1
        for (int k0 = 0; k0 < 64; k0 += 16) {
            unsigned short v[16];
#pragma unroll
            for (int u = 0; u < 16; ++u) v[u] = kb[(size_t)(k0 + u) * 128];
#pragma unroll
            for (int u = 0; u < 16; ++u) s += __uint_as_float(((unsigned)v[u]) << 16);
        }
        LAS float* red = (LAS float*)lds;
        red[threadIdx.x] = s;
        __syncthreads();
        if (threadIdx.x < 128) P.kmean[j * 128 + d] = (red[d] + red[128 + d] + red[256 + d] + red[384 + d]) * (1.f / 256.f);
    }
}

DI int list_off(int c, int n) { return c * (496 * 1024) + 1024 * (31 * n - (n * (n - 1)) / 2); }

DI void phase_gate(const Params& P, LAS unsigned char* lds) {
    const int tid = threadIdx.x, wave = tid >> 6, lane = tid & 63;
    LAS float* km = (LAS float*)lds;
    LAS int* cnt = (LAS int*)(lds + 32768);
    LAS int* base = cnt + 64;
    for (int qb = blockIdx.x; qb < 256; qb += gridDim.x) {
        const int b = qb >> 7, i = qb & 127, own = i >> 2;
        for (int e = tid; e < 2048; e += 512) ((LAS f32x4*)km)[e] = ((const f32x4*)(P.kmean + b * 8192))[e];
        if (tid < 64) cnt[tid] = 0;
        __syncthreads();
        const int hq = wave, hk = hq >> 2, t = b * SEQ + i * 64 + lane;
        float g[32];
#pragma unroll
        for (int n = 0; n < 32; ++n) g[n] = 0.f;
        const u32x4* qr = (const u32x4*)(P.qbuf + (size_t)t * DM + hq * 128);
#pragma unroll
        for (int nc = 0; nc < 4; ++nc) {
            u32x4 wa = qr[0], wb = qr[1];
#pragma unroll 1
            for (int c = 0; c < 16; ++c) {
                const u32x4 w = wa; wa = wb; wb = qr[(c + 2) & 15];
                const float q0 = bf_lo(w.x), q1 = bf_hi(w.x), q2 = bf_lo(w.y), q3 = bf_hi(w.y), q4 = bf_lo(w.z), q5 = bf_hi(w.z), q6 = bf_lo(w.w), q7 = bf_hi(w.w);
#pragma unroll
                for (int n8 = 0; n8 < 8; ++n8) {
                    const int n = nc * 8 + n8;
                    const LAS f32x4* kp = (const LAS f32x4*)(km + (hk * 32 + n) * 128 + 8 * c);
                    const f32x4 ka = kp[0], kb = kp[1];
                    g[n] += q0 * ka.x + q1 * ka.y + q2 * ka.z + q3 * ka.w + q4 * kb.x + q5 * kb.y + q6 * kb.z + q7 * kb.w;
                }
            }
        }
        const int nsel = own < 3 ? own : 3;
        int s0 = -1, s1 = -1, s2 = -1;
        { float best = -3e38f;
#pragma unroll
          for (int n = 0; n < 32; ++n) if (n < own && g[n] > best) { best = g[n]; s0 = n; } }
        { float best = -3e38f;
#pragma unroll
          for (int n = 0; n < 32; ++n) if (n < own && n != s0 && g[n] > best) { best = g[n]; s1 = n; } }
        { float best = -3e38f;
#pragma unroll
          for (int n = 0; n < 32; ++n) if (n < own && n != s0 && n != s1 && g[n] > best) { best = g[n]; s2 = n; } }
        int l0 = 0, l1 = 0, l2 = 0;
        if (nsel > 0) l0 = atomicAdd((int*)&cnt[hk * 32 + s0], 1);
        if (nsel > 1) l1 = atomicAdd((int*)&cnt[hk * 32 + s1], 1);
        if (nsel > 2) l2 = atomicAdd((int*)&cnt[hk * 32 + s2], 1);
        __syncthreads();
        if (tid < 64) { const int c = cnt[tid]; base[tid] = c > 0 ? atomicAdd(P.gcount + b * 64 + tid, c) : 0; }
        __syncthreads();
        const int row = t * 8 + hq, c2 = b * 2 + hk;
        if (nsel > 0) P.lists[list_off(c2, s0) + base[hk * 32 + s0] + l0] = row * 4 + 1;
        if (nsel > 1) P.lists[list_off(c2, s1) + base[hk * 32 + s1] + l1] = row * 4 + 2;
        if (nsel > 2) P.lists[list_off(c2, s2) + base[hk * 32 + s2] + l2] = row * 4 + 3;
        __syncthreads();
    }
}

template <bool OWN>
DI void phase_attn(const Params& P, LAS unsigned char* lds, int bid) {
    const int tid = threadIdx.x, wave = __builtin_amdgcn_readfirstlane(tid >> 6), lane = tid & 63, h = lane >> 5, l32 = lane & 31;
    LAS unsigned char* Ks = lds;
    LAS unsigned char* Vs = lds + 69632;
    LAS int* pref = (LAS int*)(lds + 136192);
    if constexpr (!OWN) {
        LAS int* cntl = pref + 132;
        if (tid < 128) cntl[tid] = (P.gcount[tid] + 255) >> 8;
        __syncthreads();
        if (tid <= 128) { int a = 0; for (int i = 0; i < 128; ++i) a += (i < tid) ? cntl[i] : 0; pref[tid] = a; }
        __syncthreads();
    }
    const int total = OWN ? 512 : pref[128];
    constexpr float LOG2E = 1.4426950408889634f;
    int rnd = 0;
    for (int idx = bid; idx < total; idx += gridDim.x, ++rnd) {
        const int item = (OWN && (rnd & 1)) ? (idx ^ 3) : idx;
        int c, n, i_q = 0, nrows = 256; const int* lst = P.lists; constexpr bool is_own = OWN;
        if (is_own) { c = item >> 7; i_q = item & 127; n = i_q >> 2; }
        else {
            const int s = item; int lo = 0, hi = 128;
            while (hi - lo > 1) { const int mid = (lo + hi) >> 1; if (pref[mid] <= s) lo = mid; else hi = mid; }
            c = lo >> 5; n = lo & 31; const int grp = s - pref[lo]; lst = P.lists + list_off(c, n) + grp * 256; nrows = P.gcount[lo] - grp * 256; if (nrows > 256) nrows = 256;
        }
        const int b = c >> 1, hk = c & 1;
        {
            const bf16_t* kg = P.kbuf + ((size_t)c * SEQ + n * 256) * 128;
            const bf16_t* vg = P.vT + (size_t)c * 128 * SEQ + n * 256;
            const bf16_t* kgl = kg + (size_t)(tid >> 4) * 128 + (tid & 15) * 8;
            LAS unsigned char* kl = Ks + (tid >> 4) * 272 + (tid & 15) * 16;
#pragma unroll
            for (int q = 0; q < 8; ++q) { const u32x4 w = *(const u32x4*)(kgl + q * 4096); *(LAS u32x4*)(kl + q * 8704) = w; }
            const bf16_t* vgl = vg + (size_t)(tid >> 5) * SEQ + (tid & 31) * 8;
            LAS unsigned char* vl = Vs + (tid >> 5) * 520 + (tid & 31) * 16;
#pragma unroll
            for (int q = 0; q < 8; ++q) { const u32x4 w = *(const u32x4*)(vgl + (size_t)q * 16 * SEQ); LAS u32x2* dst = (LAS u32x2*)(vl + q * 8320); dst[0] = (u32x2){w.x, w.y}; dst[1] = (u32x2){w.z, w.w}; }
        }
        int ent; bool valid = true; const int rho = wave * 32 + l32;
        if (is_own) { const int hq = hk * 4 + (rho >> 6), t = b * SEQ + i_q * 64 + (rho & 63); ent = (t * 8 + hq) * 4; }
        else { valid = rho < nrows; ent = lst[valid ? rho : 0]; }
        bf16x8 qf[8];
        { const int row = ent >> 2, t = row >> 3, hq = row & 7; const bf16_t* qp = P.qbuf + (size_t)t * DM + hq * 128 + 8 * h;
#pragma unroll
          for (int ks = 0; ks < 8; ++ks) qf[ks] = *(const bf16x8*)(qp + ks * 16); }
        __syncthreads();
        if (wave < 4) __builtin_amdgcn_s_setprio(2);
        if (wave * 32 < nrows) {
            const int nkt = is_own ? (2 * (i_q & 3) + (wave & 1) + 1) : 8;
            const int posb = is_own ? (64 * (i_q & 3) + (rho & 63)) : 100000;
            float m_run = -1e30f, l_run = 0.f;
            f32x16 o[4];
#pragma unroll
            for (int db = 0; db < 4; ++db)
#pragma unroll
                for (int r = 0; r < 16; ++r) o[db][r] = 0.f;
#pragma unroll 1
            for (int hf = 0; hf < 2; ++hf) {
                if (4 * hf >= nkt) break;
                f32x16 s[4];
#pragma unroll
                for (int kq = 0; kq < 4; ++kq) {
                    const int kt = 4 * hf + kq;
                    if (kt < nkt) {
#pragma unroll
                        for (int r = 0; r < 16; ++r) s[kq][r] = 0.f;
#pragma unroll
                        for (int ks = 0; ks < 8; ++ks) {
                            const bf16x8 a = *(const LAS bf16x8*)(Ks + (kt * 32 + l32) * 272 + ks * 32 + 16 * h);
                            s[kq] = __builtin_amdgcn_mfma_f32_32x32x16_bf16(a, qf[ks], s[kq], 0, 0, 0);
                            asm volatile("" :: "v"(a));
                        }
                        if (is_own) {
#pragma unroll
                            for (int r = 0; r < 16; ++r) { const int key = kt * 32 + (r & 3) + 8 * (r >> 2) + 4 * h; if (key > posb) s[kq][r] = -1e30f; }
                        }
                    } else {
#pragma unroll
                        for (int r = 0; r < 16; ++r) s[kq][r] = -1e30f;
                    }
                    __builtin_amdgcn_sched_barrier(0);
                }
                float mx = -1e30f;
#pragma unroll
                for (int kq = 0; kq < 4; ++kq)
#pragma unroll
                    for (int r = 0; r < 16; ++r) mx = fmaxf(mx, s[kq][r]);
                mx = fmaxf(mx, __shfl_xor(mx, 32));
                const float m_new = fmaxf(m_run, mx), mL = m_new * LOG2E;
                const float alpha = __builtin_amdgcn_exp2f((m_run - m_new) * LOG2E);
                float lsum = 0.f;
#pragma unroll
                for (int kq = 0; kq < 4; ++kq)
#pragma unroll
                    for (int r = 0; r < 16; ++r) { const float p = __builtin_amdgcn_exp2f(s[kq][r] * LOG2E - mL); s[kq][r] = p; lsum += p; }
                lsum += __shfl_xor(lsum, 32);
                l_run = l_run * alpha + lsum; m_run = m_new;
                if (hf == 1) {
#pragma unroll
                    for (int db = 0; db < 4; ++db)
#pragma unroll
                        for (int r = 0; r < 16; ++r) o[db][r] *= alpha;
                }
#pragma unroll
                for (int kq = 0; kq < 4; ++kq) {
                    const int kt = 4 * hf + kq;
                    if (kt < nkt) {
#pragma unroll
                        for (int st = 0; st < 2; ++st) {
                            u32x4 pw;
                            pw.x = pk_bf16(s[kq][8 * st + 0], s[kq][8 * st + 1]); pw.y = pk_bf16(s[kq][8 * st + 2], s[kq][8 * st + 3]);
                            pw.z = pk_bf16(s[kq][8 * st + 4], s[kq][8 * st + 5]); pw.w = pk_bf16(s[kq][8 * st + 6], s[kq][8 * st + 7]);
                            const bf16x8 pf = __builtin_bit_cast(bf16x8, pw);
#pragma unroll
                            for (int db = 0; db < 4; ++db) {
                                const LAS unsigned char* va = Vs + (32 * db + l32) * 520 + (kt * 32 + 16 * st + 4 * h) * 2;
                                const u32x2 vlo = *(const LAS u32x2*)va, vhi = *(const LAS u32x2*)(va + 16);
                                const u32x4 vw = {vlo.x, vlo.y, vhi.x, vhi.y};
                                o[db] = __builtin_amdgcn_mfma_f32_32x32x16_bf16(__builtin_bit_cast(bf16x8, vw), pf, o[db], 0, 0, 0);
                            }
                            __builtin_amdgcn_sched_barrier(0);
                        }
                    }
                }
            }
            asm volatile("" : "+v"(ent));
            if constexpr (!OWN) {
                if (valid) {
                    const float inv = 1.f / l_run;
                    const int slot = ent & 3; const int row = ent >> 2;
                    if (h == 0) *(f32x2*)(P.part_ml + (size_t)ent * 2) = (f32x2){m_run, l_run};
                    int h2 = h; asm volatile("" : "+v"(h2));
                    bf16_t* pb = P.part[1];
                    if (slot == 2) pb = P.part[2]; else if (slot == 3) pb = P.part[3];
                    bf16_t* po = pb + ((size_t)row * 128 + 4 * h2);
#pragma unroll
                    for (int db = 0; db < 4; ++db)
#pragma unroll
                        for (int rq = 0; rq < 4; ++rq) {
                            u32x2 w; w.x = pk_bf16(o[db][4 * rq] * inv, o[db][4 * rq + 1] * inv); w.y = pk_bf16(o[db][4 * rq + 2] * inv, o[db][4 * rq + 3] * inv);
                            *(u32x2*)(po + 32 * db + 8 * rq) = w;
                        }
                }
            } else {
                const int row = ent >> 2, nsel = n < 3 ? n : 3;
                int h2 = h; asm volatile("" : "+v"(h2));
                float M = m_run; f32x2 ml[3];
#pragma unroll
                for (int s2 = 0; s2 < 3; ++s2) { ml[s2] = (f32x2){-1e30f, 0.f}; if (s2 < nsel) { ml[s2] = *(const f32x2*)(P.part_ml + ((size_t)row * 4 + s2 + 1) * 2); M = fmaxf(M, ml[s2].x); } }
                const float w0 = __builtin_amdgcn_exp2f((m_run - M) * LOG2E);
                float ws[3], L = l_run * w0;
#pragma unroll
                for (int s2 = 0; s2 < 3; ++s2) { ws[s2] = ml[s2].y * __builtin_amdgcn_exp2f((ml[s2].x - M) * LOG2E); L += ws[s2]; }
                const float inv = 1.f / L, w0i = w0 * inv;
                const size_t poff = (size_t)row * 128 + 4 * h2;
                bf16_t* ao = P.attn + (size_t)(row >> 3) * DM + (row & 7) * 128 + 4 * h2;
#pragma unroll
                for (int db = 0; db < 4; ++db) {
                    u32x2 pv[3][4];
#pragma unroll
                    for (int s2 = 0; s2 < 3; ++s2)
#pragma unroll
                        for (int rq = 0; rq < 4; ++rq) { pv[s2][rq] = (u32x2){0u, 0u}; if (s2 < nsel) pv[s2][rq] = *(const u32x2*)(P.part[s2 + 1] + poff + 32 * db + 8 * rq); }
#pragma unroll
                    for (int rq = 0; rq < 4; ++rq) {
                        float a0 = o[db][4 * rq] * w0i, a1 = o[db][4 * rq + 1] * w0i, a2 = o[db][4 * rq + 2] * w0i, a3 = o[db][4 * rq + 3] * w0i;
#pragma unroll
                        for (int s2 = 0; s2 < 3; ++s2) { const float wv = ws[s2] * inv; a0 += wv * bf_lo(pv[s2][rq].x); a1 += wv * bf_hi(pv[s2][rq].x); a2 += wv * bf_lo(pv[s2][rq].y); a3 += wv * bf_hi(pv[s2][rq].y); }
                        u32x2 w; w.x = pk_bf16(a0, a1); w.y = pk_bf16(a2, a3);
                        *(u32x2*)(ao + 32 * db + 8 * rq) = w;
                    }
                }
            }
        }
        __builtin_amdgcn_s_setprio(0);
        __syncthreads();
    }
}

DI void phase_combine(const Params& P) {
    const int tid = threadIdx.x, wave = tid >> 6, lane = tid & 63;
    const int gw = blockIdx.x * 8 + wave, NGW = gridDim.x * 8;
    for (int row = gw; row < T_TOK * 8; row += NGW) {
        const int t = row >> 3, hq = row & 7, own = (t & (SEQ - 1)) >> 8, nsel = own < 3 ? own : 3;
        float m[4], l[4];
#pragma unroll
        for (int s = 0; s < 4; ++s) { if (s <= nsel) { const f32x2 ml = *(const f32x2*)(P.part_ml + ((size_t)row * 4 + s) * 2); m[s] = ml.x; l[s] = ml.y; } else { m[s] = -1e30f; l[s] = 0.f; } }
        const float M = fmaxf(fmaxf(m[0], m[1]), fmaxf(m[2], m[3]));
        float o0 = 0.f, o1 = 0.f, L = 0.f;
#pragma unroll
        for (int s = 0; s < 4; ++s) {
            if (s <= nsel) {
                const float w = l[s] * __expf(m[s] - M); L += w;
                const unsigned v = *(const unsigned*)(P.part[s] + (size_t)row * 128 + 2 * lane);
                o0 += w * bf_lo(v); o1 += w * bf_hi(v);
            }
        }
        const float inv = 1.f / L;
        *(unsigned*)(P.attn + (size_t)t * DM + hq * 128 + 2 * lane) = cvt_pk_bf16(o0 * inv, o1 * inv);
    }
}

DI void phase_final(const Params& P) {
    const int tid = threadIdx.x, wave = tid >> 6, lane = tid & 63;
    const int gw = blockIdx.x * 8 + wave, NGW = gridDim.x * 8;
    for (int row = gw; row < T_TOK; row += NGW) {
        const float rs = rsqrtf(P.rowss[6 * T_TOK + row] * (1.f / DM) + RMS_EPS);
        const f32x4* xr = (const f32x4*)(P.xres + (size_t)row * DM) + lane;
        const f32x4* gr = (const f32x4*)P.final_g + lane;
        f32x4* o = (f32x4*)(P.out + (size_t)row * DM) + lane;
#pragma unroll
        for (int j = 0; j < 4; ++j) o[64 * j] = xr[64 * j] * rs * gr[64 * j];
    }
}

DI void phase_final_fused(const Params& P, LAS unsigned char* lds, int vbid) {
    pg8::StaticOrder S; S.init(T_TOK, DM, gridDim.x, vbid);
    pg8::Unit u;
    if (!S.next(0, u)) return;
    const int tid = threadIdx.x, wave = tid >> 6, lane = tid & 63;
    asm volatile("s_waitcnt vmcnt(0)" ::: "memory");
    __syncthreads();
    LAS int* flag = (LAS int*)lds;
    if (tid == 0) flag[0] = atomicAdd(P.pcnt + u.pm, 1);
    __syncthreads();
    if (flag[0] != 3) return;
    __builtin_amdgcn_fence(__ATOMIC_ACQUIRE, "agent");
    asm volatile("s_waitcnt vmcnt(0)" ::: "memory");
    const f32x4* gr = (const f32x4*)P.final_g + lane;
    const f32x4 g0 = gr[0], g1 = gr[64], g2 = gr[128], g3 = gr[192];
#pragma unroll 1
    for (int r0 = wave * 32; r0 < wave * 32 + 32; r0 += 4) {
        f32x4 v[4][4]; float ss[4];
#pragma unroll
        for (int i = 0; i < 4; ++i) {
            const int row = u.pm * 256 + r0 + i;
            const f32x4* xr = (const f32x4*)(P.xres + (size_t)row * DM) + lane;
            ss[i] = P.rowss[6 * T_TOK + row];
            v[i][0] = xr[0]; v[i][1] = xr[64]; v[i][2] = xr[128]; v[i][3] = xr[192];
        }
#pragma unroll
        for (int i = 0; i < 4; ++i) {
            const int row = u.pm * 256 + r0 + i;
            const float rs = rsqrtf(ss[i] * (1.f / DM) + RMS_EPS);
            f32x4* o = (f32x4*)(P.out + (size_t)row * DM) + lane;
            o[0] = v[i][0] * rs * g0; o[64] = v[i][1] * rs * g1; o[128] = v[i][2] * rs * g2; o[192] = v[i][3] * rs * g3;
        }
    }
}

#define XB_TMO      128
#define XB_XCNT(j)  (256  + 64 * (j))
#define XB_XSUB(j)  (1280 + 64 * (j))
#define XB_XGEN(j)  (2304 + 64 * (j))
#define XB_TOP      3328
#define XB_TOPGEN   3392
#define XCD_BAR_WORDS 3456
#define XB_SPIN_CAP (1u << 18)
DI unsigned xb_ld(unsigned* p)              { return __hip_atomic_load(p, __ATOMIC_RELAXED, __HIP_MEMORY_SCOPE_AGENT); }
DI unsigned xb_add(unsigned* p, unsigned v) { return __hip_atomic_fetch_add(p, v, __ATOMIC_RELAXED, __HIP_MEMORY_SCOPE_AGENT); }
DI unsigned xb_xcc_id() { return (unsigned)__builtin_amdgcn_s_getreg((3 << 11) | 20) & 0xFu; }
#define XB_SPIN(cond, bar) do { unsigned _sp = 0; while (cond) { __builtin_amdgcn_s_sleep(1); \
    if ((++_sp & 255u) == 0u) { if (xb_ld(&(bar)[XB_TMO])) break; if (_sp > XB_SPIN_CAP) { atomicAdd(&(bar)[XB_TMO], 1u); break; } } } } while (0)
struct XcdBarrier { unsigned* bar; unsigned x; volatile LAS unsigned* st; };
DI XcdBarrier xcd_barrier_post(unsigned* bar, volatile LAS unsigned* st) {
    XcdBarrier b; b.bar = bar; b.x = xb_xcc_id(); b.st = st;
    if (threadIdx.x == 0) (void)xb_add(&bar[XB_XCNT(b.x)], 1u);
    return b;
}
DI void xcd_barrier_complete(unsigned* bar, unsigned x, unsigned& nloc, unsigned& nx) {
    const unsigned G = gridDim.x * gridDim.y * gridDim.z;
    unsigned sum, cnt, mine, sp = 0u;
    for (;;) {
        sum = 0u; cnt = 0u; mine = 0u;
#pragma unroll
        for (unsigned j = 0; j < 16; ++j) { const unsigned c = xb_ld(&bar[XB_XCNT(j)]); sum += c; cnt += (c > 0u) ? 1u : 0u; mine = (j == x) ? c : mine; }
        if (sum == G) break;
        __builtin_amdgcn_s_sleep(1);
        if ((++sp & 255u) == 0u) { if (xb_ld(&bar[XB_TMO])) break; if (sp > XB_SPIN_CAP) { atomicAdd(&bar[XB_TMO], 1u); break; } }
    }
    nloc = mine > 0u ? mine : 1u; nx = cnt > 0u ? cnt : 1u;
}
DI void xcd_barrier(const XcdBarrier& b) {
    asm volatile("s_waitcnt vmcnt(0)" ::: "memory");
    __syncthreads();
    if (threadIdx.x == 0) {
        unsigned* bar = b.bar;
        __builtin_amdgcn_s_waitcnt(0);
        unsigned nloc = b.st[0], nx = b.st[1];
        if (nloc == 0u) { xcd_barrier_complete(bar, b.x, nloc, nx); b.st[0] = nloc; b.st[1] = nx; }
        const unsigned old = xb_add(&bar[XB_XSUB(b.x)], 1u);
        const unsigned gen = old / nloc;
        if (old + 1u == (gen + 1u) * nloc) {
            __builtin_amdgcn_fence(__ATOMIC_RELEASE, "agent");
            asm volatile("s_waitcnt vmcnt(0)" ::: "memory");
            const unsigned og = xb_add(&bar[XB_TOP], 1u);
            const unsigned tg = og / nx;
            if (og + 1u == (tg + 1u) * nx) xb_add(&bar[XB_TOPGEN], 1u);
            else XB_SPIN(xb_ld(&bar[XB_TOPGEN]) == tg, bar);
            __builtin_amdgcn_fence(__ATOMIC_ACQUIRE, "agent");
            xb_add(&bar[XB_XGEN(b.x)], 1u);
            asm volatile("s_waitcnt vmcnt(0)" ::: "memory");
        } else {
            XB_SPIN(xb_ld(&bar[XB_XGEN(b.x)]) == gen, bar);
            __builtin_amdgcn_fence(__ATOMIC_ACQUIRE, "agent");
            asm volatile("s_waitcnt vmcnt(0)" ::: "memory");
        }
    }
    __syncthreads();
}

constexpr int NPHASES = 18;
#ifndef PHMASK
#define PHMASK 0xFFFFF
#endif
#define PHON(n) if constexpr (((PHMASK) >> (n)) & 1)
#ifndef DUPSEL
#define DUPSEL 0
#endif
__global__ void __launch_bounds__(512, 2) mega_fwd(const Params P) {
    extern __shared__ __attribute__((aligned(16))) unsigned char smem[];
    LAS unsigned char* lds = (LAS unsigned char*)smem;
    cg::grid_group grid = cg::this_grid();
    if (P.ph_hi < 0) grid.sync();
    volatile LAS unsigned* xst = (volatile LAS unsigned*)(lds + 139264);
    if (threadIdx.x == 0) { xst[0] = 0u; xst[1] = 0u; xst[2] = 0u; xst[3] = 0u; xst[4] = 0u; }
    __syncthreads();
    XcdBarrier xb; xb.bar = P.bar; xb.x = xb_xcc_id(); xb.st = xst;
    if (threadIdx.x == 0) xst[2] = xb_add(&P.bar[XB_XCNT(xb.x)], 1u);
    PHON(0) if (P.ph_lo <= 0 && 0 < P.ph_hi) { phase_prep(P, lds); }
    if constexpr (DUPSEL == 4) { xcd_barrier(xb); phase_prep(P, lds); }
    if (P.ph_lo < 1 && 1 < P.ph_hi) xcd_barrier(xb);
    if (threadIdx.x == 0) {
        bool ok = (gridDim.x % 8u) == 0u;
        for (unsigned j = 0; j < 16; ++j) { const unsigned c = xb_ld(&P.bar[XB_XCNT(j)]); ok = ok && (c == (j < 8 ? gridDim.x / 8u : 0u)); }
        xst[3] = ok ? (xb.x + 8u * xst[2]) : blockIdx.x; xst[4] = ok ? 1u : 0u;
    }
    __syncthreads();
    const int vbid = (int)xst[3];
    const bool vb_ok = xst[4] != 0u;
    const int abid = vb_ok ? ((vbid & 7) * (int)(gridDim.x >> 3) + (vbid >> 3)) : (int)blockIdx.x;
    preload_rs(lds, vbid, P.rowss + 0 * T_TOK, 5632); run_gemm_v(lds, vbid, P.xb, P.wt_up[0], 5632, DM, EpiAct{P.act, P.rowss + 0 * T_TOK, P.kbuf, P.vT, P.rope, (const LAS float*)(lds + 131072)});
    convert_by_light_blocks(P, lds, vbid, 64 * 22, P.it1, P.it2);
    if constexpr (DUPSEL == 2) { xcd_barrier(xb); preload_rs(lds, vbid, P.rowss + 0 * T_TOK, 5632); run_gemm_v(lds, vbid, P.xb, P.wt_up[0], 5632, DM, EpiAct{P.act, P.rowss + 0 * T_TOK, P.kbuf, P.vT, P.rope, (const LAS float*)(lds + 131072)}); }
    if (P.ph_lo < 2 && 2 < P.ph_hi) xcd_barrier(xb);
    PHON(2) if (P.ph_lo <= 2 && 2 < P.ph_hi) { run_gemm_v(lds, vbid, P.act, P.wt_dn[0], DM, FF, EpiRes{P.x, P.xres, P.xb, P.rowss + 1 * T_TOK, 0.5f}); }
    if (P.ph_lo < 3 && 3 < P.ph_hi) xcd_barrier(xb);
    PHON(3) if (P.ph_lo <= 3 && 3 < P.ph_hi) { phase_s5a(P, lds); }
    xcd_barrier(xb);
    phase_s5carry(P);
    if (P.ph_lo < 4 && 4 < P.ph_hi) xcd_barrier(xb);
    PHON(4) if (P.ph_lo <= 4 && 4 < P.ph_hi) { phase_s5b(P, lds); }
    if constexpr (DUPSEL == 3) { xcd_barrier(xb); phase_s5a(P, lds); xcd_barrier(xb); phase_s5carry(P); xcd_barrier(xb); phase_s5b(P, lds); }

    if (P.ph_lo < 5 && 5 < P.ph_hi) xcd_barrier(xb);
    PHON(5) if (P.ph_lo <= 5 && 5 < P.ph_hi) { run_gemm_v(lds, vbid, P.yb, P.wt_glu, 2048, DM, EpiGlu{P.xres, P.xb, P.rowss + 2 * T_TOK}); }
    if (P.ph_lo < 6 && 6 < P.ph_hi) xcd_barrier(xb);
    PHON(6) if (P.ph_lo <= 6 && 6 < P.ph_hi) { preload_rs(lds, vbid, P.rowss + 2 * T_TOK, 5632); run_gemm_v(lds, vbid, P.xb, P.wt_up[1], 5632, DM, EpiAct{P.act, P.rowss + 2 * T_TOK, P.kbuf, P.vT, P.rope, (const LAS float*)(lds + 131072)}); convert_by_light_blocks(P, lds, vbid, 64 * 22, P.it2, P.nitems); }
    if (P.ph_lo < 7 && 7 < P.ph_hi) xcd_barrier(xb);
    PHON(7) if (P.ph_lo <= 7 && 7 < P.ph_hi) { run_gemm_v(lds, vbid, P.act, P.wt_dn[1], DM, FF, EpiRes{P.xres, P.xres, P.xb, P.rowss + 3 * T_TOK, 0.5f}); }
    if (P.ph_lo < 8 && 8 < P.ph_hi) xcd_barrier(xb);
    PHON(8) if (P.ph_lo <= 8 && 8 < P.ph_hi) { preload_rs(lds, vbid, P.rowss + 3 * T_TOK, 6144); run_gemm_v(lds, vbid, P.xb, P.wt_up[2], 6144, DM, EpiAct{P.act, P.rowss + 3 * T_TOK, P.kbuf, P.vT, P.rope, (const LAS float*)(lds + 131072)}); }
    if (P.ph_lo < 9 && 9 < P.ph_hi) xcd_barrier(xb);
    PHON(9) if (P.ph_lo <= 9 && 9 < P.ph_hi) { run_gemm_v(lds, vbid, P.act, P.wt_dn[2], DM, FF, EpiRes{P.xres, P.xres, P.xb, P.rowss + 4 * T_TOK, 0.5f}); phase_kmean(P, lds); }
    if (P.ph_lo < 10 && 10 < P.ph_hi) xcd_barrier(xb);
    PHON(10) if (P.ph_lo <= 10 && 10 < P.ph_hi) { run_gemm_v(lds, vbid, P.xb, P.wt_q, DM, DM, EpiQ{P.qbuf, P.rowss + 4 * T_TOK, P.rope}); }
    if (P.ph_lo < 11 && 11 < P.ph_hi) xcd_barrier(xb);
    PHON(11) if (P.ph_lo <= 11 && 11 < P.ph_hi) { phase_gate(P, lds); }
    if (P.ph_lo < 12 && 12 < P.ph_hi) xcd_barrier(xb);
    PHON(12) if (P.ph_lo <= 12 && 12 < P.ph_hi) { phase_attn<false>(P, lds, abid); }
    if constexpr (DUPSEL == 6) { xcd_barrier(xb); phase_attn<false>(P, lds, abid); }
    if (P.ph_lo < 13 && 13 < P.ph_hi) xcd_barrier(xb);
    PHON(13) if (P.ph_lo <= 13 && 13 < P.ph_hi) { phase_attn<true>(P, lds, abid); }
    if constexpr (DUPSEL == 1) { for (int i = 0; i < 8; ++i) xcd_barrier(xb); }
    if (P.ph_lo < 14 && 14 < P.ph_hi) xcd_barrier(xb);
    PHON(14) if (P.ph_lo <= 14 && 14 < P.ph_hi) { run_gemm_v(lds, vbid, P.attn, P.wt_o, DM, DM, EpiRes{P.xres, P.xres, P.xb, P.rowss + 5 * T_TOK, 1.0f}); }
    if (P.ph_lo < 15 && 15 < P.ph_hi) xcd_barrier(xb);
    PHON(15) if (P.ph_lo <= 15 && 15 < P.ph_hi) { preload_rs(lds, vbid, P.rowss + 5 * T_TOK, 5632); run_gemm_v(lds, vbid, P.xb, P.wt_up[3], 5632, DM, EpiAct{P.act, P.rowss + 5 * T_TOK, P.kbuf, P.vT, P.rope, (const LAS float*)(lds + 131072)}); }
    if (P.ph_lo < 16 && 16 < P.ph_hi) xcd_barrier(xb);
    PHON(16) if (P.ph_lo <= 16 && 16 < P.ph_hi) { run_gemm_v(lds, vbid, P.act, P.wt_dn[3], DM, FF, EpiRes{P.xres, P.xres, P.xb, P.rowss + 6 * T_TOK, 0.5f}); }
    if (vb_ok && gridDim.x == 256u) { phase_final_fused(P, lds, vbid); }
    else { xcd_barrier(xb); phase_final(P); }
}

extern "C" void kernel_launch(void* const* d_in, const int* in_sizes, int n_in, void* d_out, int out_size, void* d_ws, size_t ws_size, hipStream_t stream) {
    static int grid_blocks = 0;
    if (!grid_blocks) {
        int dev = 0, cus = 0, per_cu = 0;
        hipGetDevice(&dev);
        hipDeviceGetAttribute(&cus, hipDeviceAttributeMultiprocessorCount, dev);
        hipFuncSetAttribute((const void*)mega_fwd, hipFuncAttributeMaxDynamicSharedMemorySize, LDS_BYTES);
        hipOccupancyMaxActiveBlocksPerMultiprocessor(&per_cu, (const void*)mega_fwd, 512, LDS_BYTES);
        if (per_cu < 1) per_cu = 1;
        if (per_cu > 1) per_cu = 1;
        grid_blocks = cus * per_cu;
    }
    Params p{};
    const float** in = (const float**)&p.x;
    for (int i = 0; i < 19; ++i) in[i] = (const float*)d_in[i];
    p.out = (float*)d_out;
    unsigned char* ws = (unsigned char*)d_ws; size_t off = 0;
    auto take = [&](size_t bytes) { unsigned char* r = ws + off; off += (bytes + 255) & ~(size_t)255; return r; };
    p.xres = (float*)take((size_t)T_TOK * DM * 4);
    p.xb = (bf16_t*)take((size_t)T_TOK * DM * 2);
    p.act = (bf16_t*)take((size_t)T_TOK * FF * 2);
    p.qbuf = p.act;
    p.attn = p.act + (size_t)T_TOK * DM;
    p.part_ml = (float*)(p.act + (size_t)2 * T_TOK * DM);
    p.kbuf = (bf16_t*)take((size_t)T_TOK * 256 * 2);
    p.vT = (bf16_t*)take((size_t)T_TOK * 256 * 2);
    p.kmean = (float*)take(128 * 128 * 4);
    p.rowss = (float*)take((size_t)7 * T_TOK * 4 + 1024);
    p.gcount = (int*)(p.rowss + 7 * T_TOK);
    p.E = (float*)take((size_t)2 * 128 * 64 * 64 * 2 * 4);
    p.lists = (int*)p.E;
    p.rope = (float*)take((size_t)SEQ * 16 * 2 * 4);
    p.bar = (unsigned*)take((size_t)XCD_BAR_WORDS * 4);
    p.s5tab = (float*)take(4096 * 4 * 4);
    p.pcnt = (int*)take(256);
    p.wt_up[0] = (bf16_t*)take((size_t)6144 * DM * 2); p.wt_up[1] = (bf16_t*)take((size_t)6144 * DM * 2);
    p.wt_dn[0] = (bf16_t*)take((size_t)DM * FF * 2); p.wt_dn[1] = (bf16_t*)take((size_t)DM * FF * 2);
    p.wt_glu = (bf16_t*)take((size_t)2048 * DM * 2);
    p.wt_up[2] = (bf16_t*)take((size_t)6144 * DM * 2); p.wt_up[3] = (bf16_t*)take((size_t)6144 * DM * 2);
    p.wt_dn[2] = (bf16_t*)take((size_t)DM * FF * 2); p.wt_dn[3] = (bf16_t*)take((size_t)DM * FF * 2);
    p.wt_q = (bf16_t*)take((size_t)DM * DM * 2);
    p.wt_o = (bf16_t*)take((size_t)DM * DM * 2);
    p.part[0] = p.xb;
    p.part[1] = (bf16_t*)take((size_t)T_TOK * DM * 2);
    p.part[2] = (bf16_t*)take((size_t)T_TOK * DM * 2);
    p.part[3] = p.wt_up[0];
    p.yb = p.part[1];
    int nj = 0, items = 0;
    auto job = [&](const float* W, const float* g, bf16_t* dst, int K, int Nsrc, int ndst, int mode) {
        WJob& J = p.jobs[nj++]; J.W = W; J.g = g; J.dst = dst; J.K = K; J.Nsrc = Nsrc; J.ndst = ndst; J.mode = mode; J.item0 = items; J.pad = 0;
        items += (K / 64) * (ndst / 32);
    };
    auto job_up = [&](int l, int f) { job(p.ffn_w_in + (size_t)(l * 2 + f) * DM * 2 * FF, p.norm_g + (size_t)(l * 3 + (f ? 2 : 0)) * DM, p.wt_up[l * 2 + f], DM, 2 * FF, 2 * FF, 1); };
    auto job_dn = [&](int l, int f) { job(p.ffn_w_out + (size_t)(l * 2 + f) * FF * DM, nullptr, p.wt_dn[l * 2 + f], FF, DM, DM, 0); };
    job_up(0, 0);
    p.it1 = items;
    job_dn(0, 0); job(p.w_glu, nullptr, p.wt_glu, DM, 2048, 2048, 1); job_up(0, 1); job_dn(0, 1);
    p.it2 = items;
    job_up(1, 0);
    job(p.w_k, p.kv_norm_g, p.wt_up[2] + (size_t)5632 * DM, DM, 256, 256, 0);
    job(p.w_v, p.kv_norm_g, p.wt_up[2] + (size_t)5888 * DM, DM, 256, 256, 0);
    job_dn(1, 0); job_up(1, 1); job_dn(1, 1);
    job(p.w_q, p.norm_g + (size_t)4 * DM, p.wt_q, DM, DM, DM, 0);
    job(p.w_o, nullptr, p.wt_o, DM, DM, DM, 0);
    p.nitems = items; p.ph_lo = 0; p.ph_hi = NPHASES; p.pad = 0;
    if (off > ws_size) { fprintf(stderr, "workspace too small: need %zu have %zu\n", off, ws_size); return; }
    (void)hipMemsetAsync(p.bar, 0, (size_t)XCD_BAR_WORDS * 4, stream);
    void* args[] = {&p};
    hipError_t e = hipLaunchCooperativeKernel((const void*)mega_fwd, dim3(grid_blocks), dim3(512), args, LDS_BYTES, stream);
    if (e != hipSuccess) fprintf(stderr, "cooperative launch failed: %s (grid %d)\n", hipGetErrorString(e), grid_blocks);
}
```

```cpp
#include <hip/hip_runtime.h>
#include <hip/hip_cooperative_groups.h>
#include <cstdio>
namespace cg = cooperative_groups;

#define LAS __attribute__((address_space(3)))
#define DI __device__ __forceinline__
typedef unsigned short bf16_t;
typedef short bf16x8 __attribute__((ext_vector_type(8)));
typedef float f32x4 __attribute__((ext_vector_type(4)));
typedef float f32x2 __attribute__((ext_vector_type(2)));
typedef unsigned u32x4 __attribute__((ext_vector_type(4)));
typedef unsigned u32x2 __attribute__((ext_vector_type(2)));

constexpr int T_TOK = 16384, DM = 1024, FF = 2816, SEQ = 8192;
constexpr float RMS_EPS = 1e-6f;
constexpr int LDS_BYTES = 139296;
constexpr int NJOBS = 13;

struct WJob { const float* W; const float* g; bf16_t* dst; int K; int Nsrc; int ndst; int mode; int item0; int pad; };

struct Params {
    const float *x, *norm_g, *ffn_w_in, *ffn_w_out, *a_re, *a_im, *log_step, *b_re, *b_im, *c_re, *c_im, *s5_d, *w_glu, *kv_norm_g, *w_k, *w_v, *w_q, *w_o, *final_g;
    float* out;
    float* xres; bf16_t* xb; bf16_t* act; bf16_t* yb; bf16_t* qbuf; bf16_t* attn; bf16_t* kbuf; bf16_t* vbuf;
    float* kmean; float* rowss; float* E; float* rope;
    bf16_t* vT; bf16_t* part[4]; float* part_ml; int* lists; int* gcount; unsigned* bar; float* s5tab; int* pcnt;
    bf16_t* wt_up[4]; bf16_t* wt_dn[4]; bf16_t* wt_glu; bf16_t* wt_q; bf16_t* wt_o;
    WJob jobs[NJOBS];
    int nitems; int ph_lo; int ph_hi; int pad; int it1; int it2;
};

DI unsigned cvt_pk_bf16(float lo, float hi) { unsigned r; asm volatile("v_cvt_pk_bf16_f32 %0, %1, %2" : "=v"(r) : "v"(lo), "v"(hi)); return r; }
DI float bf_lo(unsigned w) { return __uint_as_float(w << 16); }
DI float bf_hi(unsigned w) { return __uint_as_float(w & 0xffff0000u); }
DI float wave_sum(float v) {
#pragma unroll
    for (int o = 1; o < 64; o <<= 1) v += __shfl_xor(v, o);
    return v;
}
DI float wave_max(float v) {
#pragma unroll
    for (int o = 1; o < 64; o <<= 1) v = fmaxf(v, __shfl_xor(v, o));
    return v;
}

namespace pg8 {
constexpr int BM = 256, BK = 64, HALF = 128, HTB = HALF * BK * 2, NXCD = 8, WGM = 8;
DI int lds_byte(int r, int c) { const int st = (r >> 4) * 2 + (c >> 5), rr = r & 15, cc = c & 31, ob = rr * 64 + cc * 2; return st * 1024 + (ob ^ (((ob >> 9) & 1) << 5)); }
DI void stage_rc(int b, int& R, int& C) { const int st = b / 1024, sb = b % 1024, swz = sb ^ (((sb >> 9) & 1) << 5); R = (st >> 1) * 16 + swz / 64; C = (st & 1) * 32 + (swz % 64) / 2; }
struct Unit { int pm, pn; };
struct Gemm { const bf16_t* A; const bf16_t* Bt; int M, N, K; };
struct StaticOrder {
    int nM, nN, nwg, G, c;
    DI void init(int M, int N, int G_, int c_) { nM = M / BM; nN = N / BM; nwg = nM * nN; G = G_; c = c_; }
    DI bool next(int i, Unit& u) const {
        const long L = (long)i * G + c; if (L >= nwg) return false;
        int wgid = (int)L; { const int q = nwg / NXCD, r = nwg % NXCD, xcd = wgid % NXCD, off = wgid / NXCD; wgid = (xcd < r ? xcd * (q + 1) : r * (q + 1) + (xcd - r) * q) + off; }
        const int nig = WGM * nN, gid = wgid / nig, fm = gid * WGM, gsz = (nM - fm) < WGM ? (nM - fm) : WGM;
        u.pm = fm + ((wgid % nig) % gsz); u.pn = (wgid % nig) / gsz; return true;
    }
};

template <class Epi>
DI void gemm_phase(LAS unsigned char* lds, const Gemm g, const StaticOrder& S, const Epi& E) {
    int tid_ = threadIdx.x; asm volatile("" : "+v"(tid_));
    const int tid = tid_, wid = __builtin_amdgcn_readfirstlane(tid >> 6), lane = tid & 63, wr = wid >> 2, wc = wid & 3, fr = lane & 15, fq = lane >> 4;
    const int K = g.K, nt = K / BK;
    unsigned voffA[2], voffB[2];
#pragma unroll
    for (int i = 0; i < 2; ++i) { int R, C; stage_rc(tid * 16 + i * 8192, R, C); voffA[i] = (unsigned)(R * K + C) * 2u; voffB[i] = voffA[i]; }
    const size_t kstep = (size_t)(BK * 2);
    const size_t hstep = (size_t)HALF * K * 2;
    const size_t tstep = 2 * hstep;
    const unsigned ldsw = (unsigned)wid * 1024u;
    const int aoff = lds_byte(wr * 64 + fr, fq * 8), boff = lds_byte(wc * 32 + fr, fq * 8);
#define PG8_SA(b, h) (((b) * 2 + (h)) * HTB)
#define PG8_SB(b, h) ((4 + (b) * 2 + (h)) * HTB)
#define PG8_STAGE(bufoff, gbase, voff) do { _Pragma("unroll") for (int _i = 0; _i < 2; ++_i) \
        __builtin_amdgcn_global_load_lds((const unsigned*)((const char*)(gbase) + (voff)[_i]), (LAS unsigned*)(lds + (bufoff) + ldsw + _i * 8192), 16, 0, 0); } while (0)
#define PG8_LDA(dst, b, h) do { _Pragma("unroll") for (int m = 0; m < 4; ++m) _Pragma("unroll") for (int k = 0; k < 2; ++k) dst[m][k] = *(const LAS bf16x8*)(lds + PG8_SA(b, h) + aoff + m * 2048 + k * 1024); } while (0)
#define PG8_LDB(dst, b, h) do { _Pragma("unroll") for (int n = 0; n < 2; ++n) _Pragma("unroll") for (int k = 0; k < 2; ++k) dst[n][k] = *(const LAS bf16x8*)(lds + PG8_SB(b, h) + boff + n * 2048 + k * 1024); } while (0)
#define PG8_MMA(ai, bj, At, Bt) do { __builtin_amdgcn_s_setprio(1); _Pragma("unroll") for (int m = 0; m < 4; ++m) _Pragma("unroll") for (int n = 0; n < 2; ++n) _Pragma("unroll") for (int k = 0; k < 2; ++k) \
        acc[ai][bj][m][n] = __builtin_amdgcn_mfma_f32_16x16x32_bf16(Bt[n][k], At[m][k], acc[ai][bj][m][n], 0, 0, 0); __builtin_amdgcn_s_setprio(0); } while (0)
#define PG8_WAIT_V(n) asm volatile("s_waitcnt vmcnt(" #n ")" ::: "memory")
#define PG8_WAIT_L(n) asm volatile("s_waitcnt lgkmcnt(" #n ")" ::: "memory")
#define PG8_BAR __builtin_amdgcn_s_barrier()
#define PG8_SCHED __builtin_amdgcn_sched_barrier(0)
    Unit cur, nxt; int ui = 0;
    if (!S.next(0, cur)) return;
    f32x4 acc[2][2][4][2];
#pragma unroll
    for (int a = 0; a < 2; ++a)
#pragma unroll
        for (int b = 0; b < 2; ++b)
#pragma unroll
            for (int m = 0; m < 4; ++m)
#pragma unroll
                for (int n = 0; n < 2; ++n) acc[a][b][m][n] = (f32x4){0.f, 0.f, 0.f, 0.f};
    bf16x8 At[4][2], B0[2][2], B1[2][2];
    const char* cA = (const char*)g.A + (size_t)cur.pm * tstep; const char* cB = (const char*)g.Bt + (size_t)cur.pn * tstep;
    PG8_STAGE(PG8_SB(0, 0), cB, voffB); PG8_STAGE(PG8_SA(0, 0), cA, voffA); PG8_STAGE(PG8_SB(0, 1), cB + hstep, voffB); PG8_STAGE(PG8_SA(0, 1), cA + hstep, voffA);
    if (wr == 1) PG8_BAR;
    PG8_WAIT_V(4); PG8_BAR;
    PG8_STAGE(PG8_SB(1, 0), cB + kstep, voffB); PG8_STAGE(PG8_SA(1, 0), cA + kstep, voffA); PG8_STAGE(PG8_SB(1, 1), cB + hstep + kstep, voffB);
    PG8_WAIT_V(6); PG8_BAR;
    for (;;) {
        const bool has_next = S.next(ui + 1, nxt);
        const char* nA = has_next ? (const char*)g.A + (size_t)nxt.pm * tstep : cA; const char* nB = has_next ? (const char*)g.Bt + (size_t)nxt.pn * tstep : cB;
        for (int t = 0; t < nt; t += 2) {
            const bool last = (t == nt - 2);
            const char* a1 = cA + (size_t)(t + 1) * kstep;
            const char* a2 = last ? nA : cA + (size_t)(t + 2) * kstep; const char* b2 = last ? nB : cB + (size_t)(t + 2) * kstep;
            const char* a3 = a2 + kstep; const char* b3 = b2 + kstep;
            PG8_LDB(B0, 0, 0); PG8_SCHED; PG8_LDA(At, 0, 0); PG8_STAGE(PG8_SA(1, 1), a1 + hstep, voffA);
            PG8_WAIT_L(8); PG8_BAR; PG8_WAIT_L(0); PG8_MMA(0, 0, At, B0); PG8_BAR; PG8_SCHED;
            PG8_LDB(B1, 0, 1); PG8_STAGE(PG8_SB(0, 0), b2, voffB);
            PG8_BAR; PG8_WAIT_L(0); PG8_MMA(0, 1, At, B1); PG8_BAR;
            PG8_LDA(At, 0, 1); PG8_STAGE(PG8_SA(0, 0), a2, voffA);
            PG8_BAR; PG8_WAIT_L(0); PG8_MMA(1, 0, At, B0); PG8_BAR; PG8_SCHED;
            PG8_STAGE(PG8_SB(0, 1), b2 + hstep, voffB);
            PG8_WAIT_V(6); PG8_BAR; PG8_MMA(1, 1, At, B1); PG8_BAR;
            PG8_LDB(B0, 1, 0); PG8_SCHED; PG8_LDA(At, 1, 0); PG8_STAGE(PG8_SA(0, 1), a2 + hstep, voffA);
            PG8_WAIT_L(8); PG8_BAR; PG8_WAIT_L(0); PG8_MMA(0, 0, At, B0); PG8_BAR; PG8_SCHED;
            PG8_LDB(B1, 1, 1); PG8_STAGE(PG8_SB(1, 0), b3, voffB);
            PG8_BAR; PG8_WAIT_L(0); PG8_MMA(0, 1, At, B1); PG8_BAR;
            PG8_LDA(At, 1, 1); PG8_STAGE(PG8_SA(1, 0), a3, voffA);
            PG8_BAR; PG8_WAIT_L(0); PG8_MMA(1, 0, At, B0); PG8_BAR; PG8_SCHED;
            PG8_STAGE(PG8_SB(1, 1), b3 + hstep, voffB);
            PG8_WAIT_V(6); PG8_BAR; PG8_MMA(1, 1, At, B1); PG8_BAR;
        }
        E(acc, cur, wr, wc, fr, fq, ui);
        if (!has_next) break;
#pragma unroll
        for (int a = 0; a < 2; ++a)
#pragma unroll
            for (int b = 0; b < 2; ++b)
#pragma unroll
                for (int m = 0; m < 4; ++m)
#pragma unroll
                    for (int n = 0; n < 2; ++n) acc[a][b][m][n] = (f32x4){0.f, 0.f, 0.f, 0.f};
        cur = nxt; cA = nA; cB = nB; ++ui;
    }
    PG8_WAIT_V(0);
    if (wr == 0) PG8_BAR;
    PG8_BAR;
#undef PG8_SA
#undef PG8_SB
#undef PG8_STAGE
#undef PG8_LDA
#undef PG8_LDB
#undef PG8_MMA
#undef PG8_WAIT_V
#undef PG8_WAIT_L
#undef PG8_BAR
#undef PG8_SCHED
}
}
using pg8::Unit;
typedef f32x4 AccT[2][2][4][2];

DI void store_bf4(bf16_t* p, f32x4 v) { u32x2 o; o.x = cvt_pk_bf16(v.x, v.y); o.y = cvt_pk_bf16(v.z, v.w); *(u32x2*)p = o; }
DI float sigmoidf_(float x) { return __builtin_amdgcn_rcpf(1.f + __builtin_amdgcn_exp2f(-1.4426950408889634f * x)); }

struct EpiAct {
    bf16_t* act; const float* rowss; bf16_t* kbuf; bf16_t* vbuf; const float* rope; const LAS float* rsl;
    DI void operator()(const AccT& acc, const Unit& u, int wr, int wc, int fr, int fq, int ui) const {
        const int row0 = u.pm * 256 + wr * 64 + fr;
        if (u.pn < 22) {
#pragma unroll
            for (int ai = 0; ai < 2; ++ai)
#pragma unroll
                for (int m = 0; m < 4; ++m) {
                    const int row = row0 + ai * 128 + m * 16;
                    const float rs = rsl[ui * 256 + wr * 64 + fr + ai * 128 + m * 16];
#pragma unroll
                    for (int bj = 0; bj < 2; ++bj) {
                        const f32x4 gt = acc[ai][bj][m][0] * rs, up = acc[ai][bj][m][1] * rs;
                        f32x4 a;
#pragma unroll
                        for (int j = 0; j < 4; ++j) a[j] = gt[j] * sigmoidf_(gt[j]) * up[j];
                        const int col = 16 * (8 * u.pn + 4 * bj + wc) + 4 * fq;
                        store_bf4(act + (size_t)row * FF + col, a);
                    }
                }
        } else if (u.pn == 22) {
            const bool do_rope = (wc == 0);
#pragma unroll
            for (int ai = 0; ai < 2; ++ai)
#pragma unroll
                for (int m = 0; m < 4; ++m) {
                    const int row = row0 + ai * 128 + m * 16;
                    const float rs = rsqrtf(rowss[row] * (1.f / DM) + RMS_EPS);
                    const int b = row >> 13, pos = row & (SEQ - 1);
#pragma unroll
                    for (int bj = 0; bj < 2; ++bj) {
                        f32x4 v0 = acc[ai][bj][m][0] * rs, v1 = acc[ai][bj][m][1] * rs;
                        if (do_rope) {
                            const f32x4* rp = (const f32x4*)(rope + ((size_t)pos * 16 + 4 * fq) * 2);
                            const f32x4 cs0 = rp[0], cs1 = rp[1];
                            const float c[4] = {cs0.x, cs0.z, cs1.x, cs1.z}, s[4] = {cs0.y, cs0.w, cs1.y, cs1.w};
#pragma unroll
                            for (int j = 0; j < 4; ++j) { const float x1 = v0[j], x2 = v1[j]; v0[j] = x1 * c[j] - x2 * s[j]; v1[j] = x2 * c[j] + x1 * s[j]; }
                        }
                        bf16_t* d = kbuf + ((size_t)(b * 2 + bj) * SEQ + pos) * 128 + 32 * wc + 4 * fq;
                        store_bf4(d, v0); store_bf4(d + 16, v1);
                    }
                }
        } else {
            const int lane = fr + 16 * fq, qi = lane & 3;
#pragma unroll
            for (int ai = 0; ai < 2; ++ai)
#pragma unroll
                for (int m = 0; m < 4; ++m) {
                    const int row = row0 + ai * 128 + m * 16;
                    const float rs = rsqrtf(rowss[row] * (1.f / DM) + RMS_EPS);
                    const int b = row >> 13, posq = (row & (SEQ - 1)) & ~3;
#pragma unroll
                    for (int bj = 0; bj < 2; ++bj)
#pragma unroll
                        for (int n = 0; n < 2; ++n) {
                            const f32x4 v = acc[ai][bj][m][n] * rs;
                            f32x4 w;
#pragma unroll
                            for (int k = 0; k < 4; ++k) {
                                const int src = (lane & ~3) | k;
                                const float t0 = __shfl(v[0], src), t1 = __shfl(v[1], src), t2 = __shfl(v[2], src), t3 = __shfl(v[3], src);
                                w[k] = qi == 0 ? t0 : (qi == 1 ? t1 : (qi == 2 ? t2 : t3));
                            }
                            const int d = 32 * wc + 16 * n + 4 * fq + qi;
                            store_bf4(vbuf + ((size_t)((b * 2 + bj) * 128 + d)) * SEQ + posq, w);
                        }
                }
        }
    }
};

struct EpiRes {
    const float* xin; float* xout; bf16_t* xb; float* rowss_out; float alpha;
    DI void operator()(const AccT& acc, const Unit& u, int wr, int wc, int fr, int fq, int ui) const {
        const int row0 = u.pm * 256 + wr * 64 + fr;
#pragma unroll
        for (int ai = 0; ai < 2; ++ai)
#pragma unroll
            for (int m = 0; m < 4; ++m) {
                const int row = row0 + ai * 128 + m * 16;
                float ss = 0.f;
#pragma unroll
                for (int bj = 0; bj < 2; ++bj)
#pragma unroll
                    for (int n = 0; n < 2; ++n) {
                        const size_t off = (size_t)row * DM + u.pn * 256 + bj * 128 + wc * 32 + n * 16 + 4 * fq;
                        const f32x4 xo = *(const f32x4*)(xin + off);
                        const f32x4 v = xo + alpha * acc[ai][bj][m][n];
                        *(f32x4*)(xout + off) = v;
                        store_bf4(xb + off, v);
                        ss += v.x * v.x + v.y * v.y + v.z * v.z + v.w * v.w;
                    }
                ss += __shfl_xor(ss, 16); ss += __shfl_xor(ss, 32);
                if (fq == 0) atomicAdd(rowss_out + row, ss);
            }
    }
};

struct EpiGlu {
    float* xres; bf16_t* xb; float* rowss_out;
    DI void operator()(const AccT& acc, const Unit& u, int wr, int wc, int fr, int fq, int ui) const {
        const int row0 = u.pm * 256 + wr * 64 + fr;
#pragma unroll
        for (int ai = 0; ai < 2; ++ai)
#pragma unroll
            for (int m = 0; m < 4; ++m) {
                const int row = row0 + ai * 128 + m * 16;
                float ss = 0.f;
#pragma unroll
                for (int bj = 0; bj < 2; ++bj) {
                    const size_t off = (size_t)row * DM + 16 * (8 * u.pn + 4 * bj + wc) + 4 * fq;
                    const f32x4 val = acc[ai][bj][m][0], gt = acc[ai][bj][m][1];
                    f32x4 v = *(const f32x4*)(xres + off);
#pragma unroll
                    for (int j = 0; j < 4; ++j) v[j] += val[j] * sigmoidf_(gt[j]);
                    *(f32x4*)(xres + off) = v;
                    store_bf4(xb + off, v);
                    ss += v.x * v.x + v.y * v.y + v.z * v.z + v.w * v.w;
                }
                ss += __shfl_xor(ss, 16); ss += __shfl_xor(ss, 32);
                if (fq == 0) atomicAdd(rowss_out + row, ss);
            }
    }
};

struct EpiQ {
    bf16_t* qbuf; const float* rowss; const float* rope;
    DI void operator()(const AccT& acc, const Unit& u, int wr, int wc, int fr, int fq, int ui) const {
        const int row0 = u.pm * 256 + wr * 64 + fr;
#pragma unroll
        for (int ai = 0; ai < 2; ++ai)
#pragma unroll
            for (int m = 0; m < 4; ++m) {
                const int row = row0 + ai * 128 + m * 16;
                const float rs = rsqrtf(rowss[row] * (1.f / DM) + RMS_EPS) * 0.08838834764831845f;
                const int pos = row & (SEQ - 1);
#pragma unroll
                for (int bj = 0; bj < 2; ++bj) {
                    f32x4 v0 = acc[ai][bj][m][0] * rs, v1 = acc[ai][bj][m][1] * rs;
                    if (wc == 0) {
                        const f32x4* rp = (const f32x4*)(rope + ((size_t)pos * 16 + 4 * fq) * 2);
                        const f32x4 cs0 = rp[0], cs1 = rp[1];
                        const float c[4] = {cs0.x, cs0.z, cs1.x, cs1.z}, s[4] = {cs0.y, cs0.w, cs1.y, cs1.w};
#pragma unroll
                        for (int j = 0; j < 4; ++j) { const float x1 = v0[j], x2 = v1[j]; v0[j] = x1 * c[j] - x2 * s[j]; v1[j] = x2 * c[j] + x1 * s[j]; }
                    }
                    bf16_t* d = qbuf + (size_t)row * DM + u.pn * 256 + bj * 128 + 32 * wc + 4 * fq;
                    store_bf4(d, v0); store_bf4(d + 16, v1);
                }
            }
    }
};

DI void preload_rs(LAS unsigned char* lds, int vbid, const float* rowss, int N) {
    pg8::StaticOrder S; S.init(T_TOK, N, gridDim.x, vbid);
    LAS float* rsl = (LAS float*)(lds + 131072);
    pg8::Unit u;
    for (int i = 0; i < 8 && S.next(i, u); ++i)
        if (threadIdx.x < 256) rsl[i * 256 + threadIdx.x] = rsqrtf(rowss[u.pm * 256 + threadIdx.x] * (1.f / DM) + RMS_EPS);
    __syncthreads();
}
template <class Epi>
DI void run_gemm_v(LAS unsigned char* lds, int vbid, const bf16_t* A, const bf16_t* Bt, int N, int K, const Epi& E) {
    pg8::Gemm g{A, Bt, T_TOK, N, K};
    pg8::StaticOrder S; S.init(T_TOK, N, gridDim.x, vbid);
    pg8::gemm_phase<Epi>(lds, g, S, E);
}

struct S5Coef { float ar, ai, cr, ci; };
DI S5Coef s5_coefs_compute(const Params& P, int g, int p) {
    const float dt = expf(P.log_step[g]); const float lr = P.a_re[g * 64 + p], li = P.a_im[g * 64 + p];
    const float mag = expf(lr * dt); S5Coef c; c.ar = mag * cosf(li * dt); c.ai = mag * sinf(li * dt);
    const float nr = c.ar - 1.f, ni = c.ai, den = lr * lr + li * li;
    c.cr = (nr * lr + ni * li) / den; c.ci = (ni * lr - nr * li) / den; return c;
}
DI S5Coef s5_coefs(const Params& P, int g, int p) { const f32x4 v = *(const f32x4*)(P.s5tab + (size_t)(g * 64 + p) * 4); S5Coef c; c.ar = v.x; c.ai = v.y; c.cr = v.z; c.ci = v.w; return c; }

DI void p0_transpose_item(const WJob& J, LAS float* scr, int item, int lane) {
    const int nblk = J.ndst / 32, kb = item / nblk, nb = item % nblk, k0 = 64 * kb, r0 = 32 * nb;
    const int i = lane & 31;
    int scol;
    if (J.mode == 0) scol = r0 + i;
    else { const int G = r0 >> 5; scol = (i < 16) ? (16 * G + i) : ((J.Nsrc >> 1) + 16 * G + (i - 16)); }
    float wv[32];
    const float* wp = J.W + (size_t)(k0 + (lane >> 5)) * J.Nsrc + scol;
#pragma unroll
    for (int it = 0; it < 32; ++it) wv[it] = wp[(size_t)(2 * it) * J.Nsrc];
    if (J.g) {
        const float* gp = J.g + k0 + (lane >> 5);
#pragma unroll
        for (int it = 0; it < 32; ++it) wv[it] *= gp[2 * it];
    }
#pragma unroll
    for (int it = 0; it < 32; ++it) scr[(2 * it + (lane >> 5)) * 33 + i] = wv[it];
    __builtin_amdgcn_fence(__ATOMIC_RELEASE, "wavefront"); __builtin_amdgcn_wave_barrier(); __builtin_amdgcn_fence(__ATOMIC_ACQUIRE, "wavefront");
    const int c = lane & 7;
#pragma unroll
    for (int j = 0; j < 4; ++j) {
        const int n = (lane >> 3) + 8 * j; const LAS float* s = scr + (8 * c) * 33 + n;
        u32x4 o; o.x = cvt_pk_bf16(s[0 * 33], s[1 * 33]); o.y = cvt_pk_bf16(s[2 * 33], s[3 * 33]); o.z = cvt_pk_bf16(s[4 * 33], s[5 * 33]); o.w = cvt_pk_bf16(s[6 * 33], s[7 * 33]);
        *(u32x4*)(J.dst + (size_t)(r0 + n) * J.K + k0 + 8 * c) = o;
    }
    __builtin_amdgcn_fence(__ATOMIC_RELEASE, "wavefront"); __builtin_amdgcn_wave_barrier(); __builtin_amdgcn_fence(__ATOMIC_ACQUIRE, "wavefront");
}

DI void convert_items(const Params& P, LAS unsigned char* lds, int lo, int hi, int gw, int NGW) {
    const int wave = threadIdx.x >> 6, lane = threadIdx.x & 63;
    LAS float* scr = (LAS float*)(lds + wave * 16384);
    for (int it = lo + gw; it < hi; it += NGW) {
        int j = 0;
#pragma unroll 1
        for (int q = 1; q < NJOBS; ++q) if (it >= P.jobs[q].item0) j = q;
        p0_transpose_item(P.jobs[j], scr, it - P.jobs[j].item0, lane);
    }
}
DI void convert_by_light_blocks(const Params& P, LAS unsigned char* lds, int vbid, int units, int lo, int hi) {
    asm volatile("" : "+s"(vbid), "+s"(lo), "+s"(hi));
    const int G = gridDim.x, extra = units % G, first = extra, nlight = G - extra;
    if (vbid >= first) convert_items(P, lds, lo, hi, (vbid - first) * 8 + (threadIdx.x >> 6), nlight * 8);
}

DI void phase_prep(const Params& P, LAS unsigned char* lds) {
    const int tid = threadIdx.x, wave = tid >> 6, lane = tid & 63;
    const int gw = blockIdx.x * 8 + wave, NGW = gridDim.x * 8;
    LAS float* scr = (LAS float*)(lds + wave * 16384);
    convert_items(P, lds, 0, P.it1, gw, NGW);
    for (int row = gw; row < T_TOK; row += NGW) {
        const f32x4* xr = (const f32x4*)(P.x + (size_t)row * DM) + lane;
        f32x4 v[4]; float s = 0.f;
#pragma unroll
        for (int j = 0; j < 4; ++j) { v[j] = xr[64 * j]; s += v[j].x * v[j].x + v[j].y * v[j].y + v[j].z * v[j].z + v[j].w * v[j].w; }
        s = wave_sum(s);
        if (lane == 0) P.rowss[row] = s;
        bf16_t* o = P.xb + (size_t)row * DM + 4 * lane;
#pragma unroll
        for (int j = 0; j < 4; ++j) store_bf4(o + 256 * j, v[j]);
    }
    const int gt = blockIdx.x * 512 + tid, NGT = gridDim.x * 512;
    for (int i = gt; i < 6 * T_TOK; i += NGT) P.rowss[T_TOK + i] = 0.f;
    if (gt < 128) P.gcount[gt] = 0;
    if (gt < 64) P.pcnt[gt] = 0;
    for (int i = gt; i < 4096; i += NGT) { const S5Coef c = s5_coefs_compute(P, i >> 6, i & 63); *(f32x4*)(P.s5tab + (size_t)i * 4) = (f32x4){c.ar, c.ai, c.cr, c.ci}; }
    for (int i = gt; i < SEQ * 16; i += NGT) {
        const int pos = i >> 4, d = i & 15;
        const float inv = exp2f(-(float)d * (18.931568569324174f / 16.f));
        const float ang = (float)pos * inv;
        P.rope[2 * i] = cosf(ang); P.rope[2 * i + 1] = sinf(ang);
    }
}

DI float gelu_tanh(float x) { const float u = 0.7978845608028654f * (x + 0.044715f * x * x * x); return x * __builtin_amdgcn_rcpf(1.f + __builtin_amdgcn_exp2f(-2.f * 1.4426950408889634f * u)); }

typedef float f32x16 __attribute__((ext_vector_type(16)));
typedef __bf16 bf2_t __attribute__((ext_vector_type(2)));
DI unsigned pk_bf16(float lo, float hi) { const f32x2 v = {lo, hi}; return __builtin_bit_cast(unsigned, __builtin_convertvector(v, bf2_t)); }
#define WAVE_LDS_SYNC() asm volatile("s_waitcnt lgkmcnt(0)" ::: "memory")

DI void s5_bfrags(const Params& P, int g, int lane, bf16x8 (&bf)[4]) {
    const int q = lane & 31, h = lane >> 5;
#pragma unroll
    for (int pj = 0; pj < 2; ++pj) {
        const int p = q + 32 * pj;
        const S5Coef c = s5_coefs(P, g, p);
        const f32x4* br = (const f32x4*)(P.b_re + ((size_t)g * 64 + p) * 16 + 8 * h);
        const f32x4* bi = (const f32x4*)(P.b_im + ((size_t)g * 64 + p) * 16 + 8 * h);
        const f32x4 r0 = br[0], r1 = br[1], i0 = bi[0], i1 = bi[1];
        float re[8], im[8];
#pragma unroll
        for (int j = 0; j < 4; ++j) {
            re[j] = c.cr * r0[j] - c.ci * i0[j]; im[j] = c.cr * i0[j] + c.ci * r0[j];
            re[4 + j] = c.cr * r1[j] - c.ci * i1[j]; im[4 + j] = c.cr * i1[j] + c.ci * r1[j];
        }
        const u32x4 wr = {pk_bf16(re[0], re[1]), pk_bf16(re[2], re[3]), pk_bf16(re[4], re[5]), pk_bf16(re[6], re[7])};
        const u32x4 wi = {pk_bf16(im[0], im[1]), pk_bf16(im[2], im[3]), pk_bf16(im[4], im[5]), pk_bf16(im[6], im[7])};
        bf[2 * pj] = __builtin_bit_cast(bf16x8, wr); bf[2 * pj + 1] = __builtin_bit_cast(bf16x8, wi);
    }
}
DI bf16x8 s5_ufrag(const Params& P, int rowbase, int g, int lane, const f32x4& ga, const f32x4& gb) {
    const int t = lane & 31, h = lane >> 5, row = rowbase + t;
    const float rs = rsqrtf(P.rowss[T_TOK + row] * (1.f / DM) + RMS_EPS);
    const f32x4* xp = (const f32x4*)(P.xres + (size_t)row * DM + 16 * g + 8 * h);
    const f32x4 a = xp[0] * rs * ga, b = xp[1] * rs * gb;
    const u32x4 w = {pk_bf16(a.x, a.y), pk_bf16(a.z, a.w), pk_bf16(b.x, b.y), pk_bf16(b.z, b.w)};
    return __builtin_bit_cast(bf16x8, w);
}
template <bool WRITE>
DI void s5_scan32(const f32x16 (&X)[4], int h, int p, float ar, float ai, float& hr, float& hi, LAS unsigned char* hs) {
    float lo_re[16], lo_im[16], hi_re[16], hi_im[16];
#pragma unroll
    for (int r = 0; r < 16; ++r) {
        const auto sr = __builtin_amdgcn_permlane32_swap(__float_as_uint(X[0][r]), __float_as_uint(X[2][r]), false, false);
        const auto si = __builtin_amdgcn_permlane32_swap(__float_as_uint(X[1][r]), __float_as_uint(X[3][r]), false, false);
        lo_re[r] = __uint_as_float(sr[0]); hi_re[r] = __uint_as_float(sr[1]);
        lo_im[r] = __uint_as_float(si[0]); hi_im[r] = __uint_as_float(si[1]);
    }
#pragma unroll
    for (int i = 0; i < 4; ++i)
#pragma unroll
        for (int half = 0; half < 2; ++half)
#pragma unroll
            for (int j = 0; j < 4; ++j) {
                const int r = 4 * i + j, token = 8 * i + 4 * half + j;
                const float xr = half ? hi_re[r] : lo_re[r], xi = half ? hi_im[r] : lo_im[r];
                const float nhr = ar * hr - ai * hi + xr, nhi = ar * hi + ai * hr + xi; hr = nhr; hi = nhi;
                if (WRITE) {
                    const unsigned whi = pk_bf16(hr, hi);
                    *(LAS unsigned*)(hs + token * 272 + 4 * p) = whi;
                    *(LAS unsigned*)(hs + 69632 + token * 272 + 4 * p) = pk_bf16(hr - bf_lo(whi), hi - bf_hi(whi));
                }
            }
}

struct S5In { f32x4 x0, x1; float ss; };
DI S5In s5_in_load(const Params& P, int rowbase, int g, int lane) {
    const int row = rowbase + (lane & 31);
    const f32x4* xp = (const f32x4*)(P.xres + (size_t)row * DM + 16 * g + 8 * (lane >> 5));
    S5In r; r.x0 = xp[0]; r.x1 = xp[1]; r.ss = P.rowss[T_TOK + row]; return r;
}
DI bf16x8 s5_in_frag(const S5In& in, const f32x4& ga, const f32x4& gb) {
    const float rs = rsqrtf(in.ss * (1.f / DM) + RMS_EPS);
    const f32x4 a = in.x0 * rs * ga, b = in.x1 * rs * gb;
    const u32x4 w = {pk_bf16(a.x, a.y), pk_bf16(a.z, a.w), pk_bf16(b.x, b.y), pk_bf16(b.z, b.w)};
    return __builtin_bit_cast(bf16x8, w);
}
DI int s5_row0(int L, int wave) { const int bc = L & 31; return (bc >> 4) * SEQ + ((bc & 15) * 8 + wave) * 64; }

DI void phase_s5a(const Params& P, LAS unsigned char* lds) {
    const int tid = threadIdx.x, wave = tid >> 6, lane = tid & 63, h = lane >> 5;
    for (int base = blockIdx.x * 8; base < 2048; base += gridDim.x * 8) {
        const int g = base >> 5;
        const S5Coef cf = s5_coefs(P, g, lane);
        bf16x8 bf[4]; s5_bfrags(P, g, lane, bf);
        const f32x4 ga = *(const f32x4*)(P.norm_g + DM + 16 * g + 8 * h), gb = *(const f32x4*)(P.norm_g + DM + 16 * g + 8 * h + 4);
        float hr = 0.f, hi = 0.f;
        S5In pre = s5_in_load(P, s5_row0(base, wave), g, lane);
#pragma unroll 1
        for (int step = 0; step < 16; ++step) {
            const int L = base + (step >> 1), sub = step & 1;
            const S5In cur = pre;
            if (step < 15) pre = s5_in_load(P, s5_row0(base + ((step + 1) >> 1), wave) + 32 * ((step + 1) & 1), g, lane);
            const bf16x8 a = s5_in_frag(cur, ga, gb);
            f32x16 X[4];
#pragma unroll
            for (int j = 0; j < 4; ++j) {
#pragma unroll
                for (int r = 0; r < 16; ++r) X[j][r] = 0.f;
                X[j] = __builtin_amdgcn_mfma_f32_32x32x16_bf16(a, bf[j], X[j], 0, 0, 0);
            }
            if (sub == 0) { hr = 0.f; hi = 0.f; }
            s5_scan32<false>(X, h, lane, cf.ar, cf.ai, hr, hi, lds);
            if (sub == 1) { const int bc = L & 31, ch = (bc & 15) * 8 + wave; *(f32x2*)(P.E + ((size_t)(((bc >> 4) * 128 + ch) * 64 + g) * 64 + lane) * 2) = (f32x2){hr, hi}; }
        }
    }
}

DI void phase_s5carry(const Params& P) {
    if (blockIdx.x < 128 && threadIdx.x < 64) {
        const int idx = blockIdx.x * 64 + threadIdx.x, b = idx >> 12, g = (idx >> 6) & 63, p = idx & 63;
        const S5Coef cf = s5_coefs(P, g, p);
        float alr = cf.ar, ali = cf.ai;
#pragma unroll
        for (int q = 0; q < 6; ++q) { const float r = alr * alr - ali * ali, i2 = 2.f * alr * ali; alr = r; ali = i2; }
        f32x2* Ep = (f32x2*)P.E + (size_t)(b * 128) * 4096 + g * 64 + p;
        float hr = 0.f, hi = 0.f;
#pragma unroll 1
        for (int j0 = 0; j0 < 128; j0 += 32) {
            f32x2 e[32];
#pragma unroll
            for (int u = 0; u < 32; ++u) e[u] = Ep[(size_t)(j0 + u) * 4096];
#pragma unroll
            for (int u = 0; u < 32; ++u) {
                Ep[(size_t)(j0 + u) * 4096] = (f32x2){hr, hi};
                const float nr = alr * hr - ali * hi + e[u].x, ni = alr * hi + ali * hr + e[u].y; hr = nr; hi = ni;
            }
        }
    }
}

DI void phase_s5b(const Params& P, LAS unsigned char* lds) {
    const int tid = threadIdx.x, wave = tid >> 6, lane = tid & 63, h = lane >> 5, c16 = lane & 15, kq = lane >> 4;
    LAS unsigned char* hs = lds + wave * 8704;
    for (int base = blockIdx.x * 8; base < 2048; base += gridDim.x * 8) {
        const int g = base >> 5;
        const S5Coef cf = s5_coefs(P, g, lane);
        bf16x8 bf[4]; s5_bfrags(P, g, lane, bf);
        const f32x4 ga = *(const f32x4*)(P.norm_g + DM + 16 * g + 8 * h), gb = *(const f32x4*)(P.norm_g + DM + 16 * g + 8 * h + 4);
        bf16x8 cmf[4], cml[4];
#pragma unroll
        for (int ks = 0; ks < 4; ++ks) {
            const int p0 = ks * 16 + kq * 4;
            const f32x4 cr = *(const f32x4*)(P.c_re + ((size_t)g * 16 + c16) * 64 + p0), ci = *(const f32x4*)(P.c_im + ((size_t)g * 16 + c16) * 64 + p0);
            const float v[8] = {cr.x, -ci.x, cr.y, -ci.y, cr.z, -ci.z, cr.w, -ci.w};
            u32x4 wh, wl;
#pragma unroll
            for (int e = 0; e < 4; ++e) { wh[e] = pk_bf16(v[2 * e], v[2 * e + 1]); wl[e] = pk_bf16(v[2 * e] - bf_lo(wh[e]), v[2 * e + 1] - bf_hi(wh[e])); }
            cmf[ks] = __builtin_bit_cast(bf16x8, wh); cml[ks] = __builtin_bit_cast(bf16x8, wl);
        }
        const f32x4 d4 = *(const f32x4*)(P.s5_d + 16 * g + 4 * kq), ge = *(const f32x4*)(P.norm_g + DM + 16 * g + 4 * kq);
        float hr = 0.f, hi = 0.f;
        S5In pre = s5_in_load(P, s5_row0(base, wave), g, lane);
        f32x2 cpre; { const int bc = base & 31, ch = (bc & 15) * 8 + wave; cpre = *((const f32x2*)P.E + ((size_t)((bc >> 4) * 128 + ch) * 64 + g) * 64 + lane); }
#pragma unroll 1
        for (int step = 0; step < 16; ++step) {
            const int L = base + (step >> 1), sub = step & 1, rowb = s5_row0(L, wave) + 32 * sub;
            const S5In cur = pre;
            if (sub == 0) { hr = cpre.x; hi = cpre.y; }
            if (step < 15) pre = s5_in_load(P, s5_row0(base + ((step + 1) >> 1), wave) + 32 * ((step + 1) & 1), g, lane);
            if (sub == 1 && step < 15) { const int bc = (L + 1) & 31, ch = (bc & 15) * 8 + wave; cpre = *((const f32x2*)P.E + ((size_t)((bc >> 4) * 128 + ch) * 64 + g) * 64 + lane); }
            const bf16x8 a = s5_in_frag(cur, ga, gb);
            f32x16 X[4];
#pragma unroll
            for (int j = 0; j < 4; ++j) {
#pragma unroll
                for (int r = 0; r < 16; ++r) X[j][r] = 0.f;
                X[j] = __builtin_amdgcn_mfma_f32_32x32x16_bf16(a, bf[j], X[j], 0, 0, 0);
            }
            s5_scan32<true>(X, h, lane, cf.ar, cf.ai, hr, hi, hs);
            WAVE_LDS_SYNC();
#pragma unroll
            for (int tt = 0; tt < 2; ++tt) {
                f32x4 acc = {0.f, 0.f, 0.f, 0.f};
#pragma unroll
                for (int ks = 0; ks < 4; ++ks) {
                    const LAS unsigned char* ha = hs + (tt * 16 + c16) * 272 + ks * 64 + kq * 16;
                    const bf16x8 hbh = *(const LAS bf16x8*)ha, hbl = *(const LAS bf16x8*)(ha + 69632);
                    acc = __builtin_amdgcn_mfma_f32_16x16x32_bf16(cml[ks], hbh, acc, 0, 0, 0);
                    acc = __builtin_amdgcn_mfma_f32_16x16x32_bf16(cmf[ks], hbl, acc, 0, 0, 0);
                    acc = __builtin_amdgcn_mfma_f32_16x16x32_bf16(cmf[ks], hbh, acc, 0, 0, 0);
                }
                const int row = rowb + 16 * tt + c16;
                const float rs = rsqrtf(P.rowss[T_TOK + row] * (1.f / DM) + RMS_EPS);
                const f32x4 u4 = *(const f32x4*)(P.xres + (size_t)row * DM + 16 * g + 4 * kq) * rs * ge;
                f32x4 y;
#pragma unroll
                for (int j = 0; j < 4; ++j) y[j] = gelu_tanh(acc[j] + d4[j] * u4[j]);
                store_bf4(P.yb + (size_t)row * DM + 16 * g + 4 * kq, y);
            }
            WAVE_LDS_SYNC();
        }
    }
}

DI void phase_kmean(const Params& P, LAS unsigned char* lds) {
    if (blockIdx.x < 128) {
        const int j = blockIdx.x, d = threadIdx.x & 127, part = threadIdx.x >> 7;
        const bf16_t* kb = P.kbuf + ((size_t)(j >> 5) * SEQ + (j & 31) * 256 + part * 64) * 128 + d;
        float s = 0.f;
#pragma unroll 1
        for (int k0 = 0; k0 < 64; k0 += 16) {
            unsigned short v[16];
#pragma unroll
            for (int u = 0; u < 16; ++u) v[u] = kb[(size_t)(k0 + u) * 128];
#pragma unroll
            for (int u = 0; u < 16; ++u) s += __uint_as_float(((unsigned)v[u]) << 16);
        }
        LAS float* red = (LAS float*)lds;
        red[threadIdx.x] = s;
        __syncthreads();
        if (threadIdx.x < 128) P.kmean[j * 128 + d] = (red[d] + red[128 + d] + red[256 + d] + red[384 + d]) * (1.f / 256.f);
    }
}

DI int list_off(int c, int n) { return c * (496 * 1024) + 1024 * (31 * n - (n * (n - 1)) / 2); }

DI void phase_gate(const Params& P, LAS unsigned char* lds) {
    const int tid = threadIdx.x, wave = tid >> 6, lane = tid & 63;
    LAS float* km = (LAS float*)lds;
    LAS int* cnt = (LAS int*)(lds + 32768);
    LAS int* base = cnt + 64;
    for (int qb = blockIdx.x; qb < 256; qb += gridDim.x) {
        const int b = qb >> 7, i = qb & 127, own = i >> 2;
        for (int e = tid; e < 2048; e += 512) ((LAS f32x4*)km)[e] = ((const f32x4*)(P.kmean + b * 8192))[e];
        if (tid < 64) cnt[tid] = 0;
        __syncthreads();
        const int hq = wave, hk = hq >> 2, t = b * SEQ + i * 64 + lane;
        float g[32];
#pragma unroll
        for (int n = 0; n < 32; ++n) g[n] = 0.f;
        const u32x4* qr = (const u32x4*)(P.qbuf + (size_t)t * DM + hq * 128);
#pragma unroll
        for (int nc = 0; nc < 4; ++nc) {
            u32x4 wa = qr[0], wb = qr[1];
#pragma unroll 1
            for (int c = 0; c < 16; ++c) {
                const u32x4 w = wa; wa = wb; wb = qr[(c + 2) & 15];
                const float q0 = bf_lo(w.x), q1 = bf_hi(w.x), q2 = bf_lo(w.y), q3 = bf_hi(w.y), q4 = bf_lo(w.z), q5 = bf_hi(w.z), q6 = bf_lo(w.w), q7 = bf_hi(w.w);
#pragma unroll
                for (int n8 = 0; n8 < 8; ++n8) {
                    const int n = nc * 8 + n8;
                    const LAS f32x4* kp = (const LAS f32x4*)(km + (hk * 32 + n) * 128 + 8 * c);
                    const f32x4 ka = kp[0], kb = kp[1];
                    g[n] += q0 * ka.x + q1 * ka.y + q2 * ka.z + q3 * ka.w + q4 * kb.x + q5 * kb.y + q6 * kb.z + q7 * kb.w;
                }
            }
        }
        const int nsel = own < 3 ? own : 3;
        int s0 = -1, s1 = -1, s2 = -1;
        { float best = -3e38f;
#pragma unroll
          for (int n = 0; n < 32; ++n) if (n < own && g[n] > best) { best = g[n]; s0 = n; } }
        { float best = -3e38f;
#pragma unroll
          for (int n = 0; n < 32; ++n) if (n < own && n != s0 && g[n] > best) { best = g[n]; s1 = n; } }
        { float best = -3e38f;
#pragma unroll
          for (int n = 0; n < 32; ++n) if (n < own && n != s0 && n != s1 && g[n] > best) { best = g[n]; s2 = n; } }
        int l0 = 0, l1 = 0, l2 = 0;
        if (nsel > 0) l0 = atomicAdd((int*)&cnt[hk * 32 + s0], 1);
        if (nsel > 1) l1 = atomicAdd((int*)&cnt[hk * 32 + s1], 1);
        if (nsel > 2) l2 = atomicAdd((int*)&cnt[hk * 32 + s2], 1);
        __syncthreads();
        if (tid < 64) { const int c = cnt[tid]; base[tid] = c > 0 ? atomicAdd(P.gcount + b * 64 + tid, c) : 0; }
        __syncthreads();
        const int row = t * 8 + hq, c2 = b * 2 + hk;
        if (nsel > 0) P.lists[list_off(c2, s0) + base[hk * 32 + s0] + l0] = row * 4 + 1;
        if (nsel > 1) P.lists[list_off(c2, s1) + base[hk * 32 + s1] + l1] = row * 4 + 2;
        if (nsel > 2) P.lists[list_off(c2, s2) + base[hk * 32 + s2] + l2] = row * 4 + 3;
        __syncthreads();
    }
}

template <bool OWN>
DI void phase_attn(const Params& P, LAS unsigned char* lds, int bid) {
    const int tid = threadIdx.x, wave = __builtin_amdgcn_readfirstlane(tid >> 6), lane = tid & 63, h = lane >> 5, l32 = lane & 31;
    LAS unsigned char* Ks = lds;
    LAS unsigned char* Vs = lds + 69632;
    LAS int* pref = (LAS int*)(lds + 136192);
    if constexpr (!OWN) {
        LAS int* cntl = pref + 132;
        if (tid < 128) cntl[tid] = (P.gcount[tid] + 255) >> 8;
        __syncthreads();
        if (tid <= 128) { int a = 0; for (int i = 0; i < 128; ++i) a += (i < tid) ? cntl[i] : 0; pref[tid] = a; }
        __syncthreads();
    }
    const int total = OWN ? 512 : pref[128];
    constexpr float LOG2E = 1.4426950408889634f;
    int rnd = 0;
    for (int idx = bid; idx < total; idx += gridDim.x, ++rnd) {
        const int item = (OWN && (rnd & 1)) ? (idx ^ 3) : idx;
        int c, n, i_q = 0, nrows = 256; const int* lst = P.lists; constexpr bool is_own = OWN;
        if (is_own) { c = item >> 7; i_q = item & 127; n = i_q >> 2; }
        else {
            const int s = item; int lo = 0, hi = 128;
            while (hi - lo > 1) { const int mid = (lo + hi) >> 1; if (pref[mid] <= s) lo = mid; else hi = mid; }
            c = lo >> 5; n = lo & 31; const int grp = s - pref[lo]; lst = P.lists + list_off(c, n) + grp * 256; nrows = P.gcount[lo] - grp * 256; if (nrows > 256) nrows = 256;
        }
        const int b = c >> 1, hk = c & 1;
        int ent; bool valid = true; const int rho = wave * 32 + l32;
        if (is_own) { const int hq = hk * 4 + (rho >> 6), t = b * SEQ + i_q * 64 + (rho & 63); ent = (t * 8 + hq) * 4; }
        else { valid = rho < nrows; ent = lst[valid ? rho : 0]; }
        bf16x8 qf[8];
        {
            const bf16_t* kg = P.kbuf + ((size_t)c * SEQ + n * 256) * 128;
            const bf16_t* vg = P.vT + (size_t)c * 128 * SEQ + n * 256;
            const bf16_t* kgl = kg + (size_t)(tid >> 4) * 128 + (tid & 15) * 8;
            LAS unsigned char* kl = Ks + (tid >> 4) * 272 + (tid & 15) * 16;
            const bf16_t* vgl = vg + (size_t)(tid >> 5) * SEQ + (tid & 31) * 8;
            LAS unsigned char* vl = Vs + (tid >> 5) * 520 + (tid & 31) * 16;
            u32x4 kw[8], vw[8];
#pragma unroll
            for (int q = 0; q < 8; ++q) kw[q] = *(const u32x4*)(kgl + q * 4096);
#pragma unroll
            for (int q = 0; q < 8; ++q) vw[q] = *(const u32x4*)(vgl + (size_t)q * 16 * SEQ);
        { const int row = ent >> 2, t = row >> 3, hq = row & 7; const bf16_t* qp = P.qbuf + (size_t)t * DM + hq * 128 + 8 * h;
#pragma unroll
          for (int ks = 0; ks < 8; ++ks) qf[ks] = *(const bf16x8*)(qp + ks * 16); }
#pragma unroll
            for (int q = 0; q < 8; ++q) *(LAS u32x4*)(kl + q * 8704) = kw[q];
#pragma unroll
            for (int q = 0; q < 8; ++q) { LAS u32x2* dst = (LAS u32x2*)(vl + q * 8320); dst[0] = (u32x2){vw[q].x, vw[q].y}; dst[1] = (u32x2){vw[q].z, vw[q].w}; }
        }
        __syncthreads();
        if (wave < 4) __builtin_amdgcn_s_setprio(2);
        if (wave * 32 < nrows) {
            const int nkt = is_own ? (2 * (i_q & 3) + (wave & 1) + 1) : 8;
            const int posb = is_own ? (64 * (i_q & 3) + (rho & 63)) : 100000;
            float m_run = -1e30f, l_run = 0.f;
            f32x16 o[4];
#pragma unroll
            for (int db = 0; db < 4; ++db)
#pragma unroll
                for (int r = 0; r < 16; ++r) o[db][r] = 0.f;
#pragma unroll 1
            for (int hf = 0; hf < 2; ++hf) {
                if (4 * hf >= nkt) break;
                f32x16 s[4];
#pragma unroll
                for (int kq = 0; kq < 4; ++kq) {
                    const int kt = 4 * hf + kq;
                    if (kt < nkt) {
#pragma unroll
                        for (int r = 0; r < 16; ++r) s[kq][r] = 0.f;
#pragma unroll
                        for (int ks = 0; ks < 8; ++ks) {
                            const bf16x8 a = *(const LAS bf16x8*)(Ks + (kt * 32 + l32) * 272 + ks * 32 + 16 * h);
                            s[kq] = __builtin_amdgcn_mfma_f32_32x32x16_bf16(a, qf[ks], s[kq], 0, 0, 0);
                            asm volatile("" :: "v"(a));
                        }
                        if (is_own) {
#pragma unroll
                            for (int r = 0; r < 16; ++r) { const int key = kt * 32 + (r & 3) + 8 * (r >> 2) + 4 * h; if (key > posb) s[kq][r] = -1e30f; }
                        }
                    } else {
#pragma unroll
                        for (int r = 0; r < 16; ++r) s[kq][r] = -1e30f;
                    }
                    __builtin_amdgcn_sched_barrier(0);
                }
                float mx = -1e30f;
#pragma unroll
                for (int kq = 0; kq < 4; ++kq)
#pragma unroll
                    for (int r = 0; r < 16; ++r) mx = fmaxf(mx, s[kq][r]);
                mx = fmaxf(mx, __shfl_xor(mx, 32));
                const float m_new = fmaxf(m_run, mx), mL = m_new * LOG2E;
                const float alpha = __builtin_amdgcn_exp2f((m_run - m_new) * LOG2E);
                float lsum = 0.f;
#pragma unroll
                for (int kq = 0; kq < 4; ++kq)
#pragma unroll
                    for (int r = 0; r < 16; ++r) { const float p = __builtin_amdgcn_exp2f(s[kq][r] * LOG2E - mL); s[kq][r] = p; lsum += p; }
                lsum += __shfl_xor(lsum, 32);
                l_run = l_run * alpha + lsum; m_run = m_new;
                if (hf == 1) {
#pragma unroll
                    for (int db = 0; db < 4; ++db)
#pragma unroll
                        for (int r = 0; r < 16; ++r) o[db][r] *= alpha;
                }
#pragma unroll
                for (int kq = 0; kq < 4; ++kq) {
                    const int kt = 4 * hf + kq;
                    if (kt < nkt) {
#pragma unroll
                        for (int st = 0; st < 2; ++st) {
                            u32x4 pw;
                            pw.x = pk_bf16(s[kq][8 * st + 0], s[kq][8 * st + 1]); pw.y = pk_bf16(s[kq][8 * st + 2], s[kq][8 * st + 3]);
                            pw.z = pk_bf16(s[kq][8 * st + 4], s[kq][8 * st + 5]); pw.w = pk_bf16(s[kq][8 * st + 6], s[kq][8 * st + 7]);
                            const bf16x8 pf = __builtin_bit_cast(bf16x8, pw);
#pragma unroll
                            for (int db = 0; db < 4; ++db) {
                                const LAS unsigned char* va = Vs + (32 * db + l32) * 520 + (kt * 32 + 16 * st + 4 * h) * 2;
                                const u32x2 vlo = *(const LAS u32x2*)va, vhi = *(const LAS u32x2*)(va + 16);
                                const u32x4 vw = {vlo.x, vlo.y, vhi.x, vhi.y};
                                o[db] = __builtin_amdgcn_mfma_f32_32x32x16_bf16(__builtin_bit_cast(bf16x8, vw), pf, o[db], 0, 0, 0);
                            }
                            __builtin_amdgcn_sched_barrier(0);
                        }
                    }
                }
            }
            asm volatile("" : "+v"(ent));
            if constexpr (!OWN) {
                if (valid) {
                    const float inv = 1.f / l_run;
                    const int slot = ent & 3; const int row = ent >> 2;
                    if (h == 0) *(f32x2*)(P.part_ml + (size_t)ent * 2) = (f32x2){m_run, l_run};
                    int h2 = h; asm volatile("" : "+v"(h2));
                    bf16_t* pb = P.part[1];
                    if (slot == 2) pb = P.part[2]; else if (slot == 3) pb = P.part[3];
                    bf16_t* po = pb + ((size_t)row * 128 + 4 * h2);
#pragma unroll
                    for (int db = 0; db < 4; ++db)
#pragma unroll
                        for (int rq = 0; rq < 4; ++rq) {
                            u32x2 w; w.x = pk_bf16(o[db][4 * rq] * inv, o[db][4 * rq + 1] * inv); w.y = pk_bf16(o[db][4 * rq + 2] * inv, o[db][4 * rq + 3] * inv);
                            *(u32x2*)(po + 32 * db + 8 * rq) = w;
                        }
                }
            } else {
                const int row = ent >> 2, nsel = n < 3 ? n : 3;
                int h2 = h; asm volatile("" : "+v"(h2));
                float M = m_run; f32x2 ml[3];
#pragma unroll
                for (int s2 = 0; s2 < 3; ++s2) { ml[s2] = (f32x2){-1e30f, 0.f}; if (s2 < nsel) { ml[s2] = *(const f32x2*)(P.part_ml + ((size_t)row * 4 + s2 + 1) * 2); M = fmaxf(M, ml[s2].x); } }
                const float w0 = __builtin_amdgcn_exp2f((m_run - M) * LOG2E);
                float ws[3], L = l_run * w0;
#pragma unroll
                for (int s2 = 0; s2 < 3; ++s2) { ws[s2] = ml[s2].y * __builtin_amdgcn_exp2f((ml[s2].x - M) * LOG2E); L += ws[s2]; }
                const float inv = 1.f / L, w0i = w0 * inv;
                const size_t poff = (size_t)row * 128 + 4 * h2;
                bf16_t* ao = P.attn + (size_t)(row >> 3) * DM + (row & 7) * 128 + 4 * h2;
#pragma unroll
                for (int db = 0; db < 4; ++db) {
                    u32x2 pv[3][4];
#pragma unroll
                    for (int s2 = 0; s2 < 3; ++s2)
#pragma unroll
                        for (int rq = 0; rq < 4; ++rq) { pv[s2][rq] = (u32x2){0u, 0u}; if (s2 < nsel) pv[s2][rq] = *(const u32x2*)(P.part[s2 + 1] + poff + 32 * db + 8 * rq); }
#pragma unroll
                    for (int rq = 0; rq < 4; ++rq) {
                        float a0 = o[db][4 * rq] * w0i, a1 = o[db][4 * rq + 1] * w0i, a2 = o[db][4 * rq + 2] * w0i, a3 = o[db][4 * rq + 3] * w0i;
#pragma unroll
                        for (int s2 = 0; s2 < 3; ++s2) { const float wv = ws[s2] * inv; a0 += wv * bf_lo(pv[s2][rq].x); a1 += wv * bf_hi(pv[s2][rq].x); a2 += wv * bf_lo(pv[s2][rq].y); a3 += wv * bf_hi(pv[s2][rq].y); }
                        u32x2 w; w.x = pk_bf16(a0, a1); w.y = pk_bf16(a2, a3);
                        *(u32x2*)(ao + 32 * db + 8 * rq) = w;
                    }
                }
            }
        }
        __builtin_amdgcn_s_setprio(0);
        __syncthreads();
    }
}

DI void phase_combine(const Params& P) {
    const int tid = threadIdx.x, wave = tid >> 6, lane = tid & 63;
    const int gw = blockIdx.x * 8 + wave, NGW = gridDim.x * 8;
    for (int row = gw; row < T_TOK * 8; row += NGW) {
        const int t = row >> 3, hq = row & 7, own = (t & (SEQ - 1)) >> 8, nsel = own < 3 ? own : 3;
        float m[4], l[4];
#pragma unroll
        for (int s = 0; s < 4; ++s) { if (s <= nsel) { const f32x2 ml = *(const f32x2*)(P.part_ml + ((size_t)row * 4 + s) * 2); m[s] = ml.x; l[s] = ml.y; } else { m[s] = -1e30f; l[s] = 0.f; } }
        const float M = fmaxf(fmaxf(m[0], m[1]), fmaxf(m[2], m[3]));
        float o0 = 0.f, o1 = 0.f, L = 0.f;
#pragma unroll
        for (int s = 0; s < 4; ++s) {
            if (s <= nsel) {
                const float w = l[s] * __expf(m[s] - M); L += w;
                const unsigned v = *(const unsigned*)(P.part[s] + (size_t)row * 128 + 2 * lane);
                o0 += w * bf_lo(v); o1 += w * bf_hi(v);
            }
        }
        const float inv = 1.f / L;
        *(unsigned*)(P.attn + (size_t)t * DM + hq * 128 + 2 * lane) = cvt_pk_bf16(o0 * inv, o1 * inv);
    }
}

DI void phase_final(const Params& P) {
    const int tid = threadIdx.x, wave = tid >> 6, lane = tid & 63;
    const int gw = blockIdx.x * 8 + wave, NGW = gridDim.x * 8;
    for (int row = gw; row < T_TOK; row += NGW) {
        const float rs = rsqrtf(P.rowss[6 * T_TOK + row] * (1.f / DM) + RMS_EPS);
        const f32x4* xr = (const f32x4*)(P.xres + (size_t)row * DM) + lane;
        const f32x4* gr = (const f32x4*)P.final_g + lane;
        f32x4* o = (f32x4*)(P.out + (size_t)row * DM) + lane;
#pragma unroll
        for (int j = 0; j < 4; ++j) o[64 * j] = xr[64 * j] * rs * gr[64 * j];
    }
}

DI void phase_final_fused(const Params& P, LAS unsigned char* lds, int vbid) {
    pg8::StaticOrder S; S.init(T_TOK, DM, gridDim.x, vbid);
    pg8::Unit u;
    if (!S.next(0, u)) return;
    const int tid = threadIdx.x, wave = tid >> 6, lane = tid & 63;
    asm volatile("s_waitcnt vmcnt(0)" ::: "memory");
    __syncthreads();
    LAS int* flag = (LAS int*)lds;
    if (tid == 0) flag[0] = atomicAdd(P.pcnt + u.pm, 1);
    __syncthreads();
    if (flag[0] != 3) return;
    __builtin_amdgcn_fence(__ATOMIC_ACQUIRE, "agent");
    asm volatile("s_waitcnt vmcnt(0)" ::: "memory");
    const f32x4* gr = (const f32x4*)P.final_g + lane;
    const f32x4 g0 = gr[0], g1 = gr[64], g2 = gr[128], g3 = gr[192];
#pragma unroll 1
    for (int r0 = wave * 32; r0 < wave * 32 + 32; r0 += 4) {
        f32x4 v[4][4]; float ss[4];
#pragma unroll
        for (int i = 0; i < 4; ++i) {
            const int row = u.pm * 256 + r0 + i;
            const f32x4* xr = (const f32x4*)(P.xres + (size_t)row * DM) + lane;
            ss[i] = P.rowss[6 * T_TOK + row];
            v[i][0] = xr[0]; v[i][1] = xr[64]; v[i][2] = xr[128]; v[i][3] = xr[192];
        }
#pragma unroll
        for (int i = 0; i < 4; ++i) {
            const int row = u.pm * 256 + r0 + i;
            const float rs = rsqrtf(ss[i] * (1.f / DM) + RMS_EPS);
            f32x4* o = (f32x4*)(P.out + (size_t)row * DM) + lane;
            o[0] = v[i][0] * rs * g0; o[64] = v[i][1] * rs * g1; o[128] = v[i][2] * rs * g2; o[192] = v[i][3] * rs * g3;
        }
    }
}

#define XB_TMO      128
#define XB_XCNT(j)  (256  + 64 * (j))
#define XB_XSUB(j)  (1280 + 64 * (j))
#define XB_XGEN(j)  (2304 + 64 * (j))
#define XB_TOP      3328
#define XB_TOPGEN   3392
#define XCD_BAR_WORDS 3456
#define XB_SPIN_CAP (1u << 18)
DI unsigned xb_ld(unsigned* p)              { return __hip_atomic_load(p, __ATOMIC_RELAXED, __HIP_MEMORY_SCOPE_AGENT); }
DI unsigned xb_add(unsigned* p, unsigned v) { return __hip_atomic_fetch_add(p, v, __ATOMIC_RELAXED, __HIP_MEMORY_SCOPE_AGENT); }
DI unsigned xb_xcc_id() { return (unsigned)__builtin_amdgcn_s_getreg((3 << 11) | 20) & 0xFu; }
#define XB_SPIN(cond, bar) do { unsigned _sp = 0; while (cond) { __builtin_amdgcn_s_sleep(1); \
    if ((++_sp & 255u) == 0u) { if (xb_ld(&(bar)[XB_TMO])) break; if (_sp > XB_SPIN_CAP) { atomicAdd(&(bar)[XB_TMO], 1u); break; } } } } while (0)
struct XcdBarrier { unsigned* bar; unsigned x; volatile LAS unsigned* st; };
DI XcdBarrier xcd_barrier_post(unsigned* bar, volatile LAS unsigned* st) {
    XcdBarrier b; b.bar = bar; b.x = xb_xcc_id(); b.st = st;
    if (threadIdx.x == 0) (void)xb_add(&bar[XB_XCNT(b.x)], 1u);
    return b;
}
DI void xcd_barrier_complete(unsigned* bar, unsigned x, unsigned& nloc, unsigned& nx) {
    const unsigned G = gridDim.x * gridDim.y * gridDim.z;
    unsigned sum, cnt, mine, sp = 0u;
    for (;;) {
        sum = 0u; cnt = 0u; mine = 0u;
#pragma unroll
        for (unsigned j = 0; j < 16; ++j) { const unsigned c = xb_ld(&bar[XB_XCNT(j)]); sum += c; cnt += (c > 0u) ? 1u : 0u; mine = (j == x) ? c : mine; }
        if (sum == G) break;
        __builtin_amdgcn_s_sleep(1);
        if ((++sp & 255u) == 0u) { if (xb_ld(&bar[XB_TMO])) break; if (sp > XB_SPIN_CAP) { atomicAdd(&bar[XB_TMO], 1u); break; } }
    }
    nloc = mine > 0u ? mine : 1u; nx = cnt > 0u ? cnt : 1u;
}
DI void xcd_barrier(const XcdBarrier& b) {
    asm volatile("s_waitcnt vmcnt(0)" ::: "memory");
    __syncthreads();
    if (threadIdx.x == 0) {
        unsigned* bar = b.bar;
        __builtin_amdgcn_s_waitcnt(0);
        unsigned nloc = b.st[0], nx = b.st[1];
        if (nloc == 0u) { xcd_barrier_complete(bar, b.x, nloc, nx); b.st[0] = nloc; b.st[1] = nx; }
        const unsigned old = xb_add(&bar[XB_XSUB(b.x)], 1u);
        const unsigned gen = old / nloc;
        if (old + 1u == (gen + 1u) * nloc) {
            __builtin_amdgcn_fence(__ATOMIC_RELEASE, "agent");
            asm volatile("s_waitcnt vmcnt(0)" ::: "memory");
            const unsigned og = xb_add(&bar[XB_TOP], 1u);
            const unsigned tg = og / nx;
            if (og + 1u == (tg + 1u) * nx) xb_add(&bar[XB_TOPGEN], 1u);
            else XB_SPIN(xb_ld(&bar[XB_TOPGEN]) == tg, bar);
            __builtin_amdgcn_fence(__ATOMIC_ACQUIRE, "agent");
            xb_add(&bar[XB_XGEN(b.x)], 1u);
            asm volatile("s_waitcnt vmcnt(0)" ::: "memory");
        } else {
            XB_SPIN(xb_ld(&bar[XB_XGEN(b.x)]) == gen, bar);
            __builtin_amdgcn_fence(__ATOMIC_ACQUIRE, "agent");
            asm volatile("s_waitcnt vmcnt(0)" ::: "memory");
        }
    }
    __syncthreads();
}

constexpr int NPHASES = 18;
#ifndef PHMASK
#define PHMASK 0xFFFFF
#endif
#define PHON(n) if constexpr (((PHMASK) >> (n)) & 1)
#ifndef DUPSEL
#define DUPSEL 0
#endif
__global__ void __launch_bounds__(512, 2) mega_fwd(const Params P) {
    extern __shared__ __attribute__((aligned(16))) unsigned char smem[];
    LAS unsigned char* lds = (LAS unsigned char*)smem;
    cg::grid_group grid = cg::this_grid();
    if (P.ph_hi < 0) grid.sync();
    volatile LAS unsigned* xst = (volatile LAS unsigned*)(lds + 139264);
    if (threadIdx.x == 0) { xst[0] = 0u; xst[1] = 0u; xst[2] = 0u; xst[3] = 0u; xst[4] = 0u; }
    __syncthreads();
    XcdBarrier xb; xb.bar = P.bar; xb.x = xb_xcc_id(); xb.st = xst;
    if (threadIdx.x == 0) xst[2] = xb_add(&P.bar[XB_XCNT(xb.x)], 1u);
    PHON(0) if (P.ph_lo <= 0 && 0 < P.ph_hi) { phase_prep(P, lds); }
    if constexpr (DUPSEL == 4) { xcd_barrier(xb); phase_prep(P, lds); }
    if (P.ph_lo < 1 && 1 < P.ph_hi) xcd_barrier(xb);
    if (threadIdx.x == 0) {
        bool ok = (gridDim.x % 8u) == 0u;
        for (unsigned j = 0; j < 16; ++j) { const unsigned c = xb_ld(&P.bar[XB_XCNT(j)]); ok = ok && (c == (j < 8 ? gridDim.x / 8u : 0u)); }
        xst[3] = ok ? (xb.x + 8u * xst[2]) : blockIdx.x; xst[4] = ok ? 1u : 0u;
    }
    __syncthreads();
    const int vbid = (int)xst[3];
    const bool vb_ok = xst[4] != 0u;
    const int abid = vb_ok ? ((vbid & 7) * (int)(gridDim.x >> 3) + (vbid >> 3)) : (int)blockIdx.x;
    preload_rs(lds, vbid, P.rowss + 0 * T_TOK, 5632); run_gemm_v(lds, vbid, P.xb, P.wt_up[0], 5632, DM, EpiAct{P.act, P.rowss + 0 * T_TOK, P.kbuf, P.vT, P.rope, (const LAS float*)(lds + 131072)});
    convert_by_light_blocks(P, lds, vbid, 64 * 22, P.it1, P.it2);
    if constexpr (DUPSEL == 2) { xcd_barrier(xb); preload_rs(lds, vbid, P.rowss + 0 * T_TOK, 5632); run_gemm_v(lds, vbid, P.xb, P.wt_up[0], 5632, DM, EpiAct{P.act, P.rowss + 0 * T_TOK, P.kbuf, P.vT, P.rope, (const LAS float*)(lds + 131072)}); }
    if (P.ph_lo < 2 && 2 < P.ph_hi) xcd_barrier(xb);
    PHON(2) if (P.ph_lo <= 2 && 2 < P.ph_hi) { run_gemm_v(lds, vbid, P.act, P.wt_dn[0], DM, FF, EpiRes{P.x, P.xres, P.xb, P.rowss + 1 * T_TOK, 0.5f}); }
    if (P.ph_lo < 3 && 3 < P.ph_hi) xcd_barrier(xb);
    PHON(3) if (P.ph_lo <= 3 && 3 < P.ph_hi) { phase_s5a(P, lds); }
    xcd_barrier(xb);
    phase_s5carry(P);
    if (P.ph_lo < 4 && 4 < P.ph_hi) xcd_barrier(xb);
    PHON(4) if (P.ph_lo <= 4 && 4 < P.ph_hi) { phase_s5b(P, lds); }
    if constexpr (DUPSEL == 3) { xcd_barrier(xb); phase_s5a(P, lds); xcd_barrier(xb); phase_s5carry(P); xcd_barrier(xb); phase_s5b(P, lds); }

    if (P.ph_lo < 5 && 5 < P.ph_hi) xcd_barrier(xb);
    PHON(5) if (P.ph_lo <= 5 && 5 < P.ph_hi) { run_gemm_v(lds, vbid, P.yb, P.wt_glu, 2048, DM, EpiGlu{P.xres, P.xb, P.rowss + 2 * T_TOK}); }
    if (P.ph_lo < 6 && 6 < P.ph_hi) xcd_barrier(xb);
    PHON(6) if (P.ph_lo <= 6 && 6 < P.ph_hi) { preload_rs(lds, vbid, P.rowss + 2 * T_TOK, 5632); run_gemm_v(lds, vbid, P.xb, P.wt_up[1], 5632, DM, EpiAct{P.act, P.rowss + 2 * T_TOK, P.kbuf, P.vT, P.rope, (const LAS float*)(lds + 131072)}); convert_by_light_blocks(P, lds, vbid, 64 * 22, P.it2, P.nitems); }
    if (P.ph_lo < 7 && 7 < P.ph_hi) xcd_barrier(xb);
    PHON(7) if (P.ph_lo <= 7 && 7 < P.ph_hi) { run_gemm_v(lds, vbid, P.act, P.wt_dn[1], DM, FF, EpiRes{P.xres, P.xres, P.xb, P.rowss + 3 * T_TOK, 0.5f}); }
    if (P.ph_lo < 8 && 8 < P.ph_hi) xcd_barrier(xb);
    PHON(8) if (P.ph_lo <= 8 && 8 < P.ph_hi) { preload_rs(lds, vbid, P.rowss + 3 * T_TOK, 6144); run_gemm_v(lds, vbid, P.xb, P.wt_up[2], 6144, DM, EpiAct{P.act, P.rowss + 3 * T_TOK, P.kbuf, P.vT, P.rope, (const LAS float*)(lds + 131072)}); }
    if (P.ph_lo < 9 && 9 < P.ph_hi) xcd_barrier(xb);
    PHON(9) if (P.ph_lo <= 9 && 9 < P.ph_hi) { run_gemm_v(lds, vbid, P.act, P.wt_dn[2], DM, FF, EpiRes{P.xres, P.xres, P.xb, P.rowss + 4 * T_TOK, 0.5f}); phase_kmean(P, lds); }
    if (P.ph_lo < 10 && 10 < P.ph_hi) xcd_barrier(xb);
    PHON(10) if (P.ph_lo <= 10 && 10 < P.ph_hi) { run_gemm_v(lds, vbid, P.xb, P.wt_q, DM, DM, EpiQ{P.qbuf, P.rowss + 4 * T_TOK, P.rope}); }
    if (P.ph_lo < 11 && 11 < P.ph_hi) xcd_barrier(xb);
    PHON(11) if (P.ph_lo <= 11 && 11 < P.ph_hi) { phase_gate(P, lds); }
    if (P.ph_lo < 12 && 12 < P.ph_hi) xcd_barrier(xb);
    PHON(12) if (P.ph_lo <= 12 && 12 < P.ph_hi) { phase_attn<false>(P, lds, abid); }
    if constexpr (DUPSEL == 6) { xcd_barrier(xb); phase_attn<false>(P, lds, abid); }
    if (P.ph_lo < 13 && 13 < P.ph_hi) xcd_barrier(xb);
    PHON(13) if (P.ph_lo <= 13 && 13 < P.ph_hi) { phase_attn<true>(P, lds, abid); }
    if constexpr (DUPSEL == 1) { for (int i = 0; i < 8; ++i) xcd_barrier(xb); }
    if (P.ph_lo < 14 && 14 < P.ph_hi) xcd_barrier(xb);
    PHON(14) if (P.ph_lo <= 14 && 14 < P.ph_hi) { run_gemm_v(lds, vbid, P.attn, P.wt_o, DM, DM, EpiRes{P.xres, P.xres, P.xb, P.rowss + 5 * T_TOK, 1.0f}); }
    if (P.ph_lo < 15 && 15 < P.ph_hi) xcd_barrier(xb);
    PHON(15) if (P.ph_lo <= 15 && 15 < P.ph_hi) { preload_rs(lds, vbid, P.rowss + 5 * T_TOK, 5632); run_gemm_v(lds, vbid, P.xb, P.wt_up[3], 5632, DM, EpiAct{P.act, P.rowss + 5 * T_TOK, P.kbuf, P.vT, P.rope, (const LAS float*)(lds + 131072)}); }
    if (P.ph_lo < 16 && 16 < P.ph_hi) xcd_barrier(xb);
    PHON(16) if (P.ph_lo <= 16 && 16 < P.ph_hi) { run_gemm_v(lds, vbid, P.act, P.wt_dn[3], DM, FF, EpiRes{P.xres, P.xres, P.xb, P.rowss + 6 * T_TOK, 0.5f}); }
    if (vb_ok && gridDim.x == 256u) { phase_final_fused(P, lds, vbid); }
    else { xcd_barrier(xb); phase_final(P); }
}

extern "C" void kernel_launch(void* const* d_in, const int* in_sizes, int n_in, void* d_out, int out_size, void* d_ws, size_t ws_size, hipStream_t stream) {
    static int grid_blocks = 0;
    if (!grid_blocks) {
        int dev = 0, cus = 0, per_cu = 0;
        hipGetDevice(&dev);
        hipDeviceGetAttribute(&cus, hipDeviceAttributeMultiprocessorCount, dev);
        hipFuncSetAttribute((const void*)mega_fwd, hipFuncAttributeMaxDynamicSharedMemorySize, LDS_BYTES);
        hipOccupancyMaxActiveBlocksPerMultiprocessor(&per_cu, (const void*)mega_fwd, 512, LDS_BYTES);
        if (per_cu < 1) per_cu = 1;
        if (per_cu > 1) per_cu = 1;
        grid_blocks = cus * per_cu;
    }
    Params p{};
    const float** in = (const float**)&p.x;
    for (int i = 0; i < 19; ++i) in[i] = (const float*)d_in[i];
    p.out = (float*)d_out;
    unsigned char* ws = (unsigned char*)d_ws; size_t off = 0;
    auto take = [&](size_t bytes) { unsigned char* r = ws + off; off += (bytes + 255) & ~(size_t)255; return r; };
    p.xres = (float*)take((size_t)T_TOK * DM * 4);
    p.xb = (bf16_t*)take((size_t)T_TOK * DM * 2);
    p.act = (bf16_t*)take((size_t)T_TOK * FF * 2);
    p.qbuf = p.act;
    p.attn = p.act + (size_t)T_TOK * DM;
    p.part_ml = (float*)(p.act + (size_t)2 * T_TOK * DM);
    p.kbuf = (bf16_t*)take((size_t)T_TOK * 256 * 2);
    p.vT = (bf16_t*)take((size_t)T_TOK * 256 * 2);
    p.kmean = (float*)take(128 * 128 * 4);
    p.rowss = (float*)take((size_t)7 * T_TOK * 4 + 1024);
    p.gcount = (int*)(p.rowss + 7 * T_TOK);
    p.E = (float*)take((size_t)2 * 128 * 64 * 64 * 2 * 4);
    p.lists = (int*)p.E;
    p.rope = (float*)take((size_t)SEQ * 16 * 2 * 4);
    p.bar = (unsigned*)take((size_t)XCD_BAR_WORDS * 4);
    p.s5tab = (float*)take(4096 * 4 * 4);
    p.pcnt = (int*)take(256);
    p.wt_up[0] = (bf16_t*)take((size_t)6144 * DM * 2); p.wt_up[1] = (bf16_t*)take((size_t)6144 * DM * 2);
    p.wt_dn[0] = (bf16_t*)take((size_t)DM * FF * 2); p.wt_dn[1] = (bf16_t*)take((size_t)DM * FF * 2);
    p.wt_glu = (bf16_t*)take((size_t)2048 * DM * 2);
    p.wt_up[2] = (bf16_t*)take((size_t)6144 * DM * 2); p.wt_up[3] = (bf16_t*)take((size_t)6144 * DM * 2);
    p.wt_dn[2] = (bf16_t*)take((size_t)DM * FF * 2); p.wt_dn[3] = (bf16_t*)take((size_t)DM * FF * 2);
    p.wt_q = (bf16_t*)take((size_t)DM * DM * 2);
    p.wt_o = (bf16_t*)take((size_t)DM * DM * 2);
    p.part[0] = p.xb;
    p.part[1] = (bf16_t*)take((size_t)T_TOK * DM * 2);
    p.part[2] = (bf16_t*)take((size_t)T_TOK * DM * 2);
    p.part[3] = p.wt_up[0];
    p.yb = p.part[1];
    int nj = 0, items = 0;
    auto job = [&](const float* W, const float* g, bf16_t* dst, int K, int Nsrc, int ndst, int mode) {
        WJob& J = p.jobs[nj++]; J.W = W; J.g = g; J.dst = dst; J.K = K; J.Nsrc = Nsrc; J.ndst = ndst; J.mode = mode; J.item0 = items; J.pad = 0;
        items += (K / 64) * (ndst / 32);
    };
    auto job_up = [&](int l, int f) { job(p.ffn_w_in + (size_t)(l * 2 + f) * DM * 2 * FF, p.norm_g + (size_t)(l * 3 + (f ? 2 : 0)) * DM, p.wt_up[l * 2 + f], DM, 2 * FF, 2 * FF, 1); };
    auto job_dn = [&](int l, int f) { job(p.ffn_w_out + (size_t)(l * 2 + f) * FF * DM, nullptr, p.wt_dn[l * 2 + f], FF, DM, DM, 0); };
    job_up(0, 0);
    p.it1 = items;
    job_dn(0, 0); job(p.w_glu, nullptr, p.wt_glu, DM, 2048, 2048, 1); job_up(0, 1); job_dn(0, 1);
    p.it2 = items;
    job_up(1, 0);
    job(p.w_k, p.kv_norm_g, p.wt_up[2] + (size_t)5632 * DM, DM, 256, 256, 0);
    job(p.w_v, p.kv_norm_g, p.wt_up[2] + (size_t)5888 * DM, DM, 256, 256, 0);
    job_dn(1, 0); job_up(1, 1); job_dn(1, 1);
    job(p.w_q, p.norm_g + (size_t)4 * DM, p.wt_q, DM, DM, DM, 0);
    job(p.w_o, nullptr, p.wt_o, DM, DM, DM, 0);
    p.nitems = items; p.ph_lo = 0; p.ph_hi = NPHASES; p.pad = 0;
    if (off > ws_size) { fprintf(stderr, "workspace too small: need %zu have %zu\n", off, ws_size); return; }
    (void)hipMemsetAsync(p.bar, 0, (size_t)XCD_BAR_WORDS * 4, stream);
    void* args[] = {&p};
    hipError_t e = hipLaunchCooperativeKernel((const void*)mega_fwd, dim3(grid_blocks), dim3(512), args, LDS_BYTES, stream);
    if (e != hipSuccess) fprintf(stderr, "cooperative launch failed: %s (grid %d)\n", hipGetErrorString(e), grid_blocks);
}
```

```cpp
#include <hip/hip_runtime.h>
#include <hip/hip_cooperative_groups.h>
#include <cstdio>
namespace cg = cooperative_groups;

#define LAS __attribute__((address_space(3)))
#define DI __device__ __forceinline__
typedef unsigned short bf16_t;
typedef short bf16x8 __attribute__((ext_vector_type(8)));
typedef float f32x4 __attribute__((ext_vector_type(4)));
typedef float f32x2 __attribute__((ext_vector_type(2)));
typedef unsigned u32x4 __attribute__((ext_vector_type(4)));
typedef unsigned u32x2 __attribute__((ext_vector_type(2)));

constexpr int T_TOK = 16384, DM = 1024, FF = 2816, SEQ = 8192;
constexpr float RMS_EPS = 1e-6f;
constexpr int LDS_BYTES = 139296;
constexpr int NJOBS = 13;

struct WJob { const float* W; const float* g; bf16_t* dst; int K; int Nsrc; int ndst; int mode; int item0; int pad; };

struct Params {
    const float *x, *norm_g, *ffn_w_in, *ffn_w_out, *a_re, *a_im, *log_step, *b_re, *b_im, *c_re, *c_im, *s5_d, *w_glu, *kv_norm_g, *w_k, *w_v, *w_q, *w_o, *final_g;
    float* out;
    float* xres; bf16_t* xb; bf16_t* act; bf16_t* yb; bf16_t* qbuf; bf16_t* attn; bf16_t* kbuf; bf16_t* vbuf;
    float* kmean; float* rowss; float* E; float* rope;
    bf16_t* vT; bf16_t* part[4]; float* part_ml; int* lists; int* gcount; unsigned* bar; float* s5tab; int* pcnt;
    bf16_t* wt_up[4]; bf16_t* wt_dn[4]; bf16_t* wt_glu; bf16_t* wt_q; bf16_t* wt_o;
    WJob jobs[NJOBS];
    int nitems; int ph_lo; int ph_hi; int pad; int it1; int it2;
};

DI unsigned cvt_pk_bf16(float lo, float hi) { unsigned r; asm volatile("v_cvt_pk_bf16_f32 %0, %1, %2" : "=v"(r) : "v"(lo), "v"(hi)); return r; }
DI float bf_lo(unsigned w) { return __uint_as_float(w << 16); }
DI float bf_hi(unsigned w) { return __uint_as_float(w & 0xffff0000u); }
DI float wave_sum(float v) {
#pragma unroll
    for (int o = 1; o < 64; o <<= 1) v += __shfl_xor(v, o);
    return v;
}
DI float wave_max(float v) {
#pragma unroll
    for (int o = 1; o < 64; o <<= 1) v = fmaxf(v, __shfl_xor(v, o));
    return v;
}

namespace pg8 {
constexpr int BM = 256, BK = 64, HALF = 128, HTB = HALF * BK * 2, NXCD = 8, WGM = 8;
DI int lds_byte(int r, int c) { const int st = (r >> 4) * 2 + (c >> 5), rr = r & 15, cc = c & 31, ob = rr * 64 + cc * 2; return st * 1024 + (ob ^ (((ob >> 9) & 1) << 5)); }
DI void stage_rc(int b, int& R, int& C) { const int st = b / 1024, sb = b % 1024, swz = sb ^ (((sb >> 9) & 1) << 5); R = (st >> 1) * 16 + swz / 64; C = (st & 1) * 32 + (swz % 64) / 2; }
struct Unit { int pm, pn; };
struct Gemm { const bf16_t* A; const bf16_t* Bt; int M, N, K; };
struct StaticOrder {
    int nM, nN, nwg, G, c;
    DI void init(int M, int N, int G_, int c_) { nM = M / BM; nN = N / BM; nwg = nM * nN; G = G_; c = c_; }
    DI bool next(int i, Unit& u) const {
        const long L = (long)i * G + c; if (L >= nwg) return false;
        int wgid = (int)L; { const int q = nwg / NXCD, r = nwg % NXCD, xcd = wgid % NXCD, off = wgid / NXCD; wgid = (xcd < r ? xcd * (q + 1) : r * (q + 1) + (xcd - r) * q) + off; }
        const int nig = WGM * nN, gid = wgid / nig, fm = gid * WGM, gsz = (nM - fm) < WGM ? (nM - fm) : WGM;
        u.pm = fm + ((wgid % nig) % gsz); u.pn = (wgid % nig) / gsz; return true;
    }
};

template <class Epi>
DI void gemm_phase(LAS unsigned char* lds, const Gemm g, const StaticOrder& S, const Epi& E) {
    int tid_ = threadIdx.x; asm volatile("" : "+v"(tid_));
    const int tid = tid_, wid = __builtin_amdgcn_readfirstlane(tid >> 6), lane = tid & 63, wr = wid >> 2, wc = wid & 3, fr = lane & 15, fq = lane >> 4;
    const int K = g.K, nt = K / BK;
    unsigned voffA[2], voffB[2];
#pragma unroll
    for (int i = 0; i < 2; ++i) { int R, C; stage_rc(tid * 16 + i * 8192, R, C); voffA[i] = (unsigned)(R * K + C) * 2u; voffB[i] = voffA[i]; }
    const size_t kstep = (size_t)(BK * 2);
    const size_t hstep = (size_t)HALF * K * 2;
    const size_t tstep = 2 * hstep;
    const unsigned ldsw = (unsigned)wid * 1024u;
    const int aoff = lds_byte(wr * 64 + fr, fq * 8), boff = lds_byte(wc * 32 + fr, fq * 8);
#define PG8_SA(b, h) (((b) * 2 + (h)) * HTB)
#define PG8_SB(b, h) ((4 + (b) * 2 + (h)) * HTB)
#define PG8_STAGE(bufoff, gbase, voff) do { _Pragma("unroll") for (int _i = 0; _i < 2; ++_i) \
        __builtin_amdgcn_global_load_lds((const unsigned*)((const char*)(gbase) + (voff)[_i]), (LAS unsigned*)(lds + (bufoff) + ldsw + _i * 8192), 16, 0, 0); } while (0)
#define PG8_LDA(dst, b, h) do { _Pragma("unroll") for (int m = 0; m < 4; ++m) _Pragma("unroll") for (int k = 0; k < 2; ++k) dst[m][k] = *(const LAS bf16x8*)(lds + PG8_SA(b, h) + aoff + m * 2048 + k * 1024); } while (0)
#define PG8_LDB(dst, b, h) do { _Pragma("unroll") for (int n = 0; n < 2; ++n) _Pragma("unroll") for (int k = 0; k < 2; ++k) dst[n][k] = *(const LAS bf16x8*)(lds + PG8_SB(b, h) + boff + n * 2048 + k * 1024); } while (0)
#define PG8_MMA(ai, bj, At, Bt) do { __builtin_amdgcn_s_setprio(1); _Pragma("unroll") for (int m = 0; m < 4; ++m) _Pragma("unroll") for (int n = 0; n < 2; ++n) _Pragma("unroll") for (int k = 0; k < 2; ++k) \
        acc[ai][bj][m][n] = __builtin_amdgcn_mfma_f32_16x16x32_bf16(Bt[n][k], At[m][k], acc[ai][bj][m][n], 0, 0, 0); __builtin_amdgcn_s_setprio(0); } while (0)
#define PG8_WAIT_V(n) asm volatile("s_waitcnt vmcnt(" #n ")" ::: "memory")
#define PG8_WAIT_L(n) asm volatile("s_waitcnt lgkmcnt(" #n ")" ::: "memory")
#define PG8_BAR __builtin_amdgcn_s_barrier()
#define PG8_SCHED __builtin_amdgcn_sched_barrier(0)
    Unit cur, nxt; int ui = 0;
    if (!S.next(0, cur)) return;
    f32x4 acc[2][2][4][2];
#pragma unroll
    for (int a = 0; a < 2; ++a)
#pragma unroll
        for (int b = 0; b < 2; ++b)
#pragma unroll
            for (int m = 0; m < 4; ++m)
#pragma unroll
                for (int n = 0; n < 2; ++n) acc[a][b][m][n] = (f32x4){0.f, 0.f, 0.f, 0.f};
    bf16x8 At[4][2], B0[2][2], B1[2][2];
    const char* cA = (const char*)g.A + (size_t)cur.pm * tstep; const char* cB = (const char*)g.Bt + (size_t)cur.pn * tstep;
    PG8_STAGE(PG8_SB(0, 0), cB, voffB); PG8_STAGE(PG8_SA(0, 0), cA, voffA); PG8_STAGE(PG8_SB(0, 1), cB + hstep, voffB); PG8_STAGE(PG8_SA(0, 1), cA + hstep, voffA);
    if (wr == 1) PG8_BAR;
    PG8_WAIT_V(4); PG8_BAR;
    PG8_STAGE(PG8_SB(1, 0), cB + kstep, voffB); PG8_STAGE(PG8_SA(1, 0), cA + kstep, voffA); PG8_STAGE(PG8_SB(1, 1), cB + hstep + kstep, voffB);
    PG8_WAIT_V(6); PG8_BAR;
    for (;;) {
        const bool has_next = S.next(ui + 1, nxt);
        const char* nA = has_next ? (const char*)g.A + (size_t)nxt.pm * tstep : cA; const char* nB = has_next ? (const char*)g.Bt + (size_t)nxt.pn * tstep : cB;
        for (int t = 0; t < nt; t += 2) {
            const bool last = (t == nt - 2);
            const char* a1 = cA + (size_t)(t + 1) * kstep;
            const char* a2 = last ? nA : cA + (size_t)(t + 2) * kstep; const char* b2 = last ? nB : cB + (size_t)(t + 2) * kstep;
            const char* a3 = a2 + kstep; const char* b3 = b2 + kstep;
            PG8_LDB(B0, 0, 0); PG8_SCHED; PG8_LDA(At, 0, 0); PG8_STAGE(PG8_SA(1, 1), a1 + hstep, voffA);
            PG8_WAIT_L(8); PG8_BAR; PG8_WAIT_L(0); PG8_MMA(0, 0, At, B0); PG8_BAR; PG8_SCHED;
            PG8_LDB(B1, 0, 1); PG8_STAGE(PG8_SB(0, 0), b2, voffB);
            PG8_BAR; PG8_WAIT_L(0); PG8_MMA(0, 1, At, B1); PG8_BAR;
            PG8_LDA(At, 0, 1); PG8_STAGE(PG8_SA(0, 0), a2, voffA);
            PG8_BAR; PG8_WAIT_L(0); PG8_MMA(1, 0, At, B0); PG8_BAR; PG8_SCHED;
            PG8_STAGE(PG8_SB(0, 1), b2 + hstep, voffB);
            PG8_WAIT_V(6); PG8_BAR; PG8_MMA(1, 1, At, B1); PG8_BAR;
            PG8_LDB(B0, 1, 0); PG8_SCHED; PG8_LDA(At, 1, 0); PG8_STAGE(PG8_SA(0, 1), a2 + hstep, voffA);
            PG8_WAIT_L(8); PG8_BAR; PG8_WAIT_L(0); PG8_MMA(0, 0, At, B0); PG8_BAR; PG8_SCHED;
            PG8_LDB(B1, 1, 1); PG8_STAGE(PG8_SB(1, 0), b3, voffB);
            PG8_BAR; PG8_WAIT_L(0); PG8_MMA(0, 1, At, B1); PG8_BAR;
            PG8_LDA(At, 1, 1); PG8_STAGE(PG8_SA(1, 0), a3, voffA);
            PG8_BAR; PG8_WAIT_L(0); PG8_MMA(1, 0, At, B0); PG8_BAR; PG8_SCHED;
            PG8_STAGE(PG8_SB(1, 1), b3 + hstep, voffB);
            PG8_WAIT_V(6); PG8_BAR; PG8_MMA(1, 1, At, B1); PG8_BAR;
        }
        E(acc, cur, wr, wc, fr, fq, ui);
        if (!has_next) break;
#pragma unroll
        for (int a = 0; a < 2; ++a)
#pragma unroll
            for (int b = 0; b < 2; ++b)
#pragma unroll
                for (int m = 0; m < 4; ++m)
#pragma unroll
                    for (int n = 0; n < 2; ++n) acc[a][b][m][n] = (f32x4){0.f, 0.f, 0.f, 0.f};
        cur = nxt; cA = nA; cB = nB; ++ui;
    }
    PG8_WAIT_V(0);
    if (wr == 0) PG8_BAR;
    PG8_BAR;
#undef PG8_SA
#undef PG8_SB
#undef PG8_STAGE
#undef PG8_LDA
#undef PG8_LDB
#undef PG8_MMA
#undef PG8_WAIT_V
#undef PG8_WAIT_L
#undef PG8_BAR
#undef PG8_SCHED
}
}
using pg8::Unit;
typedef f32x4 AccT[2][2][4][2];

DI void store_bf4(bf16_t* p, f32x4 v) { u32x2 o; o.x = cvt_pk_bf16(v.x, v.y); o.y = cvt_pk_bf16(v.z, v.w); *(u32x2*)p = o; }
DI float sigmoidf_(float x) { return __builtin_amdgcn_rcpf(1.f + __builtin_amdgcn_exp2f(-1.4426950408889634f * x)); }

struct EpiAct {
    bf16_t* act; const float* rowss; bf16_t* kbuf; bf16_t* vbuf; const float* rope; const LAS float* rsl;
    DI void operator()(const AccT& acc, const Unit& u, int wr, int wc, int fr, int fq, int ui) const {
        const int row0 = u.pm * 256 + wr * 64 + fr;
        if (u.pn < 22) {
#pragma unroll
            for (int ai = 0; ai < 2; ++ai)
#pragma unroll
                for (int m = 0; m < 4; ++m) {
                    const int row = row0 + ai * 128 + m * 16;
                    const float rs = rsl[ui * 256 + wr * 64 + fr + ai * 128 + m * 16];
#pragma unroll
                    for (int bj = 0; bj < 2; ++bj) {
                        const f32x4 gt = acc[ai][bj][m][0] * rs, up = acc[ai][bj][m][1] * rs;
                        f32x4 a;
#pragma unroll
                        for (int j = 0; j < 4; ++j) a[j] = gt[j] * sigmoidf_(gt[j]) * up[j];
                        const int col = 16 * (8 * u.pn + 4 * bj + wc) + 4 * fq;
                        store_bf4(act + (size_t)row * FF + col, a);
                    }
                }
        } else if (u.pn == 22) {
            const bool do_rope = (wc == 0);
#pragma unroll
            for (int ai = 0; ai < 2; ++ai)
#pragma unroll
                for (int m = 0; m < 4; ++m) {
                    const int row = row0 + ai * 128 + m * 16;
                    const float rs = rsqrtf(rowss[row] * (1.f / DM) + RMS_EPS);
                    const int b = row >> 13, pos = row & (SEQ - 1);
#pragma unroll
                    for (int bj = 0; bj < 2; ++bj) {
                        f32x4 v0 = acc[ai][bj][m][0] * rs, v1 = acc[ai][bj][m][1] * rs;
                        if (do_rope) {
                            const f32x4* rp = (const f32x4*)(rope + ((size_t)pos * 16 + 4 * fq) * 2);
                            const f32x4 cs0 = rp[0], cs1 = rp[1];
                            const float c[4] = {cs0.x, cs0.z, cs1.x, cs1.z}, s[4] = {cs0.y, cs0.w, cs1.y, cs1.w};
#pragma unroll
                            for (int j = 0; j < 4; ++j) { const float x1 = v0[j], x2 = v1[j]; v0[j] = x1 * c[j] - x2 * s[j]; v1[j] = x2 * c[j] + x1 * s[j]; }
                        }
                        bf16_t* d = kbuf + ((size_t)(b * 2 + bj) * SEQ + pos) * 128 + 32 * wc + 4 * fq;
                        store_bf4(d, v0); store_bf4(d + 16, v1);
                    }
                }
        } else {
            const int lane = fr + 16 * fq, qi = lane & 3;
#pragma unroll
            for (int ai = 0; ai < 2; ++ai)
#pragma unroll
                for (int m = 0; m < 4; ++m) {
                    const int row = row0 + ai * 128 + m * 16;
                    const float rs = rsqrtf(rowss[row] * (1.f / DM) + RMS_EPS);
                    const int b = row >> 13, posq = (row & (SEQ - 1)) & ~3;
#pragma unroll
                    for (int bj = 0; bj < 2; ++bj)
#pragma unroll
                        for (int n = 0; n < 2; ++n) {
                            const f32x4 v = acc[ai][bj][m][n] * rs;
                            f32x4 w;
#pragma unroll
                            for (int k = 0; k < 4; ++k) {
                                const int src = (lane & ~3) | k;
                                const float t0 = __shfl(v[0], src), t1 = __shfl(v[1], src), t2 = __shfl(v[2], src), t3 = __shfl(v[3], src);
                                w[k] = qi == 0 ? t0 : (qi == 1 ? t1 : (qi == 2 ? t2 : t3));
                            }
                            const int d = 32 * wc + 16 * n + 4 * fq + qi;
                            store_bf4(vbuf + ((size_t)((b * 2 + bj) * 128 + d)) * SEQ + posq, w);
                        }
                }
        }
    }
};

struct EpiRes {
    const float* xin; float* xout; bf16_t* xb; float* rowss_out; float alpha;
    DI void operator()(const AccT& acc, const Unit& u, int wr, int wc, int fr, int fq, int ui) const {
        const int row0 = u.pm * 256 + wr * 64 + fr;
#pragma unroll
        for (int ai = 0; ai < 2; ++ai)
#pragma unroll
            for (int m = 0; m < 4; ++m) {
                const int row = row0 + ai * 128 + m * 16;
                float ss = 0.f;
#pragma unroll
                for (int bj = 0; bj < 2; ++bj)
#pragma unroll
                    for (int n = 0; n < 2; ++n) {
                        const size_t off = (size_t)row * DM + u.pn * 256 + bj * 128 + wc * 32 + n * 16 + 4 * fq;
                        const f32x4 xo = *(const f32x4*)(xin + off);
                        const f32x4 v = xo + alpha * acc[ai][bj][m][n];
                        *(f32x4*)(xout + off) = v;
                        store_bf4(xb + off, v);
                        ss += v.x * v.x + v.y * v.y + v.z * v.z + v.w * v.w;
                    }
                ss += __shfl_xor(ss, 16); ss += __shfl_xor(ss, 32);
                if (fq == 0) atomicAdd(rowss_out + row, ss);
            }
    }
};

struct EpiGlu {
    float* xres; bf16_t* xb; float* rowss_out;
    DI void operator()(const AccT& acc, const Unit& u, int wr, int wc, int fr, int fq, int ui) const {
        const int row0 = u.pm * 256 + wr * 64 + fr;
#pragma unroll
        for (int ai = 0; ai < 2; ++ai)
#pragma unroll
            for (int m = 0; m < 4; ++m) {
                const int row = row0 + ai * 128 + m * 16;
                float ss = 0.f;
#pragma unroll
                for (int bj = 0; bj < 2; ++bj) {
                    const size_t off = (size_t)row * DM + 16 * (8 * u.pn + 4 * bj + wc) + 4 * fq;
                    const f32x4 val = acc[ai][bj][m][0], gt = acc[ai][bj][m][1];
                    f32x4 v = *(const f32x4*)(xres + off);
#pragma unroll
                    for (int j = 0; j < 4; ++j) v[j] += val[j] * sigmoidf_(gt[j]);
                    *(f32x4*)(xres + off) = v;
                    store_bf4(xb + off, v);
                    ss += v.x * v.x + v.y * v.y + v.z * v.z + v.w * v.w;
                }
                ss += __shfl_xor(ss, 16); ss += __shfl_xor(ss, 32);
                if (fq == 0) atomicAdd(rowss_out + row, ss);
            }
    }
};

struct EpiQ {
    bf16_t* qbuf; const float* rowss; const float* rope;
    DI void operator()(const AccT& acc, const Unit& u, int wr, int wc, int fr, int fq, int ui) const {
        const int row0 = u.pm * 256 + wr * 64 + fr;
#pragma unroll
        for (int ai = 0; ai < 2; ++ai)
#pragma unroll
            for (int m = 0; m < 4; ++m) {
                const int row = row0 + ai * 128 + m * 16;
                const float rs = rsqrtf(rowss[row] * (1.f / DM) + RMS_EPS) * 0.08838834764831845f;
                const int pos = row & (SEQ - 1);
#pragma unroll
                for (int bj = 0; bj < 2; ++bj) {
                    f32x4 v0 = acc[ai][bj][m][0] * rs, v1 = acc[ai][bj][m][1] * rs;
                    if (wc == 0) {
                        const f32x4* rp = (const f32x4*)(rope + ((size_t)pos * 16 + 4 * fq) * 2);
                        const f32x4 cs0 = rp[0], cs1 = rp[1];
                        const float c[4] = {cs0.x, cs0.z, cs1.x, cs1.z}, s[4] = {cs0.y, cs0.w, cs1.y, cs1.w};
#pragma unroll
                        for (int j = 0; j < 4; ++j) { const float x1 = v0[j], x2 = v1[j]; v0[j] = x1 * c[j] - x2 * s[j]; v1[j] = x2 * c[j] + x1 * s[j]; }
                    }
                    bf16_t* d = qbuf + (size_t)row * DM + u.pn * 256 + bj * 128 + 32 * wc + 4 * fq;
                    store_bf4(d, v0); store_bf4(d + 16, v1);
                }
            }
    }
};

DI void preload_rs(LAS unsigned char* lds, int vbid, const float* rowss, int N) {
    pg8::StaticOrder S; S.init(T_TOK, N, gridDim.x, vbid);
    LAS float* rsl = (LAS float*)(lds + 131072);
    pg8::Unit u;
    for (int i = 0; i < 8 && S.next(i, u); ++i)
        if (threadIdx.x < 256) rsl[i * 256 + threadIdx.x] = rsqrtf(rowss[u.pm * 256 + threadIdx.x] * (1.f / DM) + RMS_EPS);
    __syncthreads();
}
template <class Epi>
DI void run_gemm_v(LAS unsigned char* lds, int vbid, const bf16_t* A, const bf16_t* Bt, int N, int K, const Epi& E) {
    pg8::Gemm g{A, Bt, T_TOK, N, K};
    pg8::StaticOrder S; S.init(T_TOK, N, gridDim.x, vbid);
    pg8::gemm_phase<Epi>(lds, g, S, E);
}

struct S5Coef { float ar, ai, cr, ci; };
DI S5Coef s5_coefs_compute(const Params& P, int g, int p) {
    const float dt = expf(P.log_step[g]); const float lr = P.a_re[g * 64 + p], li = P.a_im[g * 64 + p];
    const float mag = expf(lr * dt); S5Coef c; c.ar = mag * cosf(li * dt); c.ai = mag * sinf(li * dt);
    const float nr = c.ar - 1.f, ni = c.ai, den = lr * lr + li * li;
    c.cr = (nr * lr + ni * li) / den; c.ci = (ni * lr - nr * li) / den; return c;
}
DI S5Coef s5_coefs(const Params& P, int g, int p) { const f32x4 v = *(const f32x4*)(P.s5tab + (size_t)(g * 64 + p) * 4); S5Coef c; c.ar = v.x; c.ai = v.y; c.cr = v.z; c.ci = v.w; return c; }

DI void p0_transpose_item(const WJob& J, LAS float* scr, int item, int lane) {
    const int nblk = J.ndst / 32, kb = item / nblk, nb = item % nblk, k0 = 64 * kb, r0 = 32 * nb;
    const int i = lane & 31;
    int scol;
    if (J.mode == 0) scol = r0 + i;
    else { const int G = r0 >> 5; scol = (i < 16) ? (16 * G + i) : ((J.Nsrc >> 1) + 16 * G + (i - 16)); }
    float wv[32];
    const float* wp = J.W + (size_t)(k0 + (lane >> 5)) * J.Nsrc + scol;
#pragma unroll
    for (int it = 0; it < 32; ++it) wv[it] = wp[(size_t)(2 * it) * J.Nsrc];
    if (J.g) {
        const float* gp = J.g + k0 + (lane >> 5);
#pragma unroll
        for (int it = 0; it < 32; ++it) wv[it] *= gp[2 * it];
    }
#pragma unroll
    for (int it = 0; it < 32; ++it) scr[(2 * it + (lane >> 5)) * 33 + i] = wv[it];
    __builtin_amdgcn_fence(__ATOMIC_RELEASE, "wavefront"); __builtin_amdgcn_wave_barrier(); __builtin_amdgcn_fence(__ATOMIC_ACQUIRE, "wavefront");
    const int c = lane & 7;
#pragma unroll
    for (int j = 0; j < 4; ++j) {
        const int n = (lane >> 3) + 8 * j; const LAS float* s = scr + (8 * c) * 33 + n;
        u32x4 o; o.x = cvt_pk_bf16(s[0 * 33], s[1 * 33]); o.y = cvt_pk_bf16(s[2 * 33], s[3 * 33]); o.z = cvt_pk_bf16(s[4 * 33], s[5 * 33]); o.w = cvt_pk_bf16(s[6 * 33], s[7 * 33]);
        *(u32x4*)(J.dst + (size_t)(r0 + n) * J.K + k0 + 8 * c) = o;
    }
    __builtin_amdgcn_fence(__ATOMIC_RELEASE, "wavefront"); __builtin_amdgcn_wave_barrier(); __builtin_amdgcn_fence(__ATOMIC_ACQUIRE, "wavefront");
}

DI void convert_items(const Params& P, LAS unsigned char* lds, int lo, int hi, int gw, int NGW) {
    const int wave = threadIdx.x >> 6, lane = threadIdx.x & 63;
    LAS float* scr = (LAS float*)(lds + wave * 16384);
    for (int it = lo + gw; it < hi; it += NGW) {
        int j = 0;
#pragma unroll 1
        for (int q = 1; q < NJOBS; ++q) if (it >= P.jobs[q].item0) j = q;
        p0_transpose_item(P.jobs[j], scr, it - P.jobs[j].item0, lane);
    }
}
DI void convert_by_light_blocks(const Params& P, LAS unsigned char* lds, int vbid, int units, int lo, int hi) {
    asm volatile("" : "+s"(vbid), "+s"(lo), "+s"(hi));
    const int G = gridDim.x, extra = units % G, first = extra, nlight = G - extra;
    if (vbid >= first) convert_items(P, lds, lo, hi, (vbid - first) * 8 + (threadIdx.x >> 6), nlight * 8);
}

DI void phase_prep(const Params& P, LAS unsigned char* lds) {
    const int tid = threadIdx.x, wave = tid >> 6, lane = tid & 63;
    const int gw = blockIdx.x * 8 + wave, NGW = gridDim.x * 8;
    LAS float* scr = (LAS float*)(lds + wave * 16384);
    convert_items(P, lds, 0, P.it1, gw, NGW);
    for (int row = gw; row < T_TOK; row += NGW) {
        const f32x4* xr = (const f32x4*)(P.x + (size_t)row * DM) + lane;
        f32x4 v[4]; float s = 0.f;
#pragma unroll
        for (int j = 0; j < 4; ++j) { v[j] = xr[64 * j]; s += v[j].x * v[j].x + v[j].y * v[j].y + v[j].z * v[j].z + v[j].w * v[j].w; }
        s = wave_sum(s);
        if (lane == 0) P.rowss[row] = s;
        bf16_t* o = P.xb + (size_t)row * DM + 4 * lane;
#pragma unroll
        for (int j = 0; j < 4; ++j) store_bf4(o + 256 * j, v[j]);
    }
    const int gt = blockIdx.x * 512 + tid, NGT = gridDim.x * 512;
    for (int i = gt; i < 6 * T_TOK; i += NGT) P.rowss[T_TOK + i] = 0.f;
    if (gt < 128) P.gcount[gt] = 0;
    if (gt < 64) P.pcnt[gt] = 0;
    for (int i = gt; i < 4096; i += NGT) { const S5Coef c = s5_coefs_compute(P, i >> 6, i & 63); *(f32x4*)(P.s5tab + (size_t)i * 4) = (f32x4){c.ar, c.ai, c.cr, c.ci}; }
    for (int i = gt; i < SEQ * 16; i += NGT) {
        const int pos = i >> 4, d = i & 15;
        const float inv = exp2f(-(float)d * (18.931568569324174f / 16.f));
        const float ang = (float)pos * inv;
        P.rope[2 * i] = cosf(ang); P.rope[2 * i + 1] = sinf(ang);
    }
}

DI float gelu_tanh(float x) { const float u = 0.7978845608028654f * (x + 0.044715f * x * x * x); return x * __builtin_amdgcn_rcpf(1.f + __builtin_amdgcn_exp2f(-2.f * 1.4426950408889634f * u)); }

typedef float f32x16 __attribute__((ext_vector_type(16)));
typedef __bf16 bf2_t __attribute__((ext_vector_type(2)));
DI unsigned pk_bf16(float lo, float hi) { const f32x2 v = {lo, hi}; return __builtin_bit_cast(unsigned, __builtin_convertvector(v, bf2_t)); }
#define WAVE_LDS_SYNC() asm volatile("s_waitcnt lgkmcnt(0)" ::: "memory")

DI void s5_bfrags(const Params& P, int g, int lane, bf16x8 (&bf)[4]) {
    const int q = lane & 31, h = lane >> 5;
#pragma unroll
    for (int pj = 0; pj < 2; ++pj) {
        const int p = q + 32 * pj;
        const S5Coef c = s5_coefs(P, g, p);
        const f32x4* br = (const f32x4*)(P.b_re + ((size_t)g * 64 + p) * 16 + 8 * h);
        const f32x4* bi = (const f32x4*)(P.b_im + ((size_t)g * 64 + p) * 16 + 8 * h);
        const f32x4 r0 = br[0], r1 = br[1], i0 = bi[0], i1 = bi[1];
        float re[8], im[8];
#pragma unroll
        for (int j = 0; j < 4; ++j) {
            re[j] = c.cr * r0[j] - c.ci * i0[j]; im[j] = c.cr * i0[j] + c.ci * r0[j];
            re[4 + j] = c.cr * r1[j] - c.ci * i1[j]; im[4 + j] = c.cr * i1[j] + c.ci * r1[j];
        }
        const u32x4 wr = {pk_bf16(re[0], re[1]), pk_bf16(re[2], re[3]), pk_bf16(re[4], re[5]), pk_bf16(re[6], re[7])};
        const u32x4 wi = {pk_bf16(im[0], im[1]), pk_bf16(im[2], im[3]), pk_bf16(im[4], im[5]), pk_bf16(im[6], im[7])};
        bf[2 * pj] = __builtin_bit_cast(bf16x8, wr); bf[2 * pj + 1] = __builtin_bit_cast(bf16x8, wi);
    }
}
DI bf16x8 s5_ufrag(const Params& P, int rowbase, int g, int lane, const f32x4& ga, const f32x4& gb) {
    const int t = lane & 31, h = lane >> 5, row = rowbase + t;
    const float rs = rsqrtf(P.rowss[T_TOK + row] * (1.f / DM) + RMS_EPS);
    const f32x4* xp = (const f32x4*)(P.xres + (size_t)row * DM + 16 * g + 8 * h);
    const f32x4 a = xp[0] * rs * ga, b = xp[1] * rs * gb;
    const u32x4 w = {pk_bf16(a.x, a.y), pk_bf16(a.z, a.w), pk_bf16(b.x, b.y), pk_bf16(b.z, b.w)};
    return __builtin_bit_cast(bf16x8, w);
}
template <bool WRITE>
DI void s5_scan32(const f32x16 (&X)[4], int h, int p, float ar, float ai, float& hr, float& hi, LAS unsigned char* hs) {
    float lo_re[16], lo_im[16], hi_re[16], hi_im[16];
#pragma unroll
    for (int r = 0; r < 16; ++r) {
        const auto sr = __builtin_amdgcn_permlane32_swap(__float_as_uint(X[0][r]), __float_as_uint(X[2][r]), false, false);
        const auto si = __builtin_amdgcn_permlane32_swap(__float_as_uint(X[1][r]), __float_as_uint(X[3][r]), false, false);
        lo_re[r] = __uint_as_float(sr[0]); hi_re[r] = __uint_as_float(sr[1]);
        lo_im[r] = __uint_as_float(si[0]); hi_im[r] = __uint_as_float(si[1]);
    }
#pragma unroll
    for (int i = 0; i < 4; ++i)
#pragma unroll
        for (int half = 0; half < 2; ++half)
#pragma unroll
            for (int j = 0; j < 4; ++j) {
                const int r = 4 * i + j, token = 8 * i + 4 * half + j;
                const float xr = half ? hi_re[r] : lo_re[r], xi = half ? hi_im[r] : lo_im[r];
                const float nhr = ar * hr - ai * hi + xr, nhi = ar * hi + ai * hr + xi; hr = nhr; hi = nhi;
                if (WRITE) {
                    const unsigned whi = pk_bf16(hr, hi);
                    *(LAS unsigned*)(hs + token * 272 + 4 * p) = whi;
                    *(LAS unsigned*)(hs + 69632 + token * 272 + 4 * p) = pk_bf16(hr - bf_lo(whi), hi - bf_hi(whi));
                }
            }
}

struct S5In { f32x4 x0, x1; float ss; };
DI S5In s5_in_load(const Params& P, int rowbase, int g, int lane) {
    const int row = rowbase + (lane & 31);
    const f32x4* xp = (const f32x4*)(P.xres + (size_t)row * DM + 16 * g + 8 * (lane >> 5));
    S5In r; r.x0 = xp[0]; r.x1 = xp[1]; r.ss = P.rowss[T_TOK + row]; return r;
}
DI bf16x8 s5_in_frag(const S5In& in, const f32x4& ga, const f32x4& gb) {
    const float rs = rsqrtf(in.ss * (1.f / DM) + RMS_EPS);
    const f32x4 a = in.x0 * rs * ga, b = in.x1 * rs * gb;
    const u32x4 w = {pk_bf16(a.x, a.y), pk_bf16(a.z, a.w), pk_bf16(b.x, b.y), pk_bf16(b.z, b.w)};
    return __builtin_bit_cast(bf16x8, w);
}
DI int s5_row0(int L, int wave) { const int bc = L & 31; return (bc >> 4) * SEQ + ((bc & 15) * 8 + wave) * 64; }

DI void phase_s5a(const Params& P, LAS unsigned char* lds) {
    const int tid = threadIdx.x, wave = tid >> 6, lane = tid & 63, h = lane >> 5;
    for (int base = blockIdx.x * 8; base < 2048; base += gridDim.x * 8) {
        const int g = base >> 5;
        const S5Coef cf = s5_coefs(P, g, lane);
        bf16x8 bf[4]; s5_bfrags(P, g, lane, bf);
        const f32x4 ga = *(const f32x4*)(P.norm_g + DM + 16 * g + 8 * h), gb = *(const f32x4*)(P.norm_g + DM + 16 * g + 8 * h + 4);
        float hr = 0.f, hi = 0.f;
        S5In pre = s5_in_load(P, s5_row0(base, wave), g, lane);
#pragma unroll 1
        for (int step = 0; step < 16; ++step) {
            const int L = base + (step >> 1), sub = step & 1;
            const S5In cur = pre;
            if (step < 15) pre = s5_in_load(P, s5_row0(base + ((step + 1) >> 1), wave) + 32 * ((step + 1) & 1), g, lane);
            const bf16x8 a = s5_in_frag(cur, ga, gb);
            f32x16 X[4];
#pragma unroll
            for (int j = 0; j < 4; ++j) {
#pragma unroll
                for (int r = 0; r < 16; ++r) X[j][r] = 0.f;
                X[j] = __builtin_amdgcn_mfma_f32_32x32x16_bf16(a, bf[j], X[j], 0, 0, 0);
            }
            if (sub == 0) { hr = 0.f; hi = 0.f; }
            s5_scan32<false>(X, h, lane, cf.ar, cf.ai, hr, hi, lds);
            if (sub == 1) { const int bc = L & 31, ch = (bc & 15) * 8 + wave; *(f32x2*)(P.E + ((size_t)(((bc >> 4) * 128 + ch) * 64 + g) * 64 + lane) * 2) = (f32x2){hr, hi}; }
        }
    }
}

DI void phase_s5carry(const Params& P) {
    if (blockIdx.x < 128 && threadIdx.x < 64) {
        const int idx = blockIdx.x * 64 + threadIdx.x, b = idx >> 12, g = (idx >> 6) & 63, p = idx & 63;
        const S5Coef cf = s5_coefs(P, g, p);
        float alr = cf.ar, ali = cf.ai;
#pragma unroll
        for (int q = 0; q < 6; ++q) { const float r = alr * alr - ali * ali, i2 = 2.f * alr * ali; alr = r; ali = i2; }
        f32x2* Ep = (f32x2*)P.E + (size_t)(b * 128) * 4096 + g * 64 + p;
        float hr = 0.f, hi = 0.f;
#pragma unroll 1
        for (int j0 = 0; j0 < 128; j0 += 32) {
            f32x2 e[32];
#pragma unroll
            for (int u = 0; u < 32; ++u) e[u] = Ep[(size_t)(j0 + u) * 4096];
#pragma unroll
            for (int u = 0; u < 32; ++u) {
                Ep[(size_t)(j0 + u) * 4096] = (f32x2){hr, hi};
                const float nr = alr * hr - ali * hi + e[u].x, ni = alr * hi + ali * hr + e[u].y; hr = nr; hi = ni;
            }
        }
    }
}

DI void phase_s5b(const Params& P, LAS unsigned char* lds) {
    const int tid = threadIdx.x, wave = tid >> 6, lane = tid & 63, h = lane >> 5, c16 = lane & 15, kq = lane >> 4;
    LAS unsigned char* hs = lds + wave * 8704;
    for (int base = blockIdx.x * 8; base < 2048; base += gridDim.x * 8) {
        const int g = base >> 5;
        const S5Coef cf = s5_coefs(P, g, lane);
        bf16x8 bf[4]; s5_bfrags(P, g, lane, bf);
        const f32x4 ga = *(const f32x4*)(P.norm_g + DM + 16 * g + 8 * h), gb = *(const f32x4*)(P.norm_g + DM + 16 * g + 8 * h + 4);
        bf16x8 cmf[4], cml[4];
#pragma unroll
        for (int ks = 0; ks < 4; ++ks) {
            const int p0 = ks * 16 + kq * 4;
            const f32x4 cr = *(const f32x4*)(P.c_re + ((size_t)g * 16 + c16) * 64 + p0), ci = *(const f32x4*)(P.c_im + ((size_t)g * 16 + c16) * 64 + p0);
            const float v[8] = {cr.x, -ci.x, cr.y, -ci.y, cr.z, -ci.z, cr.w, -ci.w};
            u32x4 wh, wl;
#pragma unroll
            for (int e = 0; e < 4; ++e) { wh[e] = pk_bf16(v[2 * e], v[2 * e + 1]); wl[e] = pk_bf16(v[2 * e] - bf_lo(wh[e]), v[2 * e + 1] - bf_hi(wh[e])); }
            cmf[ks] = __builtin_bit_cast(bf16x8, wh); cml[ks] = __builtin_bit_cast(bf16x8, wl);
        }
        const f32x4 d4 = *(const f32x4*)(P.s5_d + 16 * g + 4 * kq), ge = *(const f32x4*)(P.norm_g + DM + 16 * g + 4 * kq);
        float hr = 0.f, hi = 0.f;
        S5In pre = s5_in_load(P, s5_row0(base, wave), g, lane);
        f32x2 cpre; { const int bc = base & 31, ch = (bc & 15) * 8 + wave; cpre = *((const f32x2*)P.E + ((size_t)((bc >> 4) * 128 + ch) * 64 + g) * 64 + lane); }
#pragma unroll 1
        for (int step = 0; step < 16; ++step) {
            const int L = base + (step >> 1), sub = step & 1, rowb = s5_row0(L, wave) + 32 * sub;
            const S5In cur = pre;
            if (sub == 0) { hr = cpre.x; hi = cpre.y; }
            if (step < 15) pre = s5_in_load(P, s5_row0(base + ((step + 1) >> 1), wave) + 32 * ((step + 1) & 1), g, lane);
            if (sub == 1 && step < 15) { const int bc = (L + 1) & 31, ch = (bc & 15) * 8 + wave; cpre = *((const f32x2*)P.E + ((size_t)((bc >> 4) * 128 + ch) * 64 + g) * 64 + lane); }
            const bf16x8 a = s5_in_frag(cur, ga, gb);
            f32x16 X[4];
#pragma unroll
            for (int j = 0; j < 4; ++j) {
#pragma unroll
                for (int r = 0; r < 16; ++r) X[j][r] = 0.f;
                X[j] = __builtin_amdgcn_mfma_f32_32x32x16_bf16(a, bf[j], X[j], 0, 0, 0);
            }
            s5_scan32<true>(X, h, lane, cf.ar, cf.ai, hr, hi, hs);
            WAVE_LDS_SYNC();
#pragma unroll
            for (int tt = 0; tt < 2; ++tt) {
                f32x4 acc = {0.f, 0.f, 0.f, 0.f};
#pragma unroll
                for (int ks = 0; ks < 4; ++ks) {
                    const LAS unsigned char* ha = hs + (tt * 16 + c16) * 272 + ks * 64 + kq * 16;
                    const bf16x8 hbh = *(const LAS bf16x8*)ha, hbl = *(const LAS bf16x8*)(ha + 69632);
                    acc = __builtin_amdgcn_mfma_f32_16x16x32_bf16(cml[ks], hbh, acc, 0, 0, 0);
                    acc = __builtin_amdgcn_mfma_f32_16x16x32_bf16(cmf[ks], hbl, acc, 0, 0, 0);
                    acc = __builtin_amdgcn_mfma_f32_16x16x32_bf16(cmf[ks], hbh, acc, 0, 0, 0);
                }
                const int row = rowb + 16 * tt + c16;
                const float rs = rsqrtf(P.rowss[T_TOK + row] * (1.f / DM) + RMS_EPS);
                const f32x4 u4 = *(const f32x4*)(P.xres + (size_t)row * DM + 16 * g + 4 * kq) * rs * ge;
                f32x4 y;
#pragma unroll
                for (int j = 0; j < 4; ++j) y[j] = gelu_tanh(acc[j] + d4[j] * u4[j]);
                store_bf4(P.yb + (size_t)row * DM + 16 * g + 4 * kq, y);
            }
            WAVE_LDS_SYNC();
        }
    }
}

DI void phase_kmean(const Params& P, LAS unsigned char* lds) {
    if (blockIdx.x < 128) {
        const int j = blockIdx.x, d = threadIdx.x & 127, part = threadIdx.x >> 7;
        const bf16_t* kb = P.kbuf + ((size_t)(j >> 5) * SEQ + (j & 31) * 256 + part * 64) * 128 + d;
        float s = 0.f;
#pragma unroll 1
        for (int k0 = 0; k0 < 64; k0 += 16) {
            unsigned short v[16];
#pragma unroll
            for (int u = 0; u < 16; ++u) v[u] = kb[(size_t)(k0 + u) * 128];
#pragma unroll
            for (int u = 0; u < 16; ++u) s += __uint_as_float(((unsigned)v[u]) << 16);
        }
        LAS float* red = (LAS float*)lds;
        red[threadIdx.x] = s;
        __syncthreads();
        if (threadIdx.x < 128) P.kmean[j * 128 + d] = (red[d] + red[128 + d] + red[256 + d] + red[384 + d]) * (1.f / 256.f);
    }
}

DI int list_off(int c, int n) { return c * (496 * 1024) + 1024 * (31 * n - (n * (n - 1)) / 2); }

DI void phase_gate(const Params& P, LAS unsigned char* lds) {
    const int tid = threadIdx.x, wave = tid >> 6, lane = tid & 63;
    LAS float* km = (LAS float*)lds;
    LAS int* cnt = (LAS int*)(lds + 32768);
    LAS int* base = cnt + 64;
    for (int qb = blockIdx.x; qb < 256; qb += gridDim.x) {
        const int b = qb >> 7, i = qb & 127, own = i >> 2;
        for (int e = tid; e < 2048; e += 512) {
            const f32x4 v = ((const f32x4*)(P.kmean + b * 8192))[e];
            const int hn = e >> 5, d4 = (e & 31) * 4, hk2 = hn >> 5, n = hn & 31;
            LAS float* dst = km + (hk2 * 128 + d4) * 32 + n;
            dst[0] = v.x; dst[32] = v.y; dst[64] = v.z; dst[96] = v.w;
        }
        if (tid < 64) cnt[tid] = 0;
        __syncthreads();
        const int hq = wave, hk = hq >> 2, t = b * SEQ + i * 64 + lane;
        f32x2 g2[16];
#pragma unroll
        for (int n2 = 0; n2 < 16; ++n2) g2[n2] = (f32x2){0.f, 0.f};
        const u32x4* qr = (const u32x4*)(P.qbuf + (size_t)t * DM + hq * 128);
        {
            u32x4 wa = qr[0], wb = qr[1];
#pragma unroll 1
            for (int c = 0; c < 16; ++c) {
                const u32x4 w = wa; wa = wb; wb = qr[(c + 2) & 15];
                const float qv[8] = {bf_lo(w.x), bf_hi(w.x), bf_lo(w.y), bf_hi(w.y), bf_lo(w.z), bf_hi(w.z), bf_lo(w.w), bf_hi(w.w)};
#pragma unroll
                for (int j = 0; j < 8; ++j) {
                    const LAS f32x4* kp = (const LAS f32x4*)(km + (hk * 128 + 8 * c + j) * 32);
#pragma unroll
                    for (int i4 = 0; i4 < 8; ++i4) {
                        const f32x4 k4 = kp[i4];
                        g2[2 * i4] += (f32x2){k4.x, k4.y} * qv[j];
                        g2[2 * i4 + 1] += (f32x2){k4.z, k4.w} * qv[j];
                    }
                }
            }
        }
        float g[32];
#pragma unroll
        for (int n = 0; n < 32; ++n) g[n] = g2[n >> 1][n & 1];
        const int nsel = own < 3 ? own : 3;
        int s0 = -1, s1 = -1, s2 = -1;
        { float best = -3e38f;
#pragma unroll
          for (int n = 0; n < 32; ++n) if (n < own && g[n] > best) { best = g[n]; s0 = n; } }
        { float best = -3e38f;
#pragma unroll
          for (int n = 0; n < 32; ++n) if (n < own && n != s0 && g[n] > best) { best = g[n]; s1 = n; } }
        { float best = -3e38f;
#pragma unroll
          for (int n = 0; n < 32; ++n) if (n < own && n != s0 && n != s1 && g[n] > best) { best = g[n]; s2 = n; } }
        int l0 = 0, l1 = 0, l2 = 0;
        if (nsel > 0) l0 = atomicAdd((int*)&cnt[hk * 32 + s0], 1);
        if (nsel > 1) l1 = atomicAdd((int*)&cnt[hk * 32 + s1], 1);
        if (nsel > 2) l2 = atomicAdd((int*)&cnt[hk * 32 + s2], 1);
        __syncthreads();
        if (tid < 64) { const int c = cnt[tid]; base[tid] = c > 0 ? atomicAdd(P.gcount + b * 64 + tid, c) : 0; }
        __syncthreads();
        const int row = t * 8 + hq, c2 = b * 2 + hk;
        if (nsel > 0) P.lists[list_off(c2, s0) + base[hk * 32 + s0] + l0] = row * 4 + 1;
        if (nsel > 1) P.lists[list_off(c2, s1) + base[hk * 32 + s1] + l1] = row * 4 + 2;
        if (nsel > 2) P.lists[list_off(c2, s2) + base[hk * 32 + s2] + l2] = row * 4 + 3;
        __syncthreads();
    }
}

template <bool OWN>
DI void phase_attn(const Params& P, LAS unsigned char* lds, int bid) {
    const int tid = threadIdx.x, wave = __builtin_amdgcn_readfirstlane(tid >> 6), lane = tid & 63, h = lane >> 5, l32 = lane & 31;
    LAS unsigned char* Ks = lds;
    LAS unsigned char* Vs = lds + 69632;
    LAS int* pref = (LAS int*)(lds + 136192);
    if constexpr (!OWN) {
        LAS int* cntl = pref + 132;
        if (tid < 128) cntl[tid] = (P.gcount[tid] + 255) >> 8;
        __syncthreads();
        if (tid <= 128) { int a = 0; for (int i = 0; i < 128; ++i) a += (i < tid) ? cntl[i] : 0; pref[tid] = a; }
        __syncthreads();
    }
    const int total = OWN ? 512 : pref[128];
    constexpr float LOG2E = 1.4426950408889634f;
    int rnd = 0;
    for (int idx = bid; idx < total; idx += gridDim.x, ++rnd) {
        const int item = (OWN && (rnd & 1)) ? (idx ^ 3) : idx;
        int c, n, i_q = 0, nrows = 256; const int* lst = P.lists; constexpr bool is_own = OWN;
        if (is_own) { c = item >> 7; i_q = item & 127; n = i_q >> 2; }
        else {
            const int s = item; int lo = 0, hi = 128;
            while (hi - lo > 1) { const int mid = (lo + hi) >> 1; if (pref[mid] <= s) lo = mid; else hi = mid; }
            c = lo >> 5; n = lo & 31; const int grp = s - pref[lo]; lst = P.lists + list_off(c, n) + grp * 256; nrows = P.gcount[lo] - grp * 256; if (nrows > 256) nrows = 256;
        }
        const int b = c >> 1, hk = c & 1;
        int ent; bool valid = true; const int rho = wave * 32 + l32;
        if (is_own) { const int hq = hk * 4 + (rho >> 6), t = b * SEQ + i_q * 64 + (rho & 63); ent = (t * 8 + hq) * 4; }
        else { valid = rho < nrows; ent = lst[valid ? rho : 0]; }
        bf16x8 qf[8];
        {
            const bf16_t* kg = P.kbuf + ((size_t)c * SEQ + n * 256) * 128;
            const bf16_t* vg = P.vT + (size_t)c * 128 * SEQ + n * 256;
            const bf16_t* kgl = kg + (size_t)(tid >> 4) * 128 + (tid & 15) * 8;
            LAS unsigned char* kl = Ks + (tid >> 4) * 272 + (tid & 15) * 16;
            const bf16_t* vgl = vg + (size_t)(tid >> 5) * SEQ + (tid & 31) * 8;
            LAS unsigned char* vl = Vs + (tid >> 5) * 520 + (tid & 31) * 16;
            u32x4 kw[8], vw[8];
#pragma unroll
            for (int q = 0; q < 8; ++q) kw[q] = *(const u32x4*)(kgl + q * 4096);
#pragma unroll
            for (int q = 0; q < 8; ++q) vw[q] = *(const u32x4*)(vgl + (size_t)q * 16 * SEQ);
        { const int row = ent >> 2, t = row >> 3, hq = row & 7; const bf16_t* qp = P.qbuf + (size_t)t * DM + hq * 128 + 8 * h;
#pragma unroll
          for (int ks = 0; ks < 8; ++ks) qf[ks] = *(const bf16x8*)(qp + ks * 16); }
#pragma unroll
            for (int q = 0; q < 8; ++q) *(LAS u32x4*)(kl + q * 8704) = kw[q];
#pragma unroll
            for (int q = 0; q < 8; ++q) { LAS u32x2* dst = (LAS u32x2*)(vl + q * 8320); dst[0] = (u32x2){vw[q].x, vw[q].y}; dst[1] = (u32x2){vw[q].z, vw[q].w}; }
        }
        __syncthreads();
        if (wave < 4) __builtin_amdgcn_s_setprio(2);
        if (wave * 32 < nrows) {
            const int nkt = is_own ? (2 * (i_q & 3) + (wave & 1) + 1) : 8;
            const int posb = is_own ? (64 * (i_q & 3) + (rho & 63)) : 100000;
            float m_run = -1e30f, l_run = 0.f;
            f32x16 o[4];
#pragma unroll
            for (int db = 0; db < 4; ++db)
#pragma unroll
                for (int r = 0; r < 16; ++r) o[db][r] = 0.f;
#pragma unroll 1
            for (int hf = 0; hf < 2; ++hf) {
                if (4 * hf >= nkt) break;
                f32x16 s[4];
#pragma unroll
                for (int kq = 0; kq < 4; ++kq) {
                    const int kt = 4 * hf + kq;
                    if (kt < nkt) {
#pragma unroll
                        for (int r = 0; r < 16; ++r) s[kq][r] = 0.f;
#pragma unroll
                        for (int ks = 0; ks < 8; ++ks) {
                            const bf16x8 a = *(const LAS bf16x8*)(Ks + (kt * 32 + l32) * 272 + ks * 32 + 16 * h);
                            s[kq] = __builtin_amdgcn_mfma_f32_32x32x16_bf16(a, qf[ks], s[kq], 0, 0, 0);
                            asm volatile("" :: "v"(a));
                        }
                        if (is_own) {
#pragma unroll
                            for (int r = 0; r < 16; ++r) { const int key = kt * 32 + (r & 3) + 8 * (r >> 2) + 4 * h; if (key > posb) s[kq][r] = -1e30f; }
                        }
                    } else {
#pragma unroll
                        for (int r = 0; r < 16; ++r) s[kq][r] = -1e30f;
                    }
                    __builtin_amdgcn_sched_barrier(0);
                }
                float mx = -1e30f;
#pragma unroll
                for (int kq = 0; kq < 4; ++kq)
#pragma unroll
                    for (int r = 0; r < 16; ++r) mx = fmaxf(mx, s[kq][r]);
                mx = fmaxf(mx, __shfl_xor(mx, 32));
                const float m_new = fmaxf(m_run, mx), mL = m_new * LOG2E;
                const float alpha = __builtin_amdgcn_exp2f((m_run - m_new) * LOG2E);
                float lsum = 0.f;
#pragma unroll
                for (int kq = 0; kq < 4; ++kq)
#pragma unroll
                    for (int r = 0; r < 16; ++r) { const float p = __builtin_amdgcn_exp2f(s[kq][r] * LOG2E - mL); s[kq][r] = p; lsum += p; }
                lsum += __shfl_xor(lsum, 32);
                l_run = l_run * alpha + lsum; m_run = m_new;
                if (hf == 1) {
#pragma unroll
                    for (int db = 0; db < 4; ++db)
#pragma unroll
                        for (int r = 0; r < 16; ++r) o[db][r] *= alpha;
                }
#pragma unroll
                for (int kq = 0; kq < 4; ++kq) {
                    const int kt = 4 * hf + kq;
                    if (kt < nkt) {
#pragma unroll
                        for (int st = 0; st < 2; ++st) {
                            u32x4 pw;
                            pw.x = pk_bf16(s[kq][8 * st + 0], s[kq][8 * st + 1]); pw.y = pk_bf16(s[kq][8 * st + 2], s[kq][8 * st + 3]);
                            pw.z = pk_bf16(s[kq][8 * st + 4], s[kq][8 * st + 5]); pw.w = pk_bf16(s[kq][8 * st + 6], s[kq][8 * st + 7]);
                            const bf16x8 pf = __builtin_bit_cast(bf16x8, pw);
#pragma unroll
                            for (int db = 0; db < 4; ++db) {
                                const LAS unsigned char* va = Vs + (32 * db + l32) * 520 + (kt * 32 + 16 * st + 4 * h) * 2;
                                const u32x2 vlo = *(const LAS u32x2*)va, vhi = *(const LAS u32x2*)(va + 16);
                                const u32x4 vw = {vlo.x, vlo.y, vhi.x, vhi.y};
                                o[db] = __builtin_amdgcn_mfma_f32_32x32x16_bf16(__builtin_bit_cast(bf16x8, vw), pf, o[db], 0, 0, 0);
                            }
                            __builtin_amdgcn_sched_barrier(0);
                        }
                    }
                }
            }
            asm volatile("" : "+v"(ent));
            if constexpr (!OWN) {
                if (valid) {
                    const float inv = 1.f / l_run;
                    const int slot = ent & 3; const int row = ent >> 2;
                    if (h == 0) *(f32x2*)(P.part_ml + (size_t)ent * 2) = (f32x2){m_run, l_run};
                    int h2 = h; asm volatile("" : "+v"(h2));
                    bf16_t* pb = P.part[1];
                    if (slot == 2) pb = P.part[2]; else if (slot == 3) pb = P.part[3];
                    bf16_t* po = pb + ((size_t)row * 128 + 4 * h2);
#pragma unroll
                    for (int db = 0; db < 4; ++db)
#pragma unroll
                        for (int rq = 0; rq < 4; ++rq) {
                            u32x2 w; w.x = pk_bf16(o[db][4 * rq] * inv, o[db][4 * rq + 1] * inv); w.y = pk_bf16(o[db][4 * rq + 2] * inv, o[db][4 * rq + 3] * inv);
                            *(u32x2*)(po + 32 * db + 8 * rq) = w;
                        }
                }
            } else {
                const int row = ent >> 2, nsel = n < 3 ? n : 3;
                int h2 = h; asm volatile("" : "+v"(h2));
                float M = m_run; f32x2 ml[3];
#pragma unroll
                for (int s2 = 0; s2 < 3; ++s2) { ml[s2] = (f32x2){-1e30f, 0.f}; if (s2 < nsel) { ml[s2] = *(const f32x2*)(P.part_ml + ((size_t)row * 4 + s2 + 1) * 2); M = fmaxf(M, ml[s2].x); } }
                const float w0 = __builtin_amdgcn_exp2f((m_run - M) * LOG2E);
                float ws[3], L = l_run * w0;
#pragma unroll
                for (int s2 = 0; s2 < 3; ++s2) { ws[s2] = ml[s2].y * __builtin_amdgcn_exp2f((ml[s2].x - M) * LOG2E); L += ws[s2]; }
                const float inv = 1.f / L, w0i = w0 * inv;
                const size_t poff = (size_t)row * 128 + 4 * h2;
                bf16_t* ao = P.attn + (size_t)(row >> 3) * DM + (row & 7) * 128 + 4 * h2;
#pragma unroll
                for (int db = 0; db < 4; ++db) {
                    u32x2 pv[3][4];
#pragma unroll
                    for (int s2 = 0; s2 < 3; ++s2)
#pragma unroll
                        for (int rq = 0; rq < 4; ++rq) { pv[s2][rq] = (u32x2){0u, 0u}; if (s2 < nsel) pv[s2][rq] = *(const u32x2*)(P.part[s2 + 1] + poff + 32 * db + 8 * rq); }
#pragma unroll
                    for (int rq = 0; rq < 4; ++rq) {
                        float a0 = o[db][4 * rq] * w0i, a1 = o[db][4 * rq + 1] * w0i, a2 = o[db][4 * rq + 2] * w0i, a3 = o[db][4 * rq + 3] * w0i;
#pragma unroll
                        for (int s2 = 0; s2 < 3; ++s2) { const float wv = ws[s2] * inv; a0 += wv * bf_lo(pv[s2][rq].x); a1 += wv * bf_hi(pv[s2][rq].x); a2 += wv * bf_lo(pv[s2][rq].y); a3 += wv * bf_hi(pv[s2][rq].y); }
                        u32x2 w; w.x = pk_bf16(a0, a1); w.y = pk_bf16(a2, a3);
                        *(u32x2*)(ao + 32 * db + 8 * rq) = w;
                    }
                }
            }
        }
        __builtin_amdgcn_s_setprio(0);
        __syncthreads();
    }
}

DI void phase_combine(const Params& P) {
    const int tid = threadIdx.x, wave = tid >> 6, lane = tid & 63;
    const int gw = blockIdx.x * 8 + wave, NGW = gridDim.x * 8;
    for (int row = gw; row < T_TOK * 8; row += NGW) {
        const int t = row >> 3, hq = row & 7, own = (t & (SEQ - 1)) >> 8, nsel = own < 3 ? own : 3;
        float m[4], l[4];
#pragma unroll
        for (int s = 0; s < 4; ++s) { if (s <= nsel) { const f32x2 ml = *(const f32x2*)(P.part_ml + ((size_t)row * 4 + s) * 2); m[s] = ml.x; l[s] = ml.y; } else { m[s] = -1e30f; l[s] = 0.f; } }
        const float M = fmaxf(fmaxf(m[0], m[1]), fmaxf(m[2], m[3]));
        float o0 = 0.f, o1 = 0.f, L = 0.f;
#pragma unroll
        for (int s = 0; s < 4; ++s) {
            if (s <= nsel) {
                const float w = l[s] * __expf(m[s] - M); L += w;
                const unsigned v = *(const unsigned*)(P.part[s] + (size_t)row * 128 + 2 * lane);
                o0 += w * bf_lo(v); o1 += w * bf_hi(v);
            }
        }
        const float inv = 1.f / L;
        *(unsigned*)(P.attn + (size_t)t * DM + hq * 128 + 2 * lane) = cvt_pk_bf16(o0 * inv, o1 * inv);
    }
}

DI void phase_final(const Params& P) {
    const int tid = threadIdx.x, wave = tid >> 6, lane = tid & 63;
    const int gw = blockIdx.x * 8 + wave, NGW = gridDim.x * 8;
    for (int row = gw; row < T_TOK; row += NGW) {
        const float rs = rsqrtf(P.rowss[6 * T_TOK + row] * (1.f / DM) + RMS_EPS);
        const f32x4* xr = (const f32x4*)(P.xres + (size_t)row * DM) + lane;
        const f32x4* gr = (const f32x4*)P.final_g + lane;
        f32x4* o = (f32x4*)(P.out + (size_t)row * DM) + lane;
#pragma unroll
        for (int j = 0; j < 4; ++j) o[64 * j] = xr[64 * j] * rs * gr[64 * j];
    }
}

DI void phase_final_fused(const Params& P, LAS unsigned char* lds, int vbid) {
    pg8::StaticOrder S; S.init(T_TOK, DM, gridDim.x, vbid);
    pg8::Unit u;
    if (!S.next(0, u)) return;
    const int tid = threadIdx.x, wave = tid >> 6, lane = tid & 63;
    asm volatile("s_waitcnt vmcnt(0)" ::: "memory");
    __syncthreads();
    LAS int* flag = (LAS int*)lds;
    if (tid == 0) flag[0] = atomicAdd(P.pcnt + u.pm, 1);
    __syncthreads();
    if (flag[0] != 3) return;
    __builtin_amdgcn_fence(__ATOMIC_ACQUIRE, "agent");
    asm volatile("s_waitcnt vmcnt(0)" ::: "memory");
    const f32x4* gr = (const f32x4*)P.final_g + lane;
    const f32x4 g0 = gr[0], g1 = gr[64], g2 = gr[128], g3 = gr[192];
#pragma unroll 1
    for (int r0 = wave * 32; r0 < wave * 32 + 32; r0 += 4) {
        f32x4 v[4][4]; float ss[4];
#pragma unroll
        for (int i = 0; i < 4; ++i) {
            const int row = u.pm * 256 + r0 + i;
            const f32x4* xr = (const f32x4*)(P.xres + (size_t)row * DM) + lane;
            ss[i] = P.rowss[6 * T_TOK + row];
            v[i][0] = xr[0]; v[i][1] = xr[64]; v[i][2] = xr[128]; v[i][3] = xr[192];
        }
#pragma unroll
        for (int i = 0; i < 4; ++i) {
            const int row = u.pm * 256 + r0 + i;
            const float rs = rsqrtf(ss[i] * (1.f / DM) + RMS_EPS);
            f32x4* o = (f32x4*)(P.out + (size_t)row * DM) + lane;
            o[0] = v[i][0] * rs * g0; o[64] = v[i][1] * rs * g1; o[128] = v[i][2] * rs * g2; o[192] = v[i][3] * rs * g3;
        }
    }
}

#define XB_TMO      128
#define XB_XCNT(j)  (256  + 64 * (j))
#define XB_XSUB(j)  (1280 + 64 * (j))
#define XB_XGEN(j)  (2304 + 64 * (j))
#define XB_TOP      3328
#define XB_TOPGEN   3392
#define XCD_BAR_WORDS 3456
#define XB_SPIN_CAP (1u << 18)
DI unsigned xb_ld(unsigned* p)              { return __hip_atomic_load(p, __ATOMIC_RELAXED, __HIP_MEMORY_SCOPE_AGENT); }
DI unsigned xb_add(unsigned* p, unsigned v) { return __hip_atomic_fetch_add(p, v, __ATOMIC_RELAXED, __HIP_MEMORY_SCOPE_AGENT); }
DI unsigned xb_xcc_id() { return (unsigned)__builtin_amdgcn_s_getreg((3 << 11) | 20) & 0xFu; }
#define XB_SPIN(cond, bar) do { unsigned _sp = 0; while (cond) { __builtin_amdgcn_s_sleep(1); \
    if ((++_sp & 255u) == 0u) { if (xb_ld(&(bar)[XB_TMO])) break; if (_sp > XB_SPIN_CAP) { atomicAdd(&(bar)[XB_TMO], 1u); break; } } } } while (0)
struct XcdBarrier { unsigned* bar; unsigned x; volatile LAS unsigned* st; };
DI XcdBarrier xcd_barrier_post(unsigned* bar, volatile LAS unsigned* st) {
    XcdBarrier b; b.bar = bar; b.x = xb_xcc_id(); b.st = st;
    if (threadIdx.x == 0) (void)xb_add(&bar[XB_XCNT(b.x)], 1u);
    return b;
}
DI void xcd_barrier_complete(unsigned* bar, unsigned x, unsigned& nloc, unsigned& nx) {
    const unsigned G = gridDim.x * gridDim.y * gridDim.z;
    unsigned sum, cnt, mine, sp = 0u;
    for (;;) {
        sum = 0u; cnt = 0u; mine = 0u;
#pragma unroll
        for (unsigned j = 0; j < 16; ++j) { const unsigned c = xb_ld(&bar[XB_XCNT(j)]); sum += c; cnt += (c > 0u) ? 1u : 0u; mine = (j == x) ? c : mine; }
        if (sum == G) break;
        __builtin_amdgcn_s_sleep(1);
        if ((++sp & 255u) == 0u) { if (xb_ld(&bar[XB_TMO])) break; if (sp > XB_SPIN_CAP) { atomicAdd(&bar[XB_TMO], 1u); break; } }
    }
    nloc = mine > 0u ? mine : 1u; nx = cnt > 0u ? cnt : 1u;
}
DI void xcd_barrier(const XcdBarrier& b) {
    asm volatile("s_waitcnt vmcnt(0)" ::: "memory");
    __syncthreads();
    if (threadIdx.x == 0) {
        unsigned* bar = b.bar;
        __builtin_amdgcn_s_waitcnt(0);
        unsigned nloc = b.st[0], nx = b.st[1];
        if (nloc == 0u) { xcd_barrier_complete(bar, b.x, nloc, nx); b.st[0] = nloc; b.st[1] = nx; }
        const unsigned old = xb_add(&bar[XB_XSUB(b.x)], 1u);
        const unsigned gen = old / nloc;
        if (old + 1u == (gen + 1u) * nloc) {
            __builtin_amdgcn_fence(__ATOMIC_RELEASE, "agent");
            asm volatile("s_waitcnt vmcnt(0)" ::: "memory");
            const unsigned og = xb_add(&bar[XB_TOP], 1u);
            const unsigned tg = og / nx;
            if (og + 1u == (tg + 1u) * nx) xb_add(&bar[XB_TOPGEN], 1u);
            else XB_SPIN(xb_ld(&bar[XB_TOPGEN]) == tg, bar);
            __builtin_amdgcn_fence(__ATOMIC_ACQUIRE, "agent");
            xb_add(&bar[XB_XGEN(b.x)], 1u);
            asm volatile("s_waitcnt vmcnt(0)" ::: "memory");
        } else {
            XB_SPIN(xb_ld(&bar[XB_XGEN(b.x)]) == gen, bar);
            __builtin_amdgcn_fence(__ATOMIC_ACQUIRE, "agent");
            asm volatile("s_waitcnt vmcnt(0)" ::: "memory");
        }
    }
    __syncthreads();
}

constexpr int NPHASES = 18;
#ifndef PHMASK
#define PHMASK 0xFFFFF
#endif
#define PHON(n) if constexpr (((PHMASK) >> (n)) & 1)
#ifndef DUPSEL
#define DUPSEL 0
#endif
__global__ void __launch_bounds__(512, 2) mega_fwd(const Params P) {
    extern __shared__ __attribute__((aligned(16))) unsigned char smem[];
    LAS unsigned char* lds = (LAS unsigned char*)smem;
    cg::grid_group grid = cg::this_grid();
    if (P.ph_hi < 0) grid.sync();
    volatile LAS unsigned* xst = (volatile LAS unsigned*)(lds + 139264);
    if (threadIdx.x == 0) { xst[0] = 0u; xst[1] = 0u; xst[2] = 0u; xst[3] = 0u; xst[4] = 0u; }
    __syncthreads();
    XcdBarrier xb; xb.bar = P.bar; xb.x = xb_xcc_id(); xb.st = xst;
    if (threadIdx.x == 0) xst[2] = xb_add(&P.bar[XB_XCNT(xb.x)], 1u);
    PHON(0) if (P.ph_lo <= 0 && 0 < P.ph_hi) { phase_prep(P, lds); }
    if constexpr (DUPSEL == 4) { xcd_barrier(xb); phase_prep(P, lds); }
    if (P.ph_lo < 1 && 1 < P.ph_hi) xcd_barrier(xb);
    if (threadIdx.x == 0) {
        bool ok = (gridDim.x % 8u) == 0u;
        for (unsigned j = 0; j < 16; ++j) { const unsigned c = xb_ld(&P.bar[XB_XCNT(j)]); ok = ok && (c == (j < 8 ? gridDim.x / 8u : 0u)); }
        xst[3] = ok ? (xb.x + 8u * xst[2]) : blockIdx.x; xst[4] = ok ? 1u : 0u;
    }
    __syncthreads();
    const int vbid = (int)xst[3];
    const bool vb_ok = xst[4] != 0u;
    const int abid = vb_ok ? ((vbid & 7) * (int)(gridDim.x >> 3) + (vbid >> 3)) : (int)blockIdx.x;
    preload_rs(lds, vbid, P.rowss + 0 * T_TOK, 5632); run_gemm_v(lds, vbid, P.xb, P.wt_up[0], 5632, DM, EpiAct{P.act, P.rowss + 0 * T_TOK, P.kbuf, P.vT, P.rope, (const LAS float*)(lds + 131072)});
    convert_by_light_blocks(P, lds, vbid, 64 * 22, P.it1, P.it2);
    if constexpr (DUPSEL == 2) { xcd_barrier(xb); preload_rs(lds, vbid, P.rowss + 0 * T_TOK, 5632); run_gemm_v(lds, vbid, P.xb, P.wt_up[0], 5632, DM, EpiAct{P.act, P.rowss + 0 * T_TOK, P.kbuf, P.vT, P.rope, (const LAS float*)(lds + 131072)}); }
    if (P.ph_lo < 2 && 2 < P.ph_hi) xcd_barrier(xb);
    PHON(2) if (P.ph_lo <= 2 && 2 < P.ph_hi) { run_gemm_v(lds, vbid, P.act, P.wt_dn[0], DM, FF, EpiRes{P.x, P.xres, P.xb, P.rowss + 1 * T_TOK, 0.5f}); }
    if (P.ph_lo < 3 && 3 < P.ph_hi) xcd_barrier(xb);
    PHON(3) if (P.ph_lo <= 3 && 3 < P.ph_hi) { phase_s5a(P, lds); }
    xcd_barrier(xb);
    phase_s5carry(P);
    if (P.ph_lo < 4 && 4 < P.ph_hi) xcd_barrier(xb);
    PHON(4) if (P.ph_lo <= 4 && 4 < P.ph_hi) { phase_s5b(P, lds); }
    if constexpr (DUPSEL == 3) { xcd_barrier(xb); phase_s5a(P, lds); xcd_barrier(xb); phase_s5carry(P); xcd_barrier(xb); phase_s5b(P, lds); }

    if (P.ph_lo < 5 && 5 < P.ph_hi) xcd_barrier(xb);
    PHON(5) if (P.ph_lo <= 5 && 5 < P.ph_hi) { run_gemm_v(lds, vbid, P.yb, P.wt_glu, 2048, DM, EpiGlu{P.xres, P.xb, P.rowss + 2 * T_TOK}); }
    if (P.ph_lo < 6 && 6 < P.ph_hi) xcd_barrier(xb);
    PHON(6) if (P.ph_lo <= 6 && 6 < P.ph_hi) { preload_rs(lds, vbid, P.rowss + 2 * T_TOK, 5632); run_gemm_v(lds, vbid, P.xb, P.wt_up[1], 5632, DM, EpiAct{P.act, P.rowss + 2 * T_TOK, P.kbuf, P.vT, P.rope, (const LAS float*)(lds + 131072)}); convert_by_light_blocks(P, lds, vbid, 64 * 22, P.it2, P.nitems); }
    if (P.ph_lo < 7 && 7 < P.ph_hi) xcd_barrier(xb);
    PHON(7) if (P.ph_lo <= 7 && 7 < P.ph_hi) { run_gemm_v(lds, vbid, P.act, P.wt_dn[1], DM, FF, EpiRes{P.xres, P.xres, P.xb, P.rowss + 3 * T_TOK, 0.5f}); }
    if (P.ph_lo < 8 && 8 < P.ph_hi) xcd_barrier(xb);
    PHON(8) if (P.ph_lo <= 8 && 8 < P.ph_hi) { preload_rs(lds, vbid, P.rowss + 3 * T_TOK, 6144); run_gemm_v(lds, vbid, P.xb, P.wt_up[2], 6144, DM, EpiAct{P.act, P.rowss + 3 * T_TOK, P.kbuf, P.vT, P.rope, (const LAS float*)(lds + 131072)}); }
    if (P.ph_lo < 9 && 9 < P.ph_hi) xcd_barrier(xb);
    PHON(9) if (P.ph_lo <= 9 && 9 < P.ph_hi) { run_gemm_v(lds, vbid, P.act, P.wt_dn[2], DM, FF, EpiRes{P.xres, P.xres, P.xb, P.rowss + 4 * T_TOK, 0.5f}); phase_kmean(P, lds); }
    if (P.ph_lo < 10 && 10 < P.ph_hi) xcd_barrier(xb);
    PHON(10) if (P.ph_lo <= 10 && 10 < P.ph_hi) { run_gemm_v(lds, vbid, P.xb, P.wt_q, DM, DM, EpiQ{P.qbuf, P.rowss + 4 * T_TOK, P.rope}); }
    if (P.ph_lo < 11 && 11 < P.ph_hi) xcd_barrier(xb);
    PHON(11) if (P.ph_lo <= 11 && 11 < P.ph_hi) { phase_gate(P, lds); }
    if (P.ph_lo < 12 && 12 < P.ph_hi) xcd_barrier(xb);
    PHON(12) if (P.ph_lo <= 12 && 12 < P.ph_hi) { phase_attn<false>(P, lds, abid); }
    if constexpr (DUPSEL == 6) { xcd_barrier(xb); phase_attn<false>(P, lds, abid); }
    if (P.ph_lo < 13 && 13 < P.ph_hi) xcd_barrier(xb);
    PHON(13) if (P.ph_lo <= 13 && 13 < P.ph_hi) { phase_attn<true>(P, lds, abid); }
    if constexpr (DUPSEL == 1) { for (int i = 0; i < 8; ++i) xcd_barrier(xb); }
    if (P.ph_lo < 14 && 14 < P.ph_hi) xcd_barrier(xb);
    PHON(14) if (P.ph_lo <= 14 && 14 < P.ph_hi) { run_gemm_v(lds, vbid, P.attn, P.wt_o, DM, DM, EpiRes{P.xres, P.xres, P.xb, P.rowss + 5 * T_TOK, 1.0f}); }
    if (P.ph_lo < 15 && 15 < P.ph_hi) xcd_barrier(xb);
    PHON(15) if (P.ph_lo <= 15 && 15 < P.ph_hi) { preload_rs(lds, vbid, P.rowss + 5 * T_TOK, 5632); run_gemm_v(lds, vbid, P.xb, P.wt_up[3], 5632, DM, EpiAct{P.act, P.rowss + 5 * T_TOK, P.kbuf, P.vT, P.rope, (const LAS float*)(lds + 131072)}); }
    if (P.ph_lo < 16 && 16 < P.ph_hi) xcd_barrier(xb);
    PHON(16) if (P.ph_lo <= 16 && 16 < P.ph_hi) { run_gemm_v(lds, vbid, P.act, P.wt_dn[3], DM, FF, EpiRes{P.xres, P.xres, P.xb, P.rowss + 6 * T_TOK, 0.5f}); }
    if (vb_ok && gridDim.x == 256u) { phase_final_fused(P, lds, vbid); }
    else { xcd_barrier(xb); phase_final(P); }
}

extern "C" void kernel_launch(void* const* d_in, const int* in_sizes, int n_in, void* d_out, int out_size, void* d_ws, size_t ws_size, hipStream_t stream) {
    static int grid_blocks = 0;
    if (!grid_blocks) {
        int dev = 0, cus = 0, per_cu = 0;
        hipGetDevice(&dev);
        hipDeviceGetAttribute(&cus, hipDeviceAttributeMultiprocessorCount, dev);
        hipFuncSetAttribute((const void*)mega_fwd, hipFuncAttributeMaxDynamicSharedMemorySize, LDS_BYTES);
        hipOccupancyMaxActiveBlocksPerMultiprocessor(&per_cu, (const void*)mega_fwd, 512, LDS_BYTES);
        if (per_cu < 1) per_cu = 1;
        if (per_cu > 1) per_cu = 1;
        grid_blocks = cus * per_cu;
    }
    Params p{};
    const float** in = (const float**)&p.x;
    for (int i = 0; i < 19; ++i) in[i] = (const float*)d_in[i];
    p.out = (float*)d_out;
    unsigned char* ws = (unsigned char*)d_ws; size_t off = 0;
    auto take = [&](size_t bytes) { unsigned char* r = ws + off; off += (bytes + 255) & ~(size_t)255; return r; };
    p.xres = (float*)take((size_t)T_TOK * DM * 4);
    p.xb = (bf16_t*)take((size_t)T_TOK * DM * 2);
    p.act = (bf16_t*)take((size_t)T_TOK * FF * 2);
    p.qbuf = p.act;
    p.attn = p.act + (size_t)T_TOK * DM;
    p.part_ml = (float*)(p.act + (size_t)2 * T_TOK * DM);
    p.kbuf = (bf16_t*)take((size_t)T_TOK * 256 * 2);
    p.vT = (bf16_t*)take((size_t)T_TOK * 256 * 2);
    p.kmean = (float*)take(128 * 128 * 4);
    p.rowss = (float*)take((size_t)7 * T_TOK * 4 + 1024);
    p.gcount = (int*)(p.rowss + 7 * T_TOK);
    p.E = (float*)take((size_t)2 * 128 * 64 * 64 * 2 * 4);
    p.lists = (int*)p.E;
    p.rope = (float*)take((size_t)SEQ * 16 * 2 * 4);
    p.bar = (unsigned*)take((size_t)XCD_BAR_WORDS * 4);
    p.s5tab = (float*)take(4096 * 4 * 4);
    p.pcnt = (int*)take(256);
    p.wt_up[0] = (bf16_t*)take((size_t)6144 * DM * 2); p.wt_up[1] = (bf16_t*)take((size_t)6144 * DM * 2);
    p.wt_dn[0] = (bf16_t*)take((size_t)DM * FF * 2); p.wt_dn[1] = (bf16_t*)take((size_t)DM * FF * 2);
    p.wt_glu = (bf16_t*)take((size_t)2048 * DM * 2);
    p.wt_up[2] = (bf16_t*)take((size_t)6144 * DM * 2); p.wt_up[3] = (bf16_t*)take((size_t)6144 * DM * 2);
    p.wt_dn[2] = (bf16_t*)take((size_t)DM * FF * 2); p.wt_dn[3] = (bf16_t*)take((size_t)DM * FF * 2);
    p.wt_q = (bf16_t*)take((size_t)DM * DM * 2);
    p.wt_o = (bf16_t*)take((size_t)DM * DM * 2);
    p.part[0] = p.xb;
    p.part[1] = (bf16_t*)take((size_t)T_TOK * DM * 2);
    p.part[2] = (bf16_t*)take((size_t)T_TOK * DM * 2);
    p.part[3] = p.wt_up[0];
    p.yb = p.part[1];
    int nj = 0, items = 0;
    auto job = [&](const float* W, const float* g, bf16_t* dst, int K, int Nsrc, int ndst, int mode) {
        WJob& J = p.jobs[nj++]; J.W = W; J.g = g; J.dst = dst; J.K = K; J.Nsrc = Nsrc; J.ndst = ndst; J.mode = mode; J.item0 = items; J.pad = 0;
        items += (K / 64) * (ndst / 32);
    };
    auto job_up = [&](int l, int f) { job(p.ffn_w_in + (size_t)(l * 2 + f) * DM * 2 * FF, p.norm_g + (size_t)(l * 3 + (f ? 2 : 0)) * DM, p.wt_up[l * 2 + f], DM, 2 * FF, 2 * FF, 1); };
    auto job_dn = [&](int l, int f) { job(p.ffn_w_out + (size_t)(l * 2 + f) * FF * DM, nullptr, p.wt_dn[l * 2 + f], FF, DM, DM, 0); };
    job_up(0, 0);
    p.it1 = items;
    job_dn(0, 0); job(p.w_glu, nullptr, p.wt_glu, DM, 2048, 2048, 1); job_up(0, 1); job_dn(0, 1);
    p.it2 = items;
    job_up(1, 0);
    job(p.w_k, p.kv_norm_g, p.wt_up[2] + (size_t)5632 * DM, DM, 256, 256, 0);
    job(p.w_v, p.kv_norm_g, p.wt_up[2] + (size_t)5888 * DM, DM, 256, 256, 0);
    job_dn(1, 0); job_up(1, 1); job_dn(1, 1);
    job(p.w_q, p.norm_g + (size_t)4 * DM, p.wt_q, DM, DM, DM, 0);
    job(p.w_o, nullptr, p.wt_o, DM, DM, DM, 0);
    p.nitems = items; p.ph_lo = 0; p.ph_hi = NPHASES; p.pad = 0;
    if (off > ws_size) { fprintf(stderr, "workspace too small: need %zu have %zu\n", off, ws_size); return; }
    (void)hipMemsetAsync(p.bar, 0, (size_t)XCD_BAR_WORDS * 4, stream);
    void* args[] = {&p};
    hipError_t e = hipLaunchCooperativeKernel((const void*)mega_fwd, dim3(grid_blocks), dim3(512), args, LDS_BYTES, stream);
    if (e != hipSuccess) fprintf(stderr, "cooperative launch failed: %s (grid %d)\n", hipGetErrorString(e), grid_blocks);
}
```

```cpp
#include <hip/hip_runtime.h>
#include <hip/hip_cooperative_groups.h>
#include <cstdio>
namespace cg = cooperative_groups;

#define LAS __attribute__((address_space(3)))
#define DI __device__ __forceinline__
typedef unsigned short bf16_t;
typedef short bf16x8 __attribute__((ext_vector_type(8)));
typedef float f32x4 __attribute__((ext_vector_type(4)));
typedef float f32x2 __attribute__((ext_vector_type(2)));
typedef unsigned u32x4 __attribute__((ext_vector_type(4)));
typedef unsigned u32x2 __attribute__((ext_vector_type(2)));

constexpr int T_TOK = 16384, DM = 1024, FF = 2816, SEQ = 8192;
constexpr float RMS_EPS = 1e-6f;
constexpr int LDS_BYTES = 139296;
constexpr int NJOBS = 13;

struct WJob { const float* W; const float* g; bf16_t* dst; int K; int Nsrc; int ndst; int mode; int item0; float scale; };

struct Params {
    const float *x, *norm_g, *ffn_w_in, *ffn_w_out, *a_re, *a_im, *log_step, *b_re, *b_im, *c_re, *c_im, *s5_d, *w_glu, *kv_norm_g, *w_k, *w_v, *w_q, *w_o, *final_g;
    float* out;
    float* xres; bf16_t* xb; bf16_t* act; bf16_t* yb; bf16_t* qbuf; bf16_t* attn; bf16_t* kbuf; bf16_t* vbuf;
    float* kmean; float* rowss; float* E; float* rope;
    bf16_t* vT; bf16_t* part[4]; float* part_ml; int* lists; int* gcount; unsigned* bar; float* s5tab; int* pcnt;
    bf16_t* wt_up[4]; bf16_t* wt_dn[4]; bf16_t* wt_glu; bf16_t* wt_q; bf16_t* wt_o;
    WJob jobs[NJOBS];
    int nitems; int ph_lo; int ph_hi; int pad; int it1; int it2;
};

DI unsigned cvt_pk_bf16(float lo, float hi) { unsigned r; asm volatile("v_cvt_pk_bf16_f32 %0, %1, %2" : "=v"(r) : "v"(lo), "v"(hi)); return r; }
DI float bf_lo(unsigned w) { return __uint_as_float(w << 16); }
DI float bf_hi(unsigned w) { return __uint_as_float(w & 0xffff0000u); }
DI float wave_sum(float v) {
#pragma unroll
    for (int o = 1; o < 64; o <<= 1) v += __shfl_xor(v, o);
    return v;
}
DI float wave_max(float v) {
#pragma unroll
    for (int o = 1; o < 64; o <<= 1) v = fmaxf(v, __shfl_xor(v, o));
    return v;
}

namespace pg8 {
constexpr int BM = 256, BK = 64, HALF = 128, HTB = HALF * BK * 2, NXCD = 8, WGM = 8;
DI int lds_byte(int r, int c) { const int st = (r >> 4) * 2 + (c >> 5), rr = r & 15, cc = c & 31, ob = rr * 64 + cc * 2; return st * 1024 + (ob ^ (((ob >> 9) & 1) << 5)); }
DI void stage_rc(int b, int& R, int& C) { const int st = b / 1024, sb = b % 1024, swz = sb ^ (((sb >> 9) & 1) << 5); R = (st >> 1) * 16 + swz / 64; C = (st & 1) * 32 + (swz % 64) / 2; }
struct Unit { int pm, pn; };
struct Gemm { const bf16_t* A; const bf16_t* Bt; int M, N, K; };
struct StaticOrder {
    int nM, nN, nwg, G, c;
    DI void init(int M, int N, int G_, int c_) { nM = M / BM; nN = N / BM; nwg = nM * nN; G = G_; c = c_; }
    DI bool next(int i, Unit& u) const {
        const long L = (long)i * G + c; if (L >= nwg) return false;
        int wgid = (int)L; { const int q = nwg / NXCD, r = nwg % NXCD, xcd = wgid % NXCD, off = wgid / NXCD; wgid = (xcd < r ? xcd * (q + 1) : r * (q + 1) + (xcd - r) * q) + off; }
        const int nig = WGM * nN, gid = wgid / nig, fm = gid * WGM, gsz = (nM - fm) < WGM ? (nM - fm) : WGM;
        u.pm = fm + ((wgid % nig) % gsz); u.pn = (wgid % nig) / gsz; return true;
    }
};

template <class Epi>
DI void gemm_phase(LAS unsigned char* lds, const Gemm g, const StaticOrder& S, const Epi& E) {
    int tid_ = threadIdx.x; asm volatile("" : "+v"(tid_));
    const int tid = tid_, wid = __builtin_amdgcn_readfirstlane(tid >> 6), lane = tid & 63, wr = wid >> 2, wc = wid & 3, fr = lane & 15, fq = lane >> 4;
    const int K = g.K, nt = K / BK;
    unsigned voffA[2], voffB[2];
#pragma unroll
    for (int i = 0; i < 2; ++i) { int R, C; stage_rc(tid * 16 + i * 8192, R, C); voffA[i] = (unsigned)(R * K + C) * 2u; voffB[i] = voffA[i]; }
    const size_t kstep = (size_t)(BK * 2);
    const size_t hstep = (size_t)HALF * K * 2;
    const size_t tstep = 2 * hstep;
    const unsigned ldsw = (unsigned)wid * 1024u;
    const int aoff = lds_byte(wr * 64 + fr, fq * 8), boff = lds_byte(wc * 32 + fr, fq * 8);
#define PG8_SA(b, h) (((b) * 2 + (h)) * HTB)
#define PG8_SB(b, h) ((4 + (b) * 2 + (h)) * HTB)
#define PG8_STAGE(bufoff, gbase, voff) do { _Pragma("unroll") for (int _i = 0; _i < 2; ++_i) \
        __builtin_amdgcn_global_load_lds((const unsigned*)((const char*)(gbase) + (voff)[_i]), (LAS unsigned*)(lds + (bufoff) + ldsw + _i * 8192), 16, 0, 0); } while (0)
#define PG8_LDA(dst, b, h) do { _Pragma("unroll") for (int m = 0; m < 4; ++m) _Pragma("unroll") for (int k = 0; k < 2; ++k) dst[m][k] = *(const LAS bf16x8*)(lds + PG8_SA(b, h) + aoff + m * 2048 + k * 1024); } while (0)
#define PG8_LDB(dst, b, h) do { _Pragma("unroll") for (int n = 0; n < 2; ++n) _Pragma("unroll") for (int k = 0; k < 2; ++k) dst[n][k] = *(const LAS bf16x8*)(lds + PG8_SB(b, h) + boff + n * 2048 + k * 1024); } while (0)
#define PG8_MMA(ai, bj, At, Bt) do { __builtin_amdgcn_s_setprio(1); _Pragma("unroll") for (int m = 0; m < 4; ++m) _Pragma("unroll") for (int n = 0; n < 2; ++n) _Pragma("unroll") for (int k = 0; k < 2; ++k) \
        acc[ai][bj][m][n] = __builtin_amdgcn_mfma_f32_16x16x32_bf16(Bt[n][k], At[m][k], acc[ai][bj][m][n], 0, 0, 0); __builtin_amdgcn_s_setprio(0); } while (0)
#define PG8_WAIT_V(n) asm volatile("s_waitcnt vmcnt(" #n ")" ::: "memory")
#define PG8_WAIT_L(n) asm volatile("s_waitcnt lgkmcnt(" #n ")" ::: "memory")
#define PG8_BAR __builtin_amdgcn_s_barrier()
#define PG8_SCHED __builtin_amdgcn_sched_barrier(0)
    Unit cur, nxt; int ui = 0;
    if (!S.next(0, cur)) return;
    f32x4 acc[2][2][4][2];
    if constexpr (Epi::INIT_X) E.init(acc, cur, wr, wc, fr, fq);
    else {
#pragma unroll
    for (int a = 0; a < 2; ++a)
#pragma unroll
        for (int b = 0; b < 2; ++b)
#pragma unroll
            for (int m = 0; m < 4; ++m)
#pragma unroll
                for (int n = 0; n < 2; ++n) acc[a][b][m][n] = (f32x4){0.f, 0.f, 0.f, 0.f};
    }
    bf16x8 At[4][2], B0[2][2], B1[2][2];
    const char* cA = (const char*)g.A + (size_t)cur.pm * tstep; const char* cB = (const char*)g.Bt + (size_t)cur.pn * tstep;
    PG8_STAGE(PG8_SB(0, 0), cB, voffB); PG8_STAGE(PG8_SA(0, 0), cA, voffA); PG8_STAGE(PG8_SB(0, 1), cB + hstep, voffB); PG8_STAGE(PG8_SA(0, 1), cA + hstep, voffA);
    if (wr == 1) PG8_BAR;
    PG8_WAIT_V(4); PG8_BAR;
    PG8_STAGE(PG8_SB(1, 0), cB + kstep, voffB); PG8_STAGE(PG8_SA(1, 0), cA + kstep, voffA); PG8_STAGE(PG8_SB(1, 1), cB + hstep + kstep, voffB);
    PG8_WAIT_V(6); PG8_BAR;
    for (;;) {
        const bool has_next = S.next(ui + 1, nxt);
        const char* nA = has_next ? (const char*)g.A + (size_t)nxt.pm * tstep : cA; const char* nB = has_next ? (const char*)g.Bt + (size_t)nxt.pn * tstep : cB;
        for (int t = 0; t < nt; t += 2) {
            const bool last = (t == nt - 2);
            const char* a1 = cA + (size_t)(t + 1) * kstep;
            const char* a2 = last ? nA : cA + (size_t)(t + 2) * kstep; const char* b2 = last ? nB : cB + (size_t)(t + 2) * kstep;
            const char* a3 = a2 + kstep; const char* b3 = b2 + kstep;
            PG8_LDB(B0, 0, 0); PG8_SCHED; PG8_LDA(At, 0, 0); PG8_STAGE(PG8_SA(1, 1), a1 + hstep, voffA);
            PG8_WAIT_L(8); PG8_BAR; PG8_WAIT_L(0); PG8_MMA(0, 0, At, B0); PG8_BAR; PG8_SCHED;
            PG8_LDB(B1, 0, 1); PG8_STAGE(PG8_SB(0, 0), b2, voffB);
            PG8_BAR; PG8_WAIT_L(0); PG8_MMA(0, 1, At, B1); PG8_BAR;
            PG8_LDA(At, 0, 1); PG8_STAGE(PG8_SA(0, 0), a2, voffA);
            PG8_BAR; PG8_WAIT_L(0); PG8_MMA(1, 0, At, B0); PG8_BAR; PG8_SCHED;
            PG8_STAGE(PG8_SB(0, 1), b2 + hstep, voffB);
            PG8_WAIT_V(6); PG8_BAR; PG8_MMA(1, 1, At, B1); PG8_BAR;
            PG8_LDB(B0, 1, 0); PG8_SCHED; PG8_LDA(At, 1, 0); PG8_STAGE(PG8_SA(0, 1), a2 + hstep, voffA);
            PG8_WAIT_L(8); PG8_BAR; PG8_WAIT_L(0); PG8_MMA(0, 0, At, B0); PG8_BAR; PG8_SCHED;
            PG8_LDB(B1, 1, 1); PG8_STAGE(PG8_SB(1, 0), b3, voffB);
            PG8_BAR; PG8_WAIT_L(0); PG8_MMA(0, 1, At, B1); PG8_BAR;
            PG8_LDA(At, 1, 1); PG8_STAGE(PG8_SA(1, 0), a3, voffA);
            PG8_BAR; PG8_WAIT_L(0); PG8_MMA(1, 0, At, B0); PG8_BAR; PG8_SCHED;
            PG8_STAGE(PG8_SB(1, 1), b3 + hstep, voffB);
            PG8_WAIT_V(6); PG8_BAR; PG8_MMA(1, 1, At, B1); PG8_BAR;
        }
        E(acc, cur, wr, wc, fr, fq, ui);
        if (!has_next) break;
        if constexpr (Epi::INIT_X) E.init(acc, nxt, wr, wc, fr, fq);
        else {
#pragma unroll
        for (int a = 0; a < 2; ++a)
#pragma unroll
            for (int b = 0; b < 2; ++b)
#pragma unroll
                for (int m = 0; m < 4; ++m)
#pragma unroll
                    for (int n = 0; n < 2; ++n) acc[a][b][m][n] = (f32x4){0.f, 0.f, 0.f, 0.f};
        }
        cur = nxt; cA = nA; cB = nB; ++ui;
    }
    PG8_WAIT_V(0);
    if (wr == 0) PG8_BAR;
    PG8_BAR;
#undef PG8_SA
#undef PG8_SB
#undef PG8_STAGE
#undef PG8_LDA
#undef PG8_LDB
#undef PG8_MMA
#undef PG8_WAIT_V
#undef PG8_WAIT_L
#undef PG8_BAR
#undef PG8_SCHED
}
}
using pg8::Unit;
typedef f32x4 AccT[2][2][4][2];

DI void store_bf4(bf16_t* p, f32x4 v) { u32x2 o; o.x = cvt_pk_bf16(v.x, v.y); o.y = cvt_pk_bf16(v.z, v.w); *(u32x2*)p = o; }
DI float sigmoidf_(float x) { return __builtin_amdgcn_rcpf(1.f + __builtin_amdgcn_exp2f(-1.4426950408889634f * x)); }

struct EpiAct {
    static constexpr bool INIT_X = false;
    bf16_t* act; const float* rowss; bf16_t* kbuf; bf16_t* vbuf; const float* rope; const LAS float* rsl;
    DI void operator()(const AccT& acc, const Unit& u, int wr, int wc, int fr, int fq, int ui) const {
        const int row0 = u.pm * 256 + wr * 64 + fr;
        if (u.pn < 22) {
#pragma unroll
            for (int ai = 0; ai < 2; ++ai)
#pragma unroll
                for (int m = 0; m < 4; ++m) {
                    const int row = row0 + ai * 128 + m * 16;
                    const float rs = rsl[ui * 256 + wr * 64 + fr + ai * 128 + m * 16];
#pragma unroll
                    for (int bj = 0; bj < 2; ++bj) {
                        const f32x4 gt = acc[ai][bj][m][0] * rs, up = acc[ai][bj][m][1] * rs;
                        f32x4 a;
#pragma unroll
                        for (int j = 0; j < 4; ++j) a[j] = gt[j] * sigmoidf_(gt[j]) * up[j];
                        const int col = 16 * (8 * u.pn + 4 * bj + wc) + 4 * fq;
                        store_bf4(act + (size_t)row * FF + col, a);
                    }
                }
        } else if (u.pn == 22) {
            const bool do_rope = (wc == 0);
#pragma unroll
            for (int ai = 0; ai < 2; ++ai)
#pragma unroll
                for (int m = 0; m < 4; ++m) {
                    const int row = row0 + ai * 128 + m * 16;
                    const float rs = rsqrtf(rowss[row] * (1.f / DM) + RMS_EPS);
                    const int b = row >> 13, pos = row & (SEQ - 1);
#pragma unroll
                    for (int bj = 0; bj < 2; ++bj) {
                        f32x4 v0 = acc[ai][bj][m][0] * rs, v1 = acc[ai][bj][m][1] * rs;
                        if (do_rope) {
                            const f32x4* rp = (const f32x4*)(rope + ((size_t)pos * 16 + 4 * fq) * 2);
                            const f32x4 cs0 = rp[0], cs1 = rp[1];
                            const float c[4] = {cs0.x, cs0.z, cs1.x, cs1.z}, s[4] = {cs0.y, cs0.w, cs1.y, cs1.w};
#pragma unroll
                            for (int j = 0; j < 4; ++j) { const float x1 = v0[j], x2 = v1[j]; v0[j] = x1 * c[j] - x2 * s[j]; v1[j] = x2 * c[j] + x1 * s[j]; }
                        }
                        bf16_t* d = kbuf + ((size_t)(b * 2 + bj) * SEQ + pos) * 128 + 32 * wc + 4 * fq;
                        store_bf4(d, v0); store_bf4(d + 16, v1);
                    }
                }
        } else {
            const int lane = fr + 16 * fq, qi = lane & 3;
#pragma unroll
            for (int ai = 0; ai < 2; ++ai)
#pragma unroll
                for (int m = 0; m < 4; ++m) {
                    const int row = row0 + ai * 128 + m * 16;
                    const float rs = rsqrtf(rowss[row] * (1.f / DM) + RMS_EPS);
                    const int b = row >> 13, posq = (row & (SEQ - 1)) & ~3;
#pragma unroll
                    for (int bj = 0; bj < 2; ++bj)
#pragma unroll
                        for (int n = 0; n < 2; ++n) {
                            const f32x4 v = acc[ai][bj][m][n] * rs;
                            f32x4 w;
#pragma unroll
                            for (int k = 0; k < 4; ++k) {
                                const int src = (lane & ~3) | k;
                                const float t0 = __shfl(v[0], src), t1 = __shfl(v[1], src), t2 = __shfl(v[2], src), t3 = __shfl(v[3], src);
                                w[k] = qi == 0 ? t0 : (qi == 1 ? t1 : (qi == 2 ? t2 : t3));
                            }
                            const int d = 32 * wc + 16 * n + 4 * fq + qi;
                            store_bf4(vbuf + ((size_t)((b * 2 + bj) * 128 + d)) * SEQ + posq, w);
                        }
                }
        }
    }
};

struct EpiRes {
    static constexpr bool INIT_X = true;
    const float* xin; float* xout; bf16_t* xb; float* rowss_out;
    DI void init(AccT& acc, const Unit& u, int wr, int wc, int fr, int fq) const {
        const int row0 = u.pm * 256 + wr * 64 + fr;
#pragma unroll
        for (int ai = 0; ai < 2; ++ai)
#pragma unroll
            for (int m = 0; m < 4; ++m)
#pragma unroll
                for (int bj = 0; bj < 2; ++bj)
#pragma unroll
                    for (int n = 0; n < 2; ++n)
                        acc[ai][bj][m][n] = *(const f32x4*)(xin + (size_t)(row0 + ai * 128 + m * 16) * DM + u.pn * 256 + bj * 128 + wc * 32 + n * 16 + 4 * fq);
    }
    DI void operator()(const AccT& acc, const Unit& u, int wr, int wc, int fr, int fq, int ui) const {
        const int row0 = u.pm * 256 + wr * 64 + fr;
#pragma unroll
        for (int ai = 0; ai < 2; ++ai)
#pragma unroll
            for (int m = 0; m < 4; ++m) {
                const int row = row0 + ai * 128 + m * 16;
                float ss = 0.f;
#pragma unroll
                for (int bj = 0; bj < 2; ++bj)
#pragma unroll
                    for (int n = 0; n < 2; ++n) {
                        const size_t off = (size_t)row * DM + u.pn * 256 + bj * 128 + wc * 32 + n * 16 + 4 * fq;
                        const f32x4 v = acc[ai][bj][m][n];
                        *(f32x4*)(xout + off) = v;
                        store_bf4(xb + off, v);
                        ss += v.x * v.x + v.y * v.y + v.z * v.z + v.w * v.w;
                    }
                ss += __shfl_xor(ss, 16); ss += __shfl_xor(ss, 32);
                if (fq == 0) atomicAdd(rowss_out + row, ss);
            }
    }
};

struct EpiGlu {
    static constexpr bool INIT_X = false;
    float* xres; bf16_t* xb; float* rowss_out;
    DI void operator()(const AccT& acc, const Unit& u, int wr, int wc, int fr, int fq, int ui) const {
        const int row0 = u.pm * 256 + wr * 64 + fr;
#pragma unroll
        for (int ai = 0; ai < 2; ++ai)
#pragma unroll
            for (int m = 0; m < 4; ++m) {
                const int row = row0 + ai * 128 + m * 16;
                float ss = 0.f;
#pragma unroll
                for (int bj = 0; bj < 2; ++bj) {
                    const size_t off = (size_t)row * DM + 16 * (8 * u.pn + 4 * bj + wc) + 4 * fq;
                    const f32x4 val = acc[ai][bj][m][0], gt = acc[ai][bj][m][1];
                    f32x4 v = *(const f32x4*)(xres + off);
#pragma unroll
                    for (int j = 0; j < 4; ++j) v[j] += val[j] * sigmoidf_(gt[j]);
                    *(f32x4*)(xres + off) = v;
                    store_bf4(xb + off, v);
                    ss += v.x * v.x + v.y * v.y + v.z * v.z + v.w * v.w;
                }
                ss += __shfl_xor(ss, 16); ss += __shfl_xor(ss, 32);
                if (fq == 0) atomicAdd(rowss_out + row, ss);
            }
    }
};

struct EpiQ {
    static constexpr bool INIT_X = false;
    bf16_t* qbuf; const float* rowss; const float* rope;
    DI void operator()(const AccT& acc, const Unit& u, int wr, int wc, int fr, int fq, int ui) const {
        const int row0 = u.pm * 256 + wr * 64 + fr;
#pragma unroll
        for (int ai = 0; ai < 2; ++ai)
#pragma unroll
            for (int m = 0; m < 4; ++m) {
                const int row = row0 + ai * 128 + m * 16;
                const float rs = rsqrtf(rowss[row] * (1.f / DM) + RMS_EPS) * 0.08838834764831845f;
                const int pos = row & (SEQ - 1);
#pragma unroll
                for (int bj = 0; bj < 2; ++bj) {
                    f32x4 v0 = acc[ai][bj][m][0] * rs, v1 = acc[ai][bj][m][1] * rs;
                    if (wc == 0) {
                        const f32x4* rp = (const f32x4*)(rope + ((size_t)pos * 16 + 4 * fq) * 2);
                        const f32x4 cs0 = rp[0], cs1 = rp[1];
                        const float c[4] = {cs0.x, cs0.z, cs1.x, cs1.z}, s[4] = {cs0.y, cs0.w, cs1.y, cs1.w};
#pragma unroll
                        for (int j = 0; j < 4; ++j) { const float x1 = v0[j], x2 = v1[j]; v0[j] = x1 * c[j] - x2 * s[j]; v1[j] = x2 * c[j] + x1 * s[j]; }
                    }
                    bf16_t* d = qbuf + (size_t)row * DM + u.pn * 256 + bj * 128 + 32 * wc + 4 * fq;
                    store_bf4(d, v0); store_bf4(d + 16, v1);
                }
            }
    }
};

DI void preload_rs(LAS unsigned char* lds, int vbid, const float* rowss, int N) {
    pg8::StaticOrder S; S.init(T_TOK, N, gridDim.x, vbid);
    LAS float* rsl = (LAS float*)(lds + 131072);
    pg8::Unit u;
    for (int i = 0; i < 8 && S.next(i, u); ++i)
        if (threadIdx.x < 256) rsl[i * 256 + threadIdx.x] = rsqrtf(rowss[u.pm * 256 + threadIdx.x] * (1.f / DM) + RMS_EPS);
    __syncthreads();
}
template <class Epi>
DI void run_gemm_v(LAS unsigned char* lds, int vbid, const bf16_t* A, const bf16_t* Bt, int N, int K, const Epi& E) {
    pg8::Gemm g{A, Bt, T_TOK, N, K};
    pg8::StaticOrder S; S.init(T_TOK, N, gridDim.x, vbid);
    pg8::gemm_phase<Epi>(lds, g, S, E);
}

struct S5Coef { float ar, ai, cr, ci; };
DI S5Coef s5_coefs_compute(const Params& P, int g, int p) {
    const float dt = expf(P.log_step[g]); const float lr = P.a_re[g * 64 + p], li = P.a_im[g * 64 + p];
    const float mag = expf(lr * dt); S5Coef c; c.ar = mag * cosf(li * dt); c.ai = mag * sinf(li * dt);
    const float nr = c.ar - 1.f, ni = c.ai, den = lr * lr + li * li;
    c.cr = (nr * lr + ni * li) / den; c.ci = (ni * lr - nr * li) / den; return c;
}
DI S5Coef s5_coefs(const Params& P, int g, int p) { const f32x4 v = *(const f32x4*)(P.s5tab + (size_t)(g * 64 + p) * 4); S5Coef c; c.ar = v.x; c.ai = v.y; c.cr = v.z; c.ci = v.w; return c; }

DI void p0_transpose_item(const WJob& J, LAS float* scr, int item, int lane) {
    const int nblk = J.ndst / 32, kb = item / nblk, nb = item % nblk, k0 = 64 * kb, r0 = 32 * nb;
    const int i = lane & 31;
    int scol;
    if (J.mode == 0) scol = r0 + i;
    else { const int G = r0 >> 5; scol = (i < 16) ? (16 * G + i) : ((J.Nsrc >> 1) + 16 * G + (i - 16)); }
    float wv[32];
    const float* wp = J.W + (size_t)(k0 + (lane >> 5)) * J.Nsrc + scol;
#pragma unroll
    for (int it = 0; it < 32; ++it) wv[it] = wp[(size_t)(2 * it) * J.Nsrc];
    if (J.g) {
        const float* gp = J.g + k0 + (lane >> 5);
#pragma unroll
        for (int it = 0; it < 32; ++it) wv[it] *= gp[2 * it];
    }
    if (J.scale != 1.f) {
#pragma unroll
        for (int it = 0; it < 32; ++it) wv[it] *= J.scale;
    }
#pragma unroll
    for (int it = 0; it < 32; ++it) scr[(2 * it + (lane >> 5)) * 33 + i] = wv[it];
    __builtin_amdgcn_fence(__ATOMIC_RELEASE, "wavefront"); __builtin_amdgcn_wave_barrier(); __builtin_amdgcn_fence(__ATOMIC_ACQUIRE, "wavefront");
    const int c = lane & 7;
#pragma unroll
    for (int j = 0; j < 4; ++j) {
        const int n = (lane >> 3) + 8 * j; const LAS float* s = scr + (8 * c) * 33 + n;
        u32x4 o; o.x = cvt_pk_bf16(s[0 * 33], s[1 * 33]); o.y = cvt_pk_bf16(s[2 * 33], s[3 * 33]); o.z = cvt_pk_bf16(s[4 * 33], s[5 * 33]); o.w = cvt_pk_bf16(s[6 * 33], s[7 * 33]);
        *(u32x4*)(J.dst + (size_t)(r0 + n) * J.K + k0 + 8 * c) = o;
    }
    __builtin_amdgcn_fence(__ATOMIC_RELEASE, "wavefront"); __builtin_amdgcn_wave_barrier(); __builtin_amdgcn_fence(__ATOMIC_ACQUIRE, "wavefront");
}

DI void convert_items(const Params& P, LAS unsigned char* lds, int lo, int hi, int gw, int NGW) {
    const int wave = threadIdx.x >> 6, lane = threadIdx.x & 63;
    LAS float* scr = (LAS float*)(lds + wave * 16384);
    for (int it = lo + gw; it < hi; it += NGW) {
        int j = 0;
#pragma unroll 1
        for (int q = 1; q < NJOBS; ++q) if (it >= P.jobs[q].item0) j = q;
        p0_transpose_item(P.jobs[j], scr, it - P.jobs[j].item0, lane);
    }
}
DI void convert_by_light_blocks(const Params& P, LAS unsigned char* lds, int vbid, int units, int lo, int hi) {
    asm volatile("" : "+s"(vbid), "+s"(lo), "+s"(hi));
    const int G = gridDim.x, extra = units % G, first = extra, nlight = G - extra;
    if (vbid >= first) convert_items(P, lds, lo, hi, (vbid - first) * 8 + (threadIdx.x >> 6), nlight * 8);
}

DI void phase_prep(const Params& P, LAS unsigned char* lds) {
    const int tid = threadIdx.x, wave = tid >> 6, lane = tid & 63;
    const int gw = blockIdx.x * 8 + wave, NGW = gridDim.x * 8;
    LAS float* scr = (LAS float*)(lds + wave * 16384);
    convert_items(P, lds, 0, P.it1, gw, NGW);
    for (int row = gw; row < T_TOK; row += NGW) {
        const f32x4* xr = (const f32x4*)(P.x + (size_t)row * DM) + lane;
        f32x4 v[4]; float s = 0.f;
#pragma unroll
        for (int j = 0; j < 4; ++j) { v[j] = xr[64 * j]; s += v[j].x * v[j].x + v[j].y * v[j].y + v[j].z * v[j].z + v[j].w * v[j].w; }
        s = wave_sum(s);
        if (lane == 0) P.rowss[row] = s;
        bf16_t* o = P.xb + (size_t)row * DM + 4 * lane;
#pragma unroll
        for (int j = 0; j < 4; ++j) store_bf4(o + 256 * j, v[j]);
    }
    const int gt = blockIdx.x * 512 + tid, NGT = gridDim.x * 512;
    for (int i = gt; i < 6 * T_TOK; i += NGT) P.rowss[T_TOK + i] = 0.f;
    if (gt < 128) P.gcount[gt] = 0;
    if (gt < 64) P.pcnt[gt] = 0;
    for (int i = gt; i < 4096; i += NGT) { const S5Coef c = s5_coefs_compute(P, i >> 6, i & 63); *(f32x4*)(P.s5tab + (size_t)i * 4) = (f32x4){c.ar, c.ai, c.cr, c.ci}; }
    for (int i = gt; i < SEQ * 16; i += NGT) {
        const int pos = i >> 4, d = i & 15;
        const float inv = exp2f(-(float)d * (18.931568569324174f / 16.f));
        const float ang = (float)pos * inv;
        P.rope[2 * i] = cosf(ang); P.rope[2 * i + 1] = sinf(ang);
    }
}

DI float gelu_tanh(float x) { const float u = 0.7978845608028654f * (x + 0.044715f * x * x * x); return x * __builtin_amdgcn_rcpf(1.f + __builtin_amdgcn_exp2f(-2.f * 1.4426950408889634f * u)); }

typedef float f32x16 __attribute__((ext_vector_type(16)));
typedef __bf16 bf2_t __attribute__((ext_vector_type(2)));
DI unsigned pk_bf16(float lo, float hi) { const f32x2 v = {lo, hi}; return __builtin_bit_cast(unsigned, __builtin_convertvector(v, bf2_t)); }
#define WAVE_LDS_SYNC() asm volatile("s_waitcnt lgkmcnt(0)" ::: "memory")

DI void s5_bfrags(const Params& P, int g, int lane, bf16x8 (&bf)[4]) {
    const int q = lane & 31, h = lane >> 5;
#pragma unroll
    for (int pj = 0; pj < 2; ++pj) {
        const int p = q + 32 * pj;
        const S5Coef c = s5_coefs(P, g, p);
        const f32x4* br = (const f32x4*)(P.b_re + ((size_t)g * 64 + p) * 16 + 8 * h);
        const f32x4* bi = (const f32x4*)(P.b_im + ((size_t)g * 64 + p) * 16 + 8 * h);
        const f32x4 r0 = br[0], r1 = br[1], i0 = bi[0], i1 = bi[1];
        float re[8], im[8];
#pragma unroll
        for (int j = 0; j < 4; ++j) {
            re[j] = c.cr * r0[j] - c.ci * i0[j]; im[j] = c.cr * i0[j] + c.ci * r0[j];
            re[4 + j] = c.cr * r1[j] - c.ci * i1[j]; im[4 + j] = c.cr * i1[j] + c.ci * r1[j];
        }
        const u32x4 wr = {pk_bf16(re[0], re[1]), pk_bf16(re[2], re[3]), pk_bf16(re[4], re[5]), pk_bf16(re[6], re[7])};
        const u32x4 wi = {pk_bf16(im[0], im[1]), pk_bf16(im[2], im[3]), pk_bf16(im[4], im[5]), pk_bf16(im[6], im[7])};
        bf[2 * pj] = __builtin_bit_cast(bf16x8, wr); bf[2 * pj + 1] = __builtin_bit_cast(bf16x8, wi);
    }
}
DI bf16x8 s5_ufrag(const Params& P, int rowbase, int g, int lane, const f32x4& ga, const f32x4& gb) {
    const int t = lane & 31, h = lane >> 5, row = rowbase + t;
    const float rs = rsqrtf(P.rowss[T_TOK + row] * (1.f / DM) + RMS_EPS);
    const f32x4* xp = (const f32x4*)(P.xres + (size_t)row * DM + 16 * g + 8 * h);
    const f32x4 a = xp[0] * rs * ga, b = xp[1] * rs * gb;
    const u32x4 w = {pk_bf16(a.x, a.y), pk_bf16(a.z, a.w), pk_bf16(b.x, b.y), pk_bf16(b.z, b.w)};
    return __builtin_bit_cast(bf16x8, w);
}
template <bool WRITE>
DI void s5_scan32(const f32x16 (&X)[4], int h, int p, float ar, float ai, float& hr, float& hi, LAS unsigned char* hs) {
    float lo_re[16], lo_im[16], hi_re[16], hi_im[16];
#pragma unroll
    for (int r = 0; r < 16; ++r) {
        const auto sr = __builtin_amdgcn_permlane32_swap(__float_as_uint(X[0][r]), __float_as_uint(X[2][r]), false, false);
        const auto si = __builtin_amdgcn_permlane32_swap(__float_as_uint(X[1][r]), __float_as_uint(X[3][r]), false, false);
        lo_re[r] = __uint_as_float(sr[0]); hi_re[r] = __uint_as_float(sr[1]);
        lo_im[r] = __uint_as_float(si[0]); hi_im[r] = __uint_as_float(si[1]);
    }
#pragma unroll
    for (int i = 0; i < 4; ++i)
#pragma unroll
        for (int half = 0; half < 2; ++half)
#pragma unroll
            for (int j = 0; j < 4; ++j) {
                const int r = 4 * i + j, token = 8 * i + 4 * half + j;
                const float xr = half ? hi_re[r] : lo_re[r], xi = half ? hi_im[r] : lo_im[r];
                const float nhr = ar * hr - ai * hi + xr, nhi = ar * hi + ai * hr + xi; hr = nhr; hi = nhi;
                if (WRITE) {
                    const unsigned whi = pk_bf16(hr, hi);
                    *(LAS unsigned*)(hs + token * 272 + 4 * p) = whi;
                    *(LAS unsigned*)(hs + 69632 + token * 272 + 4 * p) = pk_bf16(hr - bf_lo(whi), hi - bf_hi(whi));
                }
            }
}

struct S5In { f32x4 x0, x1; float ss; };
DI S5In s5_in_load(const Params& P, int rowbase, int g, int lane) {
    const int row = rowbase + (lane & 31);
    const f32x4* xp = (const f32x4*)(P.xres + (size_t)row * DM + 16 * g + 8 * (lane >> 5));
    S5In r; r.x0 = xp[0]; r.x1 = xp[1]; r.ss = P.rowss[T_TOK + row]; return r;
}
DI bf16x8 s5_in_frag(const S5In& in, const f32x4& ga, const f32x4& gb) {
    const float rs = rsqrtf(in.ss * (1.f / DM) + RMS_EPS);
    const f32x4 a = in.x0 * rs * ga, b = in.x1 * rs * gb;
    const u32x4 w = {pk_bf16(a.x, a.y), pk_bf16(a.z, a.w), pk_bf16(b.x, b.y), pk_bf16(b.z, b.w)};
    return __builtin_bit_cast(bf16x8, w);
}
DI int s5_row0(int L, int wave) { const int bc = L & 31; return (bc >> 4) * SEQ + ((bc & 15) * 8 + wave) * 64; }

DI void phase_s5a(const Params& P, LAS unsigned char* lds) {
    const int tid = threadIdx.x, wave = tid >> 6, lane = tid & 63, h = lane >> 5;
    for (int base = blockIdx.x * 8; base < 2048; base += gridDim.x * 8) {
        const int g = base >> 5;
        const S5Coef cf = s5_coefs(P, g, lane);
        bf16x8 bf[4]; s5_bfrags(P, g, lane, bf);
        const f32x4 ga = *(const f32x4*)(P.norm_g + DM + 16 * g + 8 * h), gb = *(const f32x4*)(P.norm_g + DM + 16 * g + 8 * h + 4);
        float hr = 0.f, hi = 0.f;
        S5In pre = s5_in_load(P, s5_row0(base, wave), g, lane);
#pragma unroll 1
        for (int step = 0; step < 16; ++step) {
            const int L = base + (step >> 1), sub = step & 1;
            const S5In cur = pre;
            if (step < 15) pre = s5_in_load(P, s5_row0(base + ((step + 1) >> 1), wave) + 32 * ((step + 1) & 1), g, lane);
            const bf16x8 a = s5_in_frag(cur, ga, gb);
            f32x16 X[4];
#pragma unroll
            for (int j = 0; j < 4; ++j) {
#pragma unroll
                for (int r = 0; r < 16; ++r) X[j][r] = 0.f;
                X[j] = __builtin_amdgcn_mfma_f32_32x32x16_bf16(a, bf[j], X[j], 0, 0, 0);
            }
            if (sub == 0) { hr = 0.f; hi = 0.f; }
            s5_scan32<false>(X, h, lane, cf.ar, cf.ai, hr, hi, lds);
            if (sub == 1) { const int bc = L & 31, ch = (bc & 15) * 8 + wave; *(f32x2*)(P.E + ((size_t)(((bc >> 4) * 128 + ch) * 64 + g) * 64 + lane) * 2) = (f32x2){hr, hi}; }
        }
    }
}

DI void phase_s5carry(const Params& P) {
    if (blockIdx.x < 128 && threadIdx.x < 64) {
        const int idx = blockIdx.x * 64 + threadIdx.x, b = idx >> 12, g = (idx >> 6) & 63, p = idx & 63;
        const S5Coef cf = s5_coefs(P, g, p);
        float alr = cf.ar, ali = cf.ai;
#pragma unroll
        for (int q = 0; q < 6; ++q) { const float r = alr * alr - ali * ali, i2 = 2.f * alr * ali; alr = r; ali = i2; }
        f32x2* Ep = (f32x2*)P.E + (size_t)(b * 128) * 4096 + g * 64 + p;
        float hr = 0.f, hi = 0.f;
#pragma unroll 1
        for (int j0 = 0; j0 < 128; j0 += 32) {
            f32x2 e[32];
#pragma unroll
            for (int u = 0; u < 32; ++u) e[u] = Ep[(size_t)(j0 + u) * 4096];
#pragma unroll
            for (int u = 0; u < 32; ++u) {
                Ep[(size_t)(j0 + u) * 4096] = (f32x2){hr, hi};
                const float nr = alr * hr - ali * hi + e[u].x, ni = alr * hi + ali * hr + e[u].y; hr = nr; hi = ni;
            }
        }
    }
}

DI void phase_s5b(const Params& P, LAS unsigned char* lds) {
    const int tid = threadIdx.x, wave = tid >> 6, lane = tid & 63, h = lane >> 5, c16 = lane & 15, kq = lane >> 4;
    LAS unsigned char* hs = lds + wave * 8704;
    for (int base = blockIdx.x * 8; base < 2048; base += gridDim.x * 8) {
        const int g = base >> 5;
        const S5Coef cf = s5_coefs(P, g, lane);
        bf16x8 bf[4]; s5_bfrags(P, g, lane, bf);
        const f32x4 ga = *(const f32x4*)(P.norm_g + DM + 16 * g + 8 * h), gb = *(const f32x4*)(P.norm_g + DM + 16 * g + 8 * h + 4);
        bf16x8 cmf[4], cml[4];
#pragma unroll
        for (int ks = 0; ks < 4; ++ks) {
            const int p0 = ks * 16 + kq * 4;
            const f32x4 cr = *(const f32x4*)(P.c_re + ((size_t)g * 16 + c16) * 64 + p0), ci = *(const f32x4*)(P.c_im + ((size_t)g * 16 + c16) * 64 + p0);
            const float v[8] = {cr.x, -ci.x, cr.y, -ci.y, cr.z, -ci.z, cr.w, -ci.w};
            u32x4 wh, wl;
#pragma unroll
            for (int e = 0; e < 4; ++e) { wh[e] = pk_bf16(v[2 * e], v[2 * e + 1]); wl[e] = pk_bf16(v[2 * e] - bf_lo(wh[e]), v[2 * e + 1] - bf_hi(wh[e])); }
            cmf[ks] = __builtin_bit_cast(bf16x8, wh); cml[ks] = __builtin_bit_cast(bf16x8, wl);
        }
        const f32x4 d4 = *(const f32x4*)(P.s5_d + 16 * g + 4 * kq), ge = *(const f32x4*)(P.norm_g + DM + 16 * g + 4 * kq);
        float hr = 0.f, hi = 0.f;
        S5In pre = s5_in_load(P, s5_row0(base, wave), g, lane);
        f32x2 cpre; { const int bc = base & 31, ch = (bc & 15) * 8 + wave; cpre = *((const f32x2*)P.E + ((size_t)((bc >> 4) * 128 + ch) * 64 + g) * 64 + lane); }
#pragma unroll 1
        for (int step = 0; step < 16; ++step) {
            const int L = base + (step >> 1), sub = step & 1, rowb = s5_row0(L, wave) + 32 * sub;
            const S5In cur = pre;
            if (sub == 0) { hr = cpre.x; hi = cpre.y; }
            if (step < 15) pre = s5_in_load(P, s5_row0(base + ((step + 1) >> 1), wave) + 32 * ((step + 1) & 1), g, lane);
            if (sub == 1 && step < 15) { const int bc = (L + 1) & 31, ch = (bc & 15) * 8 + wave; cpre = *((const f32x2*)P.E + ((size_t)((bc >> 4) * 128 + ch) * 64 + g) * 64 + lane); }
            const bf16x8 a = s5_in_frag(cur, ga, gb);
            f32x16 X[4];
#pragma unroll
            for (int j = 0; j < 4; ++j) {
#pragma unroll
                for (int r = 0; r < 16; ++r) X[j][r] = 0.f;
                X[j] = __builtin_amdgcn_mfma_f32_32x32x16_bf16(a, bf[j], X[j], 0, 0, 0);
            }
            s5_scan32<true>(X, h, lane, cf.ar, cf.ai, hr, hi, hs);
            WAVE_LDS_SYNC();
#pragma unroll
            for (int tt = 0; tt < 2; ++tt) {
                f32x4 acc = {0.f, 0.f, 0.f, 0.f};
#pragma unroll
                for (int ks = 0; ks < 4; ++ks) {
                    const LAS unsigned char* ha = hs + (tt * 16 + c16) * 272 + ks * 64 + kq * 16;
                    const bf16x8 hbh = *(const LAS bf16x8*)ha, hbl = *(const LAS bf16x8*)(ha + 69632);
                    acc = __builtin_amdgcn_mfma_f32_16x16x32_bf16(cml[ks], hbh, acc, 0, 0, 0);
                    acc = __builtin_amdgcn_mfma_f32_16x16x32_bf16(cmf[ks], hbl, acc, 0, 0, 0);
                    acc = __builtin_amdgcn_mfma_f32_16x16x32_bf16(cmf[ks], hbh, acc, 0, 0, 0);
                }
                const int row = rowb + 16 * tt + c16;
                const float rs = rsqrtf(P.rowss[T_TOK + row] * (1.f / DM) + RMS_EPS);
                const f32x4 u4 = *(const f32x4*)(P.xres + (size_t)row * DM + 16 * g + 4 * kq) * rs * ge;
                f32x4 y;
#pragma unroll
                for (int j = 0; j < 4; ++j) y[j] = gelu_tanh(acc[j] + d4[j] * u4[j]);
                store_bf4(P.yb + (size_t)row * DM + 16 * g + 4 * kq, y);
            }
            WAVE_LDS_SYNC();
        }
    }
}

DI void phase_kmean(const Params& P, LAS unsigned char* lds) {
    if (blockIdx.x < 128) {
        const int j = blockIdx.x, d = threadIdx.x & 127, part = threadIdx.x >> 7;
        const bf16_t* kb = P.kbuf + ((size_t)(j >> 5) * SEQ + (j & 31) * 256 + part * 64) * 128 + d;
        float s = 0.f;
#pragma unroll 1
        for (int k0 = 0; k0 < 64; k0 += 16) {
            unsigned short v[16];
#pragma unroll
            for (int u = 0; u < 16; ++u) v[u] = kb[(size_t)(k0 + u) * 128];
#pragma unroll
            for (int u = 0; u < 16; ++u) s += __uint_as_float(((unsigned)v[u]) << 16);
        }
        LAS float* red = (LAS float*)lds;
        red[threadIdx.x] = s;
        __syncthreads();
        if (threadIdx.x < 128) P.kmean[j * 128 + d] = (red[d] + red[128 + d] + red[256 + d] + red[384 + d]) * (1.f / 256.f);
    }
}

DI int list_off(int c, int n) { return c * (496 * 1024) + 1024 * (31 * n - (n * (n - 1)) / 2); }

DI void phase_gate(const Params& P, LAS unsigned char* lds) {
    const int tid = threadIdx.x, wave = tid >> 6, lane = tid & 63;
    LAS float* km = (LAS float*)lds;
    LAS int* cnt = (LAS int*)(lds + 32768);
    LAS int* base = cnt + 64;
    for (int qb = blockIdx.x; qb < 256; qb += gridDim.x) {
        const int b = qb >> 7, i = qb & 127, own = i >> 2;
        for (int e = tid; e < 2048; e += 512) {
            const f32x4 v = ((const f32x4*)(P.kmean + b * 8192))[e];
            const int hn = e >> 5, d4 = (e & 31) * 4, hk2 = hn >> 5, n = hn & 31;
            LAS float* dst = km + (hk2 * 128 + d4) * 32 + n;
            dst[0] = v.x; dst[32] = v.y; dst[64] = v.z; dst[96] = v.w;
        }
        if (tid < 64) cnt[tid] = 0;
        __syncthreads();
        const int hq = wave, hk = hq >> 2, t = b * SEQ + i * 64 + lane;
        f32x2 g2[16];
#pragma unroll
        for (int n2 = 0; n2 < 16; ++n2) g2[n2] = (f32x2){0.f, 0.f};
        const u32x4* qr = (const u32x4*)(P.qbuf + (size_t)t * DM + hq * 128);
        {
            u32x4 wa = qr[0], wb = qr[1];
#pragma unroll 1
            for (int c = 0; c < 16; ++c) {
                const u32x4 w = wa; wa = wb; wb = qr[(c + 2) & 15];
                const float qv[8] = {bf_lo(w.x), bf_hi(w.x), bf_lo(w.y), bf_hi(w.y), bf_lo(w.z), bf_hi(w.z), bf_lo(w.w), bf_hi(w.w)};
#pragma unroll
                for (int j = 0; j < 8; ++j) {
                    const LAS f32x4* kp = (const LAS f32x4*)(km + (hk * 128 + 8 * c + j) * 32);
#pragma unroll
                    for (int i4 = 0; i4 < 8; ++i4) {
                        const f32x4 k4 = kp[i4];
                        g2[2 * i4] += (f32x2){k4.x, k4.y} * qv[j];
                        g2[2 * i4 + 1] += (f32x2){k4.z, k4.w} * qv[j];
                    }
                }
            }
        }
        float g[32];
#pragma unroll
        for (int n = 0; n < 32; ++n) g[n] = g2[n >> 1][n & 1];
        const int nsel = own < 3 ? own : 3;
        int s0 = -1, s1 = -1, s2 = -1;
        { float best = -3e38f;
#pragma unroll
          for (int n = 0; n < 32; ++n) if (n < own && g[n] > best) { best = g[n]; s0 = n; } }
        { float best = -3e38f;
#pragma unroll
          for (int n = 0; n < 32; ++n) if (n < own && n != s0 && g[n] > best) { best = g[n]; s1 = n; } }
        { float best = -3e38f;
#pragma unroll
          for (int n = 0; n < 32; ++n) if (n < own && n != s0 && n != s1 && g[n] > best) { best = g[n]; s2 = n; } }
        int l0 = 0, l1 = 0, l2 = 0;
        if (nsel > 0) l0 = atomicAdd((int*)&cnt[hk * 32 + s0], 1);
        if (nsel > 1) l1 = atomicAdd((int*)&cnt[hk * 32 + s1], 1);
        if (nsel > 2) l2 = atomicAdd((int*)&cnt[hk * 32 + s2], 1);
        __syncthreads();
        if (tid < 64) { const int c = cnt[tid]; base[tid] = c > 0 ? atomicAdd(P.gcount + b * 64 + tid, c) : 0; }
        __syncthreads();
        const int row = t * 8 + hq, c2 = b * 2 + hk;
        if (nsel > 0) P.lists[list_off(c2, s0) + base[hk * 32 + s0] + l0] = row * 4 + 1;
        if (nsel > 1) P.lists[list_off(c2, s1) + base[hk * 32 + s1] + l1] = row * 4 + 2;
        if (nsel > 2) P.lists[list_off(c2, s2) + base[hk * 32 + s2] + l2] = row * 4 + 3;
        __syncthreads();
    }
}

template <bool OWN>
DI void phase_attn(const Params& P, LAS unsigned char* lds, int bid) {
    const int tid = threadIdx.x, wave = __builtin_amdgcn_readfirstlane(tid >> 6), lane = tid & 63, h = lane >> 5, l32 = lane & 31;
    LAS unsigned char* Ks = lds;
    LAS unsigned char* Vs = lds + 69632;
    LAS int* pref = (LAS int*)(lds + 136192);
    if constexpr (!OWN) {
        LAS int* cntl = pref + 132;
        if (tid < 128) cntl[tid] = (P.gcount[tid] + 255) >> 8;
        __syncthreads();
        if (tid <= 128) { int a = 0; for (int i = 0; i < 128; ++i) a += (i < tid) ? cntl[i] : 0; pref[tid] = a; }
        __syncthreads();
    }
    const int total = OWN ? 512 : pref[128];
    constexpr float LOG2E = 1.4426950408889634f;
    int rnd = 0;
    for (int idx = bid; idx < total; idx += gridDim.x, ++rnd) {
        const int item = (OWN && (rnd & 1)) ? (idx ^ 3) : idx;
        int c, n, i_q = 0, nrows = 256; const int* lst = P.lists; constexpr bool is_own = OWN;
        if (is_own) { c = item >> 7; i_q = item & 127; n = i_q >> 2; }
        else {
            const int s = item; int lo = 0, hi = 128;
            while (hi - lo > 1) { const int mid = (lo + hi) >> 1; if (pref[mid] <= s) lo = mid; else hi = mid; }
            c = lo >> 5; n = lo & 31; const int grp = s - pref[lo]; lst = P.lists + list_off(c, n) + grp * 256; nrows = P.gcount[lo] - grp * 256; if (nrows > 256) nrows = 256;
        }
        const int b = c >> 1, hk = c & 1;
        int ent; bool valid = true; const int rho = wave * 32 + l32;
        if (is_own) { const int hq = hk * 4 + (rho >> 6), t = b * SEQ + i_q * 64 + (rho & 63); ent = (t * 8 + hq) * 4; }
        else { valid = rho < nrows; ent = lst[valid ? rho : 0]; }
        bf16x8 qf[8];
        {
            const bf16_t* kg = P.kbuf + ((size_t)c * SEQ + n * 256) * 128;
            const bf16_t* vg = P.vT + (size_t)c * 128 * SEQ + n * 256;
            const bf16_t* kgl = kg + (size_t)(tid >> 4) * 128 + (tid & 15) * 8;
            LAS unsigned char* kl = Ks + (tid >> 4) * 272 + (tid & 15) * 16;
            const bf16_t* vgl = vg + (size_t)(tid >> 5) * SEQ + (tid & 31) * 8;
            LAS unsigned char* vl = Vs + (tid >> 5) * 520 + (tid & 31) * 16;
            u32x4 kw[8], vw[8];
#pragma unroll
            for (int q = 0; q < 8; ++q) kw[q] = *(const u32x4*)(kgl + q * 4096);
#pragma unroll
            for (int q = 0; q < 8; ++q) vw[q] = *(const u32x4*)(vgl + (size_t)q * 16 * SEQ);
        { const int row = ent >> 2, t = row >> 3, hq = row & 7; const bf16_t* qp = P.qbuf + (size_t)t * DM + hq * 128 + 8 * h;
#pragma unroll
          for (int ks = 0; ks < 8; ++ks) qf[ks] = *(const bf16x8*)(qp + ks * 16); }
#pragma unroll
            for (int q = 0; q < 8; ++q) *(LAS u32x4*)(kl + q * 8704) = kw[q];
#pragma unroll
            for (int q = 0; q < 8; ++q) { LAS u32x2* dst = (LAS u32x2*)(vl + q * 8320); dst[0] = (u32x2){vw[q].x, vw[q].y}; dst[1] = (u32x2){vw[q].z, vw[q].w}; }
        }
        __syncthreads();
        if (wave < 4) __builtin_amdgcn_s_setprio(2);
        if (wave * 32 < nrows) {
            const int nkt = is_own ? (2 * (i_q & 3) + (wave & 1) + 1) : 8;
            const int posb = is_own ? (64 * (i_q & 3) + (rho & 63)) : 100000;
            float m_run = -1e30f, l_run = 0.f;
            f32x16 o[4];
#pragma unroll
            for (int db = 0; db < 4; ++db)
#pragma unroll
                for (int r = 0; r < 16; ++r) o[db][r] = 0.f;
#pragma unroll 1
            for (int hf = 0; hf < 2; ++hf) {
                if (4 * hf >= nkt) break;
                f32x16 s[4];
#pragma unroll
                for (int kq = 0; kq < 4; ++kq) {
                    const int kt = 4 * hf + kq;
                    if (kt < nkt) {
#pragma unroll
                        for (int r = 0; r < 16; ++r) s[kq][r] = 0.f;
#pragma unroll
                        for (int ks = 0; ks < 8; ++ks) {
                            const bf16x8 a = *(const LAS bf16x8*)(Ks + (kt * 32 + l32) * 272 + ks * 32 + 16 * h);
                            s[kq] = __builtin_amdgcn_mfma_f32_32x32x16_bf16(a, qf[ks], s[kq], 0, 0, 0);
                            asm volatile("" :: "v"(a));
                        }
                        if (is_own) {
#pragma unroll
                            for (int r = 0; r < 16; ++r) { const int key = kt * 32 + (r & 3) + 8 * (r >> 2) + 4 * h; if (key > posb) s[kq][r] = -1e30f; }
                        }
                    } else {
#pragma unroll
                        for (int r = 0; r < 16; ++r) s[kq][r] = -1e30f;
                    }
                    __builtin_amdgcn_sched_barrier(0);
                }
                float mx = -1e30f;
#pragma unroll
                for (int kq = 0; kq < 4; ++kq)
#pragma unroll
                    for (int r = 0; r < 16; ++r) mx = fmaxf(mx, s[kq][r]);
                mx = fmaxf(mx, __shfl_xor(mx, 32));
                const float m_new = fmaxf(m_run, mx), mL = m_new * LOG2E;
                const float alpha = __builtin_amdgcn_exp2f((m_run - m_new) * LOG2E);
                float lsum = 0.f;
#pragma unroll
                for (int kq = 0; kq < 4; ++kq)
#pragma unroll
                    for (int r = 0; r < 16; ++r) { const float p = __builtin_amdgcn_exp2f(s[kq][r] * LOG2E - mL); s[kq][r] = p; lsum += p; }
                lsum += __shfl_xor(lsum, 32);
                l_run = l_run * alpha + lsum; m_run = m_new;
                if (hf == 1) {
#pragma unroll
                    for (int db = 0; db < 4; ++db)
#pragma unroll
                        for (int r = 0; r < 16; ++r) o[db][r] *= alpha;
                }
#pragma unroll
                for (int kq = 0; kq < 4; ++kq) {
                    const int kt = 4 * hf + kq;
                    if (kt < nkt) {
#pragma unroll
                        for (int st = 0; st < 2; ++st) {
                            u32x4 pw;
                            pw.x = pk_bf16(s[kq][8 * st + 0], s[kq][8 * st + 1]); pw.y = pk_bf16(s[kq][8 * st + 2], s[kq][8 * st + 3]);
                            pw.z = pk_bf16(s[kq][8 * st + 4], s[kq][8 * st + 5]); pw.w = pk_bf16(s[kq][8 * st + 6], s[kq][8 * st + 7]);
                            const bf16x8 pf = __builtin_bit_cast(bf16x8, pw);
#pragma unroll
                            for (int db = 0; db < 4; ++db) {
                                const LAS unsigned char* va = Vs + (32 * db + l32) * 520 + (kt * 32 + 16 * st + 4 * h) * 2;
                                const u32x2 vlo = *(const LAS u32x2*)va, vhi = *(const LAS u32x2*)(va + 16);
                                const u32x4 vw = {vlo.x, vlo.y, vhi.x, vhi.y};
                                o[db] = __builtin_amdgcn_mfma_f32_32x32x16_bf16(__builtin_bit_cast(bf16x8, vw), pf, o[db], 0, 0, 0);
                            }
                            __builtin_amdgcn_sched_barrier(0);
                        }
                    }
                }
            }
            asm volatile("" : "+v"(ent));
            if constexpr (!OWN) {
                if (valid) {
                    const float inv = 1.f / l_run;
                    const int slot = ent & 3; const int row = ent >> 2;
                    if (h == 0) *(f32x2*)(P.part_ml + (size_t)ent * 2) = (f32x2){m_run, l_run};
                    int h2 = h; asm volatile("" : "+v"(h2));
                    bf16_t* pb = P.part[1];
                    if (slot == 2) pb = P.part[2]; else if (slot == 3) pb = P.part[3];
                    bf16_t* po = pb + ((size_t)row * 128 + 4 * h2);
#pragma unroll
                    for (int db = 0; db < 4; ++db)
#pragma unroll
                        for (int rq = 0; rq < 4; ++rq) {
                            u32x2 w; w.x = pk_bf16(o[db][4 * rq] * inv, o[db][4 * rq + 1] * inv); w.y = pk_bf16(o[db][4 * rq + 2] * inv, o[db][4 * rq + 3] * inv);
                            *(u32x2*)(po + 32 * db + 8 * rq) = w;
                        }
                }
            } else {
                const int row = ent >> 2, nsel = n < 3 ? n : 3;
                int h2 = h; asm volatile("" : "+v"(h2));
                float M = m_run; f32x2 ml[3];
#pragma unroll
                for (int s2 = 0; s2 < 3; ++s2) { ml[s2] = (f32x2){-1e30f, 0.f}; if (s2 < nsel) { ml[s2] = *(const f32x2*)(P.part_ml + ((size_t)row * 4 + s2 + 1) * 2); M = fmaxf(M, ml[s2].x); } }
                const float w0 = __builtin_amdgcn_exp2f((m_run - M) * LOG2E);
                float ws[3], L = l_run * w0;
#pragma unroll
                for (int s2 = 0; s2 < 3; ++s2) { ws[s2] = ml[s2].y * __builtin_amdgcn_exp2f((ml[s2].x - M) * LOG2E); L += ws[s2]; }
                const float inv = 1.f / L, w0i = w0 * inv;
                const size_t poff = (size_t)row * 128 + 4 * h2;
                bf16_t* ao = P.attn + (size_t)(row >> 3) * DM + (row & 7) * 128 + 4 * h2;
#pragma unroll
                for (int db = 0; db < 4; ++db) {
                    u32x2 pv[3][4];
#pragma unroll
                    for (int s2 = 0; s2 < 3; ++s2)
#pragma unroll
                        for (int rq = 0; rq < 4; ++rq) { pv[s2][rq] = (u32x2){0u, 0u}; if (s2 < nsel) pv[s2][rq] = *(const u32x2*)(P.part[s2 + 1] + poff + 32 * db + 8 * rq); }
#pragma unroll
                    for (int rq = 0; rq < 4; ++rq) {
                        float a0 = o[db][4 * rq] * w0i, a1 = o[db][4 * rq + 1] * w0i, a2 = o[db][4 * rq + 2] * w0i, a3 = o[db][4 * rq + 3] * w0i;
#pragma unroll
                        for (int s2 = 0; s2 < 3; ++s2) { const float wv = ws[s2] * inv; a0 += wv * bf_lo(pv[s2][rq].x); a1 += wv * bf_hi(pv[s2][rq].x); a2 += wv * bf_lo(pv[s2][rq].y); a3 += wv * bf_hi(pv[s2][rq].y); }
                        u32x2 w; w.x = pk_bf16(a0, a1); w.y = pk_bf16(a2, a3);
                        *(u32x2*)(ao + 32 * db + 8 * rq) = w;
                    }
                }
            }
        }
        __builtin_amdgcn_s_setprio(0);
        __syncthreads();
    }
}

DI void phase_combine(const Params& P) {
    const int tid = threadIdx.x, wave = tid >> 6, lane = tid & 63;
    const int gw = blockIdx.x * 8 + wave, NGW = gridDim.x * 8;
    for (int row = gw; row < T_TOK * 8; row += NGW) {
        const int t = row >> 3, hq = row & 7, own = (t & (SEQ - 1)) >> 8, nsel = own < 3 ? own : 3;
        float m[4], l[4];
#pragma unroll
        for (int s = 0; s < 4; ++s) { if (s <= nsel) { const f32x2 ml = *(const f32x2*)(P.part_ml + ((size_t)row * 4 + s) * 2); m[s] = ml.x; l[s] = ml.y; } else { m[s] = -1e30f; l[s] = 0.f; } }
        const float M = fmaxf(fmaxf(m[0], m[1]), fmaxf(m[2], m[3]));
        float o0 = 0.f, o1 = 0.f, L = 0.f;
#pragma unroll
        for (int s = 0; s < 4; ++s) {
            if (s <= nsel) {
                const float w = l[s] * __expf(m[s] - M); L += w;
                const unsigned v = *(const unsigned*)(P.part[s] + (size_t)row * 128 + 2 * lane);
                o0 += w * bf_lo(v); o1 += w * bf_hi(v);
            }
        }
        const float inv = 1.f / L;
        *(unsigned*)(P.attn + (size_t)t * DM + hq * 128 + 2 * lane) = cvt_pk_bf16(o0 * inv, o1 * inv);
    }
}

DI void phase_final(const Params& P) {
    const int tid = threadIdx.x, wave = tid >> 6, lane = tid & 63;
    const int gw = blockIdx.x * 8 + wave, NGW = gridDim.x * 8;
    for (int row = gw; row < T_TOK; row += NGW) {
        const float rs = rsqrtf(P.rowss[6 * T_TOK + row] * (1.f / DM) + RMS_EPS);
        const f32x4* xr = (const f32x4*)(P.xres + (size_t)row * DM) + lane;
        const f32x4* gr = (const f32x4*)P.final_g + lane;
        f32x4* o = (f32x4*)(P.out + (size_t)row * DM) + lane;
#pragma unroll
        for (int j = 0; j < 4; ++j) o[64 * j] = xr[64 * j] * rs * gr[64 * j];
    }
}

DI void phase_final_fused(const Params& P, LAS unsigned char* lds, int vbid) {
    pg8::StaticOrder S; S.init(T_TOK, DM, gridDim.x, vbid);
    pg8::Unit u;
    if (!S.next(0, u)) return;
    const int tid = threadIdx.x, wave = tid >> 6, lane = tid & 63;
    asm volatile("s_waitcnt vmcnt(0)" ::: "memory");
    __syncthreads();
    LAS int* flag = (LAS int*)lds;
    if (tid == 0) flag[0] = atomicAdd(P.pcnt + u.pm, 1);
    __syncthreads();
    if (flag[0] != 3) return;
    __builtin_amdgcn_fence(__ATOMIC_ACQUIRE, "agent");
    asm volatile("s_waitcnt vmcnt(0)" ::: "memory");
    const f32x4* gr = (const f32x4*)P.final_g + lane;
    const f32x4 g0 = gr[0], g1 = gr[64], g2 = gr[128], g3 = gr[192];
#pragma unroll 1
    for (int r0 = wave * 32; r0 < wave * 32 + 32; r0 += 4) {
        f32x4 v[4][4]; float ss[4];
#pragma unroll
        for (int i = 0; i < 4; ++i) {
            const int row = u.pm * 256 + r0 + i;
            const f32x4* xr = (const f32x4*)(P.xres + (size_t)row * DM) + lane;
            ss[i] = P.rowss[6 * T_TOK + row];
            v[i][0] = xr[0]; v[i][1] = xr[64]; v[i][2] = xr[128]; v[i][3] = xr[192];
        }
#pragma unroll
        for (int i = 0; i < 4; ++i) {
            const int row = u.pm * 256 + r0 + i;
            const float rs = rsqrtf(ss[i] * (1.f / DM) + RMS_EPS);
            f32x4* o = (f32x4*)(P.out + (size_t)row * DM) + lane;
            o[0] = v[i][0] * rs * g0; o[64] = v[i][1] * rs * g1; o[128] = v[i][2] * rs * g2; o[192] = v[i][3] * rs * g3;
        }
    }
}

#define XB_TMO      128
#define XB_XCNT(j)  (256  + 64 * (j))
#define XB_XSUB(j)  (1280 + 64 * (j))
#define XB_XGEN(j)  (2304 + 64 * (j))
#define XB_TOP      3328
#define XB_TOPGEN   3392
#define XCD_BAR_WORDS 3456
#define XB_SPIN_CAP (1u << 18)
DI unsigned xb_ld(unsigned* p)              { return __hip_atomic_load(p, __ATOMIC_RELAXED, __HIP_MEMORY_SCOPE_AGENT); }
DI unsigned xb_add(unsigned* p, unsigned v) { return __hip_atomic_fetch_add(p, v, __ATOMIC_RELAXED, __HIP_MEMORY_SCOPE_AGENT); }
DI unsigned xb_xcc_id() { return (unsigned)__builtin_amdgcn_s_getreg((3 << 11) | 20) & 0xFu; }
#define XB_SPIN(cond, bar) do { unsigned _sp = 0; while (cond) { __builtin_amdgcn_s_sleep(1); \
    if ((++_sp & 255u) == 0u) { if (xb_ld(&(bar)[XB_TMO])) break; if (_sp > XB_SPIN_CAP) { atomicAdd(&(bar)[XB_TMO], 1u); break; } } } } while (0)
struct XcdBarrier { unsigned* bar; unsigned x; volatile LAS unsigned* st; };
DI XcdBarrier xcd_barrier_post(unsigned* bar, volatile LAS unsigned* st) {
    XcdBarrier b; b.bar = bar; b.x = xb_xcc_id(); b.st = st;
    if (threadIdx.x == 0) (void)xb_add(&bar[XB_XCNT(b.x)], 1u);
    return b;
}
DI void xcd_barrier_complete(unsigned* bar, unsigned x, unsigned& nloc, unsigned& nx) {
    const unsigned G = gridDim.x * gridDim.y * gridDim.z;
    unsigned sum, cnt, mine, sp = 0u;
    for (;;) {
        sum = 0u; cnt = 0u; mine = 0u;
#pragma unroll
        for (unsigned j = 0; j < 16; ++j) { const unsigned c = xb_ld(&bar[XB_XCNT(j)]); sum += c; cnt += (c > 0u) ? 1u : 0u; mine = (j == x) ? c : mine; }
        if (sum == G) break;
        __builtin_amdgcn_s_sleep(1);
        if ((++sp & 255u) == 0u) { if (xb_ld(&bar[XB_TMO])) break; if (sp > XB_SPIN_CAP) { atomicAdd(&bar[XB_TMO], 1u); break; } }
    }
    nloc = mine > 0u ? mine : 1u; nx = cnt > 0u ? cnt : 1u;
}
DI void xcd_barrier(const XcdBarrier& b) {
    asm volatile("s_waitcnt vmcnt(0)" ::: "memory");
    __syncthreads();
    if (threadIdx.x == 0) {
        unsigned* bar = b.bar;
        __builtin_amdgcn_s_waitcnt(0);
        unsigned nloc = b.st[0], nx = b.st[1];
        if (nloc == 0u) { xcd_barrier_complete(bar, b.x, nloc, nx); b.st[0] = nloc; b.st[1] = nx; }
        const unsigned old = xb_add(&bar[XB_XSUB(b.x)], 1u);
        const unsigned gen = old / nloc;
        if (old + 1u == (gen + 1u) * nloc) {
            __builtin_amdgcn_fence(__ATOMIC_RELEASE, "agent");
            asm volatile("s_waitcnt vmcnt(0)" ::: "memory");
            const unsigned og = xb_add(&bar[XB_TOP], 1u);
            const unsigned tg = og / nx;
            if (og + 1u == (tg + 1u) * nx) xb_add(&bar[XB_TOPGEN], 1u);
            else XB_SPIN(xb_ld(&bar[XB_TOPGEN]) == tg, bar);
            __builtin_amdgcn_fence(__ATOMIC_ACQUIRE, "agent");
            xb_add(&bar[XB_XGEN(b.x)], 1u);
            asm volatile("s_waitcnt vmcnt(0)" ::: "memory");
        } else {
            XB_SPIN(xb_ld(&bar[XB_XGEN(b.x)]) == gen, bar);
            __builtin_amdgcn_fence(__ATOMIC_ACQUIRE, "agent");
            asm volatile("s_waitcnt vmcnt(0)" ::: "memory");
        }
    }
    __syncthreads();
}

constexpr int NPHASES = 18;
#ifndef PHMASK
#define PHMASK 0xFFFFF
#endif
#define PHON(n) if constexpr (((PHMASK) >> (n)) & 1)
#ifndef DUPSEL
#define DUPSEL 0
#endif
__global__ void __launch_bounds__(512, 2) mega_fwd(const Params P) {
    extern __shared__ __attribute__((aligned(16))) unsigned char smem[];
    LAS unsigned char* lds = (LAS unsigned char*)smem;
    cg::grid_group grid = cg::this_grid();
    if (P.ph_hi < 0) grid.sync();
    volatile LAS unsigned* xst = (volatile LAS unsigned*)(lds + 139264);
    if (threadIdx.x == 0) { xst[0] = 0u; xst[1] = 0u; xst[2] = 0u; xst[3] = 0u; xst[4] = 0u; }
    __syncthreads();
    XcdBarrier xb; xb.bar = P.bar; xb.x = xb_xcc_id(); xb.st = xst;
    if (threadIdx.x == 0) xst[2] = xb_add(&P.bar[XB_XCNT(xb.x)], 1u);
    PHON(0) if (P.ph_lo <= 0 && 0 < P.ph_hi) { phase_prep(P, lds); }
    if constexpr (DUPSEL == 4) { xcd_barrier(xb); phase_prep(P, lds); }
    if (P.ph_lo < 1 && 1 < P.ph_hi) xcd_barrier(xb);
    if (threadIdx.x == 0) {
        bool ok = (gridDim.x % 8u) == 0u;
        for (unsigned j = 0; j < 16; ++j) { const unsigned c = xb_ld(&P.bar[XB_XCNT(j)]); ok = ok && (c == (j < 8 ? gridDim.x / 8u : 0u)); }
        xst[3] = ok ? (xb.x + 8u * xst[2]) : blockIdx.x; xst[4] = ok ? 1u : 0u;
    }
    __syncthreads();
    const int vbid = (int)xst[3];
    const bool vb_ok = xst[4] != 0u;
    const int abid = vb_ok ? ((vbid & 7) * (int)(gridDim.x >> 3) + (vbid >> 3)) : (int)blockIdx.x;
    preload_rs(lds, vbid, P.rowss + 0 * T_TOK, 5632); run_gemm_v(lds, vbid, P.xb, P.wt_up[0], 5632, DM, EpiAct{P.act, P.rowss + 0 * T_TOK, P.kbuf, P.vT, P.rope, (const LAS float*)(lds + 131072)});
    convert_by_light_blocks(P, lds, vbid, 64 * 22, P.it1, P.it2);
    if constexpr (DUPSEL == 2) { xcd_barrier(xb); preload_rs(lds, vbid, P.rowss + 0 * T_TOK, 5632); run_gemm_v(lds, vbid, P.xb, P.wt_up[0], 5632, DM, EpiAct{P.act, P.rowss + 0 * T_TOK, P.kbuf, P.vT, P.rope, (const LAS float*)(lds + 131072)}); }
    if (P.ph_lo < 2 && 2 < P.ph_hi) xcd_barrier(xb);
    PHON(2) if (P.ph_lo <= 2 && 2 < P.ph_hi) { run_gemm_v(lds, vbid, P.act, P.wt_dn[0], DM, FF, EpiRes{P.x, P.xres, P.xb, P.rowss + 1 * T_TOK}); }
    if (P.ph_lo < 3 && 3 < P.ph_hi) xcd_barrier(xb);
    PHON(3) if (P.ph_lo <= 3 && 3 < P.ph_hi) { phase_s5a(P, lds); }
    xcd_barrier(xb);
    phase_s5carry(P);
    if (P.ph_lo < 4 && 4 < P.ph_hi) xcd_barrier(xb);
    PHON(4) if (P.ph_lo <= 4 && 4 < P.ph_hi) { phase_s5b(P, lds); }
    if constexpr (DUPSEL == 3) { xcd_barrier(xb); phase_s5a(P, lds); xcd_barrier(xb); phase_s5carry(P); xcd_barrier(xb); phase_s5b(P, lds); }

    if (P.ph_lo < 5 && 5 < P.ph_hi) xcd_barrier(xb);
    PHON(5) if (P.ph_lo <= 5 && 5 < P.ph_hi) { run_gemm_v(lds, vbid, P.yb, P.wt_glu, 2048, DM, EpiGlu{P.xres, P.xb, P.rowss + 2 * T_TOK}); }
    if (P.ph_lo < 6 && 6 < P.ph_hi) xcd_barrier(xb);
    PHON(6) if (P.ph_lo <= 6 && 6 < P.ph_hi) { preload_rs(lds, vbid, P.rowss + 2 * T_TOK, 5632); run_gemm_v(lds, vbid, P.xb, P.wt_up[1], 5632, DM, EpiAct{P.act, P.rowss + 2 * T_TOK, P.kbuf, P.vT, P.rope, (const LAS float*)(lds + 131072)}); convert_by_light_blocks(P, lds, vbid, 64 * 22, P.it2, P.nitems); }
    if (P.ph_lo < 7 && 7 < P.ph_hi) xcd_barrier(xb);
    PHON(7) if (P.ph_lo <= 7 && 7 < P.ph_hi) { run_gemm_v(lds, vbid, P.act, P.wt_dn[1], DM, FF, EpiRes{P.xres, P.xres, P.xb, P.rowss + 3 * T_TOK}); }
    if (P.ph_lo < 8 && 8 < P.ph_hi) xcd_barrier(xb);
    PHON(8) if (P.ph_lo <= 8 && 8 < P.ph_hi) { preload_rs(lds, vbid, P.rowss + 3 * T_TOK, 6144); run_gemm_v(lds, vbid, P.xb, P.wt_up[2], 6144, DM, EpiAct{P.act, P.rowss + 3 * T_TOK, P.kbuf, P.vT, P.rope, (const LAS float*)(lds + 131072)}); }
    if (P.ph_lo < 9 && 9 < P.ph_hi) xcd_barrier(xb);
    PHON(9) if (P.ph_lo <= 9 && 9 < P.ph_hi) { run_gemm_v(lds, vbid, P.act, P.wt_dn[2], DM, FF, EpiRes{P.xres, P.xres, P.xb, P.rowss + 4 * T_TOK}); phase_kmean(P, lds); }
    if (P.ph_lo < 10 && 10 < P.ph_hi) xcd_barrier(xb);
    PHON(10) if (P.ph_lo <= 10 && 10 < P.ph_hi) { run_gemm_v(lds, vbid, P.xb, P.wt_q, DM, DM, EpiQ{P.qbuf, P.rowss + 4 * T_TOK, P.rope}); }
    if (P.ph_lo < 11 && 11 < P.ph_hi) xcd_barrier(xb);
    PHON(11) if (P.ph_lo <= 11 && 11 < P.ph_hi) { phase_gate(P, lds); }
    if (P.ph_lo < 12 && 12 < P.ph_hi) xcd_barrier(xb);
    PHON(12) if (P.ph_lo <= 12 && 12 < P.ph_hi) { phase_attn<false>(P, lds, abid); }
    if constexpr (DUPSEL == 6) { xcd_barrier(xb); phase_attn<false>(P, lds, abid); }
    if (P.ph_lo < 13 && 13 < P.ph_hi) xcd_barrier(xb);
    PHON(13) if (P.ph_lo <= 13 && 13 < P.ph_hi) { phase_attn<true>(P, lds, abid); }
    if constexpr (DUPSEL == 1) { for (int i = 0; i < 8; ++i) xcd_barrier(xb); }
    if (P.ph_lo < 14 && 14 < P.ph_hi) xcd_barrier(xb);
    PHON(14) if (P.ph_lo <= 14 && 14 < P.ph_hi) { run_gemm_v(lds, vbid, P.attn, P.wt_o, DM, DM, EpiRes{P.xres, P.xres, P.xb, P.rowss + 5 * T_TOK}); }
    if (P.ph_lo < 15 && 15 < P.ph_hi) xcd_barrier(xb);
    PHON(15) if (P.ph_lo <= 15 && 15 < P.ph_hi) { preload_rs(lds, vbid, P.rowss + 5 * T_TOK, 5632); run_gemm_v(lds, vbid, P.xb, P.wt_up[3], 5632, DM, EpiAct{P.act, P.rowss + 5 * T_TOK, P.kbuf, P.vT, P.rope, (const LAS float*)(lds + 131072)}); }
    if (P.ph_lo < 16 && 16 < P.ph_hi) xcd_barrier(xb);
    PHON(16) if (P.ph_lo <= 16 && 16 < P.ph_hi) { run_gemm_v(lds, vbid, P.act, P.wt_dn[3], DM, FF, EpiRes{P.xres, P.xres, P.xb, P.rowss + 6 * T_TOK}); }
    if (vb_ok && gridDim.x == 256u) { phase_final_fused(P, lds, vbid); }
    else { xcd_barrier(xb); phase_final(P); }
}

extern "C" void kernel_launch(void* const* d_in, const int* in_sizes, int n_in, void* d_out, int out_size, void* d_ws, size_t ws_size, hipStream_t stream) {
    static int grid_blocks = 0;
    if (!grid_blocks) {
        int dev = 0, cus = 0, per_cu = 0;
        hipGetDevice(&dev);
        hipDeviceGetAttribute(&cus, hipDeviceAttributeMultiprocessorCount, dev);
        hipFuncSetAttribute((const void*)mega_fwd, hipFuncAttributeMaxDynamicSharedMemorySize, LDS_BYTES);
        hipOccupancyMaxActiveBlocksPerMultiprocessor(&per_cu, (const void*)mega_fwd, 512, LDS_BYTES);
        if (per_cu < 1) per_cu = 1;
        if (per_cu > 1) per_cu = 1;
        grid_blocks = cus * per_cu;
    }
    Params p{};
    const float** in = (const float**)&p.x;
    for (int i = 0; i < 19; ++i) in[i] = (const float*)d_in[i];
    p.out = (float*)d_out;
    unsigned char* ws = (unsigned char*)d_ws; size_t off = 0;
    auto take = [&](size_t bytes) { unsigned char* r = ws + off; off += (bytes + 255) & ~(size_t)255; return r; };
    p.xres = (float*)take((size_t)T_TOK * DM * 4);
    p.xb = (bf16_t*)take((size_t)T_TOK * DM * 2);
    p.act = (bf16_t*)take((size_t)T_TOK * FF * 2);
    p.qbuf = p.act;
    p.attn = p.act + (size_t)T_TOK * DM;
    p.part_ml = (float*)(p.act + (size_t)2 * T_TOK * DM);
    p.kbuf = (bf16_t*)take((size_t)T_TOK * 256 * 2);
    p.vT = (bf16_t*)take((size_t)T_TOK * 256 * 2);
    p.kmean = (float*)take(128 * 128 * 4);
    p.rowss = (float*)take((size_t)7 * T_TOK * 4 + 1024);
    p.gcount = (int*)(p.rowss + 7 * T_TOK);
    p.E = (float*)take((size_t)2 * 128 * 64 * 64 * 2 * 4);
    p.lists = (int*)p.E;
    p.rope = (float*)take((size_t)SEQ * 16 * 2 * 4);
    p.bar = (unsigned*)take((size_t)XCD_BAR_WORDS * 4);
    p.s5tab = (float*)take(4096 * 4 * 4);
    p.pcnt = (int*)take(256);
    p.wt_up[0] = (bf16_t*)take((size_t)6144 * DM * 2); p.wt_up[1] = (bf16_t*)take((size_t)6144 * DM * 2);
    p.wt_dn[0] = (bf16_t*)take((size_t)DM * FF * 2); p.wt_dn[1] = (bf16_t*)take((size_t)DM * FF * 2);
    p.wt_glu = (bf16_t*)take((size_t)2048 * DM * 2);
    p.wt_up[2] = (bf16_t*)take((size_t)6144 * DM * 2); p.wt_up[3] = (bf16_t*)take((size_t)6144 * DM * 2);
    p.wt_dn[2] = (bf16_t*)take((size_t)DM * FF * 2); p.wt_dn[3] = (bf16_t*)take((size_t)DM * FF * 2);
    p.wt_q = (bf16_t*)take((size_t)DM * DM * 2);
    p.wt_o = (bf16_t*)take((size_t)DM * DM * 2);
    p.part[0] = p.xb;
    p.part[1] = (bf16_t*)take((size_t)T_TOK * DM * 2);
    p.part[2] = (bf16_t*)take((size_t)T_TOK * DM * 2);
    p.part[3] = p.wt_up[0];
    p.yb = p.part[1];
    int nj = 0, items = 0;
    auto job = [&](const float* W, const float* g, bf16_t* dst, int K, int Nsrc, int ndst, int mode, float scale = 1.f) {
        WJob& J = p.jobs[nj++]; J.W = W; J.g = g; J.dst = dst; J.K = K; J.Nsrc = Nsrc; J.ndst = ndst; J.mode = mode; J.item0 = items; J.scale = scale;
        items += (K / 64) * (ndst / 32);
    };
    auto job_up = [&](int l, int f) { job(p.ffn_w_in + (size_t)(l * 2 + f) * DM * 2 * FF, p.norm_g + (size_t)(l * 3 + (f ? 2 : 0)) * DM, p.wt_up[l * 2 + f], DM, 2 * FF, 2 * FF, 1); };
    auto job_dn = [&](int l, int f) { job(p.ffn_w_out + (size_t)(l * 2 + f) * FF * DM, nullptr, p.wt_dn[l * 2 + f], FF, DM, DM, 0, 0.5f); };
    job_up(0, 0);
    p.it1 = items;
    job_dn(0, 0); job(p.w_glu, nullptr, p.wt_glu, DM, 2048, 2048, 1); job_up(0, 1); job_dn(0, 1);
    p.it2 = items;
    job_up(1, 0);
    job(p.w_k, p.kv_norm_g, p.wt_up[2] + (size_t)5632 * DM, DM, 256, 256, 0);
    job(p.w_v, p.kv_norm_g, p.wt_up[2] + (size_t)5888 * DM, DM, 256, 256, 0);
    job_dn(1, 0); job_up(1, 1); job_dn(1, 1);
    job(p.w_q, p.norm_g + (size_t)4 * DM, p.wt_q, DM, DM, DM, 0);
    job(p.w_o, nullptr, p.wt_o, DM, DM, DM, 0);
    p.nitems = items; p.ph_lo = 0; p.ph_hi = NPHASES; p.pad = 0;
    if (off > ws_size) { fprintf(stderr, "workspace too small: need %zu have %zu\n", off, ws_size); return; }
    (void)hipMemsetAsync(p.bar, 0, (size_t)XCD_BAR_WORDS * 4, stream);
    void* args[] = {&p};
    hipError_t e = hipLaunchCooperativeKernel((const void*)mega_fwd, dim3(grid_blocks), dim3(512), args, LDS_BYTES, stream);
    if (e != hipSuccess) fprintf(stderr, "cooperative launch failed: %s (grid %d)\n", hipGetErrorString(e), grid_blocks);
}
```

```cpp
#include <hip/hip_runtime.h>
#include <hip/hip_cooperative_groups.h>
#include <cstdio>
namespace cg = cooperative_groups;

#define LAS __attribute__((address_space(3)))
#define DI __device__ __forceinline__
typedef unsigned short bf16_t;
typedef short bf16x8 __attribute__((ext_vector_type(8)));
typedef float f32x4 __attribute__((ext_vector_type(4)));
typedef float f32x2 __attribute__((ext_vector_type(2)));
typedef unsigned u32x4 __attribute__((ext_vector_type(4)));
typedef unsigned u32x2 __attribute__((ext_vector_type(2)));

constexpr int T_TOK = 16384, DM = 1024, FF = 2816, SEQ = 8192;
constexpr float RMS_EPS = 1e-6f;
constexpr int LDS_BYTES = 139296;
constexpr int NJOBS = 13;

struct WJob { const float* W; const float* g; bf16_t* dst; int K; int Nsrc; int ndst; int mode; int item0; float scale; };

struct Params {
    const float *x, *norm_g, *ffn_w_in, *ffn_w_out, *a_re, *a_im, *log_step, *b_re, *b_im, *c_re, *c_im, *s5_d, *w_glu, *kv_norm_g, *w_k, *w_v, *w_q, *w_o, *final_g;
    float* out;
    float* xres; bf16_t* xb; bf16_t* act; bf16_t* yb; bf16_t* qbuf; bf16_t* attn; bf16_t* kbuf; bf16_t* vbuf;
    float* kmean; float* rowss; float* E; float* rope;
    bf16_t* vT; bf16_t* part[4]; float* part_ml; int* lists; int* gcount; unsigned* bar; float* s5tab; int* pcnt;
    bf16_t* wt_up[4]; bf16_t* wt_dn[4]; bf16_t* wt_glu; bf16_t* wt_q; bf16_t* wt_o;
    WJob jobs[NJOBS];
    int nitems; int ph_lo; int ph_hi; int pad; int it1; int it2;
};

DI unsigned cvt_pk_bf16(float lo, float hi) { unsigned r; asm volatile("v_cvt_pk_bf16_f32 %0, %1, %2" : "=v"(r) : "v"(lo), "v"(hi)); return r; }
DI float bf_lo(unsigned w) { return __uint_as_float(w << 16); }
DI float bf_hi(unsigned w) { return __uint_as_float(w & 0xffff0000u); }
DI float wave_sum(float v) {
#pragma unroll
    for (int o = 1; o < 64; o <<= 1) v += __shfl_xor(v, o);
    return v;
}
DI float wave_max(float v) {
#pragma unroll
    for (int o = 1; o < 64; o <<= 1) v = fmaxf(v, __shfl_xor(v, o));
    return v;
}

namespace pg8 {
constexpr int BM = 256, BK = 64, HALF = 128, HTB = HALF * BK * 2, NXCD = 8, WGM = 8;
DI int lds_byte(int r, int c) { const int st = (r >> 4) * 2 + (c >> 5), rr = r & 15, cc = c & 31, ob = rr * 64 + cc * 2; return st * 1024 + (ob ^ (((ob >> 9) & 1) << 5)); }
DI void stage_rc(int b, int& R, int& C) { const int st = b / 1024, sb = b % 1024, swz = sb ^ (((sb >> 9) & 1) << 5); R = (st >> 1) * 16 + swz / 64; C = (st & 1) * 32 + (swz % 64) / 2; }
struct Unit { int pm, pn; };
struct Gemm { const bf16_t* A; const bf16_t* Bt; int M, N, K; };
struct StaticOrder {
    int nM, nN, nwg, G, c;
    DI void init(int M, int N, int G_, int c_) { nM = M / BM; nN = N / BM; nwg = nM * nN; G = G_; c = c_; }
    DI bool next(int i, Unit& u) const {
        const long L = (long)i * G + c; if (L >= nwg) return false;
        int wgid = (int)L; { const int q = nwg / NXCD, r = nwg % NXCD, xcd = wgid % NXCD, off = wgid / NXCD; wgid = (xcd < r ? xcd * (q + 1) : r * (q + 1) + (xcd - r) * q) + off; }
        const int nig = WGM * nN, gid = wgid / nig, fm = gid * WGM, gsz = (nM - fm) < WGM ? (nM - fm) : WGM;
        u.pm = fm + ((wgid % nig) % gsz); u.pn = (wgid % nig) / gsz; return true;
    }
};

template <class Epi>
DI void gemm_phase(LAS unsigned char* lds, const Gemm g, const StaticOrder& S, const Epi& E) {
    int tid_ = threadIdx.x; asm volatile("" : "+v"(tid_));
    const int tid = tid_, wid = __builtin_amdgcn_readfirstlane(tid >> 6), lane = tid & 63, wr = wid >> 2, wc = wid & 3, fr = lane & 15, fq = lane >> 4;
    const int K = g.K, nt = K / BK;
    unsigned voffA[2], voffB[2];
#pragma unroll
    for (int i = 0; i < 2; ++i) { int R, C; stage_rc(tid * 16 + i * 8192, R, C); voffA[i] = (unsigned)(R * K + C) * 2u; voffB[i] = voffA[i]; }
    const size_t kstep = (size_t)(BK * 2);
    const size_t hstep = (size_t)HALF * K * 2;
    const size_t tstep = 2 * hstep;
    const unsigned ldsw = (unsigned)wid * 1024u;
    const int aoff = lds_byte(wr * 64 + fr, fq * 8), boff = lds_byte(wc * 32 + fr, fq * 8);
#define PG8_SA(b, h) (((b) * 2 + (h)) * HTB)
#define PG8_SB(b, h) ((4 + (b) * 2 + (h)) * HTB)
#define PG8_STAGE(bufoff, gbase, voff) do { _Pragma("unroll") for (int _i = 0; _i < 2; ++_i) \
        __builtin_amdgcn_global_load_lds((const unsigned*)((const char*)(gbase) + (voff)[_i]), (LAS unsigned*)(lds + (bufoff) + ldsw + _i * 8192), 16, 0, 0); } while (0)
#define PG8_LDA(dst, b, h) do { _Pragma("unroll") for (int m = 0; m < 4; ++m) _Pragma("unroll") for (int k = 0; k < 2; ++k) dst[m][k] = *(const LAS bf16x8*)(lds + PG8_SA(b, h) + aoff + m * 2048 + k * 1024); } while (0)
#define PG8_LDB(dst, b, h) do { _Pragma("unroll") for (int n = 0; n < 2; ++n) _Pragma("unroll") for (int k = 0; k < 2; ++k) dst[n][k] = *(const LAS bf16x8*)(lds + PG8_SB(b, h) + boff + n * 2048 + k * 1024); } while (0)
#define PG8_MMA(ai, bj, At, Bt) do { __builtin_amdgcn_s_setprio(1); _Pragma("unroll") for (int m = 0; m < 4; ++m) _Pragma("unroll") for (int n = 0; n < 2; ++n) _Pragma("unroll") for (int k = 0; k < 2; ++k) \
        acc[ai][bj][m][n] = __builtin_amdgcn_mfma_f32_16x16x32_bf16(Bt[n][k], At[m][k], acc[ai][bj][m][n], 0, 0, 0); __builtin_amdgcn_s_setprio(0); } while (0)
#define PG8_WAIT_V(n) asm volatile("s_waitcnt vmcnt(" #n ")" ::: "memory")
#define PG8_WAIT_L(n) asm volatile("s_waitcnt lgkmcnt(" #n ")" ::: "memory")
#define PG8_BAR __builtin_amdgcn_s_barrier()
#define PG8_SCHED __builtin_amdgcn_sched_barrier(0)
    Unit cur, nxt; int ui = 0;
    if (!S.next(0, cur)) return;
    f32x4 acc[2][2][4][2];
    if constexpr (Epi::INIT_X) E.init(acc, cur, wr, wc, fr, fq);
    else {
#pragma unroll
    for (int a = 0; a < 2; ++a)
#pragma unroll
        for (int b = 0; b < 2; ++b)
#pragma unroll
            for (int m = 0; m < 4; ++m)
#pragma unroll
                for (int n = 0; n < 2; ++n) acc[a][b][m][n] = (f32x4){0.f, 0.f, 0.f, 0.f};
    }
    bf16x8 At[4][2], B0[2][2], B1[2][2];
    const char* cA = (const char*)g.A + (size_t)cur.pm * tstep; const char* cB = (const char*)g.Bt + (size_t)cur.pn * tstep;
    PG8_STAGE(PG8_SB(0, 0), cB, voffB); PG8_STAGE(PG8_SA(0, 0), cA, voffA); PG8_STAGE(PG8_SB(0, 1), cB + hstep, voffB); PG8_STAGE(PG8_SA(0, 1), cA + hstep, voffA);
    if (wr == 1) PG8_BAR;
    PG8_WAIT_V(4); PG8_BAR;
    PG8_STAGE(PG8_SB(1, 0), cB + kstep, voffB); PG8_STAGE(PG8_SA(1, 0), cA + kstep, voffA); PG8_STAGE(PG8_SB(1, 1), cB + hstep + kstep, voffB);
    PG8_WAIT_V(6); PG8_BAR;
    for (;;) {
        const bool has_next = S.next(ui + 1, nxt);
        const char* nA = has_next ? (const char*)g.A + (size_t)nxt.pm * tstep : cA; const char* nB = has_next ? (const char*)g.Bt + (size_t)nxt.pn * tstep : cB;
        for (int t = 0; t < nt; t += 2) {
            const bool last = (t == nt - 2);
            const char* a1 = cA + (size_t)(t + 1) * kstep;
            const char* a2 = last ? nA : cA + (size_t)(t + 2) * kstep; const char* b2 = last ? nB : cB + (size_t)(t + 2) * kstep;
            const char* a3 = a2 + kstep; const char* b3 = b2 + kstep;
            PG8_LDB(B0, 0, 0); PG8_SCHED; PG8_LDA(At, 0, 0); PG8_STAGE(PG8_SA(1, 1), a1 + hstep, voffA);
            PG8_WAIT_L(8); PG8_BAR; PG8_WAIT_L(0); PG8_MMA(0, 0, At, B0); PG8_BAR; PG8_SCHED;
            PG8_LDB(B1, 0, 1); PG8_STAGE(PG8_SB(0, 0), b2, voffB);
            PG8_BAR; PG8_WAIT_L(0); PG8_MMA(0, 1, At, B1); PG8_BAR;
            PG8_LDA(At, 0, 1); PG8_STAGE(PG8_SA(0, 0), a2, voffA);
            PG8_BAR; PG8_WAIT_L(0); PG8_MMA(1, 0, At, B0); PG8_BAR; PG8_SCHED;
            PG8_STAGE(PG8_SB(0, 1), b2 + hstep, voffB);
            PG8_WAIT_V(6); PG8_BAR; PG8_MMA(1, 1, At, B1); PG8_BAR;
            PG8_LDB(B0, 1, 0); PG8_SCHED; PG8_LDA(At, 1, 0); PG8_STAGE(PG8_SA(0, 1), a2 + hstep, voffA);
            PG8_WAIT_L(8); PG8_BAR; PG8_WAIT_L(0); PG8_MMA(0, 0, At, B0); PG8_BAR; PG8_SCHED;
            PG8_LDB(B1, 1, 1); PG8_STAGE(PG8_SB(1, 0), b3, voffB);
            PG8_BAR; PG8_WAIT_L(0); PG8_MMA(0, 1, At, B1); PG8_BAR;
            PG8_LDA(At, 1, 1); PG8_STAGE(PG8_SA(1, 0), a3, voffA);
            PG8_BAR; PG8_WAIT_L(0); PG8_MMA(1, 0, At, B0); PG8_BAR; PG8_SCHED;
            PG8_STAGE(PG8_SB(1, 1), b3 + hstep, voffB);
            PG8_WAIT_V(6); PG8_BAR; PG8_MMA(1, 1, At, B1); PG8_BAR;
        }
        E(acc, cur, wr, wc, fr, fq, ui);
        if (!has_next) break;
        if constexpr (Epi::INIT_X) E.init(acc, nxt, wr, wc, fr, fq);
        else {
#pragma unroll
        for (int a = 0; a < 2; ++a)
#pragma unroll
            for (int b = 0; b < 2; ++b)
#pragma unroll
                for (int m = 0; m < 4; ++m)
#pragma unroll
                    for (int n = 0; n < 2; ++n) acc[a][b][m][n] = (f32x4){0.f, 0.f, 0.f, 0.f};
        }
        cur = nxt; cA = nA; cB = nB; ++ui;
    }
    PG8_WAIT_V(0);
    if (wr == 0) PG8_BAR;
    PG8_BAR;
#undef PG8_SA
#undef PG8_SB
#undef PG8_STAGE
#undef PG8_LDA
#undef PG8_LDB
#undef PG8_MMA
#undef PG8_WAIT_V
#undef PG8_WAIT_L
#undef PG8_BAR
#undef PG8_SCHED
}
}
using pg8::Unit;
typedef f32x4 AccT[2][2][4][2];

DI void store_bf4(bf16_t* p, f32x4 v) { u32x2 o; o.x = cvt_pk_bf16(v.x, v.y); o.y = cvt_pk_bf16(v.z, v.w); *(u32x2*)p = o; }
DI float sigmoidf_(float x) { return __builtin_amdgcn_rcpf(1.f + __builtin_amdgcn_exp2f(-1.4426950408889634f * x)); }

struct EpiAct {
    static constexpr bool INIT_X = false;
    bf16_t* act; const float* rowss; bf16_t* kbuf; bf16_t* vbuf; const float* rope; const LAS float* rsl;
    DI void operator()(const AccT& acc, const Unit& u, int wr, int wc, int fr, int fq, int ui) const {
        const int row0 = u.pm * 256 + wr * 64 + fr;
        if (u.pn < 22) {
#pragma unroll
            for (int ai = 0; ai < 2; ++ai)
#pragma unroll
                for (int m = 0; m < 4; ++m) {
                    const int row = row0 + ai * 128 + m * 16;
                    const float rs = rsl[ui * 256 + wr * 64 + fr + ai * 128 + m * 16];
#pragma unroll
                    for (int bj = 0; bj < 2; ++bj) {
                        const f32x4 gt = acc[ai][bj][m][0] * rs, up = acc[ai][bj][m][1] * rs;
                        f32x4 a;
#pragma unroll
                        for (int j = 0; j < 4; ++j) a[j] = gt[j] * sigmoidf_(gt[j]) * up[j];
                        const int col = 16 * (8 * u.pn + 4 * bj + wc) + 4 * fq;
                        store_bf4(act + (size_t)row * FF + col, a);
                    }
                }
        } else if (u.pn == 22) {
            const bool do_rope = (wc == 0);
#pragma unroll
            for (int ai = 0; ai < 2; ++ai)
#pragma unroll
                for (int m = 0; m < 4; ++m) {
                    const int row = row0 + ai * 128 + m * 16;
                    const float rs = rsqrtf(rowss[row] * (1.f / DM) + RMS_EPS);
                    const int b = row >> 13, pos = row & (SEQ - 1);
#pragma unroll
                    for (int bj = 0; bj < 2; ++bj) {
                        f32x4 v0 = acc[ai][bj][m][0] * rs, v1 = acc[ai][bj][m][1] * rs;
                        if (do_rope) {
                            const f32x4* rp = (const f32x4*)(rope + ((size_t)pos * 16 + 4 * fq) * 2);
                            const f32x4 cs0 = rp[0], cs1 = rp[1];
                            const float c[4] = {cs0.x, cs0.z, cs1.x, cs1.z}, s[4] = {cs0.y, cs0.w, cs1.y, cs1.w};
#pragma unroll
                            for (int j = 0; j < 4; ++j) { const float x1 = v0[j], x2 = v1[j]; v0[j] = x1 * c[j] - x2 * s[j]; v1[j] = x2 * c[j] + x1 * s[j]; }
                        }
                        bf16_t* d = kbuf + ((size_t)(b * 2 + bj) * SEQ + pos) * 128 + 32 * wc + 4 * fq;
                        store_bf4(d, v0); store_bf4(d + 16, v1);
                    }
                }
        } else {
            const int lane = fr + 16 * fq, qi = lane & 3;
#pragma unroll
            for (int ai = 0; ai < 2; ++ai)
#pragma unroll
                for (int m = 0; m < 4; ++m) {
                    const int row = row0 + ai * 128 + m * 16;
                    const float rs = rsqrtf(rowss[row] * (1.f / DM) + RMS_EPS);
                    const int b = row >> 13, posq = (row & (SEQ - 1)) & ~3;
#pragma unroll
                    for (int bj = 0; bj < 2; ++bj)
#pragma unroll
                        for (int n = 0; n < 2; ++n) {
                            const f32x4 v = acc[ai][bj][m][n] * rs;
                            f32x4 w;
#pragma unroll
                            for (int k = 0; k < 4; ++k) {
                                const int src = (lane & ~3) | k;
                                const float t0 = __shfl(v[0], src), t1 = __shfl(v[1], src), t2 = __shfl(v[2], src), t3 = __shfl(v[3], src);
                                w[k] = qi == 0 ? t0 : (qi == 1 ? t1 : (qi == 2 ? t2 : t3));
                            }
                            const int d = 32 * wc + 16 * n + 4 * fq + qi;
                            store_bf4(vbuf + ((size_t)((b * 2 + bj) * 128 + d)) * SEQ + posq, w);
                        }
                }
        }
    }
};

struct EpiRes {
    static constexpr bool INIT_X = true;
    const float* xin; float* xout; bf16_t* xb; float* rowss_out;
    DI void init(AccT& acc, const Unit& u, int wr, int wc, int fr, int fq) const {
        const int row0 = u.pm * 256 + wr * 64 + fr;
#pragma unroll
        for (int ai = 0; ai < 2; ++ai)
#pragma unroll
            for (int m = 0; m < 4; ++m)
#pragma unroll
                for (int bj = 0; bj < 2; ++bj)
#pragma unroll
                    for (int n = 0; n < 2; ++n)
                        acc[ai][bj][m][n] = *(const f32x4*)(xin + (size_t)(row0 + ai * 128 + m * 16) * DM + u.pn * 256 + bj * 128 + wc * 32 + n * 16 + 4 * fq);
    }
    DI void operator()(const AccT& acc, const Unit& u, int wr, int wc, int fr, int fq, int ui) const {
        const int row0 = u.pm * 256 + wr * 64 + fr;
#pragma unroll
        for (int ai = 0; ai < 2; ++ai)
#pragma unroll
            for (int m = 0; m < 4; ++m) {
                const int row = row0 + ai * 128 + m * 16;
                float ss = 0.f;
#pragma unroll
                for (int bj = 0; bj < 2; ++bj)
#pragma unroll
                    for (int n = 0; n < 2; ++n) {
                        const size_t off = (size_t)row * DM + u.pn * 256 + bj * 128 + wc * 32 + n * 16 + 4 * fq;
                        const f32x4 v = acc[ai][bj][m][n];
                        *(f32x4*)(xout + off) = v;
                        store_bf4(xb + off, v);
                        ss += v.x * v.x + v.y * v.y + v.z * v.z + v.w * v.w;
                    }
                ss += __shfl_xor(ss, 16); ss += __shfl_xor(ss, 32);
                if (fq == 0) atomicAdd(rowss_out + row, ss);
            }
    }
};

struct EpiGlu {
    static constexpr bool INIT_X = false;
    float* xres; bf16_t* xb; float* rowss_out;
    DI void operator()(const AccT& acc, const Unit& u, int wr, int wc, int fr, int fq, int ui) const {
        const int row0 = u.pm * 256 + wr * 64 + fr;
#pragma unroll
        for (int ai = 0; ai < 2; ++ai)
#pragma unroll
            for (int m = 0; m < 4; ++m) {
                const int row = row0 + ai * 128 + m * 16;
                float ss = 0.f;
#pragma unroll
                for (int bj = 0; bj < 2; ++bj) {
                    const size_t off = (size_t)row * DM + 16 * (8 * u.pn + 4 * bj + wc) + 4 * fq;
                    const f32x4 val = acc[ai][bj][m][0], gt = acc[ai][bj][m][1];
                    f32x4 v = *(const f32x4*)(xres + off);
#pragma unroll
                    for (int j = 0; j < 4; ++j) v[j] += val[j] * sigmoidf_(gt[j]);
                    *(f32x4*)(xres + off) = v;
                    store_bf4(xb + off, v);
                    ss += v.x * v.x + v.y * v.y + v.z * v.z + v.w * v.w;
                }
                ss += __shfl_xor(ss, 16); ss += __shfl_xor(ss, 32);
                if (fq == 0) atomicAdd(rowss_out + row, ss);
            }
    }
};

struct EpiQ {
    static constexpr bool INIT_X = false;
    bf16_t* qbuf; const float* rowss; const float* rope;
    DI void operator()(const AccT& acc, const Unit& u, int wr, int wc, int fr, int fq, int ui) const {
        const int row0 = u.pm * 256 + wr * 64 + fr;
#pragma unroll
        for (int ai = 0; ai < 2; ++ai)
#pragma unroll
            for (int m = 0; m < 4; ++m) {
                const int row = row0 + ai * 128 + m * 16;
                const float rs = rsqrtf(rowss[row] * (1.f / DM) + RMS_EPS) * 0.08838834764831845f;
                const int pos = row & (SEQ - 1);
#pragma unroll
                for (int bj = 0; bj < 2; ++bj) {
                    f32x4 v0 = acc[ai][bj][m][0] * rs, v1 = acc[ai][bj][m][1] * rs;
                    if (wc == 0) {
                        const f32x4* rp = (const f32x4*)(rope + ((size_t)pos * 16 + 4 * fq) * 2);
                        const f32x4 cs0 = rp[0], cs1 = rp[1];
                        const float c[4] = {cs0.x, cs0.z, cs1.x, cs1.z}, s[4] = {cs0.y, cs0.w, cs1.y, cs1.w};
#pragma unroll
                        for (int j = 0; j < 4; ++j) { const float x1 = v0[j], x2 = v1[j]; v0[j] = x1 * c[j] - x2 * s[j]; v1[j] = x2 * c[j] + x1 * s[j]; }
                    }
                    bf16_t* d = qbuf + (size_t)row * DM + u.pn * 256 + bj * 128 + 32 * wc + 4 * fq;
                    store_bf4(d, v0); store_bf4(d + 16, v1);
                }
            }
    }
};

DI void preload_rs(LAS unsigned char* lds, int vbid, const float* rowss, int N) {
    pg8::StaticOrder S; S.init(T_TOK, N, gridDim.x, vbid);
    LAS float* rsl = (LAS float*)(lds + 131072);
    if (threadIdx.x < 256) {
        float v[8]; bool ok[8];
#pragma unroll
        for (int i = 0; i < 8; ++i) { pg8::Unit u; ok[i] = S.next(i, u); v[i] = ok[i] ? rowss[u.pm * 256 + threadIdx.x] : 1.f; }
#pragma unroll
        for (int i = 0; i < 8; ++i) if (ok[i]) rsl[i * 256 + threadIdx.x] = rsqrtf(v[i] * (1.f / DM) + RMS_EPS);
    }
    __syncthreads();
}
template <class Epi>
DI void run_gemm_v(LAS unsigned char* lds, int vbid, const bf16_t* A, const bf16_t* Bt, int N, int K, const Epi& E) {
    pg8::Gemm g{A, Bt, T_TOK, N, K};
    pg8::StaticOrder S; S.init(T_TOK, N, gridDim.x, vbid);
    pg8::gemm_phase<Epi>(lds, g, S, E);
}

struct S5Coef { float ar, ai, cr, ci; };
DI S5Coef s5_coefs_compute(const Params& P, int g, int p) {
    const float dt = expf(P.log_step[g]); const float lr = P.a_re[g * 64 + p], li = P.a_im[g * 64 + p];
    const float mag = expf(lr * dt); S5Coef c; c.ar = mag * cosf(li * dt); c.ai = mag * sinf(li * dt);
    const float nr = c.ar - 1.f, ni = c.ai, den = lr * lr + li * li;
    c.cr = (nr * lr + ni * li) / den; c.ci = (ni * lr - nr * li) / den; return c;
}
DI S5Coef s5_coefs(const Params& P, int g, int p) { const f32x4 v = *(const f32x4*)(P.s5tab + (size_t)(g * 64 + p) * 4); S5Coef c; c.ar = v.x; c.ai = v.y; c.cr = v.z; c.ci = v.w; return c; }

DI void p0_transpose_item(const WJob& J, LAS float* scr, int item, int lane) {
    const int nblk = J.ndst / 32, kb = item / nblk, nb = item % nblk, k0 = 64 * kb, r0 = 32 * nb;
    const int i = lane & 31;
    int scol;
    if (J.mode == 0) scol = r0 + i;
    else { const int G = r0 >> 5; scol = (i < 16) ? (16 * G + i) : ((J.Nsrc >> 1) + 16 * G + (i - 16)); }
    float wv[32];
    const float* wp = J.W + (size_t)(k0 + (lane >> 5)) * J.Nsrc + scol;
#pragma unroll
    for (int it = 0; it < 32; ++it) wv[it] = wp[(size_t)(2 * it) * J.Nsrc];
    if (J.g) {
        const float* gp = J.g + k0 + (lane >> 5);
#pragma unroll
        for (int it = 0; it < 32; ++it) wv[it] *= gp[2 * it];
    }
    if (J.scale != 1.f) {
#pragma unroll
        for (int it = 0; it < 32; ++it) wv[it] *= J.scale;
    }
#pragma unroll
    for (int it = 0; it < 32; ++it) scr[(2 * it + (lane >> 5)) * 33 + i] = wv[it];
    __builtin_amdgcn_fence(__ATOMIC_RELEASE, "wavefront"); __builtin_amdgcn_wave_barrier(); __builtin_amdgcn_fence(__ATOMIC_ACQUIRE, "wavefront");
    const int c = lane & 7;
#pragma unroll
    for (int j = 0; j < 4; ++j) {
        const int n = (lane >> 3) + 8 * j; const LAS float* s = scr + (8 * c) * 33 + n;
        u32x4 o; o.x = cvt_pk_bf16(s[0 * 33], s[1 * 33]); o.y = cvt_pk_bf16(s[2 * 33], s[3 * 33]); o.z = cvt_pk_bf16(s[4 * 33], s[5 * 33]); o.w = cvt_pk_bf16(s[6 * 33], s[7 * 33]);
        *(u32x4*)(J.dst + (size_t)(r0 + n) * J.K + k0 + 8 * c) = o;
    }
    __builtin_amdgcn_fence(__ATOMIC_RELEASE, "wavefront"); __builtin_amdgcn_wave_barrier(); __builtin_amdgcn_fence(__ATOMIC_ACQUIRE, "wavefront");
}

DI void convert_items(const Params& P, LAS unsigned char* lds, int lo, int hi, int gw, int NGW) {
    const int wave = threadIdx.x >> 6, lane = threadIdx.x & 63;
    LAS float* scr = (LAS float*)(lds + wave * 16384);
    for (int it = lo + gw; it < hi; it += NGW) {
        int j = 0;
#pragma unroll 1
        for (int q = 1; q < NJOBS; ++q) if (it >= P.jobs[q].item0) j = q;
        p0_transpose_item(P.jobs[j], scr, it - P.jobs[j].item0, lane);
    }
}
DI void convert_by_light_blocks(const Params& P, LAS unsigned char* lds, int vbid, int units, int lo, int hi) {
    asm volatile("" : "+s"(vbid), "+s"(lo), "+s"(hi));
    const int G = gridDim.x, extra = units % G, first = extra, nlight = G - extra;
    if (vbid >= first) convert_items(P, lds, lo, hi, (vbid - first) * 8 + (threadIdx.x >> 6), nlight * 8);
}

DI void phase_prep(const Params& P, LAS unsigned char* lds) {
    const int tid = threadIdx.x, wave = tid >> 6, lane = tid & 63;
    const int gw = blockIdx.x * 8 + wave, NGW = gridDim.x * 8;
    LAS float* scr = (LAS float*)(lds + wave * 16384);
    convert_items(P, lds, 0, P.it1, gw, NGW);
    for (int row = gw; row < T_TOK; row += NGW) {
        const f32x4* xr = (const f32x4*)(P.x + (size_t)row * DM) + lane;
        f32x4 v[4]; float s = 0.f;
#pragma unroll
        for (int j = 0; j < 4; ++j) { v[j] = xr[64 * j]; s += v[j].x * v[j].x + v[j].y * v[j].y + v[j].z * v[j].z + v[j].w * v[j].w; }
        s = wave_sum(s);
        if (lane == 0) P.rowss[row] = s;
        bf16_t* o = P.xb + (size_t)row * DM + 4 * lane;
#pragma unroll
        for (int j = 0; j < 4; ++j) store_bf4(o + 256 * j, v[j]);
    }
    const int gt = blockIdx.x * 512 + tid, NGT = gridDim.x * 512;
    for (int i = gt; i < 6 * T_TOK; i += NGT) P.rowss[T_TOK + i] = 0.f;
    if (gt < 128) P.gcount[gt] = 0;
    if (gt < 64) P.pcnt[gt] = 0;
    for (int i = gt; i < 4096; i += NGT) { const S5Coef c = s5_coefs_compute(P, i >> 6, i & 63); *(f32x4*)(P.s5tab + (size_t)i * 4) = (f32x4){c.ar, c.ai, c.cr, c.ci}; }
    for (int i = gt; i < SEQ * 16; i += NGT) {
        const int pos = i >> 4, d = i & 15;
        const float inv = exp2f(-(float)d * (18.931568569324174f / 16.f));
        const float ang = (float)pos * inv;
        P.rope[2 * i] = cosf(ang); P.rope[2 * i + 1] = sinf(ang);
    }
}

DI float gelu_tanh(float x) { const float u = 0.7978845608028654f * (x + 0.044715f * x * x * x); return x * __builtin_amdgcn_rcpf(1.f + __builtin_amdgcn_exp2f(-2.f * 1.4426950408889634f * u)); }

typedef float f32x16 __attribute__((ext_vector_type(16)));
typedef __bf16 bf2_t __attribute__((ext_vector_type(2)));
DI unsigned pk_bf16(float lo, float hi) { const f32x2 v = {lo, hi}; return __builtin_bit_cast(unsigned, __builtin_convertvector(v, bf2_t)); }
#define WAVE_LDS_SYNC() asm volatile("s_waitcnt lgkmcnt(0)" ::: "memory")

DI void s5_bfrags(const Params& P, int g, int lane, bf16x8 (&bf)[4]) {
    const int q = lane & 31, h = lane >> 5;
#pragma unroll
    for (int pj = 0; pj < 2; ++pj) {
        const int p = q + 32 * pj;
        const S5Coef c = s5_coefs(P, g, p);
        const f32x4* br = (const f32x4*)(P.b_re + ((size_t)g * 64 + p) * 16 + 8 * h);
        const f32x4* bi = (const f32x4*)(P.b_im + ((size_t)g * 64 + p) * 16 + 8 * h);
        const f32x4 r0 = br[0], r1 = br[1], i0 = bi[0], i1 = bi[1];
        float re[8], im[8];
#pragma unroll
        for (int j = 0; j < 4; ++j) {
            re[j] = c.cr * r0[j] - c.ci * i0[j]; im[j] = c.cr * i0[j] + c.ci * r0[j];
            re[4 + j] = c.cr * r1[j] - c.ci * i1[j]; im[4 + j] = c.cr * i1[j] + c.ci * r1[j];
        }
        const u32x4 wr = {pk_bf16(re[0], re[1]), pk_bf16(re[2], re[3]), pk_bf16(re[4], re[5]), pk_bf16(re[6], re[7])};
        const u32x4 wi = {pk_bf16(im[0], im[1]), pk_bf16(im[2], im[3]), pk_bf16(im[4], im[5]), pk_bf16(im[6], im[7])};
        bf[2 * pj] = __builtin_bit_cast(bf16x8, wr); bf[2 * pj + 1] = __builtin_bit_cast(bf16x8, wi);
    }
}
DI bf16x8 s5_ufrag(const Params& P, int rowbase, int g, int lane, const f32x4& ga, const f32x4& gb) {
    const int t = lane & 31, h = lane >> 5, row = rowbase + t;
    const float rs = rsqrtf(P.rowss[T_TOK + row] * (1.f / DM) + RMS_EPS);
    const f32x4* xp = (const f32x4*)(P.xres + (size_t)row * DM + 16 * g + 8 * h);
    const f32x4 a = xp[0] * rs * ga, b = xp[1] * rs * gb;
    const u32x4 w = {pk_bf16(a.x, a.y), pk_bf16(a.z, a.w), pk_bf16(b.x, b.y), pk_bf16(b.z, b.w)};
    return __builtin_bit_cast(bf16x8, w);
}
template <bool WRITE>
DI void s5_scan32(const f32x16 (&X)[4], int h, int p, float ar, float ai, float& hr, float& hi, LAS unsigned char* hs) {
    float lo_re[16], lo_im[16], hi_re[16], hi_im[16];
#pragma unroll
    for (int r = 0; r < 16; ++r) {
        const auto sr = __builtin_amdgcn_permlane32_swap(__float_as_uint(X[0][r]), __float_as_uint(X[2][r]), false, false);
        const auto si = __builtin_amdgcn_permlane32_swap(__float_as_uint(X[1][r]), __float_as_uint(X[3][r]), false, false);
        lo_re[r] = __uint_as_float(sr[0]); hi_re[r] = __uint_as_float(sr[1]);
        lo_im[r] = __uint_as_float(si[0]); hi_im[r] = __uint_as_float(si[1]);
    }
#pragma unroll
    for (int i = 0; i < 4; ++i)
#pragma unroll
        for (int half = 0; half < 2; ++half)
#pragma unroll
            for (int j = 0; j < 4; ++j) {
                const int r = 4 * i + j, token = 8 * i + 4 * half + j;
                const float xr = half ? hi_re[r] : lo_re[r], xi = half ? hi_im[r] : lo_im[r];
                const float nhr = ar * hr - ai * hi + xr, nhi = ar * hi + ai * hr + xi; hr = nhr; hi = nhi;
                if (WRITE) {
                    const unsigned whi = pk_bf16(hr, hi);
                    *(LAS unsigned*)(hs + token * 272 + 4 * p) = whi;
                    *(LAS unsigned*)(hs + 69632 + token * 272 + 4 * p) = pk_bf16(hr - bf_lo(whi), hi - bf_hi(whi));
                }
            }
}

struct S5In { f32x4 x0, x1; float ss; };
DI S5In s5_in_load(const Params& P, int rowbase, int g, int lane) {
    const int row = rowbase + (lane & 31);
    const f32x4* xp = (const f32x4*)(P.xres + (size_t)row * DM + 16 * g + 8 * (lane >> 5));
    S5In r; r.x0 = xp[0]; r.x1 = xp[1]; r.ss = P.rowss[T_TOK + row]; return r;
}
DI bf16x8 s5_in_frag(const S5In& in, const f32x4& ga, const f32x4& gb) {
    const float rs = rsqrtf(in.ss * (1.f / DM) + RMS_EPS);
    const f32x4 a = in.x0 * rs * ga, b = in.x1 * rs * gb;
    const u32x4 w = {pk_bf16(a.x, a.y), pk_bf16(a.z, a.w), pk_bf16(b.x, b.y), pk_bf16(b.z, b.w)};
    return __builtin_bit_cast(bf16x8, w);
}
DI int s5_row0(int L, int wave) { const int bc = L & 31; return (bc >> 4) * SEQ + ((bc & 15) * 8 + wave) * 64; }

DI void phase_s5a(const Params& P, LAS unsigned char* lds) {
    const int tid = threadIdx.x, wave = tid >> 6, lane = tid & 63, h = lane >> 5;
    for (int base = blockIdx.x * 8; base < 2048; base += gridDim.x * 8) {
        const int g = base >> 5;
        const S5Coef cf = s5_coefs(P, g, lane);
        bf16x8 bf[4]; s5_bfrags(P, g, lane, bf);
        const f32x4 ga = *(const f32x4*)(P.norm_g + DM + 16 * g + 8 * h), gb = *(const f32x4*)(P.norm_g + DM + 16 * g + 8 * h + 4);
        float hr = 0.f, hi = 0.f;
        S5In pre = s5_in_load(P, s5_row0(base, wave), g, lane);
#pragma unroll 1
        for (int step = 0; step < 16; ++step) {
            const int L = base + (step >> 1), sub = step & 1;
            const S5In cur = pre;
            if (step < 15) pre = s5_in_load(P, s5_row0(base + ((step + 1) >> 1), wave) + 32 * ((step + 1) & 1), g, lane);
            const bf16x8 a = s5_in_frag(cur, ga, gb);
            f32x16 X[4];
#pragma unroll
            for (int j = 0; j < 4; ++j) {
#pragma unroll
                for (int r = 0; r < 16; ++r) X[j][r] = 0.f;
                X[j] = __builtin_amdgcn_mfma_f32_32x32x16_bf16(a, bf[j], X[j], 0, 0, 0);
            }
            if (sub == 0) { hr = 0.f; hi = 0.f; }
            s5_scan32<false>(X, h, lane, cf.ar, cf.ai, hr, hi, lds);
            if (sub == 1) { const int bc = L & 31, ch = (bc & 15) * 8 + wave; *(f32x2*)(P.E + ((size_t)(((bc >> 4) * 128 + ch) * 64 + g) * 64 + lane) * 2) = (f32x2){hr, hi}; }
        }
    }
}

DI void phase_s5carry(const Params& P) {
    if (blockIdx.x < 128 && threadIdx.x < 64) {
        const int idx = blockIdx.x * 64 + threadIdx.x, b = idx >> 12, g = (idx >> 6) & 63, p = idx & 63;
        const S5Coef cf = s5_coefs(P, g, p);
        float alr = cf.ar, ali = cf.ai;
#pragma unroll
        for (int q = 0; q < 6; ++q) { const float r = alr * alr - ali * ali, i2 = 2.f * alr * ali; alr = r; ali = i2; }
        f32x2* Ep = (f32x2*)P.E + (size_t)(b * 128) * 4096 + g * 64 + p;
        float hr = 0.f, hi = 0.f;
#pragma unroll 1
        for (int j0 = 0; j0 < 128; j0 += 32) {
            f32x2 e[32];
#pragma unroll
            for (int u = 0; u < 32; ++u) e[u] = Ep[(size_t)(j0 + u) * 4096];
#pragma unroll
            for (int u = 0; u < 32; ++u) {
                Ep[(size_t)(j0 + u) * 4096] = (f32x2){hr, hi};
                const float nr = alr * hr - ali * hi + e[u].x, ni = alr * hi + ali * hr + e[u].y; hr = nr; hi = ni;
            }
        }
    }
}

DI void phase_s5b(const Params& P, LAS unsigned char* lds) {
    const int tid = threadIdx.x, wave = tid >> 6, lane = tid & 63, h = lane >> 5, c16 = lane & 15, kq = lane >> 4;
    LAS unsigned char* hs = lds + wave * 8704;
    for (int base = blockIdx.x * 8; base < 2048; base += gridDim.x * 8) {
        const int g = base >> 5;
        const S5Coef cf = s5_coefs(P, g, lane);
        bf16x8 bf[4]; s5_bfrags(P, g, lane, bf);
        const f32x4 ga = *(const f32x4*)(P.norm_g + DM + 16 * g + 8 * h), gb = *(const f32x4*)(P.norm_g + DM + 16 * g + 8 * h + 4);
        bf16x8 cmf[4], cml[4];
#pragma unroll
        for (int ks = 0; ks < 4; ++ks) {
            const int p0 = ks * 16 + kq * 4;
            const f32x4 cr = *(const f32x4*)(P.c_re + ((size_t)g * 16 + c16) * 64 + p0), ci = *(const f32x4*)(P.c_im + ((size_t)g * 16 + c16) * 64 + p0);
            const float v[8] = {cr.x, -ci.x, cr.y, -ci.y, cr.z, -ci.z, cr.w, -ci.w};
            u32x4 wh, wl;
#pragma unroll
            for (int e = 0; e < 4; ++e) { wh[e] = pk_bf16(v[2 * e], v[2 * e + 1]); wl[e] = pk_bf16(v[2 * e] - bf_lo(wh[e]), v[2 * e + 1] - bf_hi(wh[e])); }
            cmf[ks] = __builtin_bit_cast(bf16x8, wh); cml[ks] = __builtin_bit_cast(bf16x8, wl);
        }
        const f32x4 d4 = *(const f32x4*)(P.s5_d + 16 * g + 4 * kq), ge = *(const f32x4*)(P.norm_g + DM + 16 * g + 4 * kq);
        float hr = 0.f, hi = 0.f;
        S5In pre = s5_in_load(P, s5_row0(base, wave), g, lane);
        f32x2 cpre; { const int bc = base & 31, ch = (bc & 15) * 8 + wave; cpre = *((const f32x2*)P.E + ((size_t)((bc >> 4) * 128 + ch) * 64 + g) * 64 + lane); }
#pragma unroll 1
        for (int step = 0; step < 16; ++step) {
            const int L = base + (step >> 1), sub = step & 1, rowb = s5_row0(L, wave) + 32 * sub;
            const S5In cur = pre;
            if (sub == 0) { hr = cpre.x; hi = cpre.y; }
            if (step < 15) pre = s5_in_load(P, s5_row0(base + ((step + 1) >> 1), wave) + 32 * ((step + 1) & 1), g, lane);
            if (sub == 1 && step < 15) { const int bc = (L + 1) & 31, ch = (bc & 15) * 8 + wave; cpre = *((const f32x2*)P.E + ((size_t)((bc >> 4) * 128 + ch) * 64 + g) * 64 + lane); }
            const bf16x8 a = s5_in_frag(cur, ga, gb);
            f32x16 X[4];
#pragma unroll
            for (int j = 0; j < 4; ++j) {
#pragma unroll
                for (int r = 0; r < 16; ++r) X[j][r] = 0.f;
                X[j] = __builtin_amdgcn_mfma_f32_32x32x16_bf16(a, bf[j], X[j], 0, 0, 0);
            }
            s5_scan32<true>(X, h, lane, cf.ar, cf.ai, hr, hi, hs);
            WAVE_LDS_SYNC();
#pragma unroll
            for (int tt = 0; tt < 2; ++tt) {
                f32x4 acc = {0.f, 0.f, 0.f, 0.f};
#pragma unroll
                for (int ks = 0; ks < 4; ++ks) {
                    const LAS unsigned char* ha = hs + (tt * 16 + c16) * 272 + ks * 64 + kq * 16;
                    const bf16x8 hbh = *(const LAS bf16x8*)ha, hbl = *(const LAS bf16x8*)(ha + 69632);
                    acc = __builtin_amdgcn_mfma_f32_16x16x32_bf16(cml[ks], hbh, acc, 0, 0, 0);
                    acc = __builtin_amdgcn_mfma_f32_16x16x32_bf16(cmf[ks], hbl, acc, 0, 0, 0);
                    acc = __builtin_amdgcn_mfma_f32_16x16x32_bf16(cmf[ks], hbh, acc, 0, 0, 0);
                }
                const int row = rowb + 16 * tt + c16;
                const float rs = rsqrtf(P.rowss[T_TOK + row] * (1.f / DM) + RMS_EPS);
                const f32x4 u4 = *(const f32x4*)(P.xres + (size_t)row * DM + 16 * g + 4 * kq) * rs * ge;
                f32x4 y;
#pragma unroll
                for (int j = 0; j < 4; ++j) y[j] = gelu_tanh(acc[j] + d4[j] * u4[j]);
                store_bf4(P.yb + (size_t)row * DM + 16 * g + 4 * kq, y);
            }
            WAVE_LDS_SYNC();
        }
    }
}

DI void phase_kmean(const Params& P, LAS unsigned char* lds) {
    if (blockIdx.x < 128) {
        const int j = blockIdx.x, d = threadIdx.x & 127, part = threadIdx.x >> 7;
        const bf16_t* kb = P.kbuf + ((size_t)(j >> 5) * SEQ + (j & 31) * 256 + part * 64) * 128 + d;
        float s = 0.f;
#pragma unroll 1
        for (int k0 = 0; k0 < 64; k0 += 16) {
            unsigned short v[16];
#pragma unroll
            for (int u = 0; u < 16; ++u) v[u] = kb[(size_t)(k0 + u) * 128];
#pragma unroll
            for (int u = 0; u < 16; ++u) s += __uint_as_float(((unsigned)v[u]) << 16);
        }
        LAS float* red = (LAS float*)lds;
        red[threadIdx.x] = s;
        __syncthreads();
        if (threadIdx.x < 128) P.kmean[j * 128 + d] = (red[d] + red[128 + d] + red[256 + d] + red[384 + d]) * (1.f / 256.f);
    }
}

DI int list_off(int c, int n) { return c * (496 * 1024) + 1024 * (31 * n - (n * (n - 1)) / 2); }

DI void phase_gate(const Params& P, LAS unsigned char* lds) {
    const int tid = threadIdx.x, wave = tid >> 6, lane = tid & 63;
    LAS float* km = (LAS float*)lds;
    LAS int* cnt = (LAS int*)(lds + 32768);
    LAS int* base = cnt + 64;
    for (int qb = blockIdx.x; qb < 256; qb += gridDim.x) {
        const int b = qb >> 7, i = qb & 127, own = i >> 2;
        for (int e = tid; e < 2048; e += 512) {
            const f32x4 v = ((const f32x4*)(P.kmean + b * 8192))[e];
            const int hn = e >> 5, d4 = (e & 31) * 4, hk2 = hn >> 5, n = hn & 31;
            LAS float* dst = km + (hk2 * 128 + d4) * 32 + n;
            dst[0] = v.x; dst[32] = v.y; dst[64] = v.z; dst[96] = v.w;
        }
        if (tid < 64) cnt[tid] = 0;
        __syncthreads();
        const int hq = wave, hk = hq >> 2, t = b * SEQ + i * 64 + lane;
        f32x2 g2[16];
#pragma unroll
        for (int n2 = 0; n2 < 16; ++n2) g2[n2] = (f32x2){0.f, 0.f};
        const u32x4* qr = (const u32x4*)(P.qbuf + (size_t)t * DM + hq * 128);
        {
            u32x4 wa = qr[0], wb = qr[1];
#pragma unroll 1
            for (int c = 0; c < 16; ++c) {
                const u32x4 w = wa; wa = wb; wb = qr[(c + 2) & 15];
                const float qv[8] = {bf_lo(w.x), bf_hi(w.x), bf_lo(w.y), bf_hi(w.y), bf_lo(w.z), bf_hi(w.z), bf_lo(w.w), bf_hi(w.w)};
#pragma unroll
                for (int j = 0; j < 8; ++j) {
                    const LAS f32x4* kp = (const LAS f32x4*)(km + (hk * 128 + 8 * c + j) * 32);
#pragma unroll
                    for (int i4 = 0; i4 < 8; ++i4) {
                        const f32x4 k4 = kp[i4];
                        g2[2 * i4] += (f32x2){k4.x, k4.y} * qv[j];
                        g2[2 * i4 + 1] += (f32x2){k4.z, k4.w} * qv[j];
                    }
                }
            }
        }
        float g[32];
#pragma unroll
        for (int n = 0; n < 32; ++n) g[n] = g2[n >> 1][n & 1];
        const int nsel = own < 3 ? own : 3;
        int s0 = -1, s1 = -1, s2 = -1;
        { float best = -3e38f;
#pragma unroll
          for (int n = 0; n < 32; ++n) if (n < own && g[n] > best) { best = g[n]; s0 = n; } }
        { float best = -3e38f;
#pragma unroll
          for (int n = 0; n < 32; ++n) if (n < own && n != s0 && g[n] > best) { best = g[n]; s1 = n; } }
        { float best = -3e38f;
#pragma unroll
          for (int n = 0; n < 32; ++n) if (n < own && n != s0 && n != s1 && g[n] > best) { best = g[n]; s2 = n; } }
        int l0 = 0, l1 = 0, l2 = 0;
        if (nsel > 0) l0 = atomicAdd((int*)&cnt[hk * 32 + s0], 1);
        if (nsel > 1) l1 = atomicAdd((int*)&cnt[hk * 32 + s1], 1);
        if (nsel > 2) l2 = atomicAdd((int*)&cnt[hk * 32 + s2], 1);
        __syncthreads();
        if (tid < 64) { const int c = cnt[tid]; base[tid] = c > 0 ? atomicAdd(P.gcount + b * 64 + tid, c) : 0; }
        __syncthreads();
        const int row = t * 8 + hq, c2 = b * 2 + hk;
        if (nsel > 0) P.lists[list_off(c2, s0) + base[hk * 32 + s0] + l0] = row * 4 + 1;
        if (nsel > 1) P.lists[list_off(c2, s1) + base[hk * 32 + s1] + l1] = row * 4 + 2;
        if (nsel > 2) P.lists[list_off(c2, s2) + base[hk * 32 + s2] + l2] = row * 4 + 3;
        __syncthreads();
    }
}

template <bool OWN>
DI void phase_attn(const Params& P, LAS unsigned char* lds, int bid) {
    const int tid = threadIdx.x, wave = __builtin_amdgcn_readfirstlane(tid >> 6), lane = tid & 63, h = lane >> 5, l32 = lane & 31;
    LAS unsigned char* Ks = lds;
    LAS unsigned char* Vs = lds + 69632;
    LAS int* pref = (LAS int*)(lds + 136192);
    if constexpr (!OWN) {
        LAS int* cntl = pref + 132;
        if (tid < 128) cntl[tid] = (P.gcount[tid] + 255) >> 8;
        __syncthreads();
        if (tid <= 128) { int a = 0; for (int i = 0; i < 128; ++i) a += (i < tid) ? cntl[i] : 0; pref[tid] = a; }
        __syncthreads();
    }
    const int total = OWN ? 512 : pref[128];
    constexpr float LOG2E = 1.4426950408889634f;
    int rnd = 0;
    for (int idx = bid; idx < total; idx += gridDim.x, ++rnd) {
        const int item = (OWN && (rnd & 1)) ? (idx ^ 3) : idx;
        int c, n, i_q = 0, nrows = 256; const int* lst = P.lists; constexpr bool is_own = OWN;
        if (is_own) { c = item >> 7; i_q = item & 127; n = i_q >> 2; }
        else {
            const int s = item; int lo = 0, hi = 128;
            while (hi - lo > 1) { const int mid = (lo + hi) >> 1; if (pref[mid] <= s) lo = mid; else hi = mid; }
            c = lo >> 5; n = lo & 31; const int grp = s - pref[lo]; lst = P.lists + list_off(c, n) + grp * 256; nrows = P.gcount[lo] - grp * 256; if (nrows > 256) nrows = 256;
        }
        const int b = c >> 1, hk = c & 1;
        int ent; bool valid = true; const int rho = wave * 32 + l32;
        if (is_own) { const int hq = hk * 4 + (rho >> 6), t = b * SEQ + i_q * 64 + (rho & 63); ent = (t * 8 + hq) * 4; }
        else { valid = rho < nrows; ent = lst[valid ? rho : 0]; }
        bf16x8 qf[8];
        {
            const bf16_t* kg = P.kbuf + ((size_t)c * SEQ + n * 256) * 128;
            const bf16_t* vg = P.vT + (size_t)c * 128 * SEQ + n * 256;
            const bf16_t* kgl = kg + (size_t)(tid >> 4) * 128 + (tid & 15) * 8;
            LAS unsigned char* kl = Ks + (tid >> 4) * 272 + (tid & 15) * 16;
            const bf16_t* vgl = vg + (size_t)(tid >> 5) * SEQ + (tid & 31) * 8;
            LAS unsigned char* vl = Vs + (tid >> 5) * 520 + (tid & 31) * 16;
            u32x4 kw[8], vw[8];
#pragma unroll
            for (int q = 0; q < 8; ++q) kw[q] = *(const u32x4*)(kgl + q * 4096);
#pragma unroll
            for (int q = 0; q < 8; ++q) vw[q] = *(const u32x4*)(vgl + (size_t)q * 16 * SEQ);
        { const int row = ent >> 2, t = row >> 3, hq = row & 7; const bf16_t* qp = P.qbuf + (size_t)t * DM + hq * 128 + 8 * h;
#pragma unroll
          for (int ks = 0; ks < 8; ++ks) qf[ks] = *(const bf16x8*)(qp + ks * 16); }
#pragma unroll
            for (int q = 0; q < 8; ++q) *(LAS u32x4*)(kl + q * 8704) = kw[q];
#pragma unroll
            for (int q = 0; q < 8; ++q) { LAS u32x2* dst = (LAS u32x2*)(vl + q * 8320); dst[0] = (u32x2){vw[q].x, vw[q].y}; dst[1] = (u32x2){vw[q].z, vw[q].w}; }
        }
        __syncthreads();
        if (wave < 4) __builtin_amdgcn_s_setprio(2);
        if (wave * 32 < nrows) {
            const int nkt = is_own ? (2 * (i_q & 3) + (wave & 1) + 1) : 8;
            const int posb = is_own ? (64 * (i_q & 3) + (rho & 63)) : 100000;
            float m_run = -1e30f, l_run = 0.f;
            f32x16 o[4];
#pragma unroll
            for (int db = 0; db < 4; ++db)
#pragma unroll
                for (int r = 0; r < 16; ++r) o[db][r] = 0.f;
#pragma unroll 1
            for (int hf = 0; hf < 2; ++hf) {
                if (4 * hf >= nkt) break;
                f32x16 s[4];
#pragma unroll
                for (int kq = 0; kq < 4; ++kq) {
                    const int kt = 4 * hf + kq;
                    if (kt < nkt) {
#pragma unroll
                        for (int r = 0; r < 16; ++r) s[kq][r] = 0.f;
#pragma unroll
                        for (int ks = 0; ks < 8; ++ks) {
                            const bf16x8 a = *(const LAS bf16x8*)(Ks + (kt * 32 + l32) * 272 + ks * 32 + 16 * h);
                            s[kq] = __builtin_amdgcn_mfma_f32_32x32x16_bf16(a, qf[ks], s[kq], 0, 0, 0);
                            asm volatile("" :: "v"(a));
                        }
                        if (is_own) {
#pragma unroll
                            for (int r = 0; r < 16; ++r) { const int key = kt * 32 + (r & 3) + 8 * (r >> 2) + 4 * h; if (key > posb) s[kq][r] = -1e30f; }
                        }
                    } else {
#pragma unroll
                        for (int r = 0; r < 16; ++r) s[kq][r] = -1e30f;
                    }
                    __builtin_amdgcn_sched_barrier(0);
                }
                float mx = -1e30f;
#pragma unroll
                for (int kq = 0; kq < 4; ++kq)
#pragma unroll
                    for (int r = 0; r < 16; ++r) mx = fmaxf(mx, s[kq][r]);
                mx = fmaxf(mx, __shfl_xor(mx, 32));
                const float m_new = fmaxf(m_run, mx), mL = m_new * LOG2E;
                const float alpha = __builtin_amdgcn_exp2f((m_run - m_new) * LOG2E);
                float lsum = 0.f;
#pragma unroll
                for (int kq = 0; kq < 4; ++kq)
#pragma unroll
                    for (int r = 0; r < 16; ++r) { const float p = __builtin_amdgcn_exp2f(s[kq][r] * LOG2E - mL); s[kq][r] = p; lsum += p; }
                lsum += __shfl_xor(lsum, 32);
                l_run = l_run * alpha + lsum; m_run = m_new;
                if (hf == 1) {
#pragma unroll
                    for (int db = 0; db < 4; ++db)
#pragma unroll
                        for (int r = 0; r < 16; ++r) o[db][r] *= alpha;
                }
#pragma unroll
                for (int kq = 0; kq < 4; ++kq) {
                    const int kt = 4 * hf + kq;
                    if (kt < nkt) {
#pragma unroll
                        for (int st = 0; st < 2; ++st) {
                            u32x4 pw;
                            pw.x = pk_bf16(s[kq][8 * st + 0], s[kq][8 * st + 1]); pw.y = pk_bf16(s[kq][8 * st + 2], s[kq][8 * st + 3]);
                            pw.z = pk_bf16(s[kq][8 * st + 4], s[kq][8 * st + 5]); pw.w = pk_bf16(s[kq][8 * st + 6], s[kq][8 * st + 7]);
                            const bf16x8 pf = __builtin_bit_cast(bf16x8, pw);
#pragma unroll
                            for (int db = 0; db < 4; ++db) {
                                const LAS unsigned char* va = Vs + (32 * db + l32) * 520 + (kt * 32 + 16 * st + 4 * h) * 2;
                                const u32x2 vlo = *(const LAS u32x2*)va, vhi = *(const LAS u32x2*)(va + 16);
                                const u32x4 vw = {vlo.x, vlo.y, vhi.x, vhi.y};
                                o[db] = __builtin_amdgcn_mfma_f32_32x32x16_bf16(__builtin_bit_cast(bf16x8, vw), pf, o[db], 0, 0, 0);
                            }
                            __builtin_amdgcn_sched_barrier(0);
                        }
                    }
                }
            }
            asm volatile("" : "+v"(ent));
            if constexpr (!OWN) {
                if (valid) {
                    const float inv = 1.f / l_run;
                    const int slot = ent & 3; const int row = ent >> 2;
                    if (h == 0) *(f32x2*)(P.part_ml + (size_t)ent * 2) = (f32x2){m_run, l_run};
                    int h2 = h; asm volatile("" : "+v"(h2));
                    bf16_t* pb = P.part[1];
                    if (slot == 2) pb = P.part[2]; else if (slot == 3) pb = P.part[3];
                    bf16_t* po = pb + ((size_t)row * 128 + 4 * h2);
#pragma unroll
                    for (int db = 0; db < 4; ++db)
#pragma unroll
                        for (int rq = 0; rq < 4; ++rq) {
                            u32x2 w; w.x = pk_bf16(o[db][4 * rq] * inv, o[db][4 * rq + 1] * inv); w.y = pk_bf16(o[db][4 * rq + 2] * inv, o[db][4 * rq + 3] * inv);
                            *(u32x2*)(po + 32 * db + 8 * rq) = w;
                        }
                }
            } else {
                const int row = ent >> 2, nsel = n < 3 ? n : 3;
                int h2 = h; asm volatile("" : "+v"(h2));
                float M = m_run; f32x2 ml[3];
#pragma unroll
                for (int s2 = 0; s2 < 3; ++s2) { ml[s2] = (f32x2){-1e30f, 0.f}; if (s2 < nsel) { ml[s2] = *(const f32x2*)(P.part_ml + ((size_t)row * 4 + s2 + 1) * 2); M = fmaxf(M, ml[s2].x); } }
                const float w0 = __builtin_amdgcn_exp2f((m_run - M) * LOG2E);
                float ws[3], L = l_run * w0;
#pragma unroll
                for (int s2 = 0; s2 < 3; ++s2) { ws[s2] = ml[s2].y * __builtin_amdgcn_exp2f((ml[s2].x - M) * LOG2E); L += ws[s2]; }
                const float inv = 1.f / L, w0i = w0 * inv;
                const size_t poff = (size_t)row * 128 + 4 * h2;
                bf16_t* ao = P.attn + (size_t)(row >> 3) * DM + (row & 7) * 128 + 4 * h2;
#pragma unroll
                for (int db = 0; db < 4; ++db) {
                    u32x2 pv[3][4];
#pragma unroll
                    for (int s2 = 0; s2 < 3; ++s2)
#pragma unroll
                        for (int rq = 0; rq < 4; ++rq) { pv[s2][rq] = (u32x2){0u, 0u}; if (s2 < nsel) pv[s2][rq] = *(const u32x2*)(P.part[s2 + 1] + poff + 32 * db + 8 * rq); }
#pragma unroll
                    for (int rq = 0; rq < 4; ++rq) {
                        float a0 = o[db][4 * rq] * w0i, a1 = o[db][4 * rq + 1] * w0i, a2 = o[db][4 * rq + 2] * w0i, a3 = o[db][4 * rq + 3] * w0i;
#pragma unroll
                        for (int s2 = 0; s2 < 3; ++s2) { const float wv = ws[s2] * inv; a0 += wv * bf_lo(pv[s2][rq].x); a1 += wv * bf_hi(pv[s2][rq].x); a2 += wv * bf_lo(pv[s2][rq].y); a3 += wv * bf_hi(pv[s2][rq].y); }
                        u32x2 w; w.x = pk_bf16(a0, a1); w.y = pk_bf16(a2, a3);
                        *(u32x2*)(ao + 32 * db + 8 * rq) = w;
                    }
                }
            }
        }
        __builtin_amdgcn_s_setprio(0);
        __syncthreads();
    }
}

DI void phase_combine(const Params& P) {
    const int tid = threadIdx.x, wave = tid >> 6, lane = tid & 63;
    const int gw = blockIdx.x * 8 + wave, NGW = gridDim.x * 8;
    for (int row = gw; row < T_TOK * 8; row += NGW) {
        const int t = row >> 3, hq = row & 7, own = (t & (SEQ - 1)) >> 8, nsel = own < 3 ? own : 3;
        float m[4], l[4];
#pragma unroll
        for (int s = 0; s < 4; ++s) { if (s <= nsel) { const f32x2 ml = *(const f32x2*)(P.part_ml + ((size_t)row * 4 + s) * 2); m[s] = ml.x; l[s] = ml.y; } else { m[s] = -1e30f; l[s] = 0.f; } }
        const float M = fmaxf(fmaxf(m[0], m[1]), fmaxf(m[2], m[3]));
        float o0 = 0.f, o1 = 0.f, L = 0.f;
#pragma unroll
        for (int s = 0; s < 4; ++s) {
            if (s <= nsel) {
                const float w = l[s] * __expf(m[s] - M); L += w;
                const unsigned v = *(const unsigned*)(P.part[s] + (size_t)row * 128 + 2 * lane);
                o0 += w * bf_lo(v); o1 += w * bf_hi(v);
            }
        }
        const float inv = 1.f / L;
        *(unsigned*)(P.attn + (size_t)t * DM + hq * 128 + 2 * lane) = cvt_pk_bf16(o0 * inv, o1 * inv);
    }
}

DI void phase_final(const Params& P) {
    const int tid = threadIdx.x, wave = tid >> 6, lane = tid & 63;
    const int gw = blockIdx.x * 8 + wave, NGW = gridDim.x * 8;
    for (int row = gw; row < T_TOK; row += NGW) {
        const float rs = rsqrtf(P.rowss[6 * T_TOK + row] * (1.f / DM) + RMS_EPS);
        const f32x4* xr = (const f32x4*)(P.xres + (size_t)row * DM) + lane;
        const f32x4* gr = (const f32x4*)P.final_g + lane;
        f32x4* o = (f32x4*)(P.out + (size_t)row * DM) + lane;
#pragma unroll
        for (int j = 0; j < 4; ++j) o[64 * j] = xr[64 * j] * rs * gr[64 * j];
    }
}

DI void phase_final_fused(const Params& P, LAS unsigned char* lds, int vbid) {
    pg8::StaticOrder S; S.init(T_TOK, DM, gridDim.x, vbid);
    pg8::Unit u;
    if (!S.next(0, u)) return;
    const int tid = threadIdx.x, wave = tid >> 6, lane = tid & 63;
    asm volatile("s_waitcnt vmcnt(0)" ::: "memory");
    __syncthreads();
    LAS int* flag = (LAS int*)lds;
    if (tid == 0) flag[0] = atomicAdd(P.pcnt + u.pm, 1);
    __syncthreads();
    if (flag[0] != 3) return;
    __builtin_amdgcn_fence(__ATOMIC_ACQUIRE, "agent");
    asm volatile("s_waitcnt vmcnt(0)" ::: "memory");
    const f32x4* gr = (const f32x4*)P.final_g + lane;
    const f32x4 g0 = gr[0], g1 = gr[64], g2 = gr[128], g3 = gr[192];
#pragma unroll 1
    for (int r0 = wave * 32; r0 < wave * 32 + 32; r0 += 4) {
        f32x4 v[4][4]; float ss[4];
#pragma unroll
        for (int i = 0; i < 4; ++i) {
            const int row = u.pm * 256 + r0 + i;
            const f32x4* xr = (const f32x4*)(P.xres + (size_t)row * DM) + lane;
            ss[i] = P.rowss[6 * T_TOK + row];
            v[i][0] = xr[0]; v[i][1] = xr[64]; v[i][2] = xr[128]; v[i][3] = xr[192];
        }
#pragma unroll
        for (int i = 0; i < 4; ++i) {
            const int row = u.pm * 256 + r0 + i;
            const float rs = rsqrtf(ss[i] * (1.f / DM) + RMS_EPS);
            f32x4* o = (f32x4*)(P.out + (size_t)row * DM) + lane;
            o[0] = v[i][0] * rs * g0; o[64] = v[i][1] * rs * g1; o[128] = v[i][2] * rs * g2; o[192] = v[i][3] * rs * g3;
        }
    }
}

#define XB_TMO      128
#define XB_XCNT(j)  (256  + 64 * (j))
#define XB_XSUB(j)  (1280 + 64 * (j))
#define XB_XGEN(j)  (2304 + 64 * (j))
#define XB_TOP      3328
#define XB_TOPGEN   3392
#define XCD_BAR_WORDS 3456
#define XB_SPIN_CAP (1u << 18)
DI unsigned xb_ld(unsigned* p)              { return __hip_atomic_load(p, __ATOMIC_RELAXED, __HIP_MEMORY_SCOPE_AGENT); }
DI unsigned xb_add(unsigned* p, unsigned v) { return __hip_atomic_fetch_add(p, v, __ATOMIC_RELAXED, __HIP_MEMORY_SCOPE_AGENT); }
DI unsigned xb_xcc_id() { return (unsigned)__builtin_amdgcn_s_getreg((3 << 11) | 20) & 0xFu; }
#define XB_SPIN(cond, bar) do { unsigned _sp = 0; while (cond) { __builtin_amdgcn_s_sleep(1); \
    if ((++_sp & 255u) == 0u) { if (xb_ld(&(bar)[XB_TMO])) break; if (_sp > XB_SPIN_CAP) { atomicAdd(&(bar)[XB_TMO], 1u); break; } } } } while (0)
struct XcdBarrier { unsigned* bar; unsigned x; volatile LAS unsigned* st; };
DI XcdBarrier xcd_barrier_post(unsigned* bar, volatile LAS unsigned* st) {
    XcdBarrier b; b.bar = bar; b.x = xb_xcc_id(); b.st = st;
    if (threadIdx.x == 0) (void)xb_add(&bar[XB_XCNT(b.x)], 1u);
    return b;
}
DI void xcd_barrier_complete(unsigned* bar, unsigned x, unsigned& nloc, unsigned& nx) {
    const unsigned G = gridDim.x * gridDim.y * gridDim.z;
    unsigned sum, cnt, mine, sp = 0u;
    for (;;) {
        sum = 0u; cnt = 0u; mine = 0u;
#pragma unroll
        for (unsigned j = 0; j < 16; ++j) { const unsigned c = xb_ld(&bar[XB_XCNT(j)]); sum += c; cnt += (c > 0u) ? 1u : 0u; mine = (j == x) ? c : mine; }
        if (sum == G) break;
        __builtin_amdgcn_s_sleep(1);
        if ((++sp & 255u) == 0u) { if (xb_ld(&bar[XB_TMO])) break; if (sp > XB_SPIN_CAP) { atomicAdd(&bar[XB_TMO], 1u); break; } }
    }
    nloc = mine > 0u ? mine : 1u; nx = cnt > 0u ? cnt : 1u;
}
DI void xcd_barrier(const XcdBarrier& b) {
    asm volatile("s_waitcnt vmcnt(0)" ::: "memory");
    __syncthreads();
    if (threadIdx.x == 0) {
        unsigned* bar = b.bar;
        __builtin_amdgcn_s_waitcnt(0);
        unsigned nloc = b.st[0], nx = b.st[1];
        if (nloc == 0u) { xcd_barrier_complete(bar, b.x, nloc, nx); b.st[0] = nloc; b.st[1] = nx; }
        const unsigned old = xb_add(&bar[XB_XSUB(b.x)], 1u);
        const unsigned gen = old / nloc;
        if (old + 1u == (gen + 1u) * nloc) {
            __builtin_amdgcn_fence(__ATOMIC_RELEASE, "agent");
            asm volatile("s_waitcnt vmcnt(0)" ::: "memory");
            const unsigned og = xb_add(&bar[XB_TOP], 1u);
            const unsigned tg = og / nx;
            if (og + 1u == (tg + 1u) * nx) xb_add(&bar[XB_TOPGEN], 1u);
            else XB_SPIN(xb_ld(&bar[XB_TOPGEN]) == tg, bar);
            __builtin_amdgcn_fence(__ATOMIC_ACQUIRE, "agent");
            xb_add(&bar[XB_XGEN(b.x)], 1u);
            asm volatile("s_waitcnt vmcnt(0)" ::: "memory");
        } else {
            XB_SPIN(xb_ld(&bar[XB_XGEN(b.x)]) == gen, bar);
            __builtin_amdgcn_fence(__ATOMIC_ACQUIRE, "agent");
            asm volatile("s_waitcnt vmcnt(0)" ::: "memory");
        }
    }
    __syncthreads();
}

constexpr int NPHASES = 18;
#ifndef PHMASK
#define PHMASK 0xFFFFF
#endif
#define PHON(n) if constexpr (((PHMASK) >> (n)) & 1)
#ifndef DUPSEL
#define DUPSEL 0
#endif
__global__ void __launch_bounds__(512, 2) mega_fwd(const Params P) {
    extern __shared__ __attribute__((aligned(16))) unsigned char smem[];
    LAS unsigned char* lds = (LAS unsigned char*)smem;
    cg::grid_group grid = cg::this_grid();
    if (P.ph_hi < 0) grid.sync();
    volatile LAS unsigned* xst = (volatile LAS unsigned*)(lds + 139264);
    if (threadIdx.x == 0) { xst[0] = 0u; xst[1] = 0u; xst[2] = 0u; xst[3] = 0u; xst[4] = 0u; }
    __syncthreads();
    XcdBarrier xb; xb.bar = P.bar; xb.x = xb_xcc_id(); xb.st = xst;
    if (threadIdx.x == 0) xst[2] = xb_add(&P.bar[XB_XCNT(xb.x)], 1u);
    PHON(0) if (P.ph_lo <= 0 && 0 < P.ph_hi) { phase_prep(P, lds); }
    if constexpr (DUPSEL == 4) { xcd_barrier(xb); phase_prep(P, lds); }
    if (P.ph_lo < 1 && 1 < P.ph_hi) xcd_barrier(xb);
    if (threadIdx.x == 0) {
        bool ok = (gridDim.x % 8u) == 0u;
        for (unsigned j = 0; j < 16; ++j) { const unsigned c = xb_ld(&P.bar[XB_XCNT(j)]); ok = ok && (c == (j < 8 ? gridDim.x / 8u : 0u)); }
        xst[3] = ok ? (xb.x + 8u * xst[2]) : blockIdx.x; xst[4] = ok ? 1u : 0u;
    }
    __syncthreads();
    const int vbid = (int)xst[3];
    const bool vb_ok = xst[4] != 0u;
    const int abid = vb_ok ? ((vbid & 7) * (int)(gridDim.x >> 3) + (vbid >> 3)) : (int)blockIdx.x;
    preload_rs(lds, vbid, P.rowss + 0 * T_TOK, 5632); run_gemm_v(lds, vbid, P.xb, P.wt_up[0], 5632, DM, EpiAct{P.act, P.rowss + 0 * T_TOK, P.kbuf, P.vT, P.rope, (const LAS float*)(lds + 131072)});
    convert_by_light_blocks(P, lds, vbid, 64 * 22, P.it1, P.it2);
    if constexpr (DUPSEL == 2) { xcd_barrier(xb); preload_rs(lds, vbid, P.rowss + 0 * T_TOK, 5632); run_gemm_v(lds, vbid, P.xb, P.wt_up[0], 5632, DM, EpiAct{P.act, P.rowss + 0 * T_TOK, P.kbuf, P.vT, P.rope, (const LAS float*)(lds + 131072)}); }
    if (P.ph_lo < 2 && 2 < P.ph_hi) xcd_barrier(xb);
    PHON(2) if (P.ph_lo <= 2 && 2 < P.ph_hi) { run_gemm_v(lds, vbid, P.act, P.wt_dn[0], DM, FF, EpiRes{P.x, P.xres, P.xb, P.rowss + 1 * T_TOK}); }
    if (P.ph_lo < 3 && 3 < P.ph_hi) xcd_barrier(xb);
    PHON(3) if (P.ph_lo <= 3 && 3 < P.ph_hi) { phase_s5a(P, lds); }
    xcd_barrier(xb);
    phase_s5carry(P);
    if (P.ph_lo < 4 && 4 < P.ph_hi) xcd_barrier(xb);
    PHON(4) if (P.ph_lo <= 4 && 4 < P.ph_hi) { phase_s5b(P, lds); }
    if constexpr (DUPSEL == 3) { xcd_barrier(xb); phase_s5a(P, lds); xcd_barrier(xb); phase_s5carry(P); xcd_barrier(xb); phase_s5b(P, lds); }

    if (P.ph_lo < 5 && 5 < P.ph_hi) xcd_barrier(xb);
    PHON(5) if (P.ph_lo <= 5 && 5 < P.ph_hi) { run_gemm_v(lds, vbid, P.yb, P.wt_glu, 2048, DM, EpiGlu{P.xres, P.xb, P.rowss + 2 * T_TOK}); }
    if (P.ph_lo < 6 && 6 < P.ph_hi) xcd_barrier(xb);
    PHON(6) if (P.ph_lo <= 6 && 6 < P.ph_hi) { preload_rs(lds, vbid, P.rowss + 2 * T_TOK, 5632); run_gemm_v(lds, vbid, P.xb, P.wt_up[1], 5632, DM, EpiAct{P.act, P.rowss + 2 * T_TOK, P.kbuf, P.vT, P.rope, (const LAS float*)(lds + 131072)}); convert_by_light_blocks(P, lds, vbid, 64 * 22, P.it2, P.nitems); }
    if (P.ph_lo < 7 && 7 < P.ph_hi) xcd_barrier(xb);
    PHON(7) if (P.ph_lo <= 7 && 7 < P.ph_hi) { run_gemm_v(lds, vbid, P.act, P.wt_dn[1], DM, FF, EpiRes{P.xres, P.xres, P.xb, P.rowss + 3 * T_TOK}); }
    if (P.ph_lo < 8 && 8 < P.ph_hi) xcd_barrier(xb);
    PHON(8) if (P.ph_lo <= 8 && 8 < P.ph_hi) { preload_rs(lds, vbid, P.rowss + 3 * T_TOK, 6144); run_gemm_v(lds, vbid, P.xb, P.wt_up[2], 6144, DM, EpiAct{P.act, P.rowss + 3 * T_TOK, P.kbuf, P.vT, P.rope, (const LAS float*)(lds + 131072)}); }
    if (P.ph_lo < 9 && 9 < P.ph_hi) xcd_barrier(xb);
    PHON(9) if (P.ph_lo <= 9 && 9 < P.ph_hi) { run_gemm_v(lds, vbid, P.act, P.wt_dn[2], DM, FF, EpiRes{P.xres, P.xres, P.xb, P.rowss + 4 * T_TOK}); phase_kmean(P, lds); }
    if (P.ph_lo < 10 && 10 < P.ph_hi) xcd_barrier(xb);
    PHON(10) if (P.ph_lo <= 10 && 10 < P.ph_hi) { run_gemm_v(lds, vbid, P.xb, P.wt_q, DM, DM, EpiQ{P.qbuf, P.rowss + 4 * T_TOK, P.rope}); }
    if (P.ph_lo < 11 && 11 < P.ph_hi) xcd_barrier(xb);
    PHON(11) if (P.ph_lo <= 11 && 11 < P.ph_hi) { phase_gate(P, lds); }
    if (P.ph_lo < 12 && 12 < P.ph_hi) xcd_barrier(xb);
    PHON(12) if (P.ph_lo <= 12 && 12 < P.ph_hi) { phase_attn<false>(P, lds, abid); }
    if constexpr (DUPSEL == 6) { xcd_barrier(xb); phase_attn<false>(P, lds, abid); }
    if (P.ph_lo < 13 && 13 < P.ph_hi) xcd_barrier(xb);
    PHON(13) if (P.ph_lo <= 13 && 13 < P.ph_hi) { phase_attn<true>(P, lds, abid); }
    if constexpr (DUPSEL == 1) { for (int i = 0; i < 8; ++i) xcd_barrier(xb); }
    if (P.ph_lo < 14 && 14 < P.ph_hi) xcd_barrier(xb);
    PHON(14) if (P.ph_lo <= 14 && 14 < P.ph_hi) { run_gemm_v(lds, vbid, P.attn, P.wt_o, DM, DM, EpiRes{P.xres, P.xres, P.xb, P.rowss + 5 * T_TOK}); }
    if (P.ph_lo < 15 && 15 < P.ph_hi) xcd_barrier(xb);
    PHON(15) if (P.ph_lo <= 15 && 15 < P.ph_hi) { preload_rs(lds, vbid, P.rowss + 5 * T_TOK, 5632); run_gemm_v(lds, vbid, P.xb, P.wt_up[3], 5632, DM, EpiAct{P.act, P.rowss + 5 * T_TOK, P.kbuf, P.vT, P.rope, (const LAS float*)(lds + 131072)}); }
    if (P.ph_lo < 16 && 16 < P.ph_hi) xcd_barrier(xb);
    PHON(16) if (P.ph_lo <= 16 && 16 < P.ph_hi) { run_gemm_v(lds, vbid, P.act, P.wt_dn[3], DM, FF, EpiRes{P.xres, P.xres, P.xb, P.rowss + 6 * T_TOK}); }
    if (vb_ok && gridDim.x == 256u) { phase_final_fused(P, lds, vbid); }
    else { xcd_barrier(xb); phase_final(P); }
}

extern "C" void kernel_launch(void* const* d_in, const int* in_sizes, int n_in, void* d_out, int out_size, void* d_ws, size_t ws_size, hipStream_t stream) {
    static int grid_blocks = 0;
    if (!grid_blocks) {
        int dev = 0, cus = 0, per_cu = 0;
        hipGetDevice(&dev);
        hipDeviceGetAttribute(&cus, hipDeviceAttributeMultiprocessorCount, dev);
        hipFuncSetAttribute((const void*)mega_fwd, hipFuncAttributeMaxDynamicSharedMemorySize, LDS_BYTES);
        hipOccupancyMaxActiveBlocksPerMultiprocessor(&per_cu, (const void*)mega_fwd, 512, LDS_BYTES);
        if (per_cu < 1) per_cu = 1;
        if (per_cu > 1) per_cu = 1;
        grid_blocks = cus * per_cu;
    }
    Params p{};
    const float** in = (const float**)&p.x;
    for (int i = 0; i < 19; ++i) in[i] = (const float*)d_in[i];
    p.out = (float*)d_out;
    unsigned char* ws = (unsigned char*)d_ws; size_t off = 0;
    auto take = [&](size_t bytes) { unsigned char* r = ws + off; off += (bytes + 255) & ~(size_t)255; return r; };
    p.xres = (float*)take((size_t)T_TOK * DM * 4);
    p.xb = (bf16_t*)take((size_t)T_TOK * DM * 2);
    p.act = (bf16_t*)take((size_t)T_TOK * FF * 2);
    p.qbuf = p.act;
    p.attn = p.act + (size_t)T_TOK * DM;
    p.part_ml = (float*)(p.act + (size_t)2 * T_TOK * DM);
    p.kbuf = (bf16_t*)take((size_t)T_TOK * 256 * 2);
    p.vT = (bf16_t*)take((size_t)T_TOK * 256 * 2);
    p.kmean = (float*)take(128 * 128 * 4);
    p.rowss = (float*)take((size_t)7 * T_TOK * 4 + 1024);
    p.gcount = (int*)(p.rowss + 7 * T_TOK);
    p.E = (float*)take((size_t)2 * 128 * 64 * 64 * 2 * 4);
    p.lists = (int*)p.E;
    p.rope = (float*)take((size_t)SEQ * 16 * 2 * 4);
    p.bar = (unsigned*)take((size_t)XCD_BAR_WORDS * 4);
    p.s5tab = (float*)take(4096 * 4 * 4);
    p.pcnt = (int*)take(256);
    p.wt_up[0] = (bf16_t*)take((size_t)6144 * DM * 2); p.wt_up[1] = (bf16_t*)take((size_t)6144 * DM * 2);
    p.wt_dn[0] = (bf16_t*)take((size_t)DM * FF * 2); p.wt_dn[1] = (bf16_t*)take((size_t)DM * FF * 2);
    p.wt_glu = (bf16_t*)take((size_t)2048 * DM * 2);
    p.wt_up[2] = (bf16_t*)take((size_t)6144 * DM * 2); p.wt_up[3] = (bf16_t*)take((size_t)6144 * DM * 2);
    p.wt_dn[2] = (bf16_t*)take((size_t)DM * FF * 2); p.wt_dn[3] = (bf16_t*)take((size_t)DM * FF * 2);
    p.wt_q = (bf16_t*)take((size_t)DM * DM * 2);
    p.wt_o = (bf16_t*)take((size_t)DM * DM * 2);
    p.part[0] = p.xb;
    p.part[1] = (bf16_t*)take((size_t)T_TOK * DM * 2);
    p.part[2] = (bf16_t*)take((size_t)T_TOK * DM * 2);
    p.part[3] = p.wt_up[0];
    p.yb = p.part[1];
    int nj = 0, items = 0;
    auto job = [&](const float* W, const float* g, bf16_t* dst, int K, int Nsrc, int ndst, int mode, float scale = 1.f) {
        WJob& J = p.jobs[nj++]; J.W = W; J.g = g; J.dst = dst; J.K = K; J.Nsrc = Nsrc; J.ndst = ndst; J.mode = mode; J.item0 = items; J.scale = scale;
        items += (K / 64) * (ndst / 32);
    };
    auto job_up = [&](int l, int f) { job(p.ffn_w_in + (size_t)(l * 2 + f) * DM * 2 * FF, p.norm_g + (size_t)(l * 3 + (f ? 2 : 0)) * DM, p.wt_up[l * 2 + f], DM, 2 * FF, 2 * FF, 1); };
    auto job_dn = [&](int l, int f) { job(p.ffn_w_out + (size_t)(l * 2 + f) * FF * DM, nullptr, p.wt_dn[l * 2 + f], FF, DM, DM, 0, 0.5f); };
    job_up(0, 0);
    p.it1 = items;
    job_dn(0, 0); job(p.w_glu, nullptr, p.wt_glu, DM, 2048, 2048, 1); job_up(0, 1); job_dn(0, 1);
    p.it2 = items;
    job_up(1, 0);
    job(p.w_k, p.kv_norm_g, p.wt_up[2] + (size_t)5632 * DM, DM, 256, 256, 0);
    job(p.w_v, p.kv_norm_g, p.wt_up[2] + (size_t)5888 * DM, DM, 256, 256, 0);
    job_dn(1, 0); job_up(1, 1); job_dn(1, 1);
    job(p.w_q, p.norm_g + (size_t)4 * DM, p.wt_q, DM, DM, DM, 0);
    job(p.w_o, nullptr, p.wt_o, DM, DM, DM, 0);
    p.nitems = items; p.ph_lo = 0; p.ph_hi = NPHASES; p.pad = 0;
    if (off > ws_size) { fprintf(stderr, "workspace too small: need %zu have %zu\n", off, ws_size); return; }
    (void)hipMemsetAsync(p.bar, 0, (size_t)XCD_BAR_WORDS * 4, stream);
    void* args[] = {&p};
    hipError_t e = hipLaunchCooperativeKernel((const void*)mega_fwd, dim3(grid_blocks), dim3(512), args, LDS_BYTES, stream);
    if (e != hipSuccess) fprintf(stderr, "cooperative launch failed: %s (grid %d)\n", hipGetErrorString(e), grid_blocks);
}
```

```cpp
#include <hip/hip_runtime.h>
#include <hip/hip_cooperative_groups.h>
#include <cstdio>
namespace cg = cooperative_groups;

#define LAS __attribute__((address_space(3)))
#define DI __device__ __forceinline__
typedef unsigned short bf16_t;
typedef short bf16x8 __attribute__((ext_vector_type(8)));
typedef float f32x4 __attribute__((ext_vector_type(4)));
typedef float f32x2 __attribute__((ext_vector_type(2)));
typedef unsigned u32x4 __attribute__((ext_vector_type(4)));
typedef unsigned u32x2 __attribute__((ext_vector_type(2)));

constexpr int T_TOK = 16384, DM = 1024, FF = 2816, SEQ = 8192;
constexpr float RMS_EPS = 1e-6f;
constexpr int LDS_BYTES = 139296;
constexpr int NJOBS = 13;

struct WJob { const float* W; const float* g; bf16_t* dst; int K; int Nsrc; int ndst; int mode; int item0; float scale; };

struct Params {
    const float *x, *norm_g, *ffn_w_in, *ffn_w_out, *a_re, *a_im, *log_step, *b_re, *b_im, *c_re, *c_im, *s5_d, *w_glu, *kv_norm_g, *w_k, *w_v, *w_q, *w_o, *final_g;
    float* out;
    float* xres; bf16_t* xb; bf16_t* act; bf16_t* yb; bf16_t* qbuf; bf16_t* attn; bf16_t* kbuf; bf16_t* vbuf;
    float* kmean; float* rowss; float* E; float* rope;
    bf16_t* vT; bf16_t* part[4]; float* part_ml; int* lists; int* gcount; unsigned* bar; float* s5tab; int* pcnt;
    bf16_t* wt_up[4]; bf16_t* wt_dn[4]; bf16_t* wt_glu; bf16_t* wt_q; bf16_t* wt_o;
    WJob jobs[NJOBS];
    int nitems; int ph_lo; int ph_hi; int pad; int it1; int it2;
};

DI unsigned cvt_pk_bf16(float lo, float hi) { unsigned r; asm volatile("v_cvt_pk_bf16_f32 %0, %1, %2" : "=v"(r) : "v"(lo), "v"(hi)); return r; }
DI float bf_lo(unsigned w) { return __uint_as_float(w << 16); }
DI float bf_hi(unsigned w) { return __uint_as_float(w & 0xffff0000u); }
DI float wave_sum(float v) {
#pragma unroll
    for (int o = 1; o < 64; o <<= 1) v += __shfl_xor(v, o);
    return v;
}
DI float wave_max(float v) {
#pragma unroll
    for (int o = 1; o < 64; o <<= 1) v = fmaxf(v, __shfl_xor(v, o));
    return v;
}

namespace pg8 {
constexpr int BM = 256, BK = 64, HALF = 128, HTB = HALF * BK * 2, NXCD = 8, WGM = 8;
DI int lds_byte(int r, int c) { const int st = (r >> 4) * 2 + (c >> 5), rr = r & 15, cc = c & 31, ob = rr * 64 + cc * 2; return st * 1024 + (ob ^ (((ob >> 9) & 1) << 5)); }
DI void stage_rc(int b, int& R, int& C) { const int st = b / 1024, sb = b % 1024, swz = sb ^ (((sb >> 9) & 1) << 5); R = (st >> 1) * 16 + swz / 64; C = (st & 1) * 32 + (swz % 64) / 2; }
struct Unit { int pm, pn; };
struct Gemm { const bf16_t* A; const bf16_t* Bt; int M, N, K; };
struct StaticOrder {
    int nM, nN, nwg, G, c;
    DI void init(int M, int N, int G_, int c_) { nM = M / BM; nN = N / BM; nwg = nM * nN; G = G_; c = c_; }
    DI bool next(int i, Unit& u) const {
        const long L = (long)i * G + c; if (L >= nwg) return false;
        int wgid = (int)L; { const int q = nwg / NXCD, r = nwg % NXCD, xcd = wgid % NXCD, off = wgid / NXCD; wgid = (xcd < r ? xcd * (q + 1) : r * (q + 1) + (xcd - r) * q) + off; }
        const int nig = WGM * nN, gid = wgid / nig, fm = gid * WGM, gsz = (nM - fm) < WGM ? (nM - fm) : WGM;
        u.pm = fm + ((wgid % nig) % gsz); u.pn = (wgid % nig) / gsz; return true;
    }
};

template <class Epi>
DI void gemm_phase(LAS unsigned char* lds, const Gemm g, const StaticOrder& S, const Epi& E) {
    int tid_ = threadIdx.x; asm volatile("" : "+v"(tid_));
    const int tid = tid_, wid = __builtin_amdgcn_readfirstlane(tid >> 6), lane = tid & 63, wr = wid >> 2, wc = wid & 3, fr = lane & 15, fq = lane >> 4;
    const int K = g.K, nt = K / BK;
    unsigned voffA[2], voffB[2];
#pragma unroll
    for (int i = 0; i < 2; ++i) { int R, C; stage_rc(tid * 16 + i * 8192, R, C); voffA[i] = (unsigned)(R * K + C) * 2u; voffB[i] = voffA[i]; }
    const size_t kstep = (size_t)(BK * 2);
    const size_t hstep = (size_t)HALF * K * 2;
    const size_t tstep = 2 * hstep;
    const unsigned ldsw = (unsigned)wid * 1024u;
    const int aoff = lds_byte(wr * 64 + fr, fq * 8), boff = lds_byte(wc * 32 + fr, fq * 8);
#define PG8_SA(b, h) (((b) * 2 + (h)) * HTB)
#define PG8_SB(b, h) ((4 + (b) * 2 + (h)) * HTB)
#define PG8_STAGE(bufoff, gbase, voff) do { _Pragma("unroll") for (int _i = 0; _i < 2; ++_i) \
        __builtin_amdgcn_global_load_lds((const unsigned*)((const char*)(gbase) + (voff)[_i]), (LAS unsigned*)(lds + (bufoff) + ldsw + _i * 8192), 16, 0, 0); } while (0)
#define PG8_LDA(dst, b, h) do { _Pragma("unroll") for (int m = 0; m < 4; ++m) _Pragma("unroll") for (int k = 0; k < 2; ++k) dst[m][k] = *(const LAS bf16x8*)(lds + PG8_SA(b, h) + aoff + m * 2048 + k * 1024); } while (0)
#define PG8_LDB(dst, b, h) do { _Pragma("unroll") for (int n = 0; n < 2; ++n) _Pragma("unroll") for (int k = 0; k < 2; ++k) dst[n][k] = *(const LAS bf16x8*)(lds + PG8_SB(b, h) + boff + n * 2048 + k * 1024); } while (0)
#define PG8_MMA(ai, bj, At, Bt) do { __builtin_amdgcn_s_setprio(1); _Pragma("unroll") for (int m = 0; m < 4; ++m) _Pragma("unroll") for (int n = 0; n < 2; ++n) _Pragma("unroll") for (int k = 0; k < 2; ++k) \
        acc[ai][bj][m][n] = __builtin_amdgcn_mfma_f32_16x16x32_bf16(Bt[n][k], At[m][k], acc[ai][bj][m][n], 0, 0, 0); __builtin_amdgcn_s_setprio(0); } while (0)
#define PG8_WAIT_V(n) asm volatile("s_waitcnt vmcnt(" #n ")" ::: "memory")
#define PG8_WAIT_L(n) asm volatile("s_waitcnt lgkmcnt(" #n ")" ::: "memory")
#define PG8_BAR __builtin_amdgcn_s_barrier()
#define PG8_SCHED __builtin_amdgcn_sched_barrier(0)
    Unit cur, nxt; int ui = 0;
    if (!S.next(0, cur)) return;
    f32x4 acc[2][2][4][2];
    if constexpr (Epi::INIT_X) E.init(acc, cur, wr, wc, fr, fq);
    else {
#pragma unroll
    for (int a = 0; a < 2; ++a)
#pragma unroll
        for (int b = 0; b < 2; ++b)
#pragma unroll
            for (int m = 0; m < 4; ++m)
#pragma unroll
                for (int n = 0; n < 2; ++n) acc[a][b][m][n] = (f32x4){0.f, 0.f, 0.f, 0.f};
    }
    bf16x8 At[4][2], B0[2][2], B1[2][2];
    const char* cA = (const char*)g.A + (size_t)cur.pm * tstep; const char* cB = (const char*)g.Bt + (size_t)cur.pn * tstep;
    PG8_STAGE(PG8_SB(0, 0), cB, voffB); PG8_STAGE(PG8_SA(0, 0), cA, voffA); PG8_STAGE(PG8_SB(0, 1), cB + hstep, voffB); PG8_STAGE(PG8_SA(0, 1), cA + hstep, voffA);
    if (wr == 1) PG8_BAR;
    PG8_WAIT_V(4); PG8_BAR;
    PG8_STAGE(PG8_SB(1, 0), cB + kstep, voffB); PG8_STAGE(PG8_SA(1, 0), cA + kstep, voffA); PG8_STAGE(PG8_SB(1, 1), cB + hstep + kstep, voffB);
    PG8_WAIT_V(6); PG8_BAR;
    for (;;) {
        const bool has_next = S.next(ui + 1, nxt);
        const char* nA = has_next ? (const char*)g.A + (size_t)nxt.pm * tstep : cA; const char* nB = has_next ? (const char*)g.Bt + (size_t)nxt.pn * tstep : cB;
        for (int t = 0; t < nt; t += 2) {
            const bool last = (t == nt - 2);
            const char* a1 = cA + (size_t)(t + 1) * kstep;
            const char* a2 = last ? nA : cA + (size_t)(t + 2) * kstep; const char* b2 = last ? nB : cB + (size_t)(t + 2) * kstep;
            const char* a3 = a2 + kstep; const char* b3 = b2 + kstep;
            PG8_LDB(B0, 0, 0); PG8_SCHED; PG8_LDA(At, 0, 0); PG8_STAGE(PG8_SA(1, 1), a1 + hstep, voffA);
            PG8_WAIT_L(8); PG8_BAR; PG8_WAIT_L(0); PG8_MMA(0, 0, At, B0); PG8_BAR; PG8_SCHED;
            PG8_LDB(B1, 0, 1); PG8_STAGE(PG8_SB(0, 0), b2, voffB);
            PG8_BAR; PG8_WAIT_L(0); PG8_MMA(0, 1, At, B1); PG8_BAR;
            PG8_LDA(At, 0, 1); PG8_STAGE(PG8_SA(0, 0), a2, voffA);
            PG8_BAR; PG8_WAIT_L(0); PG8_MMA(1, 0, At, B0); PG8_BAR; PG8_SCHED;
            PG8_STAGE(PG8_SB(0, 1), b2 + hstep, voffB);
            PG8_WAIT_V(6); PG8_BAR; PG8_MMA(1, 1, At, B1); PG8_BAR;
            PG8_LDB(B0, 1, 0); PG8_SCHED; PG8_LDA(At, 1, 0); PG8_STAGE(PG8_SA(0, 1), a2 + hstep, voffA);
            PG8_WAIT_L(8); PG8_BAR; PG8_WAIT_L(0); PG8_MMA(0, 0, At, B0); PG8_BAR; PG8_SCHED;
            PG8_LDB(B1, 1, 1); PG8_STAGE(PG8_SB(1, 0), b3, voffB);
            PG8_BAR; PG8_WAIT_L(0); PG8_MMA(0, 1, At, B1); PG8_BAR;
            PG8_LDA(At, 1, 1); PG8_STAGE(PG8_SA(1, 0), a3, voffA);
            PG8_BAR; PG8_WAIT_L(0); PG8_MMA(1, 0, At, B0); PG8_BAR; PG8_SCHED;
            PG8_STAGE(PG8_SB(1, 1), b3 + hstep, voffB);
            PG8_WAIT_V(6); PG8_BAR; PG8_MMA(1, 1, At, B1); PG8_BAR;
        }
        E(acc, cur, wr, wc, fr, fq, ui);
        if (!has_next) break;
        if constexpr (Epi::INIT_X) E.init(acc, nxt, wr, wc, fr, fq);
        else {
#pragma unroll
        for (int a = 0; a < 2; ++a)
#pragma unroll
            for (int b = 0; b < 2; ++b)
#pragma unroll
                for (int m = 0; m < 4; ++m)
#pragma unroll
                    for (int n = 0; n < 2; ++n) acc[a][b][m][n] = (f32x4){0.f, 0.f, 0.f, 0.f};
        }
        cur = nxt; cA = nA; cB = nB; ++ui;
    }
    PG8_WAIT_V(0);
    if (wr == 0) PG8_BAR;
    PG8_BAR;
#undef PG8_SA
#undef PG8_SB
#undef PG8_STAGE
#undef PG8_LDA
#undef PG8_LDB
#undef PG8_MMA
#undef PG8_WAIT_V
#undef PG8_WAIT_L
#undef PG8_BAR
#undef PG8_SCHED
}
}
using pg8::Unit;
typedef f32x4 AccT[2][2][4][2];

DI void store_bf4(bf16_t* p, f32x4 v) { u32x2 o; o.x = cvt_pk_bf16(v.x, v.y); o.y = cvt_pk_bf16(v.z, v.w); *(u32x2*)p = o; }
DI float sigmoidf_(float x) { return __builtin_amdgcn_rcpf(1.f + __builtin_amdgcn_exp2f(-1.4426950408889634f * x)); }

struct EpiAct {
    static constexpr bool INIT_X = false;
    bf16_t* act; const float* rowss; bf16_t* kbuf; bf16_t* vbuf; const float* rope; const LAS float* rsl;
    DI void operator()(const AccT& acc, const Unit& u, int wr, int wc, int fr, int fq, int ui) const {
        const int row0 = u.pm * 256 + wr * 64 + fr;
        if (u.pn < 22) {
#pragma unroll
            for (int ai = 0; ai < 2; ++ai)
#pragma unroll
                for (int m = 0; m < 4; ++m) {
                    const int row = row0 + ai * 128 + m * 16;
                    const float rs = rsl[ui * 256 + wr * 64 + fr + ai * 128 + m * 16];
#pragma unroll
                    for (int bj = 0; bj < 2; ++bj) {
                        const f32x4 gt = acc[ai][bj][m][0] * rs, up = acc[ai][bj][m][1] * rs;
                        f32x4 a;
#pragma unroll
                        for (int j = 0; j < 4; ++j) a[j] = gt[j] * sigmoidf_(gt[j]) * up[j];
                        const int col = 16 * (8 * u.pn + 4 * bj + wc) + 4 * fq;
                        store_bf4(act + (size_t)row * FF + col, a);
                    }
                }
        } else if (u.pn == 22) {
            const bool do_rope = (wc == 0);
#pragma unroll
            for (int ai = 0; ai < 2; ++ai)
#pragma unroll
                for (int m = 0; m < 4; ++m) {
                    const int row = row0 + ai * 128 + m * 16;
                    const float rs = rsqrtf(rowss[row] * (1.f / DM) + RMS_EPS);
                    const int b = row >> 13, pos = row & (SEQ - 1);
#pragma unroll
                    for (int bj = 0; bj < 2; ++bj) {
                        f32x4 v0 = acc[ai][bj][m][0] * rs, v1 = acc[ai][bj][m][1] * rs;
                        if (do_rope) {
                            const f32x4* rp = (const f32x4*)(rope + ((size_t)pos * 16 + 4 * fq) * 2);
                            const f32x4 cs0 = rp[0], cs1 = rp[1];
                            const float c[4] = {cs0.x, cs0.z, cs1.x, cs1.z}, s[4] = {cs0.y, cs0.w, cs1.y, cs1.w};
#pragma unroll
                            for (int j = 0; j < 4; ++j) { const float x1 = v0[j], x2 = v1[j]; v0[j] = x1 * c[j] - x2 * s[j]; v1[j] = x2 * c[j] + x1 * s[j]; }
                        }
                        bf16_t* d = kbuf + ((size_t)(b * 2 + bj) * SEQ + pos) * 128 + 32 * wc + 4 * fq;
                        store_bf4(d, v0); store_bf4(d + 16, v1);
                    }
                }
        } else {
            const int lane = fr + 16 * fq, qi = lane & 3;
#pragma unroll
            for (int ai = 0; ai < 2; ++ai)
#pragma unroll
                for (int m = 0; m < 4; ++m) {
                    const int row = row0 + ai * 128 + m * 16;
                    const float rs = rsqrtf(rowss[row] * (1.f / DM) + RMS_EPS);
                    const int b = row >> 13, posq = (row & (SEQ - 1)) & ~3;
#pragma unroll
                    for (int bj = 0; bj < 2; ++bj)
#pragma unroll
                        for (int n = 0; n < 2; ++n) {
                            const f32x4 v = acc[ai][bj][m][n] * rs;
                            f32x4 w;
#pragma unroll
                            for (int k = 0; k < 4; ++k) {
                                const int src = (lane & ~3) | k;
                                const float t0 = __shfl(v[0], src), t1 = __shfl(v[1], src), t2 = __shfl(v[2], src), t3 = __shfl(v[3], src);
                                w[k] = qi == 0 ? t0 : (qi == 1 ? t1 : (qi == 2 ? t2 : t3));
                            }
                            const int d = 32 * wc + 16 * n + 4 * fq + qi;
                            store_bf4(vbuf + ((size_t)((b * 2 + bj) * 128 + d)) * SEQ + posq, w);
                        }
                }
        }
    }
};

struct EpiRes {
    static constexpr bool INIT_X = true;
    const float* xin; float* xout; bf16_t* xb; float* rowss_out;
    DI void init(AccT& acc, const Unit& u, int wr, int wc, int fr, int fq) const {
        const int row0 = u.pm * 256 + wr * 64 + fr;
#pragma unroll
        for (int ai = 0; ai < 2; ++ai)
#pragma unroll
            for (int m = 0; m < 4; ++m)
#pragma unroll
                for (int bj = 0; bj < 2; ++bj)
#pragma unroll
                    for (int n = 0; n < 2; ++n)
                        acc[ai][bj][m][n] = *(const f32x4*)(xin + (size_t)(row0 + ai * 128 + m * 16) * DM + u.pn * 256 + bj * 128 + wc * 32 + n * 16 + 4 * fq);
    }
    DI void operator()(const AccT& acc, const Unit& u, int wr, int wc, int fr, int fq, int ui) const {
        const int row0 = u.pm * 256 + wr * 64 + fr;
#pragma unroll
        for (int ai = 0; ai < 2; ++ai)
#pragma unroll
            for (int m = 0; m < 4; ++m) {
                const int row = row0 + ai * 128 + m * 16;
                float ss = 0.f;
#pragma unroll
                for (int bj = 0; bj < 2; ++bj)
#pragma unroll
                    for (int n = 0; n < 2; ++n) {
                        const size_t off = (size_t)row * DM + u.pn * 256 + bj * 128 + wc * 32 + n * 16 + 4 * fq;
                        const f32x4 v = acc[ai][bj][m][n];
                        *(f32x4*)(xout + off) = v;
                        store_bf4(xb + off, v);
                        ss += v.x * v.x + v.y * v.y + v.z * v.z + v.w * v.w;
                    }
                ss += __shfl_xor(ss, 16); ss += __shfl_xor(ss, 32);
                if (fq == 0) atomicAdd(rowss_out + row, ss);
            }
    }
};

struct EpiGlu {
    static constexpr bool INIT_X = false;
    float* xres; bf16_t* xb; float* rowss_out;
    DI void operator()(const AccT& acc, const Unit& u, int wr, int wc, int fr, int fq, int ui) const {
        const int row0 = u.pm * 256 + wr * 64 + fr;
#pragma unroll
        for (int ai = 0; ai < 2; ++ai)
#pragma unroll
            for (int m = 0; m < 4; ++m) {
                const int row = row0 + ai * 128 + m * 16;
                float ss = 0.f;
#pragma unroll
                for (int bj = 0; bj < 2; ++bj) {
                    const size_t off = (size_t)row * DM + 16 * (8 * u.pn + 4 * bj + wc) + 4 * fq;
                    const f32x4 val = acc[ai][bj][m][0], gt = acc[ai][bj][m][1];
                    f32x4 v = *(const f32x4*)(xres + off);
#pragma unroll
                    for (int j = 0; j < 4; ++j) v[j] += val[j] * sigmoidf_(gt[j]);
                    *(f32x4*)(xres + off) = v;
                    store_bf4(xb + off, v);
                    ss += v.x * v.x + v.y * v.y + v.z * v.z + v.w * v.w;
                }
                ss += __shfl_xor(ss, 16); ss += __shfl_xor(ss, 32);
                if (fq == 0) atomicAdd(rowss_out + row, ss);
            }
    }
};

struct EpiQ {
    static constexpr bool INIT_X = false;
    bf16_t* qbuf; const float* rowss; const float* rope;
    DI void operator()(const AccT& acc, const Unit& u, int wr, int wc, int fr, int fq, int ui) const {
        const int row0 = u.pm * 256 + wr * 64 + fr;
#pragma unroll
        for (int ai = 0; ai < 2; ++ai)
#pragma unroll
            for (int m = 0; m < 4; ++m) {
                const int row = row0 + ai * 128 + m * 16;
                const float rs = rsqrtf(rowss[row] * (1.f / DM) + RMS_EPS) * 0.08838834764831845f;
                const int pos = row & (SEQ - 1);
#pragma unroll
                for (int bj = 0; bj < 2; ++bj) {
                    f32x4 v0 = acc[ai][bj][m][0] * rs, v1 = acc[ai][bj][m][1] * rs;
                    if (wc == 0) {
                        const f32x4* rp = (const f32x4*)(rope + ((size_t)pos * 16 + 4 * fq) * 2);
                        const f32x4 cs0 = rp[0], cs1 = rp[1];
                        const float c[4] = {cs0.x, cs0.z, cs1.x, cs1.z}, s[4] = {cs0.y, cs0.w, cs1.y, cs1.w};
#pragma unroll
                        for (int j = 0; j < 4; ++j) { const float x1 = v0[j], x2 = v1[j]; v0[j] = x1 * c[j] - x2 * s[j]; v1[j] = x2 * c[j] + x1 * s[j]; }
                    }
                    bf16_t* d = qbuf + (size_t)row * DM + u.pn * 256 + bj * 128 + 32 * wc + 4 * fq;
                    store_bf4(d, v0); store_bf4(d + 16, v1);
                }
            }
    }
};

DI void preload_rs(LAS unsigned char* lds, int vbid, const float* rowss, int N) {
    pg8::StaticOrder S; S.init(T_TOK, N, gridDim.x, vbid);
    LAS float* rsl = (LAS float*)(lds + 131072);
    if (threadIdx.x < 256) {
        float v[8]; bool ok[8];
#pragma unroll
        for (int i = 0; i < 8; ++i) { pg8::Unit u; ok[i] = S.next(i, u); v[i] = ok[i] ? rowss[u.pm * 256 + threadIdx.x] : 1.f; }
#pragma unroll
        for (int i = 0; i < 8; ++i) if (ok[i]) rsl[i * 256 + threadIdx.x] = rsqrtf(v[i] * (1.f / DM) + RMS_EPS);
    }
    __syncthreads();
}
template <class Epi>
DI void run_gemm_v(LAS unsigned char* lds, int vbid, const bf16_t* A, const bf16_t* Bt, int N, int K, const Epi& E) {
    pg8::Gemm g{A, Bt, T_TOK, N, K};
    pg8::StaticOrder S; S.init(T_TOK, N, gridDim.x, vbid);
    pg8::gemm_phase<Epi>(lds, g, S, E);
}

struct S5Coef { float ar, ai, cr, ci; };
DI S5Coef s5_coefs_compute(const Params& P, int g, int p) {
    const float dt = expf(P.log_step[g]); const float lr = P.a_re[g * 64 + p], li = P.a_im[g * 64 + p];
    const float mag = expf(lr * dt); S5Coef c; c.ar = mag * cosf(li * dt); c.ai = mag * sinf(li * dt);
    const float nr = c.ar - 1.f, ni = c.ai, den = lr * lr + li * li;
    c.cr = (nr * lr + ni * li) / den; c.ci = (ni * lr - nr * li) / den; return c;
}
DI S5Coef s5_coefs(const Params& P, int g, int p) { const f32x4 v = *(const f32x4*)(P.s5tab + (size_t)(g * 64 + p) * 4); S5Coef c; c.ar = v.x; c.ai = v.y; c.cr = v.z; c.ci = v.w; return c; }

DI void p0_transpose_item(const WJob& J, LAS float* scr, int item, int lane) {
    const int nblk = J.ndst / 32, kb = item / nblk, nb = item % nblk, k0 = 64 * kb, r0 = 32 * nb;
    const int i = lane & 31;
    int scol;
    if (J.mode == 0) scol = r0 + i;
    else { const int G = r0 >> 5; scol = (i < 16) ? (16 * G + i) : ((J.Nsrc >> 1) + 16 * G + (i - 16)); }
    float wv[32];
    const float* wp = J.W + (size_t)(k0 + (lane >> 5)) * J.Nsrc + scol;
#pragma unroll
    for (int it = 0; it < 32; ++it) wv[it] = wp[(size_t)(2 * it) * J.Nsrc];
    if (J.g) {
        const float* gp = J.g + k0 + (lane >> 5);
#pragma unroll
        for (int it = 0; it < 32; ++it) wv[it] *= gp[2 * it];
    }
    if (J.scale != 1.f) {
#pragma unroll
        for (int it = 0; it < 32; ++it) wv[it] *= J.scale;
    }
#pragma unroll
    for (int it = 0; it < 32; ++it) scr[(2 * it + (lane >> 5)) * 33 + i] = wv[it];
    __builtin_amdgcn_fence(__ATOMIC_RELEASE, "wavefront"); __builtin_amdgcn_wave_barrier(); __builtin_amdgcn_fence(__ATOMIC_ACQUIRE, "wavefront");
    const int c = lane & 7;
#pragma unroll
    for (int j = 0; j < 4; ++j) {
        const int n = (lane >> 3) + 8 * j; const LAS float* s = scr + (8 * c) * 33 + n;
        u32x4 o; o.x = cvt_pk_bf16(s[0 * 33], s[1 * 33]); o.y = cvt_pk_bf16(s[2 * 33], s[3 * 33]); o.z = cvt_pk_bf16(s[4 * 33], s[5 * 33]); o.w = cvt_pk_bf16(s[6 * 33], s[7 * 33]);
        *(u32x4*)(J.dst + (size_t)(r0 + n) * J.K + k0 + 8 * c) = o;
    }
    __builtin_amdgcn_fence(__ATOMIC_RELEASE, "wavefront"); __builtin_amdgcn_wave_barrier(); __builtin_amdgcn_fence(__ATOMIC_ACQUIRE, "wavefront");
}

DI void convert_items(const Params& P, LAS unsigned char* lds, int lo, int hi, int gw, int NGW) {
    const int wave = threadIdx.x >> 6, lane = threadIdx.x & 63;
    LAS float* scr = (LAS float*)(lds + wave * 16384);
    for (int it = lo + gw; it < hi; it += NGW) {
        int j = 0;
#pragma unroll 1
        for (int q = 1; q < NJOBS; ++q) if (it >= P.jobs[q].item0) j = q;
        p0_transpose_item(P.jobs[j], scr, it - P.jobs[j].item0, lane);
    }
}
DI void convert_by_light_blocks(const Params& P, LAS unsigned char* lds, int vbid, int units, int lo, int hi) {
    asm volatile("" : "+s"(vbid), "+s"(lo), "+s"(hi));
    const int G = gridDim.x, extra = units % G, first = extra, nlight = G - extra;
    if (vbid >= first) convert_items(P, lds, lo, hi, (vbid - first) * 8 + (threadIdx.x >> 6), nlight * 8);
}

DI void phase_prep(const Params& P, LAS unsigned char* lds) {
    const int tid = threadIdx.x, wave = tid >> 6, lane = tid & 63;
    const int gw = blockIdx.x * 8 + wave, NGW = gridDim.x * 8;
    LAS float* scr = (LAS float*)(lds + wave * 16384);
    convert_items(P, lds, 0, P.it1, gw, NGW);
    for (int row = gw; row < T_TOK; row += 2 * NGW) {
        const int row2 = row + NGW; const bool has2 = row2 < T_TOK;
        const f32x4* xr = (const f32x4*)(P.x + (size_t)row * DM) + lane;
        const f32x4* xr2 = (const f32x4*)(P.x + (size_t)(has2 ? row2 : row) * DM) + lane;
        f32x4 v[4], w[4]; float s = 0.f, s2 = 0.f;
#pragma unroll
        for (int j = 0; j < 4; ++j) { v[j] = xr[64 * j]; w[j] = xr2[64 * j]; }
#pragma unroll
        for (int j = 0; j < 4; ++j) { s += v[j].x * v[j].x + v[j].y * v[j].y + v[j].z * v[j].z + v[j].w * v[j].w; s2 += w[j].x * w[j].x + w[j].y * w[j].y + w[j].z * w[j].z + w[j].w * w[j].w; }
        s = wave_sum(s); s2 = wave_sum(s2);
        if (lane == 0) { P.rowss[row] = s; if (has2) P.rowss[row2] = s2; }
        bf16_t* o = P.xb + (size_t)row * DM + 4 * lane;
#pragma unroll
        for (int j = 0; j < 4; ++j) store_bf4(o + 256 * j, v[j]);
        if (has2) {
            bf16_t* o2 = P.xb + (size_t)row2 * DM + 4 * lane;
#pragma unroll
            for (int j = 0; j < 4; ++j) store_bf4(o2 + 256 * j, w[j]);
        }
    }
    const int gt = blockIdx.x * 512 + tid, NGT = gridDim.x * 512;
    for (int i = gt; i < 6 * T_TOK; i += NGT) P.rowss[T_TOK + i] = 0.f;
    if (gt < 128) P.gcount[gt] = 0;
    if (gt < 64) P.pcnt[gt] = 0;
    for (int i = gt; i < 4096; i += NGT) { const S5Coef c = s5_coefs_compute(P, i >> 6, i & 63); *(f32x4*)(P.s5tab + (size_t)i * 4) = (f32x4){c.ar, c.ai, c.cr, c.ci}; }
    for (int i = gt; i < SEQ * 16; i += NGT) {
        const int pos = i >> 4, d = i & 15;
        const float inv = exp2f(-(float)d * (18.931568569324174f / 16.f));
        const float ang = (float)pos * inv;
        P.rope[2 * i] = cosf(ang); P.rope[2 * i + 1] = sinf(ang);
    }
}

DI float gelu_tanh(float x) { const float u = 0.7978845608028654f * (x + 0.044715f * x * x * x); return x * __builtin_amdgcn_rcpf(1.f + __builtin_amdgcn_exp2f(-2.f * 1.4426950408889634f * u)); }

typedef float f32x16 __attribute__((ext_vector_type(16)));
typedef __bf16 bf2_t __attribute__((ext_vector_type(2)));
DI unsigned pk_bf16(float lo, float hi) { const f32x2 v = {lo, hi}; return __builtin_bit_cast(unsigned, __builtin_convertvector(v, bf2_t)); }
#define WAVE_LDS_SYNC() asm volatile("s_waitcnt lgkmcnt(0)" ::: "memory")

DI void s5_bfrags(const Params& P, int g, int lane, bf16x8 (&bf)[4]) {
    const int q = lane & 31, h = lane >> 5;
#pragma unroll
    for (int pj = 0; pj < 2; ++pj) {
        const int p = q + 32 * pj;
        const S5Coef c = s5_coefs(P, g, p);
        const f32x4* br = (const f32x4*)(P.b_re + ((size_t)g * 64 + p) * 16 + 8 * h);
        const f32x4* bi = (const f32x4*)(P.b_im + ((size_t)g * 64 + p) * 16 + 8 * h);
        const f32x4 r0 = br[0], r1 = br[1], i0 = bi[0], i1 = bi[1];
        float re[8], im[8];
#pragma unroll
        for (int j = 0; j < 4; ++j) {
            re[j] = c.cr * r0[j] - c.ci * i0[j]; im[j] = c.cr * i0[j] + c.ci * r0[j];
            re[4 + j] = c.cr * r1[j] - c.ci * i1[j]; im[4 + j] = c.cr * i1[j] + c.ci * r1[j];
        }
        const u32x4 wr = {pk_bf16(re[0], re[1]), pk_bf16(re[2], re[3]), pk_bf16(re[4], re[5]), pk_bf16(re[6], re[7])};
        const u32x4 wi = {pk_bf16(im[0], im[1]), pk_bf16(im[2], im[3]), pk_bf16(im[4], im[5]), pk_bf16(im[6], im[7])};
        bf[2 * pj] = __builtin_bit_cast(bf16x8, wr); bf[2 * pj + 1] = __builtin_bit_cast(bf16x8, wi);
    }
}
DI bf16x8 s5_ufrag(const Params& P, int rowbase, int g, int lane, const f32x4& ga, const f32x4& gb) {
    const int t = lane & 31, h = lane >> 5, row = rowbase + t;
    const float rs = rsqrtf(P.rowss[T_TOK + row] * (1.f / DM) + RMS_EPS);
    const f32x4* xp = (const f32x4*)(P.xres + (size_t)row * DM + 16 * g + 8 * h);
    const f32x4 a = xp[0] * rs * ga, b = xp[1] * rs * gb;
    const u32x4 w = {pk_bf16(a.x, a.y), pk_bf16(a.z, a.w), pk_bf16(b.x, b.y), pk_bf16(b.z, b.w)};
    return __builtin_bit_cast(bf16x8, w);
}
template <bool WRITE>
DI void s5_scan32(const f32x16 (&X)[4], int h, int p, float ar, float ai, float& hr, float& hi, LAS unsigned char* hs) {
    float lo_re[16], lo_im[16], hi_re[16], hi_im[16];
#pragma unroll
    for (int r = 0; r < 16; ++r) {
        const auto sr = __builtin_amdgcn_permlane32_swap(__float_as_uint(X[0][r]), __float_as_uint(X[2][r]), false, false);
        const auto si = __builtin_amdgcn_permlane32_swap(__float_as_uint(X[1][r]), __float_as_uint(X[3][r]), false, false);
        lo_re[r] = __uint_as_float(sr[0]); hi_re[r] = __uint_as_float(sr[1]);
        lo_im[r] = __uint_as_float(si[0]); hi_im[r] = __uint_as_float(si[1]);
    }
#pragma unroll
    for (int i = 0; i < 4; ++i)
#pragma unroll
        for (int half = 0; half < 2; ++half)
#pragma unroll
            for (int j = 0; j < 4; ++j) {
                const int r = 4 * i + j, token = 8 * i + 4 * half + j;
                const float xr = half ? hi_re[r] : lo_re[r], xi = half ? hi_im[r] : lo_im[r];
                const float nhr = ar * hr - ai * hi + xr, nhi = ar * hi + ai * hr + xi; hr = nhr; hi = nhi;
                if (WRITE) {
                    const unsigned whi = pk_bf16(hr, hi);
                    *(LAS unsigned*)(hs + token * 272 + 4 * p) = whi;
                    *(LAS unsigned*)(hs + 69632 + token * 272 + 4 * p) = pk_bf16(hr - bf_lo(whi), hi - bf_hi(whi));
                }
            }
}

struct S5In { f32x4 x0, x1; float ss; };
DI S5In s5_in_load(const Params& P, int rowbase, int g, int lane) {
    const int row = rowbase + (lane & 31);
    const f32x4* xp = (const f32x4*)(P.xres + (size_t)row * DM + 16 * g + 8 * (lane >> 5));
    S5In r; r.x0 = xp[0]; r.x1 = xp[1]; r.ss = P.rowss[T_TOK + row]; return r;
}
DI bf16x8 s5_in_frag(const S5In& in, const f32x4& ga, const f32x4& gb) {
    const float rs = rsqrtf(in.ss * (1.f / DM) + RMS_EPS);
    const f32x4 a = in.x0 * rs * ga, b = in.x1 * rs * gb;
    const u32x4 w = {pk_bf16(a.x, a.y), pk_bf16(a.z, a.w), pk_bf16(b.x, b.y), pk_bf16(b.z, b.w)};
    return __builtin_bit_cast(bf16x8, w);
}
DI int s5_row0(int L, int wave) { const int bc = L & 31; return (bc >> 4) * SEQ + ((bc & 15) * 8 + wave) * 64; }

DI void phase_s5a(const Params& P, LAS unsigned char* lds) {
    const int tid = threadIdx.x, wave = tid >> 6, lane = tid & 63, h = lane >> 5;
    for (int base = blockIdx.x * 8; base < 2048; base += gridDim.x * 8) {
        const int g = base >> 5;
        const S5Coef cf = s5_coefs(P, g, lane);
        bf16x8 bf[4]; s5_bfrags(P, g, lane, bf);
        const f32x4 ga = *(const f32x4*)(P.norm_g + DM + 16 * g + 8 * h), gb = *(const f32x4*)(P.norm_g + DM + 16 * g + 8 * h + 4);
        float hr = 0.f, hi = 0.f;
        S5In pre = s5_in_load(P, s5_row0(base, wave), g, lane);
#pragma unroll 1
        for (int step = 0; step < 16; ++step) {
            const int L = base + (step >> 1), sub = step & 1;
            const S5In cur = pre;
            if (step < 15) pre = s5_in_load(P, s5_row0(base + ((step + 1) >> 1), wave) + 32 * ((step + 1) & 1), g, lane);
            const bf16x8 a = s5_in_frag(cur, ga, gb);
            f32x16 X[4];
#pragma unroll
            for (int j = 0; j < 4; ++j) {
#pragma unroll
                for (int r = 0; r < 16; ++r) X[j][r] = 0.f;
                X[j] = __builtin_amdgcn_mfma_f32_32x32x16_bf16(a, bf[j], X[j], 0, 0, 0);
            }
            if (sub == 0) { hr = 0.f; hi = 0.f; }
            s5_scan32<false>(X, h, lane, cf.ar, cf.ai, hr, hi, lds);
            if (sub == 1) { const int bc = L & 31, ch = (bc & 15) * 8 + wave; *(f32x2*)(P.E + ((size_t)(((bc >> 4) * 128 + ch) * 64 + g) * 64 + lane) * 2) = (f32x2){hr, hi}; }
        }
    }
}

DI void phase_s5carry(const Params& P) {
    if (blockIdx.x < 128 && threadIdx.x < 64) {
        const int idx = blockIdx.x * 64 + threadIdx.x, b = idx >> 12, g = (idx >> 6) & 63, p = idx & 63;
        const S5Coef cf = s5_coefs(P, g, p);
        float alr = cf.ar, ali = cf.ai;
#pragma unroll
        for (int q = 0; q < 6; ++q) { const float r = alr * alr - ali * ali, i2 = 2.f * alr * ali; alr = r; ali = i2; }
        f32x2* Ep = (f32x2*)P.E + (size_t)(b * 128) * 4096 + g * 64 + p;
        float hr = 0.f, hi = 0.f;
#pragma unroll 1
        for (int j0 = 0; j0 < 128; j0 += 32) {
            f32x2 e[32];
#pragma unroll
            for (int u = 0; u < 32; ++u) e[u] = Ep[(size_t)(j0 + u) * 4096];
#pragma unroll
            for (int u = 0; u < 32; ++u) {
                Ep[(size_t)(j0 + u) * 4096] = (f32x2){hr, hi};
                const float nr = alr * hr - ali * hi + e[u].x, ni = alr * hi + ali * hr + e[u].y; hr = nr; hi = ni;
            }
        }
    }
}

DI void phase_s5b(const Params& P, LAS unsigned char* lds) {
    const int tid = threadIdx.x, wave = tid >> 6, lane = tid & 63, h = lane >> 5, c16 = lane & 15, kq = lane >> 4;
    LAS unsigned char* hs = lds + wave * 8704;
    for (int base = blockIdx.x * 8; base < 2048; base += gridDim.x * 8) {
        const int g = base >> 5;
        const S5Coef cf = s5_coefs(P, g, lane);
        bf16x8 bf[4]; s5_bfrags(P, g, lane, bf);
        const f32x4 ga = *(const f32x4*)(P.norm_g + DM + 16 * g + 8 * h), gb = *(const f32x4*)(P.norm_g + DM + 16 * g + 8 * h + 4);
        bf16x8 cmf[4], cml[4];
#pragma unroll
        for (int ks = 0; ks < 4; ++ks) {
            const int p0 = ks * 16 + kq * 4;
            const f32x4 cr = *(const f32x4*)(P.c_re + ((size_t)g * 16 + c16) * 64 + p0), ci = *(const f32x4*)(P.c_im + ((size_t)g * 16 + c16) * 64 + p0);
            const float v[8] = {cr.x, -ci.x, cr.y, -ci.y, cr.z, -ci.z, cr.w, -ci.w};
            u32x4 wh, wl;
#pragma unroll
            for (int e = 0; e < 4; ++e) { wh[e] = pk_bf16(v[2 * e], v[2 * e + 1]); wl[e] = pk_bf16(v[2 * e] - bf_lo(wh[e]), v[2 * e + 1] - bf_hi(wh[e])); }
            cmf[ks] = __builtin_bit_cast(bf16x8, wh); cml[ks] = __builtin_bit_cast(bf16x8, wl);
        }
        const f32x4 d4 = *(const f32x4*)(P.s5_d + 16 * g + 4 * kq), ge = *(const f32x4*)(P.norm_g + DM + 16 * g + 4 * kq);
        float hr = 0.f, hi = 0.f;
        S5In pre = s5_in_load(P, s5_row0(base, wave), g, lane);
        f32x2 cpre; { const int bc = base & 31, ch = (bc & 15) * 8 + wave; cpre = *((const f32x2*)P.E + ((size_t)((bc >> 4) * 128 + ch) * 64 + g) * 64 + lane); }
#pragma unroll 1
        for (int step = 0; step < 16; ++step) {
            const int L = base + (step >> 1), sub = step & 1, rowb = s5_row0(L, wave) + 32 * sub;
            const S5In cur = pre;
            if (sub == 0) { hr = cpre.x; hi = cpre.y; }
            if (step < 15) pre = s5_in_load(P, s5_row0(base + ((step + 1) >> 1), wave) + 32 * ((step + 1) & 1), g, lane);
            if (sub == 1 && step < 15) { const int bc = (L + 1) & 31, ch = (bc & 15) * 8 + wave; cpre = *((const f32x2*)P.E + ((size_t)((bc >> 4) * 128 + ch) * 64 + g) * 64 + lane); }
            const bf16x8 a = s5_in_frag(cur, ga, gb);
            f32x16 X[4];
#pragma unroll
            for (int j = 0; j < 4; ++j) {
#pragma unroll
                for (int r = 0; r < 16; ++r) X[j][r] = 0.f;
                X[j] = __builtin_amdgcn_mfma_f32_32x32x16_bf16(a, bf[j], X[j], 0, 0, 0);
            }
            s5_scan32<true>(X, h, lane, cf.ar, cf.ai, hr, hi, hs);
            WAVE_LDS_SYNC();
#pragma unroll
            for (int tt = 0; tt < 2; ++tt) {
                f32x4 acc = {0.f, 0.f, 0.f, 0.f};
#pragma unroll
                for (int ks = 0; ks < 4; ++ks) {
                    const LAS unsigned char* ha = hs + (tt * 16 + c16) * 272 + ks * 64 + kq * 16;
                    const bf16x8 hbh = *(const LAS bf16x8*)ha, hbl = *(const LAS bf16x8*)(ha + 69632);
                    acc = __builtin_amdgcn_mfma_f32_16x16x32_bf16(cml[ks], hbh, acc, 0, 0, 0);
                    acc = __builtin_amdgcn_mfma_f32_16x16x32_bf16(cmf[ks], hbl, acc, 0, 0, 0);
                    acc = __builtin_amdgcn_mfma_f32_16x16x32_bf16(cmf[ks], hbh, acc, 0, 0, 0);
                }
                const int row = rowb + 16 * tt + c16;
                const float rs = rsqrtf(P.rowss[T_TOK + row] * (1.f / DM) + RMS_EPS);
                const f32x4 u4 = *(const f32x4*)(P.xres + (size_t)row * DM + 16 * g + 4 * kq) * rs * ge;
                f32x4 y;
#pragma unroll
                for (int j = 0; j < 4; ++j) y[j] = gelu_tanh(acc[j] + d4[j] * u4[j]);
                store_bf4(P.yb + (size_t)row * DM + 16 * g + 4 * kq, y);
            }
            WAVE_LDS_SYNC();
        }
    }
}

DI void phase_kmean(const Params& P, LAS unsigned char* lds) {
    if (blockIdx.x < 128) {
        const int j = blockIdx.x, d = threadIdx.x & 127, part = threadIdx.x >> 7;
        const bf16_t* kb = P.kbuf + ((size_t)(j >> 5) * SEQ + (j & 31) * 256 + part * 64) * 128 + d;
        float s = 0.f;
#pragma unroll 1
        for (int k0 = 0; k0 < 64; k0 += 16) {
            unsigned short v[16];
#pragma unroll
            for (int u = 0; u < 16; ++u) v[u] = kb[(size_t)(k0 + u) * 128];
#pragma unroll
            for (int u = 0; u < 16; ++u) s += __uint_as_float(((unsigned)v[u]) << 16);
        }
        LAS float* red = (LAS float*)lds;
        red[threadIdx.x] = s;
        __syncthreads();
        if (threadIdx.x < 128) P.kmean[j * 128 + d] = (red[d] + red[128 + d] + red[256 + d] + red[384 + d]) * (1.f / 256.f);
    }
}

DI int list_off(int c, int n) { return c * (496 * 1024) + 1024 * (31 * n - (n * (n - 1)) / 2); }

DI void phase_gate(const Params& P, LAS unsigned char* lds) {
    const int tid = threadIdx.x, wave = tid >> 6, lane = tid & 63;
    LAS float* km = (LAS float*)lds;
    LAS int* cnt = (LAS int*)(lds + 32768);
    LAS int* base = cnt + 64;
    for (int qb = blockIdx.x; qb < 256; qb += gridDim.x) {
        const int b = qb >> 7, i = qb & 127, own = i >> 2;
        for (int e = tid; e < 2048; e += 512) {
            const f32x4 v = ((const f32x4*)(P.kmean + b * 8192))[e];
            const int hn = e >> 5, d4 = (e & 31) * 4, hk2 = hn >> 5, n = hn & 31;
            LAS float* dst = km + (hk2 * 128 + d4) * 32 + n;
            dst[0] = v.x; dst[32] = v.y; dst[64] = v.z; dst[96] = v.w;
        }
        if (tid < 64) cnt[tid] = 0;
        __syncthreads();
        const int hq = wave, hk = hq >> 2, t = b * SEQ + i * 64 + lane;
        f32x2 g2[16];
#pragma unroll
        for (int n2 = 0; n2 < 16; ++n2) g2[n2] = (f32x2){0.f, 0.f};
        const u32x4* qr = (const u32x4*)(P.qbuf + (size_t)t * DM + hq * 128);
        {
            u32x4 wa = qr[0], wb = qr[1];
#pragma unroll 1
            for (int c = 0; c < 16; ++c) {
                const u32x4 w = wa; wa = wb; wb = qr[(c + 2) & 15];
                const float qv[8] = {bf_lo(w.x), bf_hi(w.x), bf_lo(w.y), bf_hi(w.y), bf_lo(w.z), bf_hi(w.z), bf_lo(w.w), bf_hi(w.w)};
#pragma unroll
                for (int j = 0; j < 8; ++j) {
                    const LAS f32x4* kp = (const LAS f32x4*)(km + (hk * 128 + 8 * c + j) * 32);
#pragma unroll
                    for (int i4 = 0; i4 < 8; ++i4) {
                        const f32x4 k4 = kp[i4];
                        g2[2 * i4] += (f32x2){k4.x, k4.y} * qv[j];
                        g2[2 * i4 + 1] += (f32x2){k4.z, k4.w} * qv[j];
                    }
                }
            }
        }
        float g[32];
#pragma unroll
        for (int n = 0; n < 32; ++n) g[n] = g2[n >> 1][n & 1];
        const int nsel = own < 3 ? own : 3;
        int s0 = -1, s1 = -1, s2 = -1;
        { float best = -3e38f;
#pragma unroll
          for (int n = 0; n < 32; ++n) if (n < own && g[n] > best) { best = g[n]; s0 = n; } }
        { float best = -3e38f;
#pragma unroll
          for (int n = 0; n < 32; ++n) if (n < own && n != s0 && g[n] > best) { best = g[n]; s1 = n; } }
        { float best = -3e38f;
#pragma unroll
          for (int n = 0; n < 32; ++n) if (n < own && n != s0 && n != s1 && g[n] > best) { best = g[n]; s2 = n; } }
        int l0 = 0, l1 = 0, l2 = 0;
        if (nsel > 0) l0 = atomicAdd((int*)&cnt[hk * 32 + s0], 1);
        if (nsel > 1) l1 = atomicAdd((int*)&cnt[hk * 32 + s1], 1);
        if (nsel > 2) l2 = atomicAdd((int*)&cnt[hk * 32 + s2], 1);
        __syncthreads();
        if (tid < 64) { const int c = cnt[tid]; base[tid] = c > 0 ? atomicAdd(P.gcount + b * 64 + tid, c) : 0; }
        __syncthreads();
        const int row = t * 8 + hq, c2 = b * 2 + hk;
        if (nsel > 0) P.lists[list_off(c2, s0) + base[hk * 32 + s0] + l0] = row * 4 + 1;
        if (nsel > 1) P.lists[list_off(c2, s1) + base[hk * 32 + s1] + l1] = row * 4 + 2;
        if (nsel > 2) P.lists[list_off(c2, s2) + base[hk * 32 + s2] + l2] = row * 4 + 3;
        __syncthreads();
    }
}

template <bool OWN>
DI void phase_attn(const Params& P, LAS unsigned char* lds, int bid) {
    const int tid = threadIdx.x, wave = __builtin_amdgcn_readfirstlane(tid >> 6), lane = tid & 63, h = lane >> 5, l32 = lane & 31;
    LAS unsigned char* Ks = lds;
    LAS unsigned char* Vs = lds + 69632;
    LAS int* pref = (LAS int*)(lds + 136192);
    if constexpr (!OWN) {
        LAS int* cntl = pref + 132;
        if (tid < 128) cntl[tid] = (P.gcount[tid] + 255) >> 8;
        __syncthreads();
        if (tid <= 128) { int a = 0; for (int i = 0; i < 128; ++i) a += (i < tid) ? cntl[i] : 0; pref[tid] = a; }
        __syncthreads();
    }
    const int total = OWN ? 512 : pref[128];
    constexpr float LOG2E = 1.4426950408889634f;
    int rnd = 0;
    for (int idx = bid; idx < total; idx += gridDim.x, ++rnd) {
        const int item = (OWN && (rnd & 1)) ? (idx ^ 3) : idx;
        int c, n, i_q = 0, nrows = 256; const int* lst = P.lists; constexpr bool is_own = OWN;
        if (is_own) { c = item >> 7; i_q = item & 127; n = i_q >> 2; }
        else {
            const int s = item; int lo = 0, hi = 128;
            while (hi - lo > 1) { const int mid = (lo + hi) >> 1; if (pref[mid] <= s) lo = mid; else hi = mid; }
            c = lo >> 5; n = lo & 31; const int grp = s - pref[lo]; lst = P.lists + list_off(c, n) + grp * 256; nrows = P.gcount[lo] - grp * 256; if (nrows > 256) nrows = 256;
        }
        const int b = c >> 1, hk = c & 1;
        int ent; bool valid = true; const int rho = wave * 32 + l32;
        if (is_own) { const int hq = hk * 4 + (rho >> 6), t = b * SEQ + i_q * 64 + (rho & 63); ent = (t * 8 + hq) * 4; }
        else { valid = rho < nrows; ent = lst[valid ? rho : 0]; }
        bf16x8 qf[8];
        {
            const bf16_t* kg = P.kbuf + ((size_t)c * SEQ + n * 256) * 128;
            const bf16_t* vg = P.vT + (size_t)c * 128 * SEQ + n * 256;
            const bf16_t* kgl = kg + (size_t)(tid >> 4) * 128 + (tid & 15) * 8;
            LAS unsigned char* kl = Ks + (tid >> 4) * 272 + (tid & 15) * 16;
            const bf16_t* vgl = vg + (size_t)(tid >> 5) * SEQ + (tid & 31) * 8;
            LAS unsigned char* vl = Vs + (tid >> 5) * 520 + (tid & 31) * 16;
            u32x4 kw[8], vw[8];
#pragma unroll
            for (int q = 0; q < 8; ++q) kw[q] = *(const u32x4*)(kgl + q * 4096);
#pragma unroll
            for (int q = 0; q < 8; ++q) vw[q] = *(const u32x4*)(vgl + (size_t)q * 16 * SEQ);
        { const int row = ent >> 2, t = row >> 3, hq = row & 7; const bf16_t* qp = P.qbuf + (size_t)t * DM + hq * 128 + 8 * h;
#pragma unroll
          for (int ks = 0; ks < 8; ++ks) qf[ks] = *(const bf16x8*)(qp + ks * 16); }
#pragma unroll
            for (int q = 0; q < 8; ++q) *(LAS u32x4*)(kl + q * 8704) = kw[q];
#pragma unroll
            for (int q = 0; q < 8; ++q) { LAS u32x2* dst = (LAS u32x2*)(vl + q * 8320); dst[0] = (u32x2){vw[q].x, vw[q].y}; dst[1] = (u32x2){vw[q].z, vw[q].w}; }
        }
        __syncthreads();
        if (wave < 4) __builtin_amdgcn_s_setprio(2);
        if (wave * 32 < nrows) {
            const int nkt = is_own ? (2 * (i_q & 3) + (wave & 1) + 1) : 8;
            const int posb = is_own ? (64 * (i_q & 3) + (rho & 63)) : 100000;
            float m_run = -1e30f, l_run = 0.f;
            f32x16 o[4];
#pragma unroll
            for (int db = 0; db < 4; ++db)
#pragma unroll
                for (int r = 0; r < 16; ++r) o[db][r] = 0.f;
#pragma unroll 1
            for (int hf = 0; hf < 2; ++hf) {
                if (4 * hf >= nkt) break;
                f32x16 s[4];
#pragma unroll
                for (int kq = 0; kq < 4; ++kq) {
                    const int kt = 4 * hf + kq;
                    if (kt < nkt) {
#pragma unroll
                        for (int r = 0; r < 16; ++r) s[kq][r] = 0.f;
#pragma unroll
                        for (int ks = 0; ks < 8; ++ks) {
                            const bf16x8 a = *(const LAS bf16x8*)(Ks + (kt * 32 + l32) * 272 + ks * 32 + 16 * h);
                            s[kq] = __builtin_amdgcn_mfma_f32_32x32x16_bf16(a, qf[ks], s[kq], 0, 0, 0);
                            asm volatile("" :: "v"(a));
                        }
                        if (is_own) {
#pragma unroll
                            for (int r = 0; r < 16; ++r) { const int key = kt * 32 + (r & 3) + 8 * (r >> 2) + 4 * h; if (key > posb) s[kq][r] = -1e30f; }
                        }
                    } else {
#pragma unroll
                        for (int r = 0; r < 16; ++r) s[kq][r] = -1e30f;
                    }
                    __builtin_amdgcn_sched_barrier(0);
                }
                float mx = -1e30f;
#pragma unroll
                for (int kq = 0; kq < 4; ++kq)
#pragma unroll
                    for (int r = 0; r < 16; ++r) mx = fmaxf(mx, s[kq][r]);
                mx = fmaxf(mx, __shfl_xor(mx, 32));
                const float m_new = fmaxf(m_run, mx), mL = m_new * LOG2E;
                const float alpha = __builtin_amdgcn_exp2f((m_run - m_new) * LOG2E);
                float lsum = 0.f;
#pragma unroll
                for (int kq = 0; kq < 4; ++kq)
#pragma unroll
                    for (int r = 0; r < 16; ++r) { const float p = __builtin_amdgcn_exp2f(s[kq][r] * LOG2E - mL); s[kq][r] = p; lsum += p; }
                lsum += __shfl_xor(lsum, 32);
                l_run = l_run * alpha + lsum; m_run = m_new;
                if (hf == 1) {
#pragma unroll
                    for (int db = 0; db < 4; ++db)
#pragma unroll
                        for (int r = 0; r < 16; ++r) o[db][r] *= alpha;
                }
#pragma unroll
                for (int kq = 0; kq < 4; ++kq) {
                    const int kt = 4 * hf + kq;
                    if (kt < nkt) {
#pragma unroll
                        for (int st = 0; st < 2; ++st) {
                            u32x4 pw;
                            pw.x = pk_bf16(s[kq][8 * st + 0], s[kq][8 * st + 1]); pw.y = pk_bf16(s[kq][8 * st + 2], s[kq][8 * st + 3]);
                            pw.z = pk_bf16(s[kq][8 * st + 4], s[kq][8 * st + 5]); pw.w = pk_bf16(s[kq][8 * st + 6], s[kq][8 * st + 7]);
                            const bf16x8 pf = __builtin_bit_cast(bf16x8, pw);
#pragma unroll
                            for (int db = 0; db < 4; ++db) {
                                const LAS unsigned char* va = Vs + (32 * db + l32) * 520 + (kt * 32 + 16 * st + 4 * h) * 2;
                                const u32x2 vlo = *(const LAS u32x2*)va, vhi = *(const LAS u32x2*)(va + 16);
                                const u32x4 vw = {vlo.x, vlo.y, vhi.x, vhi.y};
                                o[db] = __builtin_amdgcn_mfma_f32_32x32x16_bf16(__builtin_bit_cast(bf16x8, vw), pf, o[db], 0, 0, 0);
                            }
                            __builtin_amdgcn_sched_barrier(0);
                        }
                    }
                }
            }
            asm volatile("" : "+v"(ent));
            if constexpr (!OWN) {
                if (valid) {
                    const float inv = 1.f / l_run;
                    const int slot = ent & 3; const int row = ent >> 2;
                    if (h == 0) *(f32x2*)(P.part_ml + (size_t)ent * 2) = (f32x2){m_run, l_run};
                    int h2 = h; asm volatile("" : "+v"(h2));
                    bf16_t* pb = P.part[1];
                    if (slot == 2) pb = P.part[2]; else if (slot == 3) pb = P.part[3];
                    bf16_t* po = pb + ((size_t)row * 128 + 4 * h2);
#pragma unroll
                    for (int db = 0; db < 4; ++db)
#pragma unroll
                        for (int rq = 0; rq < 4; ++rq) {
                            u32x2 w; w.x = pk_bf16(o[db][4 * rq] * inv, o[db][4 * rq + 1] * inv); w.y = pk_bf16(o[db][4 * rq + 2] * inv, o[db][4 * rq + 3] * inv);
                            *(u32x2*)(po + 32 * db + 8 * rq) = w;
                        }
                }
            } else {
                const int row = ent >> 2, nsel = n < 3 ? n : 3;
                int h2 = h; asm volatile("" : "+v"(h2));
                float M = m_run; f32x2 ml[3];
#pragma unroll
                for (int s2 = 0; s2 < 3; ++s2) { ml[s2] = (f32x2){-1e30f, 0.f}; if (s2 < nsel) { ml[s2] = *(const f32x2*)(P.part_ml + ((size_t)row * 4 + s2 + 1) * 2); M = fmaxf(M, ml[s2].x); } }
                const float w0 = __builtin_amdgcn_exp2f((m_run - M) * LOG2E);
                float ws[3], L = l_run * w0;
#pragma unroll
                for (int s2 = 0; s2 < 3; ++s2) { ws[s2] = ml[s2].y * __builtin_amdgcn_exp2f((ml[s2].x - M) * LOG2E); L += ws[s2]; }
                const float inv = 1.f / L, w0i = w0 * inv;
                const size_t poff = (size_t)row * 128 + 4 * h2;
                bf16_t* ao = P.attn + (size_t)(row >> 3) * DM + (row & 7) * 128 + 4 * h2;
#pragma unroll
                for (int db = 0; db < 4; ++db) {
                    u32x2 pv[3][4];
#pragma unroll
                    for (int s2 = 0; s2 < 3; ++s2)
#pragma unroll
                        for (int rq = 0; rq < 4; ++rq) { pv[s2][rq] = (u32x2){0u, 0u}; if (s2 < nsel) pv[s2][rq] = *(const u32x2*)(P.part[s2 + 1] + poff + 32 * db + 8 * rq); }
#pragma unroll
                    for (int rq = 0; rq < 4; ++rq) {
                        float a0 = o[db][4 * rq] * w0i, a1 = o[db][4 * rq + 1] * w0i, a2 = o[db][4 * rq + 2] * w0i, a3 = o[db][4 * rq + 3] * w0i;
#pragma unroll
                        for (int s2 = 0; s2 < 3; ++s2) { const float wv = ws[s2] * inv; a0 += wv * bf_lo(pv[s2][rq].x); a1 += wv * bf_hi(pv[s2][rq].x); a2 += wv * bf_lo(pv[s2][rq].y); a3 += wv * bf_hi(pv[s2][rq].y); }
                        u32x2 w; w.x = pk_bf16(a0, a1); w.y = pk_bf16(a2, a3);
                        *(u32x2*)(ao + 32 * db + 8 * rq) = w;
                    }
                }
            }
        }
        __builtin_amdgcn_s_setprio(0);
        __syncthreads();
    }
}

DI void phase_combine(const Params& P) {
    const int tid = threadIdx.x, wave = tid >> 6, lane = tid & 63;
    const int gw = blockIdx.x * 8 + wave, NGW = gridDim.x * 8;
    for (int row = gw; row < T_TOK * 8; row += NGW) {
        const int t = row >> 3, hq = row & 7, own = (t & (SEQ - 1)) >> 8, nsel = own < 3 ? own : 3;
        float m[4], l[4];
#pragma unroll
        for (int s = 0; s < 4; ++s) { if (s <= nsel) { const f32x2 ml = *(const f32x2*)(P.part_ml + ((size_t)row * 4 + s) * 2); m[s] = ml.x; l[s] = ml.y; } else { m[s] = -1e30f; l[s] = 0.f; } }
        const float M = fmaxf(fmaxf(m[0], m[1]), fmaxf(m[2], m[3]));
        float o0 = 0.f, o1 = 0.f, L = 0.f;
#pragma unroll
        for (int s = 0; s < 4; ++s) {
            if (s <= nsel) {
                const float w = l[s] * __expf(m[s] - M); L += w;
                const unsigned v = *(const unsigned*)(P.part[s] + (size_t)row * 128 + 2 * lane);
                o0 += w * bf_lo(v); o1 += w * bf_hi(v);
            }
        }
        const float inv = 1.f / L;
        *(unsigned*)(P.attn + (size_t)t * DM + hq * 128 + 2 * lane) = cvt_pk_bf16(o0 * inv, o1 * inv);
    }
}

DI void phase_final(const Params& P) {
    const int tid = threadIdx.x, wave = tid >> 6, lane = tid & 63;
    const int gw = blockIdx.x * 8 + wave, NGW = gridDim.x * 8;
    for (int row = gw; row < T_TOK; row += NGW) {
        const float rs = rsqrtf(P.rowss[6 * T_TOK + row] * (1.f / DM) + RMS_EPS);
        const f32x4* xr = (const f32x4*)(P.xres + (size_t)row * DM) + lane;
        const f32x4* gr = (const f32x4*)P.final_g + lane;
        f32x4* o = (f32x4*)(P.out + (size_t)row * DM) + lane;
#pragma unroll
        for (int j = 0; j < 4; ++j) o[64 * j] = xr[64 * j] * rs * gr[64 * j];
    }
}

DI void phase_final_fused(const Params& P, LAS unsigned char* lds, int vbid) {
    pg8::StaticOrder S; S.init(T_TOK, DM, gridDim.x, vbid);
    pg8::Unit u;
    if (!S.next(0, u)) return;
    const int tid = threadIdx.x, wave = tid >> 6, lane = tid & 63;
    asm volatile("s_waitcnt vmcnt(0)" ::: "memory");
    __syncthreads();
    LAS int* flag = (LAS int*)lds;
    if (tid == 0) flag[0] = atomicAdd(P.pcnt + u.pm, 1);
    __syncthreads();
    if (flag[0] != 3) return;
    __builtin_amdgcn_fence(__ATOMIC_ACQUIRE, "agent");
    asm volatile("s_waitcnt vmcnt(0)" ::: "memory");
    const f32x4* gr = (const f32x4*)P.final_g + lane;
    const f32x4 g0 = gr[0], g1 = gr[64], g2 = gr[128], g3 = gr[192];
#pragma unroll 1
    for (int r0 = wave * 32; r0 < wave * 32 + 32; r0 += 4) {
        f32x4 v[4][4]; float ss[4];
#pragma unroll
        for (int i = 0; i < 4; ++i) {
            const int row = u.pm * 256 + r0 + i;
            const f32x4* xr = (const f32x4*)(P.xres + (size_t)row * DM) + lane;
            ss[i] = P.rowss[6 * T_TOK + row];
            v[i][0] = xr[0]; v[i][1] = xr[64]; v[i][2] = xr[128]; v[i][3] = xr[192];
        }
#pragma unroll
        for (int i = 0; i < 4; ++i) {
            const int row = u.pm * 256 + r0 + i;
            const float rs = rsqrtf(ss[i] * (1.f / DM) + RMS_EPS);
            f32x4* o = (f32x4*)(P.out + (size_t)row * DM) + lane;
            o[0] = v[i][0] * rs * g0; o[64] = v[i][1] * rs * g1; o[128] = v[i][2] * rs * g2; o[192] = v[i][3] * rs * g3;
        }
    }
}

#define XB_TMO      128
#define XB_XCNT(j)  (256  + 64 * (j))
#define XB_XSUB(j)  (1280 + 64 * (j))
#define XB_XGEN(j)  (2304 + 64 * (j))
#define XB_TOP      3328
#define XB_TOPGEN   3392
#define XCD_BAR_WORDS 3456
#define XB_SPIN_CAP (1u << 18)
DI unsigned xb_ld(unsigned* p)              { return __hip_atomic_load(p, __ATOMIC_RELAXED, __HIP_MEMORY_SCOPE_AGENT); }
DI unsigned xb_add(unsigned* p, unsigned v) { return __hip_atomic_fetch_add(p, v, __ATOMIC_RELAXED, __HIP_MEMORY_SCOPE_AGENT); }
DI unsigned xb_xcc_id() { return (unsigned)__builtin_amdgcn_s_getreg((3 << 11) | 20) & 0xFu; }
#define XB_SPIN(cond, bar) do { unsigned _sp = 0; while (cond) { __builtin_amdgcn_s_sleep(1); \
    if ((++_sp & 255u) == 0u) { if (xb_ld(&(bar)[XB_TMO])) break; if (_sp > XB_SPIN_CAP) { atomicAdd(&(bar)[XB_TMO], 1u); break; } } } } while (0)
struct XcdBarrier { unsigned* bar; unsigned x; volatile LAS unsigned* st; };
DI XcdBarrier xcd_barrier_post(unsigned* bar, volatile LAS unsigned* st) {
    XcdBarrier b; b.bar = bar; b.x = xb_xcc_id(); b.st = st;
    if (threadIdx.x == 0) (void)xb_add(&bar[XB_XCNT(b.x)], 1u);
    return b;
}
DI void xcd_barrier_complete(unsigned* bar, unsigned x, unsigned& nloc, unsigned& nx) {
    const unsigned G = gridDim.x * gridDim.y * gridDim.z;
    unsigned sum, cnt, mine, sp = 0u;
    for (;;) {
        sum = 0u; cnt = 0u; mine = 0u;
#pragma unroll
        for (unsigned j = 0; j < 16; ++j) { const unsigned c = xb_ld(&bar[XB_XCNT(j)]); sum += c; cnt += (c > 0u) ? 1u : 0u; mine = (j == x) ? c : mine; }
        if (sum == G) break;
        __builtin_amdgcn_s_sleep(1);
        if ((++sp & 255u) == 0u) { if (xb_ld(&bar[XB_TMO])) break; if (sp > XB_SPIN_CAP) { atomicAdd(&bar[XB_TMO], 1u); break; } }
    }
    nloc = mine > 0u ? mine : 1u; nx = cnt > 0u ? cnt : 1u;
}
DI void xcd_barrier(const XcdBarrier& b) {
    asm volatile("s_waitcnt vmcnt(0)" ::: "memory");
    __syncthreads();
    if (threadIdx.x == 0) {
        unsigned* bar = b.bar;
        __builtin_amdgcn_s_waitcnt(0);
        unsigned nloc = b.st[0], nx = b.st[1];
        if (nloc == 0u) { xcd_barrier_complete(bar, b.x, nloc, nx); b.st[0] = nloc; b.st[1] = nx; }
        const unsigned old = xb_add(&bar[XB_XSUB(b.x)], 1u);
        const unsigned gen = old / nloc;
        if (old + 1u == (gen + 1u) * nloc) {
            __builtin_amdgcn_fence(__ATOMIC_RELEASE, "agent");
            asm volatile("s_waitcnt vmcnt(0)" ::: "memory");
            const unsigned og = xb_add(&bar[XB_TOP], 1u);
            const unsigned tg = og / nx;
            if (og + 1u == (tg + 1u) * nx) xb_add(&bar[XB_TOPGEN], 1u);
            else XB_SPIN(xb_ld(&bar[XB_TOPGEN]) == tg, bar);
            __builtin_amdgcn_fence(__ATOMIC_ACQUIRE, "agent");
            xb_add(&bar[XB_XGEN(b.x)], 1u);
            asm volatile("s_waitcnt vmcnt(0)" ::: "memory");
        } else {
            XB_SPIN(xb_ld(&bar[XB_XGEN(b.x)]) == gen, bar);
            __builtin_amdgcn_fence(__ATOMIC_ACQUIRE, "agent");
            asm volatile("s_waitcnt vmcnt(0)" ::: "memory");
        }
    }
    __syncthreads();
}

constexpr int NPHASES = 18;
#ifndef PHMASK
#define PHMASK 0xFFFFF
#endif
#define PHON(n) if constexpr (((PHMASK) >> (n)) & 1)
#ifndef DUPSEL
#define DUPSEL 0
#endif
__global__ void __launch_bounds__(512, 2) mega_fwd(const Params P) {
    extern __shared__ __attribute__((aligned(16))) unsigned char smem[];
    LAS unsigned char* lds = (LAS unsigned char*)smem;
    cg::grid_group grid = cg::this_grid();
    if (P.ph_hi < 0) grid.sync();
    volatile LAS unsigned* xst = (volatile LAS unsigned*)(lds + 139264);
    if (threadIdx.x == 0) { xst[0] = 0u; xst[1] = 0u; xst[2] = 0u; xst[3] = 0u; xst[4] = 0u; }
    __syncthreads();
    XcdBarrier xb; xb.bar = P.bar; xb.x = xb_xcc_id(); xb.st = xst;
    if (threadIdx.x == 0) xst[2] = xb_add(&P.bar[XB_XCNT(xb.x)], 1u);
    PHON(0) if (P.ph_lo <= 0 && 0 < P.ph_hi) { phase_prep(P, lds); }
    if constexpr (DUPSEL == 4) { xcd_barrier(xb); phase_prep(P, lds); }
    if (P.ph_lo < 1 && 1 < P.ph_hi) xcd_barrier(xb);
    if (threadIdx.x == 0) {
        bool ok = (gridDim.x % 8u) == 0u;
        for (unsigned j = 0; j < 16; ++j) { const unsigned c = xb_ld(&P.bar[XB_XCNT(j)]); ok = ok && (c == (j < 8 ? gridDim.x / 8u : 0u)); }
        xst[3] = ok ? (xb.x + 8u * xst[2]) : blockIdx.x; xst[4] = ok ? 1u : 0u;
    }
    __syncthreads();
    const int vbid = (int)xst[3];
    const bool vb_ok = xst[4] != 0u;
    const int abid = vb_ok ? ((vbid & 7) * (int)(gridDim.x >> 3) + (vbid >> 3)) : (int)blockIdx.x;
    preload_rs(lds, vbid, P.rowss + 0 * T_TOK, 5632); run_gemm_v(lds, vbid, P.xb, P.wt_up[0], 5632, DM, EpiAct{P.act, P.rowss + 0 * T_TOK, P.kbuf, P.vT, P.rope, (const LAS float*)(lds + 131072)});
    convert_by_light_blocks(P, lds, vbid, 64 * 22, P.it1, P.it2);
    if constexpr (DUPSEL == 2) { xcd_barrier(xb); preload_rs(lds, vbid, P.rowss + 0 * T_TOK, 5632); run_gemm_v(lds, vbid, P.xb, P.wt_up[0], 5632, DM, EpiAct{P.act, P.rowss + 0 * T_TOK, P.kbuf, P.vT, P.rope, (const LAS float*)(lds + 131072)}); }
    if (P.ph_lo < 2 && 2 < P.ph_hi) xcd_barrier(xb);
    PHON(2) if (P.ph_lo <= 2 && 2 < P.ph_hi) { run_gemm_v(lds, vbid, P.act, P.wt_dn[0], DM, FF, EpiRes{P.x, P.xres, P.xb, P.rowss + 1 * T_TOK}); }
    if (P.ph_lo < 3 && 3 < P.ph_hi) xcd_barrier(xb);
    PHON(3) if (P.ph_lo <= 3 && 3 < P.ph_hi) { phase_s5a(P, lds); }
    xcd_barrier(xb);
    phase_s5carry(P);
    if (P.ph_lo < 4 && 4 < P.ph_hi) xcd_barrier(xb);
    PHON(4) if (P.ph_lo <= 4 && 4 < P.ph_hi) { phase_s5b(P, lds); }
    if constexpr (DUPSEL == 3) { xcd_barrier(xb); phase_s5a(P, lds); xcd_barrier(xb); phase_s5carry(P); xcd_barrier(xb); phase_s5b(P, lds); }

    if (P.ph_lo < 5 && 5 < P.ph_hi) xcd_barrier(xb);
    PHON(5) if (P.ph_lo <= 5 && 5 < P.ph_hi) { run_gemm_v(lds, vbid, P.yb, P.wt_glu, 2048, DM, EpiGlu{P.xres, P.xb, P.rowss + 2 * T_TOK}); }
    if (P.ph_lo < 6 && 6 < P.ph_hi) xcd_barrier(xb);
    PHON(6) if (P.ph_lo <= 6 && 6 < P.ph_hi) { preload_rs(lds, vbid, P.rowss + 2 * T_TOK, 5632); run_gemm_v(lds, vbid, P.xb, P.wt_up[1], 5632, DM, EpiAct{P.act, P.rowss + 2 * T_TOK, P.kbuf, P.vT, P.rope, (const LAS float*)(lds + 131072)}); convert_by_light_blocks(P, lds, vbid, 64 * 22, P.it2, P.nitems); }
    if (P.ph_lo < 7 && 7 < P.ph_hi) xcd_barrier(xb);
    PHON(7) if (P.ph_lo <= 7 && 7 < P.ph_hi) { run_gemm_v(lds, vbid, P.act, P.wt_dn[1], DM, FF, EpiRes{P.xres, P.xres, P.xb, P.rowss + 3 * T_TOK}); }
    if (P.ph_lo < 8 && 8 < P.ph_hi) xcd_barrier(xb);
    PHON(8) if (P.ph_lo <= 8 && 8 < P.ph_hi) { preload_rs(lds, vbid, P.rowss + 3 * T_TOK, 6144); run_gemm_v(lds, vbid, P.xb, P.wt_up[2], 6144, DM, EpiAct{P.act, P.rowss + 3 * T_TOK, P.kbuf, P.vT, P.rope, (const LAS float*)(lds + 131072)}); }
    if (P.ph_lo < 9 && 9 < P.ph_hi) xcd_barrier(xb);
    PHON(9) if (P.ph_lo <= 9 && 9 < P.ph_hi) { run_gemm_v(lds, vbid, P.act, P.wt_dn[2], DM, FF, EpiRes{P.xres, P.xres, P.xb, P.rowss + 4 * T_TOK}); phase_kmean(P, lds); }
    if (P.ph_lo < 10 && 10 < P.ph_hi) xcd_barrier(xb);
    PHON(10) if (P.ph_lo <= 10 && 10 < P.ph_hi) { run_gemm_v(lds, vbid, P.xb, P.wt_q, DM, DM, EpiQ{P.qbuf, P.rowss + 4 * T_TOK, P.rope}); }
    if (P.ph_lo < 11 && 11 < P.ph_hi) xcd_barrier(xb);
    PHON(11) if (P.ph_lo <= 11 && 11 < P.ph_hi) { phase_gate(P, lds); }
    if (P.ph_lo < 12 && 12 < P.ph_hi) xcd_barrier(xb);
    PHON(12) if (P.ph_lo <= 12 && 12 < P.ph_hi) { phase_attn<false>(P, lds, abid); }
    if constexpr (DUPSEL == 6) { xcd_barrier(xb); phase_attn<false>(P, lds, abid); }
    if (P.ph_lo < 13 && 13 < P.ph_hi) xcd_barrier(xb);
    PHON(13) if (P.ph_lo <= 13 && 13 < P.ph_hi) { phase_attn<true>(P, lds, abid); }
    if constexpr (DUPSEL == 1) { for (int i = 0; i < 8; ++i) xcd_barrier(xb); }
    if (P.ph_lo < 14 && 14 < P.ph_hi) xcd_barrier(xb);
    PHON(14) if (P.ph_lo <= 14 && 14 < P.ph_hi) { run_gemm_v(lds, vbid, P.attn, P.wt_o, DM, DM, EpiRes{P.xres, P.xres, P.xb, P.rowss + 5 * T_TOK}); }
    if (P.ph_lo < 15 && 15 < P.ph_hi) xcd_barrier(xb);
    PHON(15) if (P.ph_lo <= 15 && 15 < P.ph_hi) { preload_rs(lds, vbid, P.rowss + 5 * T_TOK, 5632); run_gemm_v(lds, vbid, P.xb, P.wt_up[3], 5632, DM, EpiAct{P.act, P.rowss + 5 * T_TOK, P.kbuf, P.vT, P.rope, (const LAS float*)(lds + 131072)}); }
    if (P.ph_lo < 16 && 16 < P.ph_hi) xcd_barrier(xb);
    PHON(16) if (P.ph_lo <= 16 && 16 < P.ph_hi) { run_gemm_v(lds, vbid, P.act, P.wt_dn[3], DM, FF, EpiRes{P.xres, P.xres, P.xb, P.rowss + 6 * T_TOK}); }
    if (vb_ok && gridDim.x == 256u) { phase_final_fused(P, lds, vbid); }
    else { xcd_barrier(xb); phase_final(P); }
}

extern "C" void kernel_launch(void* const* d_in, const int* in_sizes, int n_in, void* d_out, int out_size, void* d_ws, size_t ws_size, hipStream_t stream) {
    static int grid_blocks = 0;
    if (!grid_blocks) {
        int dev = 0, cus = 0, per_cu = 0;
        hipGetDevice(&dev);
        hipDeviceGetAttribute(&cus, hipDeviceAttributeMultiprocessorCount, dev);
        hipFuncSetAttribute((const void*)mega_fwd, hipFuncAttributeMaxDynamicSharedMemorySize, LDS_BYTES);
        hipOccupancyMaxActiveBlocksPerMultiprocessor(&per_cu, (const void*)mega_fwd, 512, LDS_BYTES);
        if (per_cu < 1) per_cu = 1;
        if (per_cu > 1) per_cu = 1;
        grid_blocks = cus * per_cu;
    }
    Params p{};
    const float** in = (const float**)&p.x;
    for (int i = 0; i < 19; ++i) in[i] = (const float*)d_in[i];
    p.out = (float*)d_out;
    unsigned char* ws = (unsigned char*)d_ws; size_t off = 0;
    auto take = [&](size_t bytes) { unsigned char* r = ws + off; off += (bytes + 255) & ~(size_t)255; return r; };
    p.xres = (float*)take((size_t)T_TOK * DM * 4);
    p.xb = (bf16_t*)take((size_t)T_TOK * DM * 2);
    p.act = (bf16_t*)take((size_t)T_TOK * FF * 2);
    p.qbuf = p.act;
    p.attn = p.act + (size_t)T_TOK * DM;
    p.part_ml = (float*)(p.act + (size_t)2 * T_TOK * DM);
    p.kbuf = (bf16_t*)take((size_t)T_TOK * 256 * 2);
    p.vT = (bf16_t*)take((size_t)T_TOK * 256 * 2);
    p.kmean = (float*)take(128 * 128 * 4);
    p.rowss = (float*)take((size_t)7 * T_TOK * 4 + 1024);
    p.gcount = (int*)(p.rowss + 7 * T_TOK);
    p.E = (float*)take((size_t)2 * 128 * 64 * 64 * 2 * 4);
    p.lists = (int*)p.E;
    p.rope = (float*)take((size_t)SEQ * 16 * 2 * 4);
    p.bar = (unsigned*)take((size_t)XCD_BAR_WORDS * 4);
    p.s5tab = (float*)take(4096 * 4 * 4);
    p.pcnt = (int*)take(256);
    p.wt_up[0] = (bf16_t*)take((size_t)6144 * DM * 2); p.wt_up[1] = (bf16_t*)take((size_t)6144 * DM * 2);
    p.wt_dn[0] = (bf16_t*)take((size_t)DM * FF * 2); p.wt_dn[1] = (bf16_t*)take((size_t)DM * FF * 2);
    p.wt_glu = (bf16_t*)take((size_t)2048 * DM * 2);
    p.wt_up[2] = (bf16_t*)take((size_t)6144 * DM * 2); p.wt_up[3] = (bf16_t*)take((size_t)6144 * DM * 2);
    p.wt_dn[2] = (bf16_t*)take((size_t)DM * FF * 2); p.wt_dn[3] = (bf16_t*)take((size_t)DM * FF * 2);
    p.wt_q = (bf16_t*)take((size_t)DM * DM * 2);
    p.wt_o = (bf16_t*)take((size_t)DM * DM * 2);
    p.part[0] = p.xb;
    p.part[1] = (bf16_t*)take((size_t)T_TOK * DM * 2);
    p.part[2] = (bf16_t*)take((size_t)T_TOK * DM * 2);
    p.part[3] = p.wt_up[0];
    p.yb = p.part[1];
    int nj = 0, items = 0;
    auto job = [&](const float* W, const float* g, bf16_t* dst, int K, int Nsrc, int ndst, int mode, float scale = 1.f) {
        WJob& J = p.jobs[nj++]; J.W = W; J.g = g; J.dst = dst; J.K = K; J.Nsrc = Nsrc; J.ndst = ndst; J.mode = mode; J.item0 = items; J.scale = scale;
        items += (K / 64) * (ndst / 32);
    };
    auto job_up = [&](int l, int f) { job(p.ffn_w_in + (size_t)(l * 2 + f) * DM * 2 * FF, p.norm_g + (size_t)(l * 3 + (f ? 2 : 0)) * DM, p.wt_up[l * 2 + f], DM, 2 * FF, 2 * FF, 1); };
    auto job_dn = [&](int l, int f) { job(p.ffn_w_out + (size_t)(l * 2 + f) * FF * DM, nullptr, p.wt_dn[l * 2 + f], FF, DM, DM, 0, 0.5f); };
    job_up(0, 0);
    p.it1 = items;
    job_dn(0, 0); job(p.w_glu, nullptr, p.wt_glu, DM, 2048, 2048, 1); job_up(0, 1); job_dn(0, 1);
    p.it2 = items;
    job_up(1, 0);
    job(p.w_k, p.kv_norm_g, p.wt_up[2] + (size_t)5632 * DM, DM, 256, 256, 0);
    job(p.w_v, p.kv_norm_g, p.wt_up[2] + (size_t)5888 * DM, DM, 256, 256, 0);
    job_dn(1, 0); job_up(1, 1); job_dn(1, 1);
    job(p.w_q, p.norm_g + (size_t)4 * DM, p.wt_q, DM, DM, DM, 0);
    job(p.w_o, nullptr, p.wt_o, DM, DM, DM, 0);
    p.nitems = items; p.ph_lo = 0; p.ph_hi = NPHASES; p.pad = 0;
    if (off > ws_size) { fprintf(stderr, "workspace too small: need %zu have %zu\n", off, ws_size); return; }
    (void)hipMemsetAsync(p.bar, 0, (size_t)XCD_BAR_WORDS * 4, stream);
    void* args[] = {&p};
    hipError_t e = hipLaunchCooperativeKernel((const void*)mega_fwd, dim3(grid_blocks), dim3(512), args, LDS_BYTES, stream);
    if (e != hipSuccess) fprintf(stderr, "cooperative launch failed: %s (grid %d)\n", hipGetErrorString(e), grid_blocks);
}
```

```cpp
#include <hip/hip_runtime.h>
#include <hip/hip_cooperative_groups.h>
#include <cstdio>
namespace cg = cooperative_groups;

#define LAS __attribute__((address_space(3)))
#define DI __device__ __forceinline__
typedef unsigned short bf16_t;
typedef short bf16x8 __attribute__((ext_vector_type(8)));
typedef float f32x4 __attribute__((ext_vector_type(4)));
typedef float f32x2 __attribute__((ext_vector_type(2)));
typedef unsigned u32x4 __attribute__((ext_vector_type(4)));
typedef unsigned u32x2 __attribute__((ext_vector_type(2)));

constexpr int T_TOK = 16384, DM = 1024, FF = 2816, SEQ = 8192;
constexpr float RMS_EPS = 1e-6f;
constexpr int LDS_BYTES = 139296;
constexpr int NJOBS = 13;

struct WJob { const float* W; const float* g; bf16_t* dst; int K; int Nsrc; int ndst; int mode; int item0; float scale; };

struct Params {
    const float *x, *norm_g, *ffn_w_in, *ffn_w_out, *a_re, *a_im, *log_step, *b_re, *b_im, *c_re, *c_im, *s5_d, *w_glu, *kv_norm_g, *w_k, *w_v, *w_q, *w_o, *final_g;
    float* out;
    float* xres; bf16_t* xb; bf16_t* act; bf16_t* yb; bf16_t* qbuf; bf16_t* attn; bf16_t* kbuf; bf16_t* vbuf;
    float* kmean; float* rowss; float* E; float* rope;
    bf16_t* vT; bf16_t* part[4]; float* part_ml; int* lists; int* gcount; unsigned* bar; float* s5tab; int* pcnt;
    bf16_t* wt_up[4]; bf16_t* wt_dn[4]; bf16_t* wt_glu; bf16_t* wt_q; bf16_t* wt_o;
    WJob jobs[NJOBS];
    int nitems; int ph_lo; int ph_hi; int pad; int it1; int it2;
};

DI unsigned cvt_pk_bf16(float lo, float hi) { unsigned r; asm volatile("v_cvt_pk_bf16_f32 %0, %1, %2" : "=v"(r) : "v"(lo), "v"(hi)); return r; }
DI float bf_lo(unsigned w) { return __uint_as_float(w << 16); }
DI float bf_hi(unsigned w) { return __uint_as_float(w & 0xffff0000u); }
DI float wave_sum(float v) {
#pragma unroll
    for (int o = 1; o < 64; o <<= 1) v += __shfl_xor(v, o);
    return v;
}
DI float wave_max(float v) {
#pragma unroll
    for (int o = 1; o < 64; o <<= 1) v = fmaxf(v, __shfl_xor(v, o));
    return v;
}

namespace pg8 {
constexpr int BM = 256, BK = 64, HALF = 128, HTB = HALF * BK * 2, NXCD = 8, WGM = 8;
DI int lds_byte(int r, int c) { const int st = (r >> 4) * 2 + (c >> 5), rr = r & 15, cc = c & 31, ob = rr * 64 + cc * 2; return st * 1024 + (ob ^ (((ob >> 9) & 1) << 5)); }
DI void stage_rc(int b, int& R, int& C) { const int st = b / 1024, sb = b % 1024, swz = sb ^ (((sb >> 9) & 1) << 5); R = (st >> 1) * 16 + swz / 64; C = (st & 1) * 32 + (swz % 64) / 2; }
struct Unit { int pm, pn; };
struct Gemm { const bf16_t* A; const bf16_t* Bt; int M, N, K; };
struct StaticOrder {
    int nM, nN, nwg, G, c;
    DI void init(int M, int N, int G_, int c_) { nM = M / BM; nN = N / BM; nwg = nM * nN; G = G_; c = c_; }
    DI bool next(int i, Unit& u) const {
        const long L = (long)i * G + c; if (L >= nwg) return false;
        int wgid = (int)L; { const int q = nwg / NXCD, r = nwg % NXCD, xcd = wgid % NXCD, off = wgid / NXCD; wgid = (xcd < r ? xcd * (q + 1) : r * (q + 1) + (xcd - r) * q) + off; }
        const int nig = WGM * nN, gid = wgid / nig, fm = gid * WGM, gsz = (nM - fm) < WGM ? (nM - fm) : WGM;
        u.pm = fm + ((wgid % nig) % gsz); u.pn = (wgid % nig) / gsz; return true;
    }
};

template <class Epi>
DI void gemm_phase(LAS unsigned char* lds, const Gemm g, const StaticOrder& S, const Epi& E) {
    int tid_ = threadIdx.x; asm volatile("" : "+v"(tid_));
    const int tid = tid_, wid = __builtin_amdgcn_readfirstlane(tid >> 6), lane = tid & 63, wr = wid >> 2, wc = wid & 3, fr = lane & 15, fq = lane >> 4;
    const int K = g.K, nt = K / BK;
    unsigned voffA[2], voffB[2];
#pragma unroll
    for (int i = 0; i < 2; ++i) { int R, C; stage_rc(tid * 16 + i * 8192, R, C); voffA[i] = (unsigned)(R * K + C) * 2u; voffB[i] = voffA[i]; }
    const size_t kstep = (size_t)(BK * 2);
    const size_t hstep = (size_t)HALF * K * 2;
    const size_t tstep = 2 * hstep;
    const unsigned ldsw = (unsigned)wid * 1024u;
    const int aoff = lds_byte(wr * 64 + fr, fq * 8), boff = lds_byte(wc * 32 + fr, fq * 8);
#define PG8_SA(b, h) (((b) * 2 + (h)) * HTB)
#define PG8_SB(b, h) ((4 + (b) * 2 + (h)) * HTB)
#define PG8_STAGE(bufoff, gbase, voff) do { _Pragma("unroll") for (int _i = 0; _i < 2; ++_i) \
        __builtin_amdgcn_global_load_lds((const unsigned*)((const char*)(gbase) + (voff)[_i]), (LAS unsigned*)(lds + (bufoff) + ldsw + _i * 8192), 16, 0, 0); } while (0)
#define PG8_LDA(dst, b, h) do { _Pragma("unroll") for (int m = 0; m < 4; ++m) _Pragma("unroll") for (int k = 0; k < 2; ++k) dst[m][k] = *(const LAS bf16x8*)(lds + PG8_SA(b, h) + aoff + m * 2048 + k * 1024); } while (0)
#define PG8_LDB(dst, b, h) do { _Pragma("unroll") for (int n = 0; n < 2; ++n) _Pragma("unroll") for (int k = 0; k < 2; ++k) dst[n][k] = *(const LAS bf16x8*)(lds + PG8_SB(b, h) + boff + n * 2048 + k * 1024); } while (0)
#define PG8_MMA(ai, bj, At, Bt) do { __builtin_amdgcn_s_setprio(1); _Pragma("unroll") for (int m = 0; m < 4; ++m) _Pragma("unroll") for (int n = 0; n < 2; ++n) _Pragma("unroll") for (int k = 0; k < 2; ++k) \
        acc[ai][bj][m][n] = __builtin_amdgcn_mfma_f32_16x16x32_bf16(Bt[n][k], At[m][k], acc[ai][bj][m][n], 0, 0, 0); __builtin_amdgcn_s_setprio(0); } while (0)
#define PG8_WAIT_V(n) asm volatile("s_waitcnt vmcnt(" #n ")" ::: "memory")
#define PG8_WAIT_L(n) asm volatile("s_waitcnt lgkmcnt(" #n ")" ::: "memory")
#define PG8_BAR __builtin_amdgcn_s_barrier()
#define PG8_SCHED __builtin_amdgcn_sched_barrier(0)
    Unit cur, nxt; int ui = 0;
    if (!S.next(0, cur)) return;
    f32x4 acc[2][2][4][2];
    if constexpr (Epi::INIT_X) E.init(acc, cur, wr, wc, fr, fq);
    else {
#pragma unroll
    for (int a = 0; a < 2; ++a)
#pragma unroll
        for (int b = 0; b < 2; ++b)
#pragma unroll
            for (int m = 0; m < 4; ++m)
#pragma unroll
                for (int n = 0; n < 2; ++n) acc[a][b][m][n] = (f32x4){0.f, 0.f, 0.f, 0.f};
    }
    bf16x8 At[4][2], B0[2][2], B1[2][2];
    const char* cA = (const char*)g.A + (size_t)cur.pm * tstep; const char* cB = (const char*)g.Bt + (size_t)cur.pn * tstep;
    PG8_STAGE(PG8_SB(0, 0), cB, voffB); PG8_STAGE(PG8_SA(0, 0), cA, voffA); PG8_STAGE(PG8_SB(0, 1), cB + hstep, voffB); PG8_STAGE(PG8_SA(0, 1), cA + hstep, voffA);
    if (wr == 1) PG8_BAR;
    PG8_WAIT_V(4); PG8_BAR;
    PG8_STAGE(PG8_SB(1, 0), cB + kstep, voffB); PG8_STAGE(PG8_SA(1, 0), cA + kstep, voffA); PG8_STAGE(PG8_SB(1, 1), cB + hstep + kstep, voffB);
    PG8_WAIT_V(6); PG8_BAR;
    for (;;) {
        const bool has_next = S.next(ui + 1, nxt);
        const char* nA = has_next ? (const char*)g.A + (size_t)nxt.pm * tstep : cA; const char* nB = has_next ? (const char*)g.Bt + (size_t)nxt.pn * tstep : cB;
        for (int t = 0; t < nt; t += 2) {
            const bool last = (t == nt - 2);
            const char* a1 = cA + (size_t)(t + 1) * kstep;
            const char* a2 = last ? nA : cA + (size_t)(t + 2) * kstep; const char* b2 = last ? nB : cB + (size_t)(t + 2) * kstep;
            const char* a3 = a2 + kstep; const char* b3 = b2 + kstep;
            PG8_LDB(B0, 0, 0); PG8_SCHED; PG8_LDA(At, 0, 0); PG8_STAGE(PG8_SA(1, 1), a1 + hstep, voffA);
            PG8_WAIT_L(8); PG8_BAR; PG8_WAIT_L(0); PG8_MMA(0, 0, At, B0); PG8_BAR; PG8_SCHED;
            PG8_LDB(B1, 0, 1); PG8_STAGE(PG8_SB(0, 0), b2, voffB);
            PG8_BAR; PG8_WAIT_L(0); PG8_MMA(0, 1, At, B1); PG8_BAR;
            PG8_LDA(At, 0, 1); PG8_STAGE(PG8_SA(0, 0), a2, voffA);
            PG8_BAR; PG8_WAIT_L(0); PG8_MMA(1, 0, At, B0); PG8_BAR; PG8_SCHED;
            PG8_STAGE(PG8_SB(0, 1), b2 + hstep, voffB);
            PG8_WAIT_V(6); PG8_BAR; PG8_MMA(1, 1, At, B1); PG8_BAR;
            PG8_LDB(B0, 1, 0); PG8_SCHED; PG8_LDA(At, 1, 0); PG8_STAGE(PG8_SA(0, 1), a2 + hstep, voffA);
            PG8_WAIT_L(8); PG8_BAR; PG8_WAIT_L(0); PG8_MMA(0, 0, At, B0); PG8_BAR; PG8_SCHED;
            PG8_LDB(B1, 1, 1); PG8_STAGE(PG8_SB(1, 0), b3, voffB);
            PG8_BAR; PG8_WAIT_L(0); PG8_MMA(0, 1, At, B1); PG8_BAR;
            PG8_LDA(At, 1, 1); PG8_STAGE(PG8_SA(1, 0), a3, voffA);
            PG8_BAR; PG8_WAIT_L(0); PG8_MMA(1, 0, At, B0); PG8_BAR; PG8_SCHED;
            PG8_STAGE(PG8_SB(1, 1), b3 + hstep, voffB);
            PG8_WAIT_V(6); PG8_BAR; PG8_MMA(1, 1, At, B1); PG8_BAR;
        }
        E(acc, cur, wr, wc, fr, fq, ui);
        if (!has_next) break;
        if constexpr (Epi::INIT_X) E.init(acc, nxt, wr, wc, fr, fq);
        else {
#pragma unroll
        for (int a = 0; a < 2; ++a)
#pragma unroll
            for (int b = 0; b < 2; ++b)
#pragma unroll
                for (int m = 0; m < 4; ++m)
#pragma unroll
                    for (int n = 0; n < 2; ++n) acc[a][b][m][n] = (f32x4){0.f, 0.f, 0.f, 0.f};
        }
        cur = nxt; cA = nA; cB = nB; ++ui;
    }
    PG8_WAIT_V(0);
    if (wr == 0) PG8_BAR;
    PG8_BAR;
#undef PG8_SA
#undef PG8_SB
#undef PG8_STAGE
#undef PG8_LDA
#undef PG8_LDB
#undef PG8_MMA
#undef PG8_WAIT_V
#undef PG8_WAIT_L
#undef PG8_BAR
#undef PG8_SCHED
}
}
using pg8::Unit;
typedef f32x4 AccT[2][2][4][2];

DI void store_bf4(bf16_t* p, f32x4 v) { u32x2 o; o.x = cvt_pk_bf16(v.x, v.y); o.y = cvt_pk_bf16(v.z, v.w); *(u32x2*)p = o; }
DI float sigmoidf_(float x) { return __builtin_amdgcn_rcpf(1.f + __builtin_amdgcn_exp2f(-1.4426950408889634f * x)); }

struct EpiAct {
    static constexpr bool INIT_X = false;
    bf16_t* act; const float* rowss; bf16_t* kbuf; bf16_t* vbuf; const float* rope; const LAS float* rsl;
    DI void operator()(const AccT& acc, const Unit& u, int wr, int wc, int fr, int fq, int ui) const {
        const int row0 = u.pm * 256 + wr * 64 + fr;
        if (u.pn < 22) {
#pragma unroll
            for (int ai = 0; ai < 2; ++ai)
#pragma unroll
                for (int m = 0; m < 4; ++m) {
                    const int row = row0 + ai * 128 + m * 16;
                    const float rs = rsl[ui * 256 + wr * 64 + fr + ai * 128 + m * 16];
#pragma unroll
                    for (int bj = 0; bj < 2; ++bj) {
                        const f32x4 gt = acc[ai][bj][m][0] * rs, up = acc[ai][bj][m][1] * rs;
                        f32x4 a;
#pragma unroll
                        for (int j = 0; j < 4; ++j) a[j] = gt[j] * sigmoidf_(gt[j]) * up[j];
                        const int col = 16 * (8 * u.pn + 4 * bj + wc) + 4 * fq;
                        store_bf4(act + (size_t)row * FF + col, a);
                    }
                }
        } else if (u.pn == 22) {
            const bool do_rope = (wc == 0);
#pragma unroll
            for (int ai = 0; ai < 2; ++ai)
#pragma unroll
                for (int m = 0; m < 4; ++m) {
                    const int row = row0 + ai * 128 + m * 16;
                    const float rs = rsqrtf(rowss[row] * (1.f / DM) + RMS_EPS);
                    const int b = row >> 13, pos = row & (SEQ - 1);
#pragma unroll
                    for (int bj = 0; bj < 2; ++bj) {
                        f32x4 v0 = acc[ai][bj][m][0] * rs, v1 = acc[ai][bj][m][1] * rs;
                        if (do_rope) {
                            const f32x4* rp = (const f32x4*)(rope + ((size_t)pos * 16 + 4 * fq) * 2);
                            const f32x4 cs0 = rp[0], cs1 = rp[1];
                            const float c[4] = {cs0.x, cs0.z, cs1.x, cs1.z}, s[4] = {cs0.y, cs0.w, cs1.y, cs1.w};
#pragma unroll
                            for (int j = 0; j < 4; ++j) { const float x1 = v0[j], x2 = v1[j]; v0[j] = x1 * c[j] - x2 * s[j]; v1[j] = x2 * c[j] + x1 * s[j]; }
                        }
                        bf16_t* d = kbuf + ((size_t)(b * 2 + bj) * SEQ + pos) * 128 + 32 * wc + 4 * fq;
                        store_bf4(d, v0); store_bf4(d + 16, v1);
                    }
                }
        } else {
            const int lane = fr + 16 * fq, qi = lane & 3;
#pragma unroll
            for (int ai = 0; ai < 2; ++ai)
#pragma unroll
                for (int m = 0; m < 4; ++m) {
                    const int row = row0 + ai * 128 + m * 16;
                    const float rs = rsqrtf(rowss[row] * (1.f / DM) + RMS_EPS);
                    const int b = row >> 13, posq = (row & (SEQ - 1)) & ~3;
#pragma unroll
                    for (int bj = 0; bj < 2; ++bj)
#pragma unroll
                        for (int n = 0; n < 2; ++n) {
                            const f32x4 v = acc[ai][bj][m][n] * rs;
                            f32x4 w;
#pragma unroll
                            for (int k = 0; k < 4; ++k) {
                                const int src = (lane & ~3) | k;
                                const float t0 = __shfl(v[0], src), t1 = __shfl(v[1], src), t2 = __shfl(v[2], src), t3 = __shfl(v[3], src);
                                w[k] = qi == 0 ? t0 : (qi == 1 ? t1 : (qi == 2 ? t2 : t3));
                            }
                            const int d = 32 * wc + 16 * n + 4 * fq + qi;
                            store_bf4(vbuf + ((size_t)((b * 2 + bj) * 128 + d)) * SEQ + posq, w);
                        }
                }
        }
    }
};

struct EpiRes {
    static constexpr bool INIT_X = true;
    const float* xin; float* xout; bf16_t* xb; float* rowss_out;
    DI void init(AccT& acc, const Unit& u, int wr, int wc, int fr, int fq) const {
        const int row0 = u.pm * 256 + wr * 64 + fr;
#pragma unroll
        for (int ai = 0; ai < 2; ++ai)
#pragma unroll
            for (int m = 0; m < 4; ++m)
#pragma unroll
                for (int bj = 0; bj < 2; ++bj)
#pragma unroll
                    for (int n = 0; n < 2; ++n)
                        acc[ai][bj][m][n] = *(const f32x4*)(xin + (size_t)(row0 + ai * 128 + m * 16) * DM + u.pn * 256 + bj * 128 + wc * 32 + n * 16 + 4 * fq);
    }
    DI void operator()(const AccT& acc, const Unit& u, int wr, int wc, int fr, int fq, int ui) const {
        const int row0 = u.pm * 256 + wr * 64 + fr;
#pragma unroll
        for (int ai = 0; ai < 2; ++ai)
#pragma unroll
            for (int m = 0; m < 4; ++m) {
                const int row = row0 + ai * 128 + m * 16;
                float ss = 0.f;
#pragma unroll
                for (int bj = 0; bj < 2; ++bj)
#pragma unroll
                    for (int n = 0; n < 2; ++n) {
                        const size_t off = (size_t)row * DM + u.pn * 256 + bj * 128 + wc * 32 + n * 16 + 4 * fq;
                        const f32x4 v = acc[ai][bj][m][n];
                        *(f32x4*)(xout + off) = v;
                        store_bf4(xb + off, v);
                        ss += v.x * v.x + v.y * v.y + v.z * v.z + v.w * v.w;
                    }
                ss += __shfl_xor(ss, 16); ss += __shfl_xor(ss, 32);
                if (fq == 0) atomicAdd(rowss_out + row, ss);
            }
    }
};

struct EpiGlu {
    static constexpr bool INIT_X = false;
    float* xres; bf16_t* xb; float* rowss_out;
    DI void operator()(const AccT& acc, const Unit& u, int wr, int wc, int fr, int fq, int ui) const {
        const int row0 = u.pm * 256 + wr * 64 + fr;
#pragma unroll
        for (int ai = 0; ai < 2; ++ai)
#pragma unroll
            for (int m = 0; m < 4; ++m) {
                const int row = row0 + ai * 128 + m * 16;
                float ss = 0.f;
#pragma unroll
                for (int bj = 0; bj < 2; ++bj) {
                    const size_t off = (size_t)row * DM + 16 * (8 * u.pn + 4 * bj + wc) + 4 * fq;
                    const f32x4 val = acc[ai][bj][m][0], gt = acc[ai][bj][m][1];
                    f32x4 v = *(const f32x4*)(xres + off);
#pragma unroll
                    for (int j = 0; j < 4; ++j) v[j] += val[j] * sigmoidf_(gt[j]);
                    *(f32x4*)(xres + off) = v;
                    store_bf4(xb + off, v);
                    ss += v.x * v.x + v.y * v.y + v.z * v.z + v.w * v.w;
                }
                ss += __shfl_xor(ss, 16); ss += __shfl_xor(ss, 32);
                if (fq == 0) atomicAdd(rowss_out + row, ss);
            }
    }
};

struct EpiQ {
    static constexpr bool INIT_X = false;
    bf16_t* qbuf; const float* rowss; const float* rope;
    DI void operator()(const AccT& acc, const Unit& u, int wr, int wc, int fr, int fq, int ui) const {
        const int row0 = u.pm * 256 + wr * 64 + fr;
#pragma unroll
        for (int ai = 0; ai < 2; ++ai)
#pragma unroll
            for (int m = 0; m < 4; ++m) {
                const int row = row0 + ai * 128 + m * 16;
                const float rs = rsqrtf(rowss[row] * (1.f / DM) + RMS_EPS) * 0.08838834764831845f;
                const int pos = row & (SEQ - 1);
#pragma unroll
                for (int bj = 0; bj < 2; ++bj) {
                    f32x4 v0 = acc[ai][bj][m][0] * rs, v1 = acc[ai][bj][m][1] * rs;
                    if (wc == 0) {
                        const f32x4* rp = (const f32x4*)(rope + ((size_t)pos * 16 + 4 * fq) * 2);
                        const f32x4 cs0 = rp[0], cs1 = rp[1];
                        const float c[4] = {cs0.x, cs0.z, cs1.x, cs1.z}, s[4] = {cs0.y, cs0.w, cs1.y, cs1.w};
#pragma unroll
                        for (int j = 0; j < 4; ++j) { const float x1 = v0[j], x2 = v1[j]; v0[j] = x1 * c[j] - x2 * s[j]; v1[j] = x2 * c[j] + x1 * s[j]; }
                    }
                    bf16_t* d = qbuf + (size_t)row * DM + u.pn * 256 + bj * 128 + 32 * wc + 4 * fq;
                    store_bf4(d, v0); store_bf4(d + 16, v1);
                }
            }
    }
};

DI void preload_rs(LAS unsigned char* lds, int vbid, const float* rowss, int N) {
    pg8::StaticOrder S; S.init(T_TOK, N, gridDim.x, vbid);
    LAS float* rsl = (LAS float*)(lds + 131072);
    if (threadIdx.x < 256) {
        float v[8]; bool ok[8];
#pragma unroll
        for (int i = 0; i < 8; ++i) { pg8::Unit u; ok[i] = S.next(i, u); v[i] = ok[i] ? rowss[u.pm * 256 + threadIdx.x] : 1.f; }
#pragma unroll
        for (int i = 0; i < 8; ++i) if (ok[i]) rsl[i * 256 + threadIdx.x] = rsqrtf(v[i] * (1.f / DM) + RMS_EPS);
    }
    __syncthreads();
}
template <class Epi>
DI void run_gemm_v(LAS unsigned char* lds, int vbid, const bf16_t* A, const bf16_t* Bt, int N, int K, const Epi& E) {
    pg8::Gemm g{A, Bt, T_TOK, N, K};
    pg8::StaticOrder S; S.init(T_TOK, N, gridDim.x, vbid);
    pg8::gemm_phase<Epi>(lds, g, S, E);
}

struct S5Coef { float ar, ai, cr, ci; };
DI S5Coef s5_coefs_compute(const Params& P, int g, int p) {
    const float dt = expf(P.log_step[g]); const float lr = P.a_re[g * 64 + p], li = P.a_im[g * 64 + p];
    const float mag = expf(lr * dt); S5Coef c; c.ar = mag * cosf(li * dt); c.ai = mag * sinf(li * dt);
    const float nr = c.ar - 1.f, ni = c.ai, den = lr * lr + li * li;
    c.cr = (nr * lr + ni * li) / den; c.ci = (ni * lr - nr * li) / den; return c;
}
DI S5Coef s5_coefs(const Params& P, int g, int p) { const f32x4 v = *(const f32x4*)(P.s5tab + (size_t)(g * 64 + p) * 4); S5Coef c; c.ar = v.x; c.ai = v.y; c.cr = v.z; c.ci = v.w; return c; }

DI void p0_transpose_item(const WJob& J, LAS float* scr, int item, int lane) {
    const int nblk = J.ndst / 32, kb = item / nblk, nb = item % nblk, k0 = 64 * kb, r0 = 32 * nb;
    const int i = lane & 31;
    int scol;
    if (J.mode == 0) scol = r0 + i;
    else { const int G = r0 >> 5; scol = (i < 16) ? (16 * G + i) : ((J.Nsrc >> 1) + 16 * G + (i - 16)); }
    float wv[32];
    const float* wp = J.W + (size_t)(k0 + (lane >> 5)) * J.Nsrc + scol;
#pragma unroll
    for (int it = 0; it < 32; ++it) wv[it] = wp[(size_t)(2 * it) * J.Nsrc];
    if (J.g) {
        const float* gp = J.g + k0 + (lane >> 5);
#pragma unroll
        for (int it = 0; it < 32; ++it) wv[it] *= gp[2 * it];
    }
    if (J.scale != 1.f) {
#pragma unroll
        for (int it = 0; it < 32; ++it) wv[it] *= J.scale;
    }
#pragma unroll
    for (int it = 0; it < 32; ++it) scr[(2 * it + (lane >> 5)) * 33 + i] = wv[it];
    __builtin_amdgcn_fence(__ATOMIC_RELEASE, "wavefront"); __builtin_amdgcn_wave_barrier(); __builtin_amdgcn_fence(__ATOMIC_ACQUIRE, "wavefront");
    const int c = lane & 7;
#pragma unroll
    for (int j = 0; j < 4; ++j) {
        const int n = (lane >> 3) + 8 * j; const LAS float* s = scr + (8 * c) * 33 + n;
        u32x4 o; o.x = cvt_pk_bf16(s[0 * 33], s[1 * 33]); o.y = cvt_pk_bf16(s[2 * 33], s[3 * 33]); o.z = cvt_pk_bf16(s[4 * 33], s[5 * 33]); o.w = cvt_pk_bf16(s[6 * 33], s[7 * 33]);
        *(u32x4*)(J.dst + (size_t)(r0 + n) * J.K + k0 + 8 * c) = o;
    }
    __builtin_amdgcn_fence(__ATOMIC_RELEASE, "wavefront"); __builtin_amdgcn_wave_barrier(); __builtin_amdgcn_fence(__ATOMIC_ACQUIRE, "wavefront");
}

DI void convert_items(const Params& P, LAS unsigned char* lds, int lo, int hi, int gw, int NGW) {
    const int wave = threadIdx.x >> 6, lane = threadIdx.x & 63;
    LAS float* scr = (LAS float*)(lds + wave * 16384);
    for (int it = lo + gw; it < hi; it += NGW) {
        int j = 0;
#pragma unroll 1
        for (int q = 1; q < NJOBS; ++q) if (it >= P.jobs[q].item0) j = q;
        p0_transpose_item(P.jobs[j], scr, it - P.jobs[j].item0, lane);
    }
}
DI void convert_by_light_blocks(const Params& P, LAS unsigned char* lds, int vbid, int units, int lo, int hi) {
    asm volatile("" : "+s"(vbid), "+s"(lo), "+s"(hi));
    const int G = gridDim.x, extra = units % G, first = extra, nlight = G - extra;
    if (vbid >= first) convert_items(P, lds, lo, hi, (vbid - first) * 8 + (threadIdx.x >> 6), nlight * 8);
}

DI void phase_prep(const Params& P, LAS unsigned char* lds) {
    const int tid = threadIdx.x, wave = tid >> 6, lane = tid & 63;
    const int gw = blockIdx.x * 8 + wave, NGW = gridDim.x * 8;
    LAS float* scr = (LAS float*)(lds + wave * 16384);
    convert_items(P, lds, 0, P.it1, gw, NGW);
    for (int row = gw; row < T_TOK; row += 2 * NGW) {
        const int row2 = row + NGW; const bool has2 = row2 < T_TOK;
        const f32x4* xr = (const f32x4*)(P.x + (size_t)row * DM) + lane;
        const f32x4* xr2 = (const f32x4*)(P.x + (size_t)(has2 ? row2 : row) * DM) + lane;
        f32x4 v[4], w[4]; float s = 0.f, s2 = 0.f;
#pragma unroll
        for (int j = 0; j < 4; ++j) { v[j] = xr[64 * j]; w[j] = xr2[64 * j]; }
#pragma unroll
        for (int j = 0; j < 4; ++j) { s += v[j].x * v[j].x + v[j].y * v[j].y + v[j].z * v[j].z + v[j].w * v[j].w; s2 += w[j].x * w[j].x + w[j].y * w[j].y + w[j].z * w[j].z + w[j].w * w[j].w; }
        s = wave_sum(s); s2 = wave_sum(s2);
        if (lane == 0) { P.rowss[row] = s; if (has2) P.rowss[row2] = s2; }
        bf16_t* o = P.xb + (size_t)row * DM + 4 * lane;
#pragma unroll
        for (int j = 0; j < 4; ++j) store_bf4(o + 256 * j, v[j]);
        if (has2) {
            bf16_t* o2 = P.xb + (size_t)row2 * DM + 4 * lane;
#pragma unroll
            for (int j = 0; j < 4; ++j) store_bf4(o2 + 256 * j, w[j]);
        }
    }
    const int gt = blockIdx.x * 512 + tid, NGT = gridDim.x * 512;
    for (int i = gt; i < 6 * T_TOK; i += NGT) P.rowss[T_TOK + i] = 0.f;
    if (gt < 128) P.gcount[gt] = 0;
    if (gt < 64) P.pcnt[gt] = 0;
    for (int i = gt; i < 4096; i += NGT) { const S5Coef c = s5_coefs_compute(P, i >> 6, i & 63); *(f32x4*)(P.s5tab + (size_t)i * 4) = (f32x4){c.ar, c.ai, c.cr, c.ci}; }
    for (int i = gt; i < SEQ * 16; i += NGT) {
        const int pos = i >> 4, d = i & 15;
        const float inv = exp2f(-(float)d * (18.931568569324174f / 16.f));
        const float ang = (float)pos * inv;
        P.rope[2 * i] = cosf(ang); P.rope[2 * i + 1] = sinf(ang);
    }
}

DI float gelu_tanh(float x) { const float u = 0.7978845608028654f * (x + 0.044715f * x * x * x); return x * __builtin_amdgcn_rcpf(1.f + __builtin_amdgcn_exp2f(-2.f * 1.4426950408889634f * u)); }

typedef float f32x16 __attribute__((ext_vector_type(16)));
typedef __bf16 bf2_t __attribute__((ext_vector_type(2)));
DI unsigned pk_bf16(float lo, float hi) { const f32x2 v = {lo, hi}; return __builtin_bit_cast(unsigned, __builtin_convertvector(v, bf2_t)); }
#define WAVE_LDS_SYNC() asm volatile("s_waitcnt lgkmcnt(0)" ::: "memory")

DI void s5_bfrags(const Params& P, int g, int lane, bf16x8 (&bf)[4]) {
    const int q = lane & 31, h = lane >> 5;
#pragma unroll
    for (int pj = 0; pj < 2; ++pj) {
        const int p = q + 32 * pj;
        const S5Coef c = s5_coefs(P, g, p);
        const f32x4* br = (const f32x4*)(P.b_re + ((size_t)g * 64 + p) * 16 + 8 * h);
        const f32x4* bi = (const f32x4*)(P.b_im + ((size_t)g * 64 + p) * 16 + 8 * h);
        const f32x4 r0 = br[0], r1 = br[1], i0 = bi[0], i1 = bi[1];
        float re[8], im[8];
#pragma unroll
        for (int j = 0; j < 4; ++j) {
            re[j] = c.cr * r0[j] - c.ci * i0[j]; im[j] = c.cr * i0[j] + c.ci * r0[j];
            re[4 + j] = c.cr * r1[j] - c.ci * i1[j]; im[4 + j] = c.cr * i1[j] + c.ci * r1[j];
        }
        const u32x4 wr = {pk_bf16(re[0], re[1]), pk_bf16(re[2], re[3]), pk_bf16(re[4], re[5]), pk_bf16(re[6], re[7])};
        const u32x4 wi = {pk_bf16(im[0], im[1]), pk_bf16(im[2], im[3]), pk_bf16(im[4], im[5]), pk_bf16(im[6], im[7])};
        bf[2 * pj] = __builtin_bit_cast(bf16x8, wr); bf[2 * pj + 1] = __builtin_bit_cast(bf16x8, wi);
    }
}
DI bf16x8 s5_ufrag(const Params& P, int rowbase, int g, int lane, const f32x4& ga, const f32x4& gb) {
    const int t = lane & 31, h = lane >> 5, row = rowbase + t;
    const float rs = rsqrtf(P.rowss[T_TOK + row] * (1.f / DM) + RMS_EPS);
    const f32x4* xp = (const f32x4*)(P.xres + (size_t)row * DM + 16 * g + 8 * h);
    const f32x4 a = xp[0] * rs * ga, b = xp[1] * rs * gb;
    const u32x4 w = {pk_bf16(a.x, a.y), pk_bf16(a.z, a.w), pk_bf16(b.x, b.y), pk_bf16(b.z, b.w)};
    return __builtin_bit_cast(bf16x8, w);
}
template <bool WRITE>
DI void s5_scan32(const f32x16 (&X)[4], int h, int p, float ar, float ai, float& hr, float& hi, LAS unsigned char* hs) {
    float lo_re[16], lo_im[16], hi_re[16], hi_im[16];
#pragma unroll
    for (int r = 0; r < 16; ++r) {
        const auto sr = __builtin_amdgcn_permlane32_swap(__float_as_uint(X[0][r]), __float_as_uint(X[2][r]), false, false);
        const auto si = __builtin_amdgcn_permlane32_swap(__float_as_uint(X[1][r]), __float_as_uint(X[3][r]), false, false);
        lo_re[r] = __uint_as_float(sr[0]); hi_re[r] = __uint_as_float(sr[1]);
        lo_im[r] = __uint_as_float(si[0]); hi_im[r] = __uint_as_float(si[1]);
    }
#pragma unroll
    for (int i = 0; i < 4; ++i)
#pragma unroll
        for (int half = 0; half < 2; ++half)
#pragma unroll
            for (int j = 0; j < 4; ++j) {
                const int r = 4 * i + j, token = 8 * i + 4 * half + j;
                const float xr = half ? hi_re[r] : lo_re[r], xi = half ? hi_im[r] : lo_im[r];
                const float nhr = ar * hr - ai * hi + xr, nhi = ar * hi + ai * hr + xi; hr = nhr; hi = nhi;
                if (WRITE) {
                    const unsigned whi = pk_bf16(hr, hi);
                    *(LAS unsigned*)(hs + token * 272 + 4 * p) = whi;
                    *(LAS unsigned*)(hs + 69632 + token * 272 + 4 * p) = pk_bf16(hr - bf_lo(whi), hi - bf_hi(whi));
                }
            }
}

struct S5In { f32x4 x0, x1; float ss; };
DI S5In s5_in_load(const Params& P, int rowbase, int g, int lane) {
    const int row = rowbase + (lane & 31);
    const f32x4* xp = (const f32x4*)(P.xres + (size_t)row * DM + 16 * g + 8 * (lane >> 5));
    S5In r; r.x0 = xp[0]; r.x1 = xp[1]; r.ss = P.rowss[T_TOK + row]; return r;
}
DI bf16x8 s5_in_frag(const S5In& in, const f32x4& ga, const f32x4& gb) {
    const float rs = rsqrtf(in.ss * (1.f / DM) + RMS_EPS);
    const f32x4 a = in.x0 * rs * ga, b = in.x1 * rs * gb;
    const u32x4 w = {pk_bf16(a.x, a.y), pk_bf16(a.z, a.w), pk_bf16(b.x, b.y), pk_bf16(b.z, b.w)};
    return __builtin_bit_cast(bf16x8, w);
}
DI int s5_row0(int L, int wave) { const int bc = L & 31; return (bc >> 4) * SEQ + ((bc & 15) * 8 + wave) * 64; }

DI void phase_s5a(const Params& P, LAS unsigned char* lds) {
    const int tid = threadIdx.x, wave = tid >> 6, lane = tid & 63, h = lane >> 5;
    for (int base = blockIdx.x * 8; base < 2048; base += gridDim.x * 8) {
        const int g = base >> 5;
        const S5Coef cf = s5_coefs(P, g, lane);
        bf16x8 bf[4]; s5_bfrags(P, g, lane, bf);
        const f32x4 ga = *(const f32x4*)(P.norm_g + DM + 16 * g + 8 * h), gb = *(const f32x4*)(P.norm_g + DM + 16 * g + 8 * h + 4);
        float hr = 0.f, hi = 0.f;
        S5In pre = s5_in_load(P, s5_row0(base, wave), g, lane);
#pragma unroll 1
        for (int step = 0; step < 16; ++step) {
            const int L = base + (step >> 1), sub = step & 1;
            const S5In cur = pre;
            if (step < 15) pre = s5_in_load(P, s5_row0(base + ((step + 1) >> 1), wave) + 32 * ((step + 1) & 1), g, lane);
            const bf16x8 a = s5_in_frag(cur, ga, gb);
            f32x16 X[4];
#pragma unroll
            for (int j = 0; j < 4; ++j) {
#pragma unroll
                for (int r = 0; r < 16; ++r) X[j][r] = 0.f;
                X[j] = __builtin_amdgcn_mfma_f32_32x32x16_bf16(a, bf[j], X[j], 0, 0, 0);
            }
            if (sub == 0) { hr = 0.f; hi = 0.f; }
            s5_scan32<false>(X, h, lane, cf.ar, cf.ai, hr, hi, lds);
            if (sub == 1) { const int bc = L & 31, ch = (bc & 15) * 8 + wave; *(f32x2*)(P.E + ((size_t)(((bc >> 4) * 128 + ch) * 64 + g) * 64 + lane) * 2) = (f32x2){hr, hi}; }
        }
    }
}

DI void phase_s5carry(const Params& P) {
    if (blockIdx.x < 128 && threadIdx.x < 64) {
        const int idx = blockIdx.x * 64 + threadIdx.x, b = idx >> 12, g = (idx >> 6) & 63, p = idx & 63;
        const S5Coef cf = s5_coefs(P, g, p);
        float alr = cf.ar, ali = cf.ai;
#pragma unroll
        for (int q = 0; q < 6; ++q) { const float r = alr * alr - ali * ali, i2 = 2.f * alr * ali; alr = r; ali = i2; }
        f32x2* Ep = (f32x2*)P.E + (size_t)(b * 128) * 4096 + g * 64 + p;
        float hr = 0.f, hi = 0.f;
#pragma unroll 1
        for (int j0 = 0; j0 < 128; j0 += 32) {
            f32x2 e[32];
#pragma unroll
            for (int u = 0; u < 32; ++u) e[u] = Ep[(size_t)(j0 + u) * 4096];
#pragma unroll
            for (int u = 0; u < 32; ++u) {
                Ep[(size_t)(j0 + u) * 4096] = (f32x2){hr, hi};
                const float nr = alr * hr - ali * hi + e[u].x, ni = alr * hi + ali * hr + e[u].y; hr = nr; hi = ni;
            }
        }
    }
}

DI void phase_s5b(const Params& P, LAS unsigned char* lds) {
    const int tid = threadIdx.x, wave = tid >> 6, lane = tid & 63, h = lane >> 5, c16 = lane & 15, kq = lane >> 4;
    LAS unsigned char* hs = lds + wave * 8704;
    for (int base = blockIdx.x * 8; base < 2048; base += gridDim.x * 8) {
        const int g = base >> 5;
        const S5Coef cf = s5_coefs(P, g, lane);
        bf16x8 bf[4]; s5_bfrags(P, g, lane, bf);
        const f32x4 ga = *(const f32x4*)(P.norm_g + DM + 16 * g + 8 * h), gb = *(const f32x4*)(P.norm_g + DM + 16 * g + 8 * h + 4);
        bf16x8 cmf[4], cml[4];
#pragma unroll
        for (int ks = 0; ks < 4; ++ks) {
            const int p0 = ks * 16 + kq * 4;
            const f32x4 cr = *(const f32x4*)(P.c_re + ((size_t)g * 16 + c16) * 64 + p0), ci = *(const f32x4*)(P.c_im + ((size_t)g * 16 + c16) * 64 + p0);
            const float v[8] = {cr.x, -ci.x, cr.y, -ci.y, cr.z, -ci.z, cr.w, -ci.w};
            u32x4 wh, wl;
#pragma unroll
            for (int e = 0; e < 4; ++e) { wh[e] = pk_bf16(v[2 * e], v[2 * e + 1]); wl[e] = pk_bf16(v[2 * e] - bf_lo(wh[e]), v[2 * e + 1] - bf_hi(wh[e])); }
            cmf[ks] = __builtin_bit_cast(bf16x8, wh); cml[ks] = __builtin_bit_cast(bf16x8, wl);
        }
        const f32x4 d4 = *(const f32x4*)(P.s5_d + 16 * g + 4 * kq), ge = *(const f32x4*)(P.norm_g + DM + 16 * g + 4 * kq);
        float hr = 0.f, hi = 0.f;
        S5In pre = s5_in_load(P, s5_row0(base, wave), g, lane);
        f32x2 cpre; { const int bc = base & 31, ch = (bc & 15) * 8 + wave; cpre = *((const f32x2*)P.E + ((size_t)((bc >> 4) * 128 + ch) * 64 + g) * 64 + lane); }
#pragma unroll 1
        for (int step = 0; step < 16; ++step) {
            const int L = base + (step >> 1), sub = step & 1, rowb = s5_row0(L, wave) + 32 * sub;
            const S5In cur = pre;
            if (sub == 0) { hr = cpre.x; hi = cpre.y; }
            if (step < 15) pre = s5_in_load(P, s5_row0(base + ((step + 1) >> 1), wave) + 32 * ((step + 1) & 1), g, lane);
            if (sub == 1 && step < 15) { const int bc = (L + 1) & 31, ch = (bc & 15) * 8 + wave; cpre = *((const f32x2*)P.E + ((size_t)((bc >> 4) * 128 + ch) * 64 + g) * 64 + lane); }
            const bf16x8 a = s5_in_frag(cur, ga, gb);
            f32x16 X[4];
#pragma unroll
            for (int j = 0; j < 4; ++j) {
#pragma unroll
                for (int r = 0; r < 16; ++r) X[j][r] = 0.f;
                X[j] = __builtin_amdgcn_mfma_f32_32x32x16_bf16(a, bf[j], X[j], 0, 0, 0);
            }
            s5_scan32<true>(X, h, lane, cf.ar, cf.ai, hr, hi, hs);
            WAVE_LDS_SYNC();
#pragma unroll
            for (int tt = 0; tt < 2; ++tt) {
                f32x4 acc = {0.f, 0.f, 0.f, 0.f};
#pragma unroll
                for (int ks = 0; ks < 4; ++ks) {
                    const LAS unsigned char* ha = hs + (tt * 16 + c16) * 272 + ks * 64 + kq * 16;
                    const bf16x8 hbh = *(const LAS bf16x8*)ha, hbl = *(const LAS bf16x8*)(ha + 69632);
                    acc = __builtin_amdgcn_mfma_f32_16x16x32_bf16(cml[ks], hbh, acc, 0, 0, 0);
                    acc = __builtin_amdgcn_mfma_f32_16x16x32_bf16(cmf[ks], hbl, acc, 0, 0, 0);
                    acc = __builtin_amdgcn_mfma_f32_16x16x32_bf16(cmf[ks], hbh, acc, 0, 0, 0);
                }
                const int row = rowb + 16 * tt + c16;
                const float rs = rsqrtf(P.rowss[T_TOK + row] * (1.f / DM) + RMS_EPS);
                const f32x4 u4 = *(const f32x4*)(P.xres + (size_t)row * DM + 16 * g + 4 * kq) * rs * ge;
                f32x4 y;
#pragma unroll
                for (int j = 0; j < 4; ++j) y[j] = gelu_tanh(acc[j] + d4[j] * u4[j]);
                store_bf4(P.yb + (size_t)row * DM + 16 * g + 4 * kq, y);
            }
            WAVE_LDS_SYNC();
        }
    }
}

DI void phase_kmean(const Params& P, LAS unsigned char* lds) {
    if (blockIdx.x < 128) {
        const int j = blockIdx.x, d = threadIdx.x & 127, part = threadIdx.x >> 7;
        const bf16_t* kb = P.kbuf + ((size_t)(j >> 5) * SEQ + (j & 31) * 256 + part * 64) * 128 + d;
        float s = 0.f;
#pragma unroll 1
        for (int k0 = 0; k0 < 64; k0 += 16) {
            unsigned short v[16];
#pragma unroll
            for (int u = 0; u < 16; ++u) v[u] = kb[(size_t)(k0 + u) * 128];
#pragma unroll
            for (int u = 0; u < 16; ++u) s += __uint_as_float(((unsigned)v[u]) << 16);
        }
        LAS float* red = (LAS float*)lds;
        red[threadIdx.x] = s;
        __syncthreads();
        if (threadIdx.x < 128) P.kmean[j * 128 + d] = (red[d] + red[128 + d] + red[256 + d] + red[384 + d]) * (1.f / 256.f);
    }
}

DI int list_off(int c, int n) { return c * (496 * 1024) + 1024 * (31 * n - (n * (n - 1)) / 2); }

DI void phase_gate(const Params& P, LAS unsigned char* lds) {
    const int tid = threadIdx.x, wave = tid >> 6, lane = tid & 63;
    LAS float* km = (LAS float*)lds;
    LAS int* cnt = (LAS int*)(lds + 32768);
    LAS int* base = cnt + 64;
    for (int qb = blockIdx.x; qb < 256; qb += gridDim.x) {
        const int b = qb >> 7, i = qb & 127, own = i >> 2;
        for (int e = tid; e < 2048; e += 512) {
            const f32x4 v = ((const f32x4*)(P.kmean + b * 8192))[e];
            const int hn = e >> 5, d4 = (e & 31) * 4, hk2 = hn >> 5, n = hn & 31;
            LAS float* dst = km + (hk2 * 128 + d4) * 32 + n;
            dst[0] = v.x; dst[32] = v.y; dst[64] = v.z; dst[96] = v.w;
        }
        if (tid < 64) cnt[tid] = 0;
        __syncthreads();
        const int hq = wave, hk = hq >> 2, t = b * SEQ + i * 64 + lane;
        f32x2 g2[16];
#pragma unroll
        for (int n2 = 0; n2 < 16; ++n2) g2[n2] = (f32x2){0.f, 0.f};
        const u32x4* qr = (const u32x4*)(P.qbuf + (size_t)t * DM + hq * 128);
        {
            u32x4 wa = qr[0], wb = qr[1];
#pragma unroll 1
            for (int c = 0; c < 16; ++c) {
                const u32x4 w = wa; wa = wb; wb = qr[(c + 2) & 15];
                const float qv[8] = {bf_lo(w.x), bf_hi(w.x), bf_lo(w.y), bf_hi(w.y), bf_lo(w.z), bf_hi(w.z), bf_lo(w.w), bf_hi(w.w)};
#pragma unroll
                for (int j = 0; j < 8; ++j) {
                    const LAS f32x4* kp = (const LAS f32x4*)(km + (hk * 128 + 8 * c + j) * 32);
#pragma unroll
                    for (int i4 = 0; i4 < 8; ++i4) {
                        const f32x4 k4 = kp[i4];
                        g2[2 * i4] += (f32x2){k4.x, k4.y} * qv[j];
                        g2[2 * i4 + 1] += (f32x2){k4.z, k4.w} * qv[j];
                    }
                }
            }
        }
        float g[32];
#pragma unroll
        for (int n = 0; n < 32; ++n) g[n] = g2[n >> 1][n & 1];
        const int nsel = own < 3 ? own : 3;
        int s0 = -1, s1 = -1, s2 = -1;
        { float best = -3e38f;
#pragma unroll
          for (int n = 0; n < 32; ++n) if (n < own && g[n] > best) { best = g[n]; s0 = n; } }
        { float best = -3e38f;
#pragma unroll
          for (int n = 0; n < 32; ++n) if (n < own && n != s0 && g[n] > best) { best = g[n]; s1 = n; } }
        { float best = -3e38f;
#pragma unroll
          for (int n = 0; n < 32; ++n) if (n < own && n != s0 && n != s1 && g[n] > best) { best = g[n]; s2 = n; } }
        int l0 = 0, l1 = 0, l2 = 0;
        if (nsel > 0) l0 = atomicAdd((int*)&cnt[hk * 32 + s0], 1);
        if (nsel > 1) l1 = atomicAdd((int*)&cnt[hk * 32 + s1], 1);
        if (nsel > 2) l2 = atomicAdd((int*)&cnt[hk * 32 + s2], 1);
        __syncthreads();
        if (tid < 64) { const int c = cnt[tid]; base[tid] = c > 0 ? atomicAdd(P.gcount + b * 64 + tid, c) : 0; }
        __syncthreads();
        const int row = t * 8 + hq, c2 = b * 2 + hk;
        if (nsel > 0) P.lists[list_off(c2, s0) + base[hk * 32 + s0] + l0] = row * 4 + 1;
        if (nsel > 1) P.lists[list_off(c2, s1) + base[hk * 32 + s1] + l1] = row * 4 + 2;
        if (nsel > 2) P.lists[list_off(c2, s2) + base[hk * 32 + s2] + l2] = row * 4 + 3;
        __syncthreads();
    }
}

template <bool OWN>
DI void phase_attn(const Params& P, LAS unsigned char* lds, int bid) {
    const int tid = threadIdx.x, wave = __builtin_amdgcn_readfirstlane(tid >> 6), lane = tid & 63, h = lane >> 5, l32 = lane & 31;
    LAS unsigned char* Ks = lds;
    LAS unsigned char* Vs = lds + 69632;
    LAS int* pref = (LAS int*)(lds + 136192);
    if constexpr (!OWN) {
        LAS int* cntl = pref + 132;
        if (tid < 128) cntl[tid] = (P.gcount[tid] + 255) >> 8;
        __syncthreads();
        if (tid <= 128) { int a = 0; for (int i = 0; i < 128; ++i) a += (i < tid) ? cntl[i] : 0; pref[tid] = a; }
        __syncthreads();
    }
    const int total = OWN ? 512 : pref[128];
    constexpr float LOG2E = 1.4426950408889634f;
    int rnd = 0;
    for (int idx = bid; idx < total; idx += gridDim.x, ++rnd) {
        const int item = (OWN && (rnd & 1)) ? (idx ^ 3) : idx;
        int c, n, i_q = 0, nrows = 256; const int* lst = P.lists; constexpr bool is_own = OWN;
        if (is_own) { c = item >> 7; i_q = item & 127; n = i_q >> 2; }
        else {
            const int s = item; int lo = 0, hi = 128;
            while (hi - lo > 1) { const int mid = (lo + hi) >> 1; if (pref[mid] <= s) lo = mid; else hi = mid; }
            c = lo >> 5; n = lo & 31; const int grp = s - pref[lo]; lst = P.lists + list_off(c, n) + grp * 256; nrows = P.gcount[lo] - grp * 256; if (nrows > 256) nrows = 256;
        }
        const int b = c >> 1, hk = c & 1;
        int ent; bool valid = true; const int rho = wave * 32 + l32;
        if (is_own) { const int hq = hk * 4 + (rho >> 6), t = b * SEQ + i_q * 64 + (rho & 63); ent = (t * 8 + hq) * 4; }
        else { valid = rho < nrows; ent = lst[valid ? rho : 0]; }
        bf16x8 qf[8];
        {
            const bf16_t* kg = P.kbuf + ((size_t)c * SEQ + n * 256) * 128;
            const bf16_t* vg = P.vT + (size_t)c * 128 * SEQ + n * 256;
            const bf16_t* kgl = kg + (size_t)(tid >> 4) * 128 + (tid & 15) * 8;
            LAS unsigned char* kl = Ks + (tid >> 4) * 272 + (tid & 15) * 16;
            const bf16_t* vgl = vg + (size_t)(tid >> 5) * SEQ + (tid & 31) * 8;
            LAS unsigned char* vl = Vs + (tid >> 5) * 520 + (tid & 31) * 16;
            u32x4 kw[8], vw[8];
            const int nqk = OWN ? 2 * ((i_q & 3) + 1) : 8;
#pragma unroll
            for (int q = 0; q < 8; ++q) { kw[q] = (u32x4){0u, 0u, 0u, 0u}; if (q < nqk) kw[q] = *(const u32x4*)(kgl + q * 4096); }
#pragma unroll
            for (int q = 0; q < 8; ++q) vw[q] = *(const u32x4*)(vgl + (size_t)q * 16 * SEQ);
        { const int row = ent >> 2, t = row >> 3, hq = row & 7; const bf16_t* qp = P.qbuf + (size_t)t * DM + hq * 128 + 8 * h;
#pragma unroll
          for (int ks = 0; ks < 8; ++ks) qf[ks] = *(const bf16x8*)(qp + ks * 16); }
#pragma unroll
            for (int q = 0; q < 8; ++q) *(LAS u32x4*)(kl + q * 8704) = kw[q];
#pragma unroll
            for (int q = 0; q < 8; ++q) { LAS u32x2* dst = (LAS u32x2*)(vl + q * 8320); dst[0] = (u32x2){vw[q].x, vw[q].y}; dst[1] = (u32x2){vw[q].z, vw[q].w}; }
        }
        __syncthreads();
        if (wave < 4) __builtin_amdgcn_s_setprio(2);
        if (wave * 32 < nrows) {
            const int nkt = is_own ? (2 * (i_q & 3) + (wave & 1) + 1) : 8;
            const int posb = is_own ? (64 * (i_q & 3) + (rho & 63)) : 100000;
            float m_run = -1e30f, l_run = 0.f;
            f32x16 o[4];
#pragma unroll
            for (int db = 0; db < 4; ++db)
#pragma unroll
                for (int r = 0; r < 16; ++r) o[db][r] = 0.f;
#pragma unroll 1
            for (int hf = 0; hf < 2; ++hf) {
                if (4 * hf >= nkt) break;
                f32x16 s[4];
#pragma unroll
                for (int kq = 0; kq < 4; ++kq) {
                    const int kt = 4 * hf + kq;
                    if (kt < nkt) {
#pragma unroll
                        for (int r = 0; r < 16; ++r) s[kq][r] = 0.f;
#pragma unroll
                        for (int ks = 0; ks < 8; ++ks) {
                            const bf16x8 a = *(const LAS bf16x8*)(Ks + (kt * 32 + l32) * 272 + ks * 32 + 16 * h);
                            s[kq] = __builtin_amdgcn_mfma_f32_32x32x16_bf16(a, qf[ks], s[kq], 0, 0, 0);
                            asm volatile("" :: "v"(a));
                        }
                        if (is_own) {
#pragma unroll
                            for (int r = 0; r < 16; ++r) { const int key = kt * 32 + (r & 3) + 8 * (r >> 2) + 4 * h; if (key > posb) s[kq][r] = -1e30f; }
                        }
                    } else {
#pragma unroll
                        for (int r = 0; r < 16; ++r) s[kq][r] = -1e30f;
                    }
                    __builtin_amdgcn_sched_barrier(0);
                }
                float mx = -1e30f;
#pragma unroll
                for (int kq = 0; kq < 4; ++kq)
#pragma unroll
                    for (int r = 0; r < 16; ++r) mx = fmaxf(mx, s[kq][r]);
                mx = fmaxf(mx, __shfl_xor(mx, 32));
                const float m_new = fmaxf(m_run, mx), mL = m_new * LOG2E;
                const float alpha = __builtin_amdgcn_exp2f((m_run - m_new) * LOG2E);
                float lsum = 0.f;
#pragma unroll
                for (int kq = 0; kq < 4; ++kq)
#pragma unroll
                    for (int r = 0; r < 16; ++r) { const float p = __builtin_amdgcn_exp2f(s[kq][r] * LOG2E - mL); s[kq][r] = p; lsum += p; }
                lsum += __shfl_xor(lsum, 32);
                l_run = l_run * alpha + lsum; m_run = m_new;
                if (hf == 1) {
#pragma unroll
                    for (int db = 0; db < 4; ++db)
#pragma unroll
                        for (int r = 0; r < 16; ++r) o[db][r] *= alpha;
                }
#pragma unroll
                for (int kq = 0; kq < 4; ++kq) {
                    const int kt = 4 * hf + kq;
                    if (kt < nkt) {
#pragma unroll
                        for (int st = 0; st < 2; ++st) {
                            u32x4 pw;
                            pw.x = pk_bf16(s[kq][8 * st + 0], s[kq][8 * st + 1]); pw.y = pk_bf16(s[kq][8 * st + 2], s[kq][8 * st + 3]);
                            pw.z = pk_bf16(s[kq][8 * st + 4], s[kq][8 * st + 5]); pw.w = pk_bf16(s[kq][8 * st + 6], s[kq][8 * st + 7]);
                            const bf16x8 pf = __builtin_bit_cast(bf16x8, pw);
#pragma unroll
                            for (int db = 0; db < 4; ++db) {
                                const LAS unsigned char* va = Vs + (32 * db + l32) * 520 + (kt * 32 + 16 * st + 4 * h) * 2;
                                const u32x2 vlo = *(const LAS u32x2*)va, vhi = *(const LAS u32x2*)(va + 16);
                                const u32x4 vw = {vlo.x, vlo.y, vhi.x, vhi.y};
                                o[db] = __builtin_amdgcn_mfma_f32_32x32x16_bf16(__builtin_bit_cast(bf16x8, vw), pf, o[db], 0, 0, 0);
                            }
                            __builtin_amdgcn_sched_barrier(0);
                        }
                    }
                }
            }
            asm volatile("" : "+v"(ent));
            if constexpr (!OWN) {
                if (valid) {
                    const float inv = 1.f / l_run;
                    const int slot = ent & 3; const int row = ent >> 2;
                    if (h == 0) *(f32x2*)(P.part_ml + (size_t)ent * 2) = (f32x2){m_run, l_run};
                    int h2 = h; asm volatile("" : "+v"(h2));
                    bf16_t* pb = P.part[1];
                    if (slot == 2) pb = P.part[2]; else if (slot == 3) pb = P.part[3];
                    bf16_t* po = pb + ((size_t)row * 128 + 4 * h2);
#pragma unroll
                    for (int db = 0; db < 4; ++db)
#pragma unroll
                        for (int rq = 0; rq < 4; ++rq) {
                            u32x2 w; w.x = pk_bf16(o[db][4 * rq] * inv, o[db][4 * rq + 1] * inv); w.y = pk_bf16(o[db][4 * rq + 2] * inv, o[db][4 * rq + 3] * inv);
                            *(u32x2*)(po + 32 * db + 8 * rq) = w;
                        }
                }
            } else {
                const int row = ent >> 2, nsel = n < 3 ? n : 3;
                int h2 = h; asm volatile("" : "+v"(h2));
                float M = m_run; f32x2 ml[3];
#pragma unroll
                for (int s2 = 0; s2 < 3; ++s2) { ml[s2] = (f32x2){-1e30f, 0.f}; if (s2 < nsel) { ml[s2] = *(const f32x2*)(P.part_ml + ((size_t)row * 4 + s2 + 1) * 2); M = fmaxf(M, ml[s2].x); } }
                const float w0 = __builtin_amdgcn_exp2f((m_run - M) * LOG2E);
                float ws[3], L = l_run * w0;
#pragma unroll
                for (int s2 = 0; s2 < 3; ++s2) { ws[s2] = ml[s2].y * __builtin_amdgcn_exp2f((ml[s2].x - M) * LOG2E); L += ws[s2]; }
                const float inv = 1.f / L, w0i = w0 * inv;
                const size_t poff = (size_t)row * 128 + 4 * h2;
                bf16_t* ao = P.attn + (size_t)(row >> 3) * DM + (row & 7) * 128 + 4 * h2;
#pragma unroll
                for (int db = 0; db < 4; ++db) {
                    u32x2 pv[3][4];
#pragma unroll
                    for (int s2 = 0; s2 < 3; ++s2)
#pragma unroll
                        for (int rq = 0; rq < 4; ++rq) { pv[s2][rq] = (u32x2){0u, 0u}; if (s2 < nsel) pv[s2][rq] = *(const u32x2*)(P.part[s2 + 1] + poff + 32 * db + 8 * rq); }
#pragma unroll
                    for (int rq = 0; rq < 4; ++rq) {
                        float a0 = o[db][4 * rq] * w0i, a1 = o[db][4 * rq + 1] * w0i, a2 = o[db][4 * rq + 2] * w0i, a3 = o[db][4 * rq + 3] * w0i;
#pragma unroll
                        for (int s2 = 0; s2 < 3; ++s2) { const float wv = ws[s2] * inv; a0 += wv * bf_lo(pv[s2][rq].x); a1 += wv * bf_hi(pv[s2][rq].x); a2 += wv * bf_lo(pv[s2][rq].y); a3 += wv * bf_hi(pv[s2][rq].y); }
                        u32x2 w; w.x = pk_bf16(a0, a1); w.y = pk_bf16(a2, a3);
                        *(u32x2*)(ao + 32 * db + 8 * rq) = w;
                    }
                }
            }
        }
        __builtin_amdgcn_s_setprio(0);
        __syncthreads();
    }
}

DI void phase_combine(const Params& P) {
    const int tid = threadIdx.x, wave = tid >> 6, lane = tid & 63;
    const int gw = blockIdx.x * 8 + wave, NGW = gridDim.x * 8;
    for (int row = gw; row < T_TOK * 8; row += NGW) {
        const int t = row >> 3, hq = row & 7, own = (t & (SEQ - 1)) >> 8, nsel = own < 3 ? own : 3;
        float m[4], l[4];
#pragma unroll
        for (int s = 0; s < 4; ++s) { if (s <= nsel) { const f32x2 ml = *(const f32x2*)(P.part_ml + ((size_t)row * 4 + s) * 2); m[s] = ml.x; l[s] = ml.y; } else { m[s] = -1e30f; l[s] = 0.f; } }
        const float M = fmaxf(fmaxf(m[0], m[1]), fmaxf(m[2], m[3]));
        float o0 = 0.f, o1 = 0.f, L = 0.f;
#pragma unroll
        for (int s = 0; s < 4; ++s) {
            if (s <= nsel) {
                const float w = l[s] * __expf(m[s] - M); L += w;
                const unsigned v = *(const unsigned*)(P.part[s] + (size_t)row * 128 + 2 * lane);
                o0 += w * bf_lo(v); o1 += w * bf_hi(v);
            }
        }
        const float inv = 1.f / L;
        *(unsigned*)(P.attn + (size_t)t * DM + hq * 128 + 2 * lane) = cvt_pk_bf16(o0 * inv, o1 * inv);
    }
}

DI void phase_final(const Params& P) {
    const int tid = threadIdx.x, wave = tid >> 6, lane = tid & 63;
    const int gw = blockIdx.x * 8 + wave, NGW = gridDim.x * 8;
    for (int row = gw; row < T_TOK; row += NGW) {
        const float rs = rsqrtf(P.rowss[6 * T_TOK + row] * (1.f / DM) + RMS_EPS);
        const f32x4* xr = (const f32x4*)(P.xres + (size_t)row * DM) + lane;
        const f32x4* gr = (const f32x4*)P.final_g + lane;
        f32x4* o = (f32x4*)(P.out + (size_t)row * DM) + lane;
#pragma unroll
        for (int j = 0; j < 4; ++j) o[64 * j] = xr[64 * j] * rs * gr[64 * j];
    }
}

DI void phase_final_fused(const Params& P, LAS unsigned char* lds, int vbid) {
    pg8::StaticOrder S; S.init(T_TOK, DM, gridDim.x, vbid);
    pg8::Unit u;
    if (!S.next(0, u)) return;
    const int tid = threadIdx.x, wave = tid >> 6, lane = tid & 63;
    asm volatile("s_waitcnt vmcnt(0)" ::: "memory");
    __syncthreads();
    LAS int* flag = (LAS int*)lds;
    if (tid == 0) flag[0] = atomicAdd(P.pcnt + u.pm, 1);
    __syncthreads();
    if (flag[0] != 3) return;
    __builtin_amdgcn_fence(__ATOMIC_ACQUIRE, "agent");
    asm volatile("s_waitcnt vmcnt(0)" ::: "memory");
    const f32x4* gr = (const f32x4*)P.final_g + lane;
    const f32x4 g0 = gr[0], g1 = gr[64], g2 = gr[128], g3 = gr[192];
#pragma unroll 1
    for (int r0 = wave * 32; r0 < wave * 32 + 32; r0 += 4) {
        f32x4 v[4][4]; float ss[4];
#pragma unroll
        for (int i = 0; i < 4; ++i) {
            const int row = u.pm * 256 + r0 + i;
            const f32x4* xr = (const f32x4*)(P.xres + (size_t)row * DM) + lane;
            ss[i] = P.rowss[6 * T_TOK + row];
            v[i][0] = xr[0]; v[i][1] = xr[64]; v[i][2] = xr[128]; v[i][3] = xr[192];
        }
#pragma unroll
        for (int i = 0; i < 4; ++i) {
            const int row = u.pm * 256 + r0 + i;
            const float rs = rsqrtf(ss[i] * (1.f / DM) + RMS_EPS);
            f32x4* o = (f32x4*)(P.out + (size_t)row * DM) + lane;
            o[0] = v[i][0] * rs * g0; o[64] = v[i][1] * rs * g1; o[128] = v[i][2] * rs * g2; o[192] = v[i][3] * rs * g3;
        }
    }
}

#define XB_TMO      128
#define XB_XCNT(j)  (256  + 64 * (j))
#define XB_XSUB(j)  (1280 + 64 * (j))
#define XB_XGEN(j)  (2304 + 64 * (j))
#define XB_TOP      3328
#define XB_TOPGEN   3392
#define XCD_BAR_WORDS 3456
#define XB_SPIN_CAP (1u << 18)
DI unsigned xb_ld(unsigned* p)              { return __hip_atomic_load(p, __ATOMIC_RELAXED, __HIP_MEMORY_SCOPE_AGENT); }
DI unsigned xb_add(unsigned* p, unsigned v) { return __hip_atomic_fetch_add(p, v, __ATOMIC_RELAXED, __HIP_MEMORY_SCOPE_AGENT); }
DI unsigned xb_xcc_id() { return (unsigned)__builtin_amdgcn_s_getreg((3 << 11) | 20) & 0xFu; }
#define XB_SPIN(cond, bar) do { unsigned _sp = 0; while (cond) { __builtin_amdgcn_s_sleep(1); \
    if ((++_sp & 255u) == 0u) { if (xb_ld(&(bar)[XB_TMO])) break; if (_sp > XB_SPIN_CAP) { atomicAdd(&(bar)[XB_TMO], 1u); break; } } } } while (0)
struct XcdBarrier { unsigned* bar; unsigned x; volatile LAS unsigned* st; };
DI XcdBarrier xcd_barrier_post(unsigned* bar, volatile LAS unsigned* st) {
    XcdBarrier b; b.bar = bar; b.x = xb_xcc_id(); b.st = st;
    if (threadIdx.x == 0) (void)xb_add(&bar[XB_XCNT(b.x)], 1u);
    return b;
}
DI void xcd_barrier_complete(unsigned* bar, unsigned x, unsigned& nloc, unsigned& nx) {
    const unsigned G = gridDim.x * gridDim.y * gridDim.z;
    unsigned sum, cnt, mine, sp = 0u;
    for (;;) {
        sum = 0u; cnt = 0u; mine = 0u;
#pragma unroll
        for (unsigned j = 0; j < 16; ++j) { const unsigned c = xb_ld(&bar[XB_XCNT(j)]); sum += c; cnt += (c > 0u) ? 1u : 0u; mine = (j == x) ? c : mine; }
        if (sum == G) break;
        __builtin_amdgcn_s_sleep(1);
        if ((++sp & 255u) == 0u) { if (xb_ld(&bar[XB_TMO])) break; if (sp > XB_SPIN_CAP) { atomicAdd(&bar[XB_TMO], 1u); break; } }
    }
    nloc = mine > 0u ? mine : 1u; nx = cnt > 0u ? cnt : 1u;
}
DI void xcd_barrier(const XcdBarrier& b) {
    asm volatile("s_waitcnt vmcnt(0)" ::: "memory");
    __syncthreads();
    if (threadIdx.x == 0) {
        unsigned* bar = b.bar;
        __builtin_amdgcn_s_waitcnt(0);
        unsigned nloc = b.st[0], nx = b.st[1];
        if (nloc == 0u) { xcd_barrier_complete(bar, b.x, nloc, nx); b.st[0] = nloc; b.st[1] = nx; }
        const unsigned old = xb_add(&bar[XB_XSUB(b.x)], 1u);
        const unsigned gen = old / nloc;
        if (old + 1u == (gen + 1u) * nloc) {
            __builtin_amdgcn_fence(__ATOMIC_RELEASE, "agent");
            asm volatile("s_waitcnt vmcnt(0)" ::: "memory");
            const unsigned og = xb_add(&bar[XB_TOP], 1u);
            const unsigned tg = og / nx;
            if (og + 1u == (tg + 1u) * nx) xb_add(&bar[XB_TOPGEN], 1u);
            else XB_SPIN(xb_ld(&bar[XB_TOPGEN]) == tg, bar);
            __builtin_amdgcn_fence(__ATOMIC_ACQUIRE, "agent");
            xb_add(&bar[XB_XGEN(b.x)], 1u);
            asm volatile("s_waitcnt vmcnt(0)" ::: "memory");
        } else {
            XB_SPIN(xb_ld(&bar[XB_XGEN(b.x)]) == gen, bar);
            __builtin_amdgcn_fence(__ATOMIC_ACQUIRE, "agent");
            asm volatile("s_waitcnt vmcnt(0)" ::: "memory");
        }
    }
    __syncthreads();
}

constexpr int NPHASES = 18;
#ifndef PHMASK
#define PHMASK 0xFFFFF
#endif
#define PHON(n) if constexpr (((PHMASK) >> (n)) & 1)
#ifndef DUPSEL
#define DUPSEL 0
#endif
__global__ void __launch_bounds__(512, 2) mega_fwd(const Params P) {
    extern __shared__ __attribute__((aligned(16))) unsigned char smem[];
    LAS unsigned char* lds = (LAS unsigned char*)smem;
    cg::grid_group grid = cg::this_grid();
    if (P.ph_hi < 0) grid.sync();
    volatile LAS unsigned* xst = (volatile LAS unsigned*)(lds + 139264);
    if (threadIdx.x == 0) { xst[0] = 0u; xst[1] = 0u; xst[2] = 0u; xst[3] = 0u; xst[4] = 0u; }
    __syncthreads();
    XcdBarrier xb; xb.bar = P.bar; xb.x = xb_xcc_id(); xb.st = xst;
    if (threadIdx.x == 0) xst[2] = xb_add(&P.bar[XB_XCNT(xb.x)], 1u);
    PHON(0) if (P.ph_lo <= 0 && 0 < P.ph_hi) { phase_prep(P, lds); }
    if constexpr (DUPSEL == 4) { xcd_barrier(xb); phase_prep(P, lds); }
    if (P.ph_lo < 1 && 1 < P.ph_hi) xcd_barrier(xb);
    if (threadIdx.x == 0) {
        bool ok = (gridDim.x % 8u) == 0u;
        for (unsigned j = 0; j < 16; ++j) { const unsigned c = xb_ld(&P.bar[XB_XCNT(j)]); ok = ok && (c == (j < 8 ? gridDim.x / 8u : 0u)); }
        xst[3] = ok ? (xb.x + 8u * xst[2]) : blockIdx.x; xst[4] = ok ? 1u : 0u;
    }
    __syncthreads();
    const int vbid = (int)xst[3];
    const bool vb_ok = xst[4] != 0u;
    const int abid = vb_ok ? ((vbid & 7) * (int)(gridDim.x >> 3) + (vbid >> 3)) : (int)blockIdx.x;
    preload_rs(lds, vbid, P.rowss + 0 * T_TOK, 5632); run_gemm_v(lds, vbid, P.xb, P.wt_up[0], 5632, DM, EpiAct{P.act, P.rowss + 0 * T_TOK, P.kbuf, P.vT, P.rope, (const LAS float*)(lds + 131072)});
    convert_by_light_blocks(P, lds, vbid, 64 * 22, P.it1, P.it2);
    if constexpr (DUPSEL == 2) { xcd_barrier(xb); preload_rs(lds, vbid, P.rowss + 0 * T_TOK, 5632); run_gemm_v(lds, vbid, P.xb, P.wt_up[0], 5632, DM, EpiAct{P.act, P.rowss + 0 * T_TOK, P.kbuf, P.vT, P.rope, (const LAS float*)(lds + 131072)}); }
    if (P.ph_lo < 2 && 2 < P.ph_hi) xcd_barrier(xb);
    PHON(2) if (P.ph_lo <= 2 && 2 < P.ph_hi) { run_gemm_v(lds, vbid, P.act, P.wt_dn[0], DM, FF, EpiRes{P.x, P.xres, P.xb, P.rowss + 1 * T_TOK}); }
    if (P.ph_lo < 3 && 3 < P.ph_hi) xcd_barrier(xb);
    PHON(3) if (P.ph_lo <= 3 && 3 < P.ph_hi) { phase_s5a(P, lds); }
    xcd_barrier(xb);
    phase_s5carry(P);
    if (P.ph_lo < 4 && 4 < P.ph_hi) xcd_barrier(xb);
    PHON(4) if (P.ph_lo <= 4 && 4 < P.ph_hi) { phase_s5b(P, lds); }
    if constexpr (DUPSEL == 3) { xcd_barrier(xb); phase_s5a(P, lds); xcd_barrier(xb); phase_s5carry(P); xcd_barrier(xb); phase_s5b(P, lds); }

    if (P.ph_lo < 5 && 5 < P.ph_hi) xcd_barrier(xb);
    PHON(5) if (P.ph_lo <= 5 && 5 < P.ph_hi) { run_gemm_v(lds, vbid, P.yb, P.wt_glu, 2048, DM, EpiGlu{P.xres, P.xb, P.rowss + 2 * T_TOK}); }
    if (P.ph_lo < 6 && 6 < P.ph_hi) xcd_barrier(xb);
    PHON(6) if (P.ph_lo <= 6 && 6 < P.ph_hi) { preload_rs(lds, vbid, P.rowss + 2 * T_TOK, 5632); run_gemm_v(lds, vbid, P.xb, P.wt_up[1], 5632, DM, EpiAct{P.act, P.rowss + 2 * T_TOK, P.kbuf, P.vT, P.rope, (const LAS float*)(lds + 131072)}); convert_by_light_blocks(P, lds, vbid, 64 * 22, P.it2, P.nitems); }
    if (P.ph_lo < 7 && 7 < P.ph_hi) xcd_barrier(xb);
    PHON(7) if (P.ph_lo <= 7 && 7 < P.ph_hi) { run_gemm_v(lds, vbid, P.act, P.wt_dn[1], DM, FF, EpiRes{P.xres, P.xres, P.xb, P.rowss + 3 * T_TOK}); }
    if (P.ph_lo < 8 && 8 < P.ph_hi) xcd_barrier(xb);
    PHON(8) if (P.ph_lo <= 8 && 8 < P.ph_hi) { preload_rs(lds, vbid, P.rowss + 3 * T_TOK, 6144); run_gemm_v(lds, vbid, P.xb, P.wt_up[2], 6144, DM, EpiAct{P.act, P.rowss + 3 * T_TOK, P.kbuf, P.vT, P.rope, (const LAS float*)(lds + 131072)}); }
    if (P.ph_lo < 9 && 9 < P.ph_hi) xcd_barrier(xb);
    PHON(9) if (P.ph_lo <= 9 && 9 < P.ph_hi) { run_gemm_v(lds, vbid, P.act, P.wt_dn[2], DM, FF, EpiRes{P.xres, P.xres, P.xb, P.rowss + 4 * T_TOK}); phase_kmean(P, lds); }
    if (P.ph_lo < 10 && 10 < P.ph_hi) xcd_barrier(xb);
    PHON(10) if (P.ph_lo <= 10 && 10 < P.ph_hi) { run_gemm_v(lds, vbid, P.xb, P.wt_q, DM, DM, EpiQ{P.qbuf, P.rowss + 4 * T_TOK, P.rope}); }
    if (P.ph_lo < 11 && 11 < P.ph_hi) xcd_barrier(xb);
    PHON(11) if (P.ph_lo <= 11 && 11 < P.ph_hi) { phase_gate(P, lds); }
    if (P.ph_lo < 12 && 12 < P.ph_hi) xcd_barrier(xb);
    PHON(12) if (P.ph_lo <= 12 && 12 < P.ph_hi) { phase_attn<false>(P, lds, abid); }
    if constexpr (DUPSEL == 6) { xcd_barrier(xb); phase_attn<false>(P, lds, abid); }
    if (P.ph_lo < 13 && 13 < P.ph_hi) xcd_barrier(xb);
    PHON(13) if (P.ph_lo <= 13 && 13 < P.ph_hi) { phase_attn<true>(P, lds, abid); }
    if constexpr (DUPSEL == 1) { for (int i = 0; i < 8; ++i) xcd_barrier(xb); }
    if (P.ph_lo < 14 && 14 < P.ph_hi) xcd_barrier(xb);
    PHON(14) if (P.ph_lo <= 14 && 14 < P.ph_hi) { run_gemm_v(lds, vbid, P.attn, P.wt_o, DM, DM, EpiRes{P.xres, P.xres, P.xb, P.rowss + 5 * T_TOK}); }
    if (P.ph_lo < 15 && 15 < P.ph_hi) xcd_barrier(xb);
    PHON(15) if (P.ph_lo <= 15 && 15 < P.ph_hi) { preload_rs(lds, vbid, P.rowss + 5 * T_TOK, 5632); run_gemm_v(lds, vbid, P.xb, P.wt_up[3], 5632, DM, EpiAct{P.act, P.rowss + 5 * T_TOK, P.kbuf, P.vT, P.rope, (const LAS float*)(lds + 131072)}); }
    if (P.ph_lo < 16 && 16 < P.ph_hi) xcd_barrier(xb);
    PHON(16) if (P.ph_lo <= 16 && 16 < P.ph_hi) { run_gemm_v(lds, vbid, P.act, P.wt_dn[3], DM, FF, EpiRes{P.xres, P.xres, P.xb, P.rowss + 6 * T_TOK}); }
    if (vb_ok && gridDim.x == 256u) { phase_final_fused(P, lds, vbid); }
    else { xcd_barrier(xb); phase_final(P); }
}

extern "C" void kernel_launch(void* const* d_in, const int* in_sizes, int n_in, void* d_out, int out_size, void* d_ws, size_t ws_size, hipStream_t stream) {
    static int grid_blocks = 0;
    if (!grid_blocks) {
        int dev = 0, cus = 0, per_cu = 0;
        hipGetDevice(&dev);
        hipDeviceGetAttribute(&cus, hipDeviceAttributeMultiprocessorCount, dev);
        hipFuncSetAttribute((const void*)mega_fwd, hipFuncAttributeMaxDynamicSharedMemorySize, LDS_BYTES);
        hipOccupancyMaxActiveBlocksPerMultiprocessor(&per_cu, (const void*)mega_fwd, 512, LDS_BYTES);
        if (per_cu < 1) per_cu = 1;
        if (per_cu > 1) per_cu = 1;
        grid_blocks = cus * per_cu;
    }
    Params p{};
    const float** in = (const float**)&p.x;
    for (int i = 0; i < 19; ++i) in[i] = (const float*)d_in[i];
    p.out = (float*)d_out;
    unsigned char* ws = (unsigned char*)d_ws; size_t off = 0;
    auto take = [&](size_t bytes) { unsigned char* r = ws + off; off += (bytes + 255) & ~(size_t)255; return r; };
    p.xres = (float*)take((size_t)T_TOK * DM * 4);
    p.xb = (bf16_t*)take((size_t)T_TOK * DM * 2);
    p.act = (bf16_t*)take((size_t)T_TOK * FF * 2);
    p.qbuf = p.act;
    p.attn = p.act + (size_t)T_TOK * DM;
    p.part_ml = (float*)(p.act + (size_t)2 * T_TOK * DM);
    p.kbuf = (bf16_t*)take((size_t)T_TOK * 256 * 2);
    p.vT = (bf16_t*)take((size_t)T_TOK * 256 * 2);
    p.kmean = (float*)take(128 * 128 * 4);
    p.rowss = (float*)take((size_t)7 * T_TOK * 4 + 1024);
    p.gcount = (int*)(p.rowss + 7 * T_TOK);
    p.E = (float*)take((size_t)2 * 128 * 64 * 64 * 2 * 4);
    p.lists = (int*)p.E;
    p.rope = (float*)take((size_t)SEQ * 16 * 2 * 4);
    p.bar = (unsigned*)take((size_t)XCD_BAR_WORDS * 4);
    p.s5tab = (float*)take(4096 * 4 * 4);
    p.pcnt = (int*)take(256);
    p.wt_up[0] = (bf16_t*)take((size_t)6144 * DM * 2); p.wt_up[1] = (bf16_t*)take((size_t)6144 * DM * 2);
    p.wt_dn[0] = (bf16_t*)take((size_t)DM * FF * 2); p.wt_dn[1] = (bf16_t*)take((size_t)DM * FF * 2);
    p.wt_glu = (bf16_t*)take((size_t)2048 * DM * 2);
    p.wt_up[2] = (bf16_t*)take((size_t)6144 * DM * 2); p.wt_up[3] = (bf16_t*)take((size_t)6144 * DM * 2);
    p.wt_dn[2] = (bf16_t*)take((size_t)DM * FF * 2); p.wt_dn[3] = (bf16_t*)take((size_t)DM * FF * 2);
    p.wt_q = (bf16_t*)take((size_t)DM * DM * 2);
    p.wt_o = (bf16_t*)take((size_t)DM * DM * 2);
    p.part[0] = p.xb;
    p.part[1] = (bf16_t*)take((size_t)T_TOK * DM * 2);
    p.part[2] = (bf16_t*)take((size_t)T_TOK * DM * 2);
    p.part[3] = p.wt_up[0];
    p.yb = p.part[1];
    int nj = 0, items = 0;
    auto job = [&](const float* W, const float* g, bf16_t* dst, int K, int Nsrc, int ndst, int mode, float scale = 1.f) {
        WJob& J = p.jobs[nj++]; J.W = W; J.g = g; J.dst = dst; J.K = K; J.Nsrc = Nsrc; J.ndst = ndst; J.mode = mode; J.item0 = items; J.scale = scale;
        items += (K / 64) * (ndst / 32);
    };
    auto job_up = [&](int l, int f) { job(p.ffn_w_in + (size_t)(l * 2 + f) * DM * 2 * FF, p.norm_g + (size_t)(l * 3 + (f ? 2 : 0)) * DM, p.wt_up[l * 2 + f], DM, 2 * FF, 2 * FF, 1); };
    auto job_dn = [&](int l, int f) { job(p.ffn_w_out + (size_t)(l * 2 + f) * FF * DM, nullptr, p.wt_dn[l * 2 + f], FF, DM, DM, 0, 0.5f); };
    job_up(0, 0);
    p.it1 = items;
    job_dn(0, 0); job(p.w_glu, nullptr, p.wt_glu, DM, 2048, 2048, 1); job_up(0, 1); job_dn(0, 1);
    p.it2 = items;
    job_up(1, 0);
    job(p.w_k, p.kv_norm_g, p.wt_up[2] + (size_t)5632 * DM, DM, 256, 256, 0);
    job(p.w_v, p.kv_norm_g, p.wt_up[2] + (size_t)5888 * DM, DM, 256, 256, 0);
    job_dn(1, 0); job_up(1, 1); job_dn(1, 1);
    job(p.w_q, p.norm_g + (size_t)4 * DM, p.wt_q, DM, DM, DM, 0);
    job(p.w_o, nullptr, p.wt_o, DM, DM, DM, 0);
    p.nitems = items; p.ph_lo = 0; p.ph_hi = NPHASES; p.pad = 0;
    if (off > ws_size) { fprintf(stderr, "workspace too small: need %zu have %zu\n", off, ws_size); return; }
    (void)hipMemsetAsync(p.bar, 0, (size_t)XCD_BAR_WORDS * 4, stream);
    void* args[] = {&p};
    hipError_t e = hipLaunchCooperativeKernel((const void*)mega_fwd, dim3(grid_blocks), dim3(512), args, LDS_BYTES, stream);
    if (e != hipSuccess) fprintf(stderr, "cooperative launch failed: %s (grid %d)\n", hipGetErrorString(e), grid_blocks);
}
```
